# Optimizing an MI355X kernel written in HIP

```python
import math
import jax
import jax.numpy as jnp
from jax import lax
import numpy as np

D_MODEL = 1024
BATCH = 8
SEQ = 4096
DEPTH = 2

GRID_W = 64
CTX_LEN = 256
EPS = 1e-6
F32 = jnp.float32

D_MIX = D_MODEL
N_MIXERS = 4
D_GROUP = D_MIX // N_MIXERS

HY_ORDER = 2
HY_HEADS = 4
HY_SHORT = 3
HY_EMB = 33
HY_BANDS = (HY_EMB - 1) // 2
HY_FFN = 64
HY_TARGET = 1e-2
HY_FAST_PCT = 0.3
HY_SLOW_PCT = 1.5

GM_CHUNK = 128
GM_HEADS = 4

CV_WIDTH = 31
CV_GROUPS = 4

MLA_HEADS = 4
MLA_NOPE = 64
MLA_ROPE = 32
MLA_V = 64
MLA_Q_RANK = 192
MLA_KV_RANK = 128
ROPE_BASE = 10000.0
ATTN_BLOCK = 128

N_EXPERTS = 16
N_EXPERT_GROUPS = 4
EXPERTS_PER_GROUP = N_EXPERTS // N_EXPERT_GROUPS
TOP_K = 2
GROUP_SCORE_TOPK = 2
D_EXPERT = 512

HY_COLS = (HY_ORDER + 1) * D_GROUP
GM_COLS = 2 * D_GROUP
CV_COLS = 2 * D_GROUP
MQ_COLS = MLA_Q_RANK
MKV_COLS = MLA_KV_RANK + MLA_ROPE
HY_OFF = 0
GM_OFF = HY_OFF + HY_COLS
CV_OFF = GM_OFF + GM_COLS
MQ_OFF = CV_OFF + CV_COLS
MKV_OFF = MQ_OFF + MQ_COLS
IN_COLS = MKV_OFF + MKV_COLS

kernel_name = "hybrid_hymba_flow_block"


def rms_norm(x, g):
    x32 = x.astype(F32)
    y = x32 * lax.rsqrt(jnp.mean(x32 * x32, axis=-1, keepdims=True) + EPS)
    return (y * g.astype(F32)).astype(x.dtype)


def layer_norm(x, g, b):
    x32 = x.astype(F32)
    mu = jnp.mean(x32, axis=-1, keepdims=True)
    var = jnp.mean(jnp.square(x32 - mu), axis=-1, keepdims=True)
    return ((x32 - mu) * lax.rsqrt(var + EPS) * g.astype(F32) + b.astype(F32)).astype(x.dtype)


def depthwise_conv(x, w, b):
    pad = (w.shape[0] - 1) // 2
    y = lax.conv_general_dilated(x, w[:, None, :].astype(x.dtype), window_strides=(1,),
                                 padding=[(pad, pad)], dimension_numbers=('NWC', 'WIO', 'NWC'),
                                 feature_group_count=x.shape[-1])
    return y + b.astype(x.dtype)


def modulation(cond, w, b):
    m = jax.nn.silu(cond) @ w + b
    return jnp.split(jnp.expand_dims(m, -2), 6, axis=-1)


def axial_rope_tables(n_lat):
    rows = n_lat // GRID_W
    row = jnp.repeat(jnp.arange(rows), GRID_W).astype(F32)
    col = jnp.tile(jnp.arange(GRID_W), rows).astype(F32)
    n_freq = MLA_ROPE // 4
    inv = ROPE_BASE ** (-jnp.arange(n_freq, dtype=F32) / n_freq)
    ang = jnp.concatenate([row[:, None] * inv, col[:, None] * inv], axis=-1)
    return jnp.cos(ang), jnp.sin(ang)


def apply_rope(x, cos, sin):
    x32 = x.astype(F32)
    x1, x2 = jnp.split(x32, 2, axis=-1)
    return jnp.concatenate([x1 * cos - x2 * sin, x1 * sin + x2 * cos], axis=-1).astype(x.dtype)


def hyena_filter_spectra(L, w1, b1, freq, w2, b2, w3):
    w1, b1, freq, w2, b2, w3 = (a.astype(F32) for a in (w1, b1, freq, w2, b2, w3))
    t = jnp.linspace(0.0, 1.0, L, dtype=F32)[:, None]
    w = 2.0 * math.pi * jnp.arange(L, dtype=F32)[:, None] / L
    f = jnp.linspace(1e-4, HY_BANDS - 1, HY_BANDS, dtype=F32)[None, :]
    z = jnp.concatenate([t, jnp.cos(f * w), -jnp.sin(f * w)], axis=-1)
    h = jnp.sin(freq * (z @ w1 + b1))
    h = jnp.sin(freq * (h @ w2 + b2))
    h = (h @ w3).reshape(L, HY_ORDER, 2, D_GROUP)
    deltas = jnp.abs(jnp.linspace(math.log(HY_TARGET) / HY_SLOW_PCT,
                                  math.log(HY_TARGET) / HY_FAST_PCT, D_GROUP, dtype=F32))
    h = h * jnp.exp(-t * deltas)[:, None, None, :]
    kf, kb = h[:, :, 0], h[:, :, 1]
    k2 = jnp.concatenate([kf, jnp.zeros_like(kf[:1]), kb[1:][::-1]], axis=0)
    k2 = k2 / jnp.sum(jnp.abs(k2), axis=0, keepdims=True)
    return jnp.fft.rfft(k2, n=2 * L, axis=0)


def long_conv(u, k_spec, bias):
    L = u.shape[1]
    u32 = u.astype(F32)
    y = jnp.fft.irfft(jnp.fft.rfft(u32, n=2 * L, axis=1) * k_spec[None], n=2 * L, axis=1)[:, :L]
    return (y + u32 * bias.astype(F32)).astype(u.dtype)


def hyena_mixer(p_hy, short_w, short_b, spectra, hy_bias):
    z = depthwise_conv(p_hy, short_w, short_b)
    x1, x2, v = jnp.split(z, HY_ORDER + 1, axis=-1)
    y = v
    for n, gate in enumerate((x1, x2)):
        y = gate * long_conv(y, spectra[:, n], hy_bias[n])
    return y


def gmlp_mixer(p_gm, ln_g, ln_b, ws, bs):
    B, L, _ = p_gm.shape
    z = jax.nn.gelu(p_gm)
    u, v = jnp.split(z, 2, axis=-1)
    v = layer_norm(v, ln_g, ln_b).reshape(B, L // GM_CHUNK, GM_CHUNK, GM_HEADS, D_GROUP // GM_HEADS)
    s = jnp.einsum('gij,bcjgd->bcigd', ws.astype(v.dtype), v) + bs.T.astype(v.dtype)[None, None, :, :, None]
    return u * s.reshape(B, L, D_GROUP)


def conv_mixer(p_cv, dw_w, dw_b, ln_g, ln_b):
    a, b = jnp.split(p_cv, 2, axis=-1)
    g = depthwise_conv(a * jax.nn.sigmoid(b), dw_w, dw_b)
    B, L, _ = g.shape
    g = layer_norm(g.reshape(B, L, CV_GROUPS, D_GROUP // CV_GROUPS),
                   ln_g.reshape(CV_GROUPS, -1), ln_b.reshape(CV_GROUPS, -1)).reshape(B, L, D_GROUP)
    return jax.nn.silu(g)


def mla_queries(cq, qa_norm, w_uq, rope):
    B, L, _ = cq.shape
    q = (rms_norm(cq, qa_norm) @ w_uq).reshape(B, L, MLA_HEADS, MLA_NOPE + MLA_ROPE)
    if rope is not None:
        cos, sin = rope
        q = jnp.concatenate([q[..., :MLA_NOPE],
                             apply_rope(q[..., MLA_NOPE:], cos[None, :, None], sin[None, :, None])], axis=-1)
    return q


def mla_keys_values(ckv, kva_norm, w_ukv, rope):
    B, L, _ = ckv.shape
    c_kv, k_rope = ckv[..., :MLA_KV_RANK], ckv[..., MLA_KV_RANK:]
    kv = (rms_norm(c_kv, kva_norm) @ w_ukv).reshape(B, L, MLA_HEADS, MLA_NOPE + MLA_V)
    k_nope, v = kv[..., :MLA_NOPE], kv[..., MLA_NOPE:]
    if rope is not None:
        cos, sin = rope
        k_rope = apply_rope(k_rope, cos[None], sin[None])
    k = jnp.concatenate([k_nope, jnp.broadcast_to(k_rope[:, :, None, :], (B, L, MLA_HEADS, MLA_ROPE))], axis=-1)
    return k, v


def block_attention(q, k, v):
    B, Lq, H, Dk = q.shape
    nb = Lq // ATTN_BLOCK
    qb = q.reshape(B, nb, ATTN_BLOCK, H, Dk).transpose(1, 0, 2, 3, 4)
    scale = 1.0 / math.sqrt(Dk)

    def attend(qblk):
        s = jnp.einsum('bqhd,bkhd->bhqk', qblk, k).astype(F32) * scale
        p = jax.nn.softmax(s, axis=-1).astype(v.dtype)
        return jnp.einsum('bhqk,bkhd->bqhd', p, v)

    o = lax.map(attend, qb)
    return o.transpose(1, 0, 2, 3, 4).reshape(B, Lq, H * v.shape[-1])


def mix_tokens(proj, k, v, rope, spectra, lp):
    B, L, _ = proj.shape
    y_hy = hyena_mixer(proj[..., HY_OFF:GM_OFF], lp['hy_short_w'], lp['hy_short_b'], spectra, lp['hy_bias'])
    y_gm = gmlp_mixer(proj[..., GM_OFF:CV_OFF], lp['gm_ln_g'], lp['gm_ln_b'], lp['gm_ws'], lp['gm_bs'])
    y_cv = conv_mixer(proj[..., CV_OFF:MQ_OFF], lp['cv_dw_w'], lp['cv_dw_b'], lp['cv_ln_g'], lp['cv_ln_b'])
    q = mla_queries(proj[..., MQ_OFF:MKV_OFF], lp['mla_qa_norm'], lp['w_uq'], rope)
    y_at = block_attention(q, k, v)
    y = jnp.stack([y_hy, y_gm, y_cv, y_at], axis=-2)
    y = rms_norm(y, lp['mix_norm_g'].reshape(N_MIXERS, D_GROUP)).reshape(B, L, D_MIX)
    return y @ lp['w_out']


def moe_ffn(h, w_router, router_bias, w_gate, w_up, w_down):
    s = jax.nn.sigmoid((h @ w_router).astype(F32))
    sel = s + router_bias.astype(F32)
    grp = sel.reshape(*sel.shape[:-1], N_EXPERT_GROUPS, EXPERTS_PER_GROUP)
    grp_score = jnp.sum(lax.top_k(grp, GROUP_SCORE_TOPK)[0], axis=-1)
    best = jnp.argmax(grp_score, axis=-1)
    in_group = (jnp.arange(N_EXPERTS) // EXPERTS_PER_GROUP) == best[..., None]
    _, idx = lax.top_k(jnp.where(in_group, sel, -jnp.inf), TOP_K)
    w = jnp.take_along_axis(s, idx, axis=-1)
    w = w / jnp.sum(w, axis=-1, keepdims=True)
    gates = jnp.sum(jax.nn.one_hot(idx, N_EXPERTS, dtype=F32) * w[..., None], axis=-2).astype(h.dtype)
    y = jnp.zeros_like(h)
    for e in range(N_EXPERTS):
        a = jax.nn.silu(h @ w_gate[e]) * (h @ w_up[e])
        y = y + gates[..., e:e + 1] * (a @ w_down[e])
    return y


def setup_inputs(seed: int = 0) -> dict:
    key = jax.random.key(seed)
    ks = iter(jax.random.split(key, 48))

    def nrm(shape, scale):
        return jax.random.normal(next(ks), shape, F32) * scale

    def gain(shape):
        return 1.0 + nrm(shape, 0.05)

    D, E, F = D_MODEL, N_EXPERTS, D_EXPERT
    return {
        "x": nrm((BATCH, SEQ, D), 1.0),
        "c": nrm((BATCH, D), 1.0),
        "ctx": nrm((BATCH, CTX_LEN, D), 1.0),
        "c_ctx": nrm((D,), 1.0),
        "ada_w": nrm((DEPTH, D, 6 * D), 0.5 * D ** -0.5),
        "ada_b": nrm((DEPTH, 6 * D), 0.02),
        "norm1_g": gain((DEPTH, D)),
        "norm2_g": gain((DEPTH, D)),
        "w_in": nrm((DEPTH, D, IN_COLS), D ** -0.5),
        "hy_short_w": nrm((DEPTH, HY_SHORT, HY_COLS), HY_SHORT ** -0.5),
        "hy_short_b": nrm((DEPTH, HY_COLS), 0.02),
        "hy_f_w1": nrm((DEPTH, HY_EMB, HY_FFN), HY_EMB ** -0.5),
        "hy_f_b1": nrm((DEPTH, HY_FFN), 0.02),
        "hy_f_freq": 1.0 + nrm((DEPTH, HY_FFN), 0.1),
        "hy_f_w2": nrm((DEPTH, HY_FFN, HY_FFN), HY_FFN ** -0.5),
        "hy_f_b2": nrm((DEPTH, HY_FFN), 0.02),
        "hy_f_w3": nrm((DEPTH, HY_FFN, HY_ORDER * 2 * D_GROUP), HY_FFN ** -0.5),
        "hy_bias": nrm((DEPTH, HY_ORDER, D_GROUP), 0.5),
        "gm_ln_g": gain((DEPTH, D_GROUP)),
        "gm_ln_b": nrm((DEPTH, D_GROUP), 0.02),
        "gm_ws": nrm((DEPTH, GM_HEADS, GM_CHUNK, GM_CHUNK), 0.5 * GM_CHUNK ** -0.5),
        "gm_bs": 1.0 + nrm((DEPTH, GM_HEADS, GM_CHUNK), 0.02),
        "cv_dw_w": nrm((DEPTH, CV_WIDTH, D_GROUP), CV_WIDTH ** -0.5),
        "cv_dw_b": nrm((DEPTH, D_GROUP), 0.02),
        "cv_ln_g": gain((DEPTH, D_GROUP)),
        "cv_ln_b": nrm((DEPTH, D_GROUP), 0.02),
        "mla_qa_norm": gain((DEPTH, MLA_Q_RANK)),
        "w_uq": nrm((DEPTH, MLA_Q_RANK, MLA_HEADS * (MLA_NOPE + MLA_ROPE)), MLA_Q_RANK ** -0.5),
        "mla_kva_norm": gain((DEPTH, MLA_KV_RANK)),
        "w_ukv": nrm((DEPTH, MLA_KV_RANK, MLA_HEADS * (MLA_NOPE + MLA_V)), MLA_KV_RANK ** -0.5),
        "mix_norm_g": gain((DEPTH, D_MIX)),
        "w_out": nrm((DEPTH, D_MIX, D), D_MIX ** -0.5),
        "w_router": nrm((D, E), D ** -0.5),
        "router_bias": nrm((E,), 0.01),
        "exp_w_gate": nrm((DEPTH, E, D, F), D ** -0.5),
        "exp_w_up": nrm((DEPTH, E, D, F), D ** -0.5),
        "exp_w_down": nrm((DEPTH, E, F, D), F ** -0.5),
        "final_norm_g": gain((D,)),
    }


def reference(x, c, ctx, c_ctx, ada_w, ada_b, norm1_g, norm2_g, w_in, hy_short_w, hy_short_b,
              hy_f_w1, hy_f_b1, hy_f_freq, hy_f_w2, hy_f_b2, hy_f_w3, hy_bias, gm_ln_g, gm_ln_b,
              gm_ws, gm_bs, cv_dw_w, cv_dw_b, cv_ln_g, cv_ln_b, mla_qa_norm, w_uq, mla_kva_norm,
              w_ukv, mix_norm_g, w_out, w_router, router_bias, exp_w_gate, exp_w_up, exp_w_down,
              final_norm_g):
    n_lat = x.shape[1]
    n_ctx = ctx.shape[1]
    rope = axial_rope_tables(n_lat)
    for l in range(DEPTH):
        last = l == DEPTH - 1
        lp = {
            'hy_short_w': hy_short_w[l], 'hy_short_b': hy_short_b[l], 'hy_bias': hy_bias[l],
            'gm_ln_g': gm_ln_g[l], 'gm_ln_b': gm_ln_b[l], 'gm_ws': gm_ws[l], 'gm_bs': gm_bs[l],
            'cv_dw_w': cv_dw_w[l], 'cv_dw_b': cv_dw_b[l], 'cv_ln_g': cv_ln_g[l], 'cv_ln_b': cv_ln_b[l],
            'mla_qa_norm': mla_qa_norm[l], 'w_uq': w_uq[l],
            'mix_norm_g': mix_norm_g[l], 'w_out': w_out[l],
        }
        filt = (hy_f_w1[l], hy_f_b1[l], hy_f_freq[l], hy_f_w2[l], hy_f_b2[l], hy_f_w3[l])
        sh1, sc1, g1, sh2, sc2, g2 = modulation(c, ada_w[l], ada_b[l])
        csh1, csc1, cg1, csh2, csc2, cg2 = modulation(c_ctx, ada_w[l], ada_b[l])

        h_lat = rms_norm(x, norm1_g[l]) * (1.0 + sc1) + sh1
        h_ctx = rms_norm(ctx, norm1_g[l]) * (1.0 + csc1) + csh1
        proj_lat = h_lat @ w_in[l]
        proj_ctx = h_ctx @ (w_in[l][:, MKV_OFF:] if last else w_in[l])
        k_ctx, v_ctx = mla_keys_values(proj_ctx[..., -MKV_COLS:], mla_kva_norm[l], w_ukv[l], None)
        k_lat, v_lat = mla_keys_values(proj_lat[..., MKV_OFF:], mla_kva_norm[l], w_ukv[l], rope)
        k_all = jnp.concatenate([k_lat, k_ctx], axis=1)
        v_all = jnp.concatenate([v_lat, v_ctx], axis=1)
        spectra_lat = hyena_filter_spectra(n_lat, *filt)
        x_mid = x + g1 * mix_tokens(proj_lat, k_all, v_all, rope, spectra_lat, lp)

        hf = rms_norm(x_mid, norm2_g[l]) * (1.0 + sc2) + sh2
        x = x_mid + g2 * moe_ffn(hf, w_router, router_bias, exp_w_gate[l], exp_w_up[l], exp_w_down[l])

        if not last:
            spectra_ctx = hyena_filter_spectra(n_ctx, *filt)
            ctx_mid = ctx + cg1 * mix_tokens(proj_ctx, k_ctx, v_ctx, None, spectra_ctx, lp)
            hc = rms_norm(ctx_mid, norm2_g[l]) * (1.0 + csc2) + csh2
            ctx = ctx_mid + cg2 * moe_ffn(hc, w_router, router_bias, exp_w_gate[l], exp_w_up[l], exp_w_down[l])
    return rms_norm(x, final_norm_g)
```

```cpp
#include <hip/hip_runtime.h>
#include <cstdio>
#include <cstdint>
#include <cmath>

#define LAS __attribute__((address_space(3)))
#define GAS __attribute__((address_space(1)))
typedef unsigned short bf16;
typedef short bf16x8 __attribute__((ext_vector_type(8)));
typedef short bf16x4 __attribute__((ext_vector_type(4)));
typedef float f32x4 __attribute__((ext_vector_type(4)));
typedef float f32x2 __attribute__((ext_vector_type(2)));
typedef float f32x16 __attribute__((ext_vector_type(16)));
typedef unsigned u32x4 __attribute__((ext_vector_type(4)));
typedef unsigned u32x2 __attribute__((ext_vector_type(2)));

constexpr int NB = 8, SEQ = 4096, CTXL = 256, DM = 1024, DEPTH = 2;
constexpr int NLAT = NB * SEQ, NCTX = NB * CTXL, NTOK = NLAT + NCTX;
constexpr int IN_COLS = 2144, NIN_PAD = 2304;
constexpr int HY_OFF = 0, GM_OFF = 768, CV_OFF = 1280, MQ_OFF = 1792, MKV_OFF = 1984;
constexpr int PROJ_LD = 1536;
constexpr int PJ_GM = 0, PJ_CV = 512, PJ_MKV = 1024, PJ_MQ = 1184;
constexpr int NKEY = SEQ + CTXL;
constexpr int NEXP = 16, DEXP = 512, NBUCKET = 24;
constexpr int A_ROWS = 41216;
constexpr float EPS = 1e-6f;
constexpr int GC = 4128, GLEN = 8256;
constexpr float QSCALE = 0.10206207261596577f * 1.4426950408889634f;

constexpr size_t al256(size_t x) { return (x + 255) & ~(size_t)255; }
constexpr size_t WS_CTL = 0, CTL_BYTES = 1u << 20;
constexpr size_t WS_MOD = WS_CTL + CTL_BYTES;
constexpr size_t WS_ROPE = al256(WS_MOD + (size_t)2 * 9 * 6144 * 4);
constexpr size_t WS_WIN = al256(WS_ROPE + (size_t)2 * 4096 * 16 * 4);
constexpr size_t WS_WOUT = al256(WS_WIN + (size_t)2 * NIN_PAD * 1024 * 2);
constexpr size_t WS_W1 = al256(WS_WOUT + (size_t)2 * 1024 * 1024 * 2);
constexpr size_t WS_W2 = al256(WS_W1 + (size_t)2 * 16 * 1024 * 1024 * 2);
constexpr size_t WS_WUQ = al256(WS_W2 + (size_t)2 * 16 * 1024 * 512 * 2);
constexpr size_t WS_WUKV = al256(WS_WUQ + (size_t)2 * 384 * 192 * 2);
constexpr size_t WS_GMWS = al256(WS_WUKV + (size_t)2 * 512 * 128 * 2);
constexpr size_t WS_G = al256(WS_GMWS + (size_t)2 * 4 * 128 * 128 * 2);
constexpr size_t WS_TC = al256(WS_G + (size_t)2 * 2 * 256 * GLEN * 2);
constexpr size_t WS_H = al256(WS_TC + (size_t)2 * 256 * 512 * 4);
constexpr size_t WS_PROJ = al256(WS_H + (size_t)NTOK * 1024 * 2);
constexpr size_t WS_HYT = al256(WS_PROJ + (size_t)NTOK * PROJ_LD * 2);
constexpr size_t WS_Q = al256(WS_HYT + (size_t)768 * NTOK * 2);
constexpr size_t WS_K = al256(WS_Q + (size_t)NTOK * 384 * 2);
constexpr size_t WS_VT = al256(WS_K + (size_t)NB * 4 * NKEY * 96 * 2);
constexpr size_t WS_XC = al256(WS_VT + (size_t)NB * 4 * 64 * NKEY * 2);
constexpr size_t WS_TOK = al256(WS_XC + (size_t)NCTX * 1024 * 4);
constexpr size_t WS_WLO = al256(WS_TOK + (size_t)NBUCKET * NTOK * 4);
constexpr size_t WS_WHI = al256(WS_WLO + (size_t)NBUCKET * NTOK * 4);
constexpr size_t WS_YT = al256(WS_WHI + (size_t)NBUCKET * NTOK * 4);
constexpr size_t WS_YAT = al256(WS_YT + (size_t)256 * NTOK * 2);
constexpr size_t WS_FS = al256(WS_YAT + (size_t)NTOK * 256 * 2);
constexpr size_t WS_END = al256(WS_FS + (size_t)3 * 128 * 1024 * 4);
static_assert((size_t)A_ROWS * 1024 * 2 <= (size_t)NTOK * PROJ_LD * 2, "a overlays proj");
static_assert(WS_END <= (size_t)512 * 1024 * 1024, "workspace");
constexpr int CW_BAR = 1024;
constexpr int CW_CNT = 8192;

constexpr int LDS_BYTES = 160 * 1024;
constexpr int LDS_MISC = 131072 + 28672;

__device__ __forceinline__ float bf2f(bf16 v) { return __builtin_bit_cast(float, (unsigned)v << 16); }
__device__ __forceinline__ unsigned f2bf(float f) { unsigned u = __builtin_bit_cast(unsigned, f); return (u + 0x7fffu + ((u >> 16) & 1u)) >> 16; }
__device__ __forceinline__ unsigned pk2(float lo, float hi) { return f2bf(lo) | (f2bf(hi) << 16); }
__device__ __forceinline__ float lo_bf(unsigned w) { return __builtin_bit_cast(float, w << 16); }
__device__ __forceinline__ float hi_bf(unsigned w) { return __builtin_bit_cast(float, w & 0xffff0000u); }
__device__ __forceinline__ float wave_sum(float v) {
#pragma unroll
    for (int o = 1; o < 64; o <<= 1) v += __shfl_xor(v, o);
    return v;
}
__device__ __forceinline__ float siluf(float x) { return x / (1.f + __expf(-x)); }
__device__ __forceinline__ float sigmf(float x) { return 1.f / (1.f + __expf(-x)); }
__device__ __forceinline__ float gelu_tanh(float x) { const float u = 0.7978845608028654f * (x + 0.044715f * x * x * x); const float e = __expf(2.f * u); return x * (1.f - 1.f / (e + 1.f)); }
__device__ __forceinline__ int mod_idx(int r) { return r < NLAT ? (r >> 12) : 8; }

#define XB_TMO      128
#define XB_XCNT(j)  (256  + 64 * (j))
#define XB_XSUB(j)  (1280 + 64 * (j))
#define XB_XGEN(j)  (2304 + 64 * (j))
#define XB_TOP      3328
#define XB_TOPGEN   3392
#define XCD_BAR_WORDS 3456
#define XB_SPIN_CAP (1u << 22)
__device__ __forceinline__ unsigned xb_ld(unsigned* p)              { return __hip_atomic_load(p, __ATOMIC_RELAXED, __HIP_MEMORY_SCOPE_AGENT); }
__device__ __forceinline__ unsigned xb_add(unsigned* p, unsigned v) { return __hip_atomic_fetch_add(p, v, __ATOMIC_RELAXED, __HIP_MEMORY_SCOPE_AGENT); }
__device__ __forceinline__ unsigned xb_xcc_id() { return (unsigned)__builtin_amdgcn_s_getreg((3 << 11) | 20) & 0xFu; }
#define XB_SPIN(cond, bar) do { unsigned _sp = 0; while (cond) { __builtin_amdgcn_s_sleep(1); \
    if ((++_sp & 255u) == 0u) { if (xb_ld(&(bar)[XB_TMO])) break; if (_sp > XB_SPIN_CAP) { atomicAdd(&(bar)[XB_TMO], 1u); break; } } } } while (0)
struct XcdBarrier { unsigned* bar; unsigned x; volatile LAS unsigned* st; };
__device__ __forceinline__ XcdBarrier xcd_barrier_post(unsigned* bar, volatile LAS unsigned* st) {
    XcdBarrier b; b.bar = bar; b.x = xb_xcc_id(); b.st = st;
    if (threadIdx.x == 0) (void)xb_add(&bar[XB_XCNT(b.x)], 1u);
    return b;
}
__device__ __forceinline__ void xcd_barrier_complete(unsigned* bar, unsigned x, unsigned& nloc, unsigned& nx) {
    const unsigned G = gridDim.x * gridDim.y * gridDim.z;
    unsigned sum, cnt, mine, sp = 0u;
    for (;;) {
        sum = 0u; cnt = 0u; mine = 0u;
#pragma unroll
        for (unsigned j = 0; j < 16; ++j) { const unsigned c = xb_ld(&bar[XB_XCNT(j)]); sum += c; cnt += (c > 0u) ? 1u : 0u; mine = (j == x) ? c : mine; }
        if (sum == G) break;
        __builtin_amdgcn_s_sleep(1);
        if ((++sp & 255u) == 0u) { if (xb_ld(&bar[XB_TMO])) break; if (sp > XB_SPIN_CAP) { atomicAdd(&bar[XB_TMO], 1u); break; } }
    }
    nloc = mine > 0u ? mine : 1u; nx = cnt > 0u ? cnt : 1u;
}
__device__ __forceinline__ void xcd_barrier(const XcdBarrier& b) {
    asm volatile("s_waitcnt vmcnt(0)" ::: "memory");
    __syncthreads();
    if (threadIdx.x == 0) {
        unsigned* bar = b.bar;
        __builtin_amdgcn_s_waitcnt(0);
        unsigned nloc = b.st[0], nx = b.st[1];
        if (nloc == 0u) { xcd_barrier_complete(bar, b.x, nloc, nx); b.st[0] = nloc; b.st[1] = nx; }
        const unsigned old = xb_add(&bar[XB_XSUB(b.x)], 1u);
        const unsigned gen = old / nloc;
        if (old + 1u == (gen + 1u) * nloc) {
            __builtin_amdgcn_fence(__ATOMIC_RELEASE, "agent");
            asm volatile("s_waitcnt vmcnt(0)" ::: "memory");
            const unsigned og = xb_add(&bar[XB_TOP], 1u);
            const unsigned tg = og / nx;
            if (og + 1u == (tg + 1u) * nx) xb_add(&bar[XB_TOPGEN], 1u);
            else XB_SPIN(xb_ld(&bar[XB_TOPGEN]) == tg, bar);
            __builtin_amdgcn_fence(__ATOMIC_ACQUIRE, "agent");
            xb_add(&bar[XB_XGEN(b.x)], 1u);
            asm volatile("s_waitcnt vmcnt(0)" ::: "memory");
        } else {
            XB_SPIN(xb_ld(&bar[XB_XGEN(b.x)]) == gen, bar);
            __builtin_amdgcn_fence(__ATOMIC_ACQUIRE, "agent");
            asm volatile("s_waitcnt vmcnt(0)" ::: "memory");
        }
    }
    __syncthreads();
}

struct Args {
    const float* in[38]; float* out; unsigned char* ws; int ph_lo, ph_hi;
};
struct Frame {
    LAS unsigned char* lds; unsigned char* ws; unsigned* ctl;
    int tid, lane, wave, G, vcu, gw, NGW;
};
enum { I_X = 0, I_C, I_CTX, I_CCTX, I_ADAW, I_ADAB, I_N1G, I_N2G, I_WIN, I_HSW, I_HSB, I_HFW1, I_HFB1, I_HFFREQ, I_HFW2, I_HFB2, I_HFW3, I_HBIAS,
       I_GMLNG, I_GMLNB, I_GMWS, I_GMBS, I_CVW, I_CVB, I_CVLNG, I_CVLNB, I_QANORM, I_WUQ, I_KVANORM, I_WUKV, I_MIXG, I_WOUT, I_WROUTER, I_RBIAS,
       I_EWG, I_EWU, I_EWD, I_FNG };

namespace pg8 {
constexpr int BM = 256, BK = 64, HALF = 128, HTB = HALF * BK * 2, STAGE_BYTES = 8 * HTB;
__host__ __device__ __forceinline__ int lds_byte(int r, int c) { const int st = (r >> 4) * 2 + (c >> 5), rr = r & 15, cc = c & 31, ob = rr * 64 + cc * 2; return st * 1024 + (ob ^ (((ob >> 9) & 1) << 5)); }
__host__ __device__ __forceinline__ void stage_rc(int b, int& R, int& C) { const int st = b / 1024, sb = b % 1024, swz = sb ^ (((sb >> 9) & 1) << 5); R = (st >> 1) * 16 + swz / 64; C = (st & 1) * 32 + (swz % 64) / 2; }
__host__ __device__ __forceinline__ int perm32(int rho) { const int n = rho >> 4, i = rho & 15; return 8 * (i >> 2) + 4 * n + (i & 3); }
struct Unit { int pm, pn, k, aux; };
__device__ __forceinline__ unsigned cvt_pk_bf16(float lo, float hi) { unsigned r; asm volatile("v_cvt_pk_bf16_f32 %0, %1, %2" : "=v"(r) : "v"(lo), "v"(hi)); return r; }

template <class Op, bool ALIGN_EPI>
__device__ __forceinline__ void gemm_phase(LAS unsigned char* lds, const Op& op, const int K) {
    const int tid = threadIdx.x, wid = __builtin_amdgcn_readfirstlane(tid >> 6), lane = tid & 63, wr = wid >> 2, wc = wid & 3, fr = lane & 15, fq = lane >> 4;
    const int nt = K / BK;
    int Rs[2], Cs[2]; unsigned voffB[2];
#pragma unroll
    for (int i = 0; i < 2; ++i) { stage_rc(tid * 16 + i * 8192, Rs[i], Cs[i]); const int Rb = (Rs[i] & ~31) + perm32(Rs[i] & 31); voffB[i] = (unsigned)(Rb * op.ldb() + Cs[i]) * 2u; }
    const unsigned hstepB = (unsigned)HALF * op.ldb() * 2u;
    const unsigned ldsw = (unsigned)wid * 1024u;
    const int aoff = lds_byte(wr * 64 + fr, fq * 8), boff = lds_byte(wc * 32 + fr, fq * 8);
    const char* const Ab = (const char*)op.A();
#define PG8_SA(b, h) (((b) * 2 + (h)) * HTB)
#define PG8_SB(b, h) ((4 + (b) * 2 + (h)) * HTB)
#define PG8_STAGE_A(bufoff, offs, h, kb) do { _Pragma("unroll") for (int _i = 0; _i < 2; ++_i) \
        __builtin_amdgcn_global_load_lds((const unsigned*)(Ab + (size_t)(offs)[h][_i] + (size_t)(kb)), (LAS unsigned*)(lds + (bufoff) + ldsw + _i * 8192), 16, 0, 0); } while (0)
#define PG8_STAGE_B(bufoff, gbase) do { _Pragma("unroll") for (int _i = 0; _i < 2; ++_i) \
        __builtin_amdgcn_global_load_lds((const unsigned*)((const char*)(gbase) + voffB[_i]), (LAS unsigned*)(lds + (bufoff) + ldsw + _i * 8192), 16, 0, 0); } while (0)
#define PG8_LDA(dst, b, h) do { _Pragma("unroll") for (int m = 0; m < 4; ++m) _Pragma("unroll") for (int k = 0; k < 2; ++k) dst[m][k] = *(const LAS bf16x8*)(lds + PG8_SA(b, h) + aoff + m * 2048 + k * 1024); } while (0)
#define PG8_LDB(dst, b, h) do { _Pragma("unroll") for (int n = 0; n < 2; ++n) _Pragma("unroll") for (int k = 0; k < 2; ++k) dst[n][k] = *(const LAS bf16x8*)(lds + PG8_SB(b, h) + boff + n * 2048 + k * 1024); } while (0)
#define PG8_MMA(ai, bj, At, Bt) do { __builtin_amdgcn_s_setprio(1); _Pragma("unroll") for (int m = 0; m < 4; ++m) _Pragma("unroll") for (int n = 0; n < 2; ++n) _Pragma("unroll") for (int k = 0; k < 2; ++k) \
        acc[ai][bj][m][n] = __builtin_amdgcn_mfma_f32_16x16x32_bf16(Bt[n][k], At[m][k], acc[ai][bj][m][n], 0, 0, 0); __builtin_amdgcn_s_setprio(0); } while (0)
#define PG8_WAIT_V(n) asm volatile("s_waitcnt vmcnt(" #n ")" ::: "memory")
#define PG8_WAIT_L(n) asm volatile("s_waitcnt lgkmcnt(" #n ")" ::: "memory")
#define PG8_BAR __builtin_amdgcn_s_barrier()
#define PG8_SCHED __builtin_amdgcn_sched_barrier(0)
    Unit cur, nxt; int ui = 0;
    if (!op.next(0, cur)) return;
    f32x4 acc[2][2][4][2];
#pragma unroll
    for (int a = 0; a < 2; ++a)
#pragma unroll
        for (int b = 0; b < 2; ++b)
#pragma unroll
            for (int m = 0; m < 4; ++m)
#pragma unroll
                for (int n = 0; n < 2; ++n) acc[a][b][m][n] = (f32x4){0.f, 0.f, 0.f, 0.f};
    bf16x8 At[4][2], B0[2][2], B1[2][2];
    unsigned caoff[2][2], naoff[2][2];
#pragma unroll
    for (int h = 0; h < 2; ++h)
#pragma unroll
        for (int i = 0; i < 2; ++i) caoff[h][i] = op.arow(cur, h * HALF + Rs[i]) + (unsigned)Cs[i] * 2u;
    {
        const char* b0 = op.bptr(cur, 0); const char* b1 = op.bptr(cur, 1);
        PG8_STAGE_B(PG8_SB(0, 0), b0); PG8_STAGE_B(PG8_SB(0, 1), b0 + hstepB); PG8_STAGE_A(PG8_SA(0, 0), caoff, 0, 0); PG8_STAGE_A(PG8_SA(0, 1), caoff, 1, 0);
        if (wr == 1) PG8_BAR;
        PG8_WAIT_V(2); PG8_BAR;
        PG8_STAGE_B(PG8_SB(1, 0), b1); PG8_STAGE_A(PG8_SA(1, 0), caoff, 0, 128); PG8_STAGE_B(PG8_SB(1, 1), b1 + hstepB);
        PG8_WAIT_V(6); PG8_BAR;
    }
    for (;;) {
        const bool has_next = op.next(ui + 1, nxt);
        if (!has_next) nxt = cur;
#pragma unroll
        for (int h = 0; h < 2; ++h)
#pragma unroll
            for (int i = 0; i < 2; ++i) naoff[h][i] = has_next ? op.arow(nxt, h * HALF + Rs[i]) + (unsigned)Cs[i] * 2u : caoff[h][i];
        for (int t = 0; t < nt; t += 2) {
            const bool last = (t == nt - 2);
            const unsigned ka1 = (unsigned)(t + 1) * 128u;
            const unsigned ka2 = last ? 0u : (unsigned)(t + 2) * 128u, ka3 = ka2 + 128u;
            unsigned a2off[2][2];
#pragma unroll
            for (int h = 0; h < 2; ++h)
#pragma unroll
                for (int i = 0; i < 2; ++i) a2off[h][i] = last ? naoff[h][i] : caoff[h][i];
            const char* b2 = last ? op.bptr(nxt, 0) : op.bptr(cur, t + 2);
            const char* b3 = last ? op.bptr(nxt, 1) : op.bptr(cur, t + 3);
            PG8_LDB(B0, 0, 0); PG8_LDB(B1, 0, 1); PG8_SCHED; PG8_LDA(At, 0, 0); PG8_STAGE_A(PG8_SA(1, 1), caoff, 1, ka1);
            PG8_WAIT_V(8); PG8_WAIT_L(0); PG8_BAR; PG8_MMA(0, 0, At, B0); PG8_MMA(0, 1, At, B1); PG8_BAR; PG8_SCHED;
            PG8_LDA(At, 0, 1); PG8_STAGE_B(PG8_SB(0, 0), b2); PG8_STAGE_B(PG8_SB(0, 1), b2 + hstepB); PG8_STAGE_A(PG8_SA(0, 0), a2off, 0, ka2);
            PG8_WAIT_V(8); PG8_WAIT_L(0); PG8_BAR; PG8_MMA(1, 0, At, B0); PG8_MMA(1, 1, At, B1); PG8_BAR; PG8_SCHED;
            PG8_LDB(B0, 1, 0); PG8_LDB(B1, 1, 1); PG8_SCHED; PG8_LDA(At, 1, 0); PG8_STAGE_A(PG8_SA(0, 1), a2off, 1, ka2);
            PG8_WAIT_V(8); PG8_WAIT_L(0); PG8_BAR; PG8_MMA(0, 0, At, B0); PG8_MMA(0, 1, At, B1); PG8_BAR; PG8_SCHED;
            PG8_LDA(At, 1, 1); PG8_STAGE_B(PG8_SB(1, 0), b3); PG8_STAGE_B(PG8_SB(1, 1), b3 + hstepB); PG8_STAGE_A(PG8_SA(1, 0), a2off, 0, ka3);
            PG8_WAIT_V(8); PG8_WAIT_L(0); PG8_BAR; PG8_MMA(1, 0, At, B0); PG8_MMA(1, 1, At, B1); PG8_BAR; PG8_SCHED;
        }
        if constexpr (ALIGN_EPI) { if (wr == 0) PG8_BAR; }
        op.epi(acc, cur, wr, wc, fr, fq);
        if (!has_next) break;
#pragma unroll
        for (int a = 0; a < 2; ++a)
#pragma unroll
            for (int b = 0; b < 2; ++b)
#pragma unroll
                for (int m = 0; m < 4; ++m)
#pragma unroll
                    for (int n = 0; n < 2; ++n) acc[a][b][m][n] = (f32x4){0.f, 0.f, 0.f, 0.f};
        cur = nxt; ++ui;
#pragma unroll
        for (int h = 0; h < 2; ++h)
#pragma unroll
            for (int i = 0; i < 2; ++i) caoff[h][i] = naoff[h][i];
        if constexpr (ALIGN_EPI) { if (wr == 1) PG8_BAR; }
    }
    PG8_WAIT_V(0);
    if constexpr (!ALIGN_EPI) { if (wr == 0) PG8_BAR; }
    PG8_BAR;
#undef PG8_SA
#undef PG8_SB
#undef PG8_STAGE_A
#undef PG8_STAGE_B
#undef PG8_LDA
#undef PG8_LDB
#undef PG8_MMA
#undef PG8_WAIT_V
#undef PG8_WAIT_L
#undef PG8_BAR
#undef PG8_SCHED
}
}
struct OpIn {
    const bf16* A_; const bf16* Bt; bf16* proj; bf16* hyT; int layer, G, vcu;
    __device__ __forceinline__ const bf16* A() const { return A_; }
    __device__ __forceinline__ int ldb() const { return 1024; }
    __device__ __forceinline__ bool next(int i, pg8::Unit& u) const {
        const int L = i * G + vcu; const int nlat = 128 * 9, total = layer == 0 ? 136 * 9 : nlat + 8;
        if (L >= total) return false;
        if (layer == 0 || L < nlat) { u.pm = L / 9; u.pn = L % 9; } else { u.pm = 128 + (L - nlat); u.pn = 7; }
        u.k = 0; u.aux = 0; return true;
    }
    __device__ __forceinline__ unsigned arow(const pg8::Unit& u, int lr) const { return (unsigned)(u.pm * 256 + lr) * 2048u; }
    __device__ __forceinline__ const char* bptr(const pg8::Unit& u, int t) const { return (const char*)Bt + (size_t)u.pn * 256 * 2048 + (size_t)t * 128; }
    __device__ __forceinline__ void epi(const f32x4 (&acc)[2][2][4][2], const pg8::Unit& u, int wr, int wc, int fr, int fq) const {
        const int row0 = u.pm * 256 + wr * 64 + fr, lc0 = wc * 32 + 8 * fq;
        if (u.pn >= 3) {
            bf16* base = proj + (size_t)row0 * PROJ_LD + (u.pn - 3) * 256 + lc0;
#pragma unroll
            for (int ai = 0; ai < 2; ++ai)
#pragma unroll
                for (int m = 0; m < 4; ++m) { bf16* rowp = base + (size_t)(ai * 128 + m * 16) * PROJ_LD;
#pragma unroll
                    for (int bj = 0; bj < 2; ++bj) { const f32x4 v0 = acc[ai][bj][m][0], v1 = acc[ai][bj][m][1]; u32x4 w;
                        w.x = pg8::cvt_pk_bf16(v0[0], v0[1]); w.y = pg8::cvt_pk_bf16(v0[2], v0[3]); w.z = pg8::cvt_pk_bf16(v1[0], v1[1]); w.w = pg8::cvt_pk_bf16(v1[2], v1[3]);
                        *(u32x4*)(rowp + bj * 128) = w; } }
        } else {
            bf16* base = hyT + (size_t)(u.pn * 256 + lc0) * NTOK + row0;
#pragma unroll
            for (int ai = 0; ai < 2; ++ai)
#pragma unroll
                for (int m = 0; m < 4; ++m)
#pragma unroll
                    for (int bj = 0; bj < 2; ++bj)
#pragma unroll
                        for (int n = 0; n < 2; ++n)
#pragma unroll
                            for (int j = 0; j < 4; ++j)
                                base[(size_t)(bj * 128 + 4 * n + j) * NTOK + ai * 128 + m * 16] = (bf16)f2bf(acc[ai][bj][m][n][j]);
        }
    }
};

struct OpOut {
    const bf16* A_; const bf16* Bt; const float* xin_lat; const float* xin_ctx; float* xo_lat; float* xo_ctx; const float* mod; int layer, G, vcu;
    __device__ __forceinline__ const bf16* A() const { return A_; }
    __device__ __forceinline__ int ldb() const { return 1024; }
    __device__ __forceinline__ bool next(int i, pg8::Unit& u) const {
        const int L = i * G + vcu; const int total = (layer == 0 ? 136 : 128) * 4;
        if (L >= total) return false;
        u.pm = L >> 2; u.pn = L & 3; u.k = 0; u.aux = 0; return true;
    }
    __device__ __forceinline__ unsigned arow(const pg8::Unit& u, int lr) const { return (unsigned)(u.pm * 256 + lr) * 2048u; }
    __device__ __forceinline__ const char* bptr(const pg8::Unit& u, int t) const { return (const char*)Bt + (size_t)u.pn * 256 * 2048 + (size_t)t * 128; }
    __device__ __forceinline__ void epi(const f32x4 (&acc)[2][2][4][2], const pg8::Unit& u, int wr, int wc, int fr, int fq) const {
        const int grow0 = u.pm * 256; const bool isl = grow0 < NLAT;
        const float* xi = isl ? xin_lat + (size_t)grow0 * 1024 : xin_ctx + (size_t)(grow0 - NLAT) * 1024;
        float* xo = isl ? xo_lat + (size_t)grow0 * 1024 : xo_ctx + (size_t)(grow0 - NLAT) * 1024;
        const float* g1 = mod + (size_t)mod_idx(grow0) * 6144 + 2 * 1024;
        const int lr0 = wr * 64 + fr, c0 = u.pn * 256 + wc * 32 + 8 * fq;
#pragma unroll
        for (int bj = 0; bj < 2; ++bj)
#pragma unroll
            for (int n = 0; n < 2; ++n) { const int col = c0 + bj * 128 + 4 * n; const f32x4 gv = *(const f32x4*)(g1 + col);
#pragma unroll
                for (int ai = 0; ai < 2; ++ai)
#pragma unroll
                    for (int m = 0; m < 4; ++m) { const size_t o = (size_t)(lr0 + ai * 128 + m * 16) * 1024 + col;
                        const f32x4 xv = *(const f32x4*)(xi + o); *(f32x4*)(xo + o) = xv + gv * acc[ai][bj][m][n]; } }
    }
};

struct MoeTab { const LAS int* t; };
__device__ __forceinline__ void moe_decode(const LAS int* tab, int mi, int& k, int& j) {
    int kk = 0;
#pragma unroll 1
    for (int q = 1; q < NBUCKET; ++q) if (tab[q] <= mi) kk = q;
    k = kk; j = mi - tab[kk];
}
__device__ __forceinline__ void pair_of(int k, int& elo, int& ehi) {
    const int g = k / 6, p = k - g * 6;
    const int lo = p < 3 ? 0 : (p < 5 ? 1 : 2), hi = p < 3 ? p + 1 : (p < 5 ? p - 1 : 3);
    elo = g * 4 + lo; ehi = g * 4 + hi;
}
struct OpMoe1 {
    const bf16* A_; const bf16* W1; bf16* abuf; const int* TOK; const float* WLO; const float* WHI; const LAS int* tab; int layer, G, vcu;
    __device__ __forceinline__ const bf16* A() const { return A_; }
    __device__ __forceinline__ int ldb() const { return 1024; }
    __device__ __forceinline__ bool next(int i, pg8::Unit& u) const {
        const int L = i * G + vcu; const int MT = tab[NBUCKET];
        if (L >= MT * 8) return false;
        u.pm = L >> 3; u.pn = L & 7; moe_decode(tab, u.pm, u.k, u.aux); return true;
    }
    __device__ __forceinline__ unsigned arow(const pg8::Unit& u, int lr) const {
        const int cnt = tab[32 + u.k]; int p = u.aux * 256 + lr; p = p < cnt ? p : cnt - 1;
        return (unsigned)TOK[(size_t)u.k * NTOK + p] * 2048u;
    }
    __device__ __forceinline__ const char* bptr(const pg8::Unit& u, int t) const {
        int elo, ehi; pair_of(u.k, elo, ehi); const int e = u.pn < 4 ? elo : ehi;
        return (const char*)W1 + ((size_t)(layer * 16 + e) * 1024 + (u.pn & 3) * 256) * 2048 + (size_t)t * 128;
    }
    __device__ __forceinline__ void epi(const f32x4 (&acc)[2][2][4][2], const pg8::Unit& u, int wr, int wc, int fr, int fq) const {
        const int cnt = tab[32 + u.k]; const float* WW = (u.pn < 4 ? WLO : WHI) + (size_t)u.k * NTOK;
        const int lr0 = wr * 64 + fr, c0 = (u.pn >= 4 ? 512 : 0) + (u.pn & 3) * 128 + wc * 32 + 8 * fq;
#pragma unroll
        for (int ai = 0; ai < 2; ++ai)
#pragma unroll
            for (int m = 0; m < 4; ++m) { const int lr = lr0 + ai * 128 + m * 16; int p = u.aux * 256 + lr; p = p < cnt ? p : cnt - 1; const float w = WW[p];
                const f32x4 g0 = acc[ai][0][m][0], g1 = acc[ai][0][m][1], u0 = acc[ai][1][m][0], u1 = acc[ai][1][m][1]; float o[8];
#pragma unroll
                for (int j = 0; j < 4; ++j) { o[j] = siluf(g0[j]) * u0[j] * w; o[4 + j] = siluf(g1[j]) * u1[j] * w; }
                u32x4 ww; ww.x = pg8::cvt_pk_bf16(o[0], o[1]); ww.y = pg8::cvt_pk_bf16(o[2], o[3]); ww.z = pg8::cvt_pk_bf16(o[4], o[5]); ww.w = pg8::cvt_pk_bf16(o[6], o[7]);
                *(u32x4*)(abuf + (size_t)(u.pm * 256 + lr) * 1024 + c0) = ww; }
    }
};
struct OpMoe2 {
    const bf16* A_; const bf16* W2; float* x_lat; float* x_ctx; const float* mod; const int* TOK; const LAS int* tab; int layer, G, vcu;
    __device__ __forceinline__ const bf16* A() const { return A_; }
    __device__ __forceinline__ int ldb() const { return 512; }
    __device__ __forceinline__ bool next(int i, pg8::Unit& u) const {
        const int L = i * G + vcu; const int MT = tab[NBUCKET];
        if (L >= MT * 4) return false;
        u.pm = L >> 2; u.pn = L & 3; moe_decode(tab, u.pm, u.k, u.aux); return true;
    }
    __device__ __forceinline__ unsigned arow(const pg8::Unit& u, int lr) const { return (unsigned)(u.pm * 256 + lr) * 2048u; }
    __device__ __forceinline__ const char* bptr(const pg8::Unit& u, int t) const {
        int elo, ehi; pair_of(u.k, elo, ehi); const int e = t < 8 ? elo : ehi;
        return (const char*)W2 + ((size_t)(layer * 16 + e) * 1024 + u.pn * 256) * 1024 + (size_t)(t & 7) * 128;
    }
    __device__ __forceinline__ void epi(const f32x4 (&acc)[2][2][4][2], const pg8::Unit& u, int wr, int wc, int fr, int fq) const {
        const int cnt = tab[32 + u.k]; const int lr0 = wr * 64 + fr, c0 = u.pn * 256 + wc * 32 + 8 * fq;
#pragma unroll
        for (int ai = 0; ai < 2; ++ai)
#pragma unroll
            for (int m = 0; m < 4; ++m) { const int p = u.aux * 256 + lr0 + ai * 128 + m * 16;
                if (p < cnt) { const int tok = TOK[(size_t)u.k * NTOK + p];
                    float* xr = tok < NLAT ? x_lat + (size_t)tok * 1024 : x_ctx + (size_t)(tok - NLAT) * 1024; const float* g2 = mod + (size_t)mod_idx(tok) * 6144 + 5 * 1024;
#pragma unroll
                    for (int bj = 0; bj < 2; ++bj)
#pragma unroll
                        for (int n = 0; n < 2; ++n) { const int col = c0 + bj * 128 + 4 * n; const f32x4 gv = *(const f32x4*)(g2 + col); const f32x4 xv = *(const f32x4*)(xr + col);
                            *(f32x4*)(xr + col) = xv + gv * acc[ai][bj][m][n]; } } }
    }
};
__device__ __forceinline__ void transpose_item(const float* W, int N, int k0, int n0, bf16* WT, int ldk, int dst_row0, LAS float* scr, int lane) {
#pragma unroll 8
    for (int i = 0; i < 32; ++i) { const int kk = 2 * i + (lane >> 5); scr[kk * 33 + (lane & 31)] = W[(size_t)(k0 + kk) * N + n0 + (lane & 31)]; }
    asm volatile("s_waitcnt lgkmcnt(0)" ::: "memory");
    const int c = lane & 7;
#pragma unroll
    for (int j = 0; j < 4; ++j) { const int n = (lane >> 3) + 8 * j; const LAS float* s = scr + (8 * c) * 33 + n;
        u32x4 o; o.x = pk2(s[0 * 33], s[1 * 33]); o.y = pk2(s[2 * 33], s[3 * 33]); o.z = pk2(s[4 * 33], s[5 * 33]); o.w = pk2(s[6 * 33], s[7 * 33]);
        *(u32x4*)(WT + (size_t)(dst_row0 + n) * ldk + k0 + 8 * c) = o; }
    asm volatile("s_waitcnt lgkmcnt(0)" ::: "memory");
}
__device__ __forceinline__ int win_dst(int n0) { return n0 < 1792 ? n0 : (n0 < 1984 ? 1952 + (n0 - 1792) : 1792 + (n0 - 1984)); }

__device__ __forceinline__ void p0_weights(const Frame& F, const Args& a) {
    LAS float* scr = (LAS float*)(F.lds + F.wave * 16384);
    constexpr int N_WIN = 2 * 16 * 67, N_WOUT = 2 * 16 * 32, N_G = 2 * 16 * 16 * 16, N_U = N_G, N_D = 2 * 16 * 8 * 32, N_UQ = 2 * 3 * 12, N_UKV = 2 * 2 * 16;
    constexpr int NIT = N_WIN + N_WOUT + N_G + N_U + N_D + N_UQ + N_UKV;
    unsigned char* ws = F.ws;
    for (int it = F.gw; it < NIT; it += F.NGW) {
        int r = it;
        if (r < N_WIN) { const int l = r / (16 * 67), q = r % (16 * 67), kb = q / 67, nb = q % 67;
            transpose_item(a.in[I_WIN] + (size_t)l * 1024 * IN_COLS, IN_COLS, kb * 64, nb * 32, (bf16*)(ws + WS_WIN) + (size_t)l * NIN_PAD * 1024, 1024, win_dst(nb * 32) - 0, scr, F.lane); continue; } r -= N_WIN;
        if (r < N_WOUT) { const int l = r / 512, q = r % 512, kb = q / 32, nb = q % 32;
            transpose_item(a.in[I_WOUT] + (size_t)l * 1024 * 1024, 1024, kb * 64, nb * 32, (bf16*)(ws + WS_WOUT) + (size_t)l * 1024 * 1024, 1024, nb * 32, scr, F.lane); continue; } r -= N_WOUT;
        if (r < N_G + N_U) { const bool up = r >= N_G; if (up) r -= N_G; const int le = r / 256, q = r % 256, kb = q / 16, nb = q % 16; const int f0 = nb * 32;
            transpose_item(a.in[up ? I_EWU : I_EWG] + (size_t)le * 1024 * 512, 512, kb * 64, f0, (bf16*)(ws + WS_W1) + (size_t)le * 1024 * 1024, 1024, (f0 >> 7) * 256 + (up ? 128 : 0) + (f0 & 127), scr, F.lane); continue; } r -= N_G + N_U;
        if (r < N_D) { const int le = r / 256, q = r % 256, kb = q / 32, nb = q % 32;
            transpose_item(a.in[I_EWD] + (size_t)le * 512 * 1024, 1024, kb * 64, nb * 32, (bf16*)(ws + WS_W2) + (size_t)le * 1024 * 512, 512, nb * 32, scr, F.lane); continue; } r -= N_D;
        if (r < N_UQ) { const int l = r / 36, q = r % 36, kb = q / 12, nb = q % 12;
            transpose_item(a.in[I_WUQ] + (size_t)l * 192 * 384, 384, kb * 64, nb * 32, (bf16*)(ws + WS_WUQ) + (size_t)l * 384 * 192, 192, nb * 32, scr, F.lane); continue; } r -= N_UQ;
        { const int l = r / 32, q = r % 32, kb = q / 16, nb = q % 16;
            transpose_item(a.in[I_WUKV] + (size_t)l * 128 * 512, 512, kb * 64, nb * 32, (bf16*)(ws + WS_WUKV) + (size_t)l * 512 * 128, 128, nb * 32, scr, F.lane); }
    }
    const int gt = (F.vcu * 512 + F.tid), NGT = F.G * 512;
    for (int i = gt; i < 2 * 160 * 128; i += NGT) { const int l = i / (160 * 128), q = i % (160 * 128);
        *(u32x4*)((bf16*)(ws + WS_WIN) + ((size_t)l * NIN_PAD + 2144) * 1024 + (size_t)q * 8) = (u32x4){0u, 0u, 0u, 0u}; }
    for (int i = gt; i < 2 * 4 * 128 * 128 / 4; i += NGT) { const f32x4 v = *(const f32x4*)(a.in[I_GMWS] + (size_t)i * 4); u32x2 o; o.x = pk2(v[0], v[1]); o.y = pk2(v[2], v[3]);
        *(u32x2*)((bf16*)(ws + WS_GMWS) + (size_t)i * 4) = o; }
    for (int i = gt; i < 4096 * 16; i += NGT) { const int t = i >> 4, j = i & 15; const float pos = (float)(j < 8 ? (t >> 6) : (t & 63));
        const float inv = powf(10000.0f, -(float)(j & 7) / 8.0f); const float ang = pos * inv;
        ((float*)(ws + WS_ROPE))[i] = cosf(ang); ((float*)(ws + WS_ROPE))[4096 * 16 + i] = sinf(ang); }
}

__device__ __forceinline__ void p0_mod(const Frame& F, const Args& a) {
    LAS float* sc = (LAS float*)F.lds;
    LAS float* part = sc + 9 * 1024;
    float* mod = (float*)(F.ws + WS_MOD);
    bool have = false;
    __syncthreads();
    for (int it = blockIdx.x; it < 2 * 96; it += F.G) {
        if (!have) { for (int i = F.tid; i < 9 * 1024; i += 512) { const int j = i >> 10, k = i & 1023; const float c = j < 8 ? a.in[I_C][j * 1024 + k] : a.in[I_CCTX][k]; sc[i] = siluf(c); } have = true; }
        __syncthreads();
        const int l = it / 96, cb = it % 96, col = F.tid & 63, kq = F.tid >> 6;
        const float* W = a.in[I_ADAW] + (size_t)l * 1024 * 6144 + cb * 64 + col;
        float acc[9];
#pragma unroll
        for (int j = 0; j < 9; ++j) acc[j] = 0.f;
        for (int k = kq * 128; k < kq * 128 + 128; ++k) { const float w = W[(size_t)k * 6144];
#pragma unroll
            for (int j = 0; j < 9; ++j) acc[j] += sc[j * 1024 + k] * w; }
#pragma unroll
        for (int j = 0; j < 9; ++j) part[(kq * 9 + j) * 64 + col] = acc[j];
        __syncthreads();
        for (int i = F.tid; i < 9 * 64; i += 512) { const int j = i >> 6, c2 = i & 63; float s = a.in[I_ADAB][l * 6144 + cb * 64 + c2];
#pragma unroll
            for (int q = 0; q < 8; ++q) s += part[(q * 9 + j) * 64 + c2];
            mod[((size_t)l * 9 + j) * 6144 + cb * 64 + c2] = s; }
    }
    __syncthreads();
}

__device__ __forceinline__ void p0_filters(const Frame& F, const Args& a) {
    LAS float* z = (LAS float*)F.lds;
    LAS float* h1 = z + 32 * 36;
    LAS float* h2 = h1 + 32 * 64;
    float* fsp = (float*)(F.ws + WS_FS);
    for (int it = blockIdx.x; it < 128 + 128 + 8; it += F.G) {
        const int set = it < 128 ? 0 : (it < 256 ? 1 : 2), tt = it < 256 ? (it & 127) : it - 256;
        const int l = set == 2 ? 0 : set, L = set == 2 ? 256 : 4096, t0 = tt * 32;
        const float* w1 = a.in[I_HFW1] + l * 33 * 64; const float* b1 = a.in[I_HFB1] + l * 64; const float* fr = a.in[I_HFFREQ] + l * 64;
        const float* w2 = a.in[I_HFW2] + l * 64 * 64; const float* b2 = a.in[I_HFB2] + l * 64; const float* w3 = a.in[I_HFW3] + (size_t)l * 64 * 1024;
        __syncthreads();
        { const int tl = F.tid >> 4, f = F.tid & 15, tg = t0 + tl;
          const float fb = 1e-4f + (float)f * ((15.0f - 1e-4f) / 15.0f); const float w = 6.283185307179586f * (float)tg / (float)L;
          const float ang = fb * w; z[tl * 36 + 1 + f] = cosf(ang); z[tl * 36 + 17 + f] = -sinf(ang);
          if (f == 0) z[tl * 36] = (float)tg / (float)(L - 1); }
        __syncthreads();
        { const int tl = F.tid >> 4, j0 = (F.tid & 15) * 4;
#pragma unroll
          for (int jj = 0; jj < 4; ++jj) { const int j = j0 + jj; float s = b1[j]; for (int i = 0; i < 33; ++i) s += z[tl * 36 + i] * w1[i * 64 + j]; h1[tl * 64 + j] = sinf(fr[j] * s); } }
        __syncthreads();
        { const int tl = F.tid >> 4, j0 = (F.tid & 15) * 4;
#pragma unroll
          for (int jj = 0; jj < 4; ++jj) { const int j = j0 + jj; float s = b2[j]; for (int i = 0; i < 64; ++i) s += h1[tl * 64 + i] * w2[i * 64 + j]; h2[tl * 64 + j] = sinf(fr[j] * s); } }
        __syncthreads();
#pragma unroll 1
        for (int o = 0; o < 2; ++o) {
            const int col = o * 512 + F.tid, dir = F.tid >> 8, c = F.tid & 255;
            float acc[32];
#pragma unroll
            for (int t = 0; t < 32; ++t) acc[t] = 0.f;
            for (int k = 0; k < 64; ++k) { const float w = w3[(size_t)k * 1024 + col];
#pragma unroll
                for (int t = 0; t < 32; ++t) acc[t] += h2[t * 64 + k] * w; }
            const float lo = -3.0701134573253945f, hi = -15.350567286626972f;
            const float delta = fabsf(lo + (float)c * ((hi - lo) / 255.0f));
            float asum = 0.f;
            if (set < 2) {
                bf16* Gp = (bf16*)(F.ws + WS_G) + ((size_t)(set * 2 + o) * 256 + c) * GLEN;
#pragma unroll
                for (int t = 0; t < 32; ++t) { const int tg = t0 + t; const float v = acc[t] * __expf(-z[t * 36] * delta);
                    if (dir == 0) { asum += fabsf(v); Gp[GC - tg] = (bf16)f2bf(v); } else if (tg >= 1) { asum += fabsf(v); Gp[GC + tg] = (bf16)f2bf(v); } }
            } else {
                float* Tp = (float*)(F.ws + WS_TC) + ((size_t)o * 256 + c) * 512;
#pragma unroll
                for (int t = 0; t < 32; ++t) { const int tg = t0 + t; const float v = acc[t] * __expf(-z[t * 36] * delta);
                    if (dir == 0) { asum += fabsf(v); Tp[256 + tg] = v; } else if (tg >= 1) { asum += fabsf(v); Tp[256 - tg] = v; } }
            }
            fsp[((size_t)set * 128 + tt) * 1024 + col] = asum;
        }
    }
    __syncthreads();
}
__device__ __forceinline__ void norm_mod_row(const float* xrow, const float* g, const float* sc, const float* sh, bf16* orow, int lane) {
    const f32x4* xr = (const f32x4*)xrow + lane;
    f32x4 v[4]; float s = 0.f;
#pragma unroll
    for (int j = 0; j < 4; ++j) { v[j] = xr[64 * j]; s += (v[j].x * v[j].x + v[j].y * v[j].y) + (v[j].z * v[j].z + v[j].w * v[j].w); }
    const float rstd = 1.f / sqrtf(wave_sum(s) * (1.f / 1024.f) + EPS);
    unsigned long long* o8 = (unsigned long long*)orow + lane;
#pragma unroll
    for (int j = 0; j < 4; ++j) { const int k = 4 * lane + 256 * j; const f32x4 gg = *(const f32x4*)(g + k), cc = *(const f32x4*)(sc + k), hh = *(const f32x4*)(sh + k);
        const f32x4 y = v[j] * rstd * gg * (cc + 1.f) + hh;
        o8[64 * j] = (unsigned long long)pk2(y.x, y.y) | ((unsigned long long)pk2(y.z, y.w) << 32); }
}
__device__ __forceinline__ void p1_norm(const Frame& F, const Args& a, int layer, const float* xlat, const float* xctx) {
    const float* mod = (const float*)(F.ws + WS_MOD) + (size_t)layer * 9 * 6144; const float* g = a.in[I_N1G] + layer * 1024; bf16* H = (bf16*)(F.ws + WS_H);
    for (int r = F.gw; r < NTOK; r += F.NGW) {
        const float* xr = r < NLAT ? xlat + (size_t)r * 1024 : xctx + (size_t)(r - NLAT) * 1024; const float* m = mod + (size_t)mod_idx(r) * 6144;
        norm_mod_row(xr, g, m + 1024, m, H + (size_t)r * 1024, F.lane);
    }
}

__device__ __forceinline__ void p7_router(const Frame& F, const Args& a, int layer, const float* xlat, const float* xctx, int nrows) {
    const float* mod = (const float*)(F.ws + WS_MOD) + (size_t)layer * 9 * 6144; const float* g = a.in[I_N2G] + layer * 1024; bf16* H = (bf16*)(F.ws + WS_H);
    LAS float* wr = (LAS float*)F.lds;
    LAS int* rb = (LAS int*)(F.lds + 65536);
    LAS float* rlo = (LAS float*)(F.lds + 65536 + 1024);
    LAS float* rhi = (LAS float*)(F.lds + 65536 + 2048);
    LAS int* bcnt = (LAS int*)(F.lds + 65536 + 3072);
    for (int i = F.tid; i < 1024 * 16 / 4; i += 512) ((LAS f32x4*)wr)[i] = ((const f32x4*)a.in[I_WROUTER])[i];
    if (F.tid < 64) bcnt[F.tid] = 0;
    __syncthreads();
    const int per = (nrows + F.G - 1) / F.G;
    const int r0 = blockIdx.x * per, r1 = min(r0 + per, nrows);
    for (int r = r0 + F.wave; r < r1; r += 8) {
        const float* xr = r < NLAT ? xlat + (size_t)r * 1024 : xctx + (size_t)(r - NLAT) * 1024; const float* m = mod + (size_t)mod_idx(r) * 6144;
        const f32x4* x4 = (const f32x4*)xr + F.lane;
        f32x4 v[4]; float s = 0.f;
#pragma unroll
        for (int j = 0; j < 4; ++j) { v[j] = x4[64 * j]; s += (v[j].x * v[j].x + v[j].y * v[j].y) + (v[j].z * v[j].z + v[j].w * v[j].w); }
        const float rstd = 1.f / sqrtf(wave_sum(s) * (1.f / 1024.f) + EPS);
        float lg[16];
#pragma unroll
        for (int e = 0; e < 16; ++e) lg[e] = 0.f;
        unsigned long long* o8 = (unsigned long long*)(H + (size_t)r * 1024) + F.lane;
#pragma unroll
        for (int j = 0; j < 4; ++j) { const int k = 4 * F.lane + 256 * j; const f32x4 gg = *(const f32x4*)(g + k), cc = *(const f32x4*)(m + 4 * 1024 + k), hh = *(const f32x4*)(m + 3 * 1024 + k);
            const f32x4 y = v[j] * rstd * gg * (cc + 1.f) + hh;
            o8[64 * j] = (unsigned long long)pk2(y.x, y.y) | ((unsigned long long)pk2(y.z, y.w) << 32);
#pragma unroll
            for (int q = 0; q < 4; ++q) { const LAS f32x4* w4 = (const LAS f32x4*)(wr + (k + q) * 16);
#pragma unroll
                for (int e4 = 0; e4 < 4; ++e4) { const f32x4 w = w4[e4]; lg[4 * e4] += y[q] * w.x; lg[4 * e4 + 1] += y[q] * w.y; lg[4 * e4 + 2] += y[q] * w.z; lg[4 * e4 + 3] += y[q] * w.w; } } }
#pragma unroll
        for (int e = 0; e < 16; ++e) lg[e] = wave_sum(lg[e]);
        if (F.lane == 0) {
            float sg[16], sel[16];
#pragma unroll
            for (int e = 0; e < 16; ++e) { sg[e] = sigmf(lg[e]); sel[e] = sg[e] + a.in[I_RBIAS][e]; }
            int best = 0; float bs = -1e30f;
#pragma unroll
            for (int gi = 0; gi < 4; ++gi) { float m1 = -1e30f, m2 = -1e30f;
#pragma unroll
                for (int q = 0; q < 4; ++q) { const float x = sel[gi * 4 + q]; if (x > m1) { m2 = m1; m1 = x; } else if (x > m2) m2 = x; }
                const float sc2 = m1 + m2; if (sc2 > bs) { bs = sc2; best = gi; } }
            int i1 = 0, i2 = 0; float m1 = -1e30f, m2 = -1e30f;
#pragma unroll
            for (int q = 0; q < 4; ++q) { float x = -1e30f;
#pragma unroll
                for (int gi = 0; gi < 4; ++gi) x = (gi == best) ? sel[gi * 4 + q] : x;
                if (x > m1) { m2 = m1; i2 = i1; m1 = x; i1 = q; } else if (x > m2) { m2 = x; i2 = q; } }
            float s1 = 0.f, s2 = 0.f;
#pragma unroll
            for (int e = 0; e < 16; ++e) { s1 = (e == best * 4 + i1) ? sg[e] : s1; s2 = (e == best * 4 + i2) ? sg[e] : s2; }
            const float inv = 1.f / (s1 + s2); const float w1 = s1 * inv, w2 = s2 * inv;
            const int lo = i1 < i2 ? i1 : i2, hi = i1 < i2 ? i2 : i1; const float wl = i1 < i2 ? w1 : w2, wh = i1 < i2 ? w2 : w1;
            const int p = lo == 0 ? hi - 1 : (lo == 1 ? hi + 1 : 5);
            const int lr = r - r0; rb[lr] = best * 6 + p; rlo[lr] = wl; rhi[lr] = wh;
        }
    }
    __syncthreads();
    const int n = r1 - r0;
    int myslot = -1, myb = 0;
    if (F.tid < n) { myb = rb[F.tid]; myslot = atomicAdd((int*)&bcnt[myb], 1); }
    __syncthreads();
    if (F.tid < NBUCKET) { const int c = bcnt[F.tid]; bcnt[32 + F.tid] = c > 0 ? (int)atomicAdd(F.ctl + CW_CNT + layer * 32 + F.tid, (unsigned)c) : 0; }
    __syncthreads();
    if (F.tid < n) { const size_t p = (size_t)myb * NTOK + bcnt[32 + myb] + myslot;
        ((int*)(F.ws + WS_TOK))[p] = r0 + F.tid; ((float*)(F.ws + WS_WLO))[p] = rlo[F.tid]; ((float*)(F.ws + WS_WHI))[p] = rhi[F.tid]; }
    __syncthreads();
}

__device__ __forceinline__ void p_final(const Frame& F, const Args& a) {
    const float* g = a.in[I_FNG];
    for (int r = F.gw; r < NLAT; r += F.NGW) {
        f32x4* xr = (f32x4*)(a.out + (size_t)r * 1024) + F.lane;
        f32x4 v[4]; float s = 0.f;
#pragma unroll
        for (int j = 0; j < 4; ++j) { v[j] = xr[64 * j]; s += (v[j].x * v[j].x + v[j].y * v[j].y) + (v[j].z * v[j].z + v[j].w * v[j].w); }
        const float rstd = 1.f / sqrtf(wave_sum(s) * (1.f / 1024.f) + EPS);
#pragma unroll
        for (int j = 0; j < 4; ++j) { const f32x4 gg = *(const f32x4*)(g + 4 * F.lane + 256 * j); xr[64 * j] = v[j] * rstd * gg; }
    }
}
__device__ __forceinline__ f32x4 mfma16(bf16x8 a, bf16x8 b, f32x4 c) { return __builtin_amdgcn_mfma_f32_16x16x32_bf16(a, b, c, 0, 0, 0); }
__device__ __forceinline__ void row_bk(int r, int& b, int& key, bool& lat) { lat = r < NLAT; if (lat) { b = r >> 12; key = r & 4095; } else { const int rc = r - NLAT; b = rc >> 8; key = 4096 + (rc & 255); } }

__device__ __forceinline__ void p3_mla_unit(const Frame& F, const Args& a, int layer, int r0) {
    LAS float* Xq = (LAS float*)F.lds;
    LAS float* Xkv = (LAS float*)(F.lds + 49152);
    LAS bf16* Aq = (LAS bf16*)(F.lds + 90112);
    LAS bf16* Akv = (LAS bf16*)(F.lds + 115712);
    LAS bf16* Kr = (LAS bf16*)(F.lds + 133120);
    const bf16* proj = (const bf16*)(F.ws + WS_PROJ);
    int b0, key0; bool lat; row_bk(r0, b0, key0, lat);
    __syncthreads();
    for (int i = F.tid; i < 64 * 24; i += 512) { const int r = i / 24, c8 = i % 24; const u32x4 w = *(const u32x4*)(proj + (size_t)(r0 + r) * PROJ_LD + PJ_MQ + c8 * 8); LAS float* d = Xq + r * 192 + c8 * 8;
        d[0] = lo_bf(w.x); d[1] = hi_bf(w.x); d[2] = lo_bf(w.y); d[3] = hi_bf(w.y); d[4] = lo_bf(w.z); d[5] = hi_bf(w.z); d[6] = lo_bf(w.w); d[7] = hi_bf(w.w); }
    for (int i = F.tid; i < 64 * 20; i += 512) { const int r = i / 20, c8 = i % 20; const u32x4 w = *(const u32x4*)(proj + (size_t)(r0 + r) * PROJ_LD + PJ_MKV + c8 * 8); LAS float* d = Xkv + r * 160 + c8 * 8;
        d[0] = lo_bf(w.x); d[1] = hi_bf(w.x); d[2] = lo_bf(w.y); d[3] = hi_bf(w.y); d[4] = lo_bf(w.z); d[5] = hi_bf(w.z); d[6] = lo_bf(w.w); d[7] = hi_bf(w.w); }
    __syncthreads();
    const float* qg = a.in[I_QANORM] + layer * 192; const float* kg = a.in[I_KVANORM] + layer * 128;
    for (int r = F.wave; r < 64; r += 8) {
        const float q0 = Xq[r * 192 + F.lane], q1 = Xq[r * 192 + 64 + F.lane], q2 = Xq[r * 192 + 128 + F.lane];
        const float rq = 1.f / sqrtf(wave_sum(q0 * q0 + q1 * q1 + q2 * q2) * (1.f / 192.f) + EPS);
        Aq[r * 200 + F.lane] = (bf16)f2bf(q0 * rq * qg[F.lane]); Aq[r * 200 + 64 + F.lane] = (bf16)f2bf(q1 * rq * qg[64 + F.lane]); Aq[r * 200 + 128 + F.lane] = (bf16)f2bf(q2 * rq * qg[128 + F.lane]);
        const float k0 = Xkv[r * 160 + F.lane], k1 = Xkv[r * 160 + 64 + F.lane];
        const float rk = 1.f / sqrtf(wave_sum(k0 * k0 + k1 * k1) * (1.f / 128.f) + EPS);
        Akv[r * 136 + F.lane] = (bf16)f2bf(k0 * rk * kg[F.lane]); Akv[r * 136 + 64 + F.lane] = (bf16)f2bf(k1 * rk * kg[64 + F.lane]);
    }
    const float* ropec = (const float*)(F.ws + WS_ROPE); const float* ropes = ropec + 4096 * 16;
    for (int i = F.tid; i < 64 * 16; i += 512) { const int r = i >> 4, j = i & 15; const float x1 = Xkv[r * 160 + 128 + j], x2 = Xkv[r * 160 + 144 + j];
        float cs = 1.f, sn = 0.f; if (lat) { cs = ropec[(key0 + r) * 16 + j]; sn = ropes[(key0 + r) * 16 + j]; }
        Kr[r * 32 + j] = (bf16)f2bf(x1 * cs - x2 * sn); Kr[r * 32 + 16 + j] = (bf16)f2bf(x1 * sn + x2 * cs); }
    __syncthreads();
    const int h = F.wave >> 1, rh = F.wave & 1, lr = F.lane & 15, lq = F.lane >> 4;
    {
        const bf16* W = (const bf16*)(F.ws + WS_WUQ) + (size_t)layer * 384 * 192;
        f32x4 acc[2][6];
#pragma unroll
        for (int mt = 0; mt < 2; ++mt)
#pragma unroll
            for (int nt = 0; nt < 6; ++nt) acc[mt][nt] = (f32x4){0.f, 0.f, 0.f, 0.f};
#pragma unroll 1
        for (int ks = 0; ks < 6; ++ks) {
            bf16x8 af[2], bfr[6];
#pragma unroll
            for (int mt = 0; mt < 2; ++mt) af[mt] = *(const LAS bf16x8*)(Aq + (rh * 32 + mt * 16 + lr) * 200 + ks * 32 + lq * 8);
#pragma unroll
            for (int nt = 0; nt < 6; ++nt) bfr[nt] = *(const bf16x8*)(W + (size_t)(h * 96 + nt * 16 + lr) * 192 + ks * 32 + lq * 8);
#pragma unroll
            for (int mt = 0; mt < 2; ++mt)
#pragma unroll
                for (int nt = 0; nt < 6; ++nt) acc[mt][nt] = mfma16(bfr[nt], af[mt], acc[mt][nt]);
        }
        bf16* Q = (bf16*)(F.ws + WS_Q);
#pragma unroll
        for (int mt = 0; mt < 2; ++mt) { const int tl = rh * 32 + mt * 16 + lr;
            if (lat) {
#pragma unroll
                for (int j = 0; j < 4; ++j) { const float cs = ropec[(key0 + tl) * 16 + lq * 4 + j], sn = ropes[(key0 + tl) * 16 + lq * 4 + j]; const float x1 = acc[mt][4][j], x2 = acc[mt][5][j];
                    acc[mt][4][j] = x1 * cs - x2 * sn; acc[mt][5][j] = x1 * sn + x2 * cs; } }
#pragma unroll
            for (int nt = 0; nt < 6; ++nt) { u32x2 w; w.x = pk2(acc[mt][nt][0] * QSCALE, acc[mt][nt][1] * QSCALE); w.y = pk2(acc[mt][nt][2] * QSCALE, acc[mt][nt][3] * QSCALE);
                *(u32x2*)(Q + (size_t)(r0 + tl) * 384 + h * 96 + nt * 16 + lq * 4) = w; } }
    }
    {
        const bf16* W = (const bf16*)(F.ws + WS_WUKV) + (size_t)layer * 512 * 128;
        f32x4 ak[2][4], av[2][4];
#pragma unroll
        for (int mt = 0; mt < 2; ++mt)
#pragma unroll
            for (int nt = 0; nt < 4; ++nt) { ak[mt][nt] = (f32x4){0.f, 0.f, 0.f, 0.f}; av[mt][nt] = (f32x4){0.f, 0.f, 0.f, 0.f}; }
#pragma unroll 1
        for (int ks = 0; ks < 4; ++ks) {
            bf16x8 af[2], bk[4], bv[4];
#pragma unroll
            for (int mt = 0; mt < 2; ++mt) af[mt] = *(const LAS bf16x8*)(Akv + (rh * 32 + mt * 16 + lr) * 136 + ks * 32 + lq * 8);
#pragma unroll
            for (int nt = 0; nt < 4; ++nt) { bk[nt] = *(const bf16x8*)(W + (size_t)(h * 128 + nt * 16 + lr) * 128 + ks * 32 + lq * 8); bv[nt] = *(const bf16x8*)(W + (size_t)(h * 128 + 64 + nt * 16 + lr) * 128 + ks * 32 + lq * 8); }
#pragma unroll
            for (int mt = 0; mt < 2; ++mt)
#pragma unroll
                for (int nt = 0; nt < 4; ++nt) { ak[mt][nt] = mfma16(bk[nt], af[mt], ak[mt][nt]); av[mt][nt] = mfma16(af[mt], bv[nt], av[mt][nt]); }
        }
        bf16* Kg = (bf16*)(F.ws + WS_K) + ((size_t)(b0 * 4 + h) * NKEY + key0) * 96;
        bf16* Vt = (bf16*)(F.ws + WS_VT) + (size_t)(b0 * 4 + h) * 64 * NKEY + key0;
#pragma unroll
        for (int mt = 0; mt < 2; ++mt)
#pragma unroll
            for (int nt = 0; nt < 4; ++nt) {
                u32x2 w; w.x = pk2(ak[mt][nt][0], ak[mt][nt][1]); w.y = pk2(ak[mt][nt][2], ak[mt][nt][3]);
                *(u32x2*)(Kg + (size_t)(rh * 32 + mt * 16 + lr) * 96 + nt * 16 + lq * 4) = w;
                u32x2 v; v.x = pk2(av[mt][nt][0], av[mt][nt][1]); v.y = pk2(av[mt][nt][2], av[mt][nt][3]);
                *(u32x2*)(Vt + (size_t)(nt * 16 + lr) * NKEY + rh * 32 + mt * 16 + lq * 4) = v; }
    }
    {
        for (int i = F.tid; i < 64 * 4 * 4; i += 512) { const int r = i >> 4, hh = (i >> 2) & 3, c8 = i & 3;
            *(u32x4*)((bf16*)(F.ws + WS_K) + ((size_t)(b0 * 4 + hh) * NKEY + key0 + r) * 96 + 64 + c8 * 8) = *(const LAS u32x4*)(Kr + r * 32 + c8 * 8); }
    }
}

__device__ __forceinline__ void p3_conv_unit(const Frame& F, const Args& a, int layer, int r0) {
    LAS float* U = (LAS float*)F.lds;
    const bf16* proj = (const bf16*)(F.ws + WS_PROJ);
    const bool lat = r0 < NLAT; const int Ls = lat ? SEQ : CTXL; const int t0 = lat ? (r0 & 4095) : ((r0 - NLAT) & 255);
    __syncthreads();
    for (int i = F.tid; i < 94 * 32; i += 512) { const int rr = i >> 5, c8 = i & 31; const int t = t0 - 15 + rr; LAS float* d = U + rr * 256 + c8 * 8;
        if (t >= 0 && t < Ls) { const bf16* p = proj + (size_t)(r0 - 15 + rr) * PROJ_LD + PJ_CV + c8 * 8; const u32x4 wa = *(const u32x4*)p, wb = *(const u32x4*)(p + 256);
            d[0] = lo_bf(wa.x) * sigmf(lo_bf(wb.x)); d[1] = hi_bf(wa.x) * sigmf(hi_bf(wb.x)); d[2] = lo_bf(wa.y) * sigmf(lo_bf(wb.y)); d[3] = hi_bf(wa.y) * sigmf(hi_bf(wb.y));
            d[4] = lo_bf(wa.z) * sigmf(lo_bf(wb.z)); d[5] = hi_bf(wa.z) * sigmf(hi_bf(wb.z)); d[6] = lo_bf(wa.w) * sigmf(lo_bf(wb.w)); d[7] = hi_bf(wa.w) * sigmf(hi_bf(wb.w)); }
        else {
#pragma unroll
            for (int j = 0; j < 8; ++j) d[j] = 0.f; } }
    __syncthreads();
    const int c = F.tid & 255, th = F.tid >> 8;
    float o[32];
    { const float* w = a.in[I_CVW] + (size_t)layer * 31 * 256 + c; const float bias = a.in[I_CVB][layer * 256 + c];
#pragma unroll
      for (int t = 0; t < 32; ++t) o[t] = bias;
#pragma unroll 1
      for (int k = 0; k < 31; ++k) { const float wk = w[k * 256];
#pragma unroll
          for (int t = 0; t < 32; ++t) o[t] += U[(th * 32 + t + k) * 256 + c] * wk; } }
    __syncthreads();
#pragma unroll
    for (int t = 0; t < 32; ++t) U[(th * 32 + t) * 256 + c] = o[t];
    __syncthreads();
    const float* lg = a.in[I_CVLNG] + layer * 256; const float* lb = a.in[I_CVLNB] + layer * 256; const float* mg = a.in[I_MIXG] + layer * 1024 + 512;
    bf16* Y = (bf16*)(F.ws + WS_H);
    for (int r = F.wave; r < 64; r += 8) {
        const f32x4 v = *(const LAS f32x4*)(U + r * 256 + 4 * F.lane);
        float s = (v.x + v.y) + (v.z + v.w);
#pragma unroll
        for (int o2 = 1; o2 < 16; o2 <<= 1) s += __shfl_xor(s, o2);
        const float mean = s * (1.f / 64.f); const f32x4 d = v - mean; float q = (d.x * d.x + d.y * d.y) + (d.z * d.z + d.w * d.w);
#pragma unroll
        for (int o2 = 1; o2 < 16; o2 <<= 1) q += __shfl_xor(q, o2);
        const float rstd = 1.f / sqrtf(q * (1.f / 64.f) + EPS);
        const f32x4 gg = *(const f32x4*)(lg + 4 * F.lane), bb = *(const f32x4*)(lb + 4 * F.lane);
        f32x4 y = d * rstd * gg + bb; y.x = siluf(y.x); y.y = siluf(y.y); y.z = siluf(y.z); y.w = siluf(y.w);
        const float ss = wave_sum((y.x * y.x + y.y * y.y) + (y.z * y.z + y.w * y.w)); const float rn = 1.f / sqrtf(ss * (1.f / 256.f) + EPS);
        const f32x4 m4 = *(const f32x4*)(mg + 4 * F.lane); y = y * rn * m4;
        u32x2 w; w.x = pk2(y.x, y.y); w.y = pk2(y.z, y.w);
        *(u32x2*)(Y + (size_t)(r0 + r) * 1024 + 512 + 4 * F.lane) = w;
    }
}

__device__ __forceinline__ void p3_gmlp_unit(const Frame& F, const Args& a, int layer, int r0) {
    LAS bf16* vT = (LAS bf16*)F.lds;
    LAS float* red = (LAS float*)(F.lds + 69632);
    const bf16* proj = (const bf16*)(F.ws + WS_PROJ);
    const float* lg = a.in[I_GMLNG] + layer * 256; const float* lb = a.in[I_GMLNB] + layer * 256;
    __syncthreads();
    for (int r = F.wave; r < 128; r += 8) {
        const u32x2 w = *(const u32x2*)(proj + (size_t)(r0 + r) * PROJ_LD + PJ_GM + 256 + 4 * F.lane);
        f32x4 v; v.x = gelu_tanh(lo_bf(w.x)); v.y = gelu_tanh(hi_bf(w.x)); v.z = gelu_tanh(lo_bf(w.y)); v.w = gelu_tanh(hi_bf(w.y));
        const float mean = wave_sum((v.x + v.y) + (v.z + v.w)) * (1.f / 256.f); const f32x4 d = v - mean;
        const float rstd = 1.f / sqrtf(wave_sum((d.x * d.x + d.y * d.y) + (d.z * d.z + d.w * d.w)) * (1.f / 256.f) + EPS);
        const f32x4 gg = *(const f32x4*)(lg + 4 * F.lane), bb = *(const f32x4*)(lb + 4 * F.lane); const f32x4 y = d * rstd * gg + bb;
        vT[(4 * F.lane + 0) * 136 + r] = (bf16)f2bf(y.x); vT[(4 * F.lane + 1) * 136 + r] = (bf16)f2bf(y.y); vT[(4 * F.lane + 2) * 136 + r] = (bf16)f2bf(y.z); vT[(4 * F.lane + 3) * 136 + r] = (bf16)f2bf(y.w);
    }
    __syncthreads();
    const int g = F.wave >> 1, ih = F.wave & 1, lr = F.lane & 15, lq = F.lane >> 4;
    const bf16* W = (const bf16*)(F.ws + WS_GMWS) + (size_t)(layer * 4 + g) * 128 * 128;
    f32x4 acc[4][4];
#pragma unroll
    for (int dt = 0; dt < 4; ++dt)
#pragma unroll
        for (int it = 0; it < 4; ++it) acc[dt][it] = (f32x4){0.f, 0.f, 0.f, 0.f};
#pragma unroll 1
    for (int ks = 0; ks < 4; ++ks) {
        bf16x8 af[4], bfr[4];
#pragma unroll
        for (int dt = 0; dt < 4; ++dt) af[dt] = *(const LAS bf16x8*)(vT + (g * 64 + dt * 16 + lr) * 136 + ks * 32 + lq * 8);
#pragma unroll
        for (int it = 0; it < 4; ++it) bfr[it] = *(const bf16x8*)(W + (size_t)(ih * 64 + it * 16 + lr) * 128 + ks * 32 + lq * 8);
#pragma unroll
        for (int dt = 0; dt < 4; ++dt)
#pragma unroll
            for (int it = 0; it < 4; ++it) acc[dt][it] = mfma16(af[dt], bfr[it], acc[dt][it]);
    }
    const float* bs = a.in[I_GMBS] + (size_t)(layer * 4 + g) * 128;
#pragma unroll
    for (int it = 0; it < 4; ++it) { const int i = ih * 64 + it * 16 + lr; const float bsi = bs[i]; float ss = 0.f;
#pragma unroll
        for (int dt = 0; dt < 4; ++dt) { const u32x2 w = *(const u32x2*)(proj + (size_t)(r0 + i) * PROJ_LD + PJ_GM + g * 64 + dt * 16 + 4 * lq);
            f32x4 u; u.x = gelu_tanh(lo_bf(w.x)); u.y = gelu_tanh(hi_bf(w.x)); u.z = gelu_tanh(lo_bf(w.y)); u.w = gelu_tanh(hi_bf(w.y));
            const f32x4 y = u * (acc[dt][it] + bsi); acc[dt][it] = y; ss += (y.x * y.x + y.y * y.y) + (y.z * y.z + y.w * y.w); }
        ss += __shfl_xor(ss, 16); ss += __shfl_xor(ss, 32);
        if (lq == 0) red[g * 128 + i] = ss; }
    __syncthreads();
    const float* mg = a.in[I_MIXG] + layer * 1024 + 256; bf16* Y = (bf16*)(F.ws + WS_H);
#pragma unroll
    for (int it = 0; it < 4; ++it) { const int i = ih * 64 + it * 16 + lr; const float rn = 1.f / sqrtf((red[i] + red[128 + i] + red[256 + i] + red[384 + i]) * (1.f / 256.f) + EPS);
#pragma unroll
        for (int dt = 0; dt < 4; ++dt) { const int col = g * 64 + dt * 16 + 4 * lq; const f32x4 m4 = *(const f32x4*)(mg + col); const f32x4 y = acc[dt][it] * rn * m4;
            u32x2 w; w.x = pk2(y.x, y.y); w.y = pk2(y.z, y.w); *(u32x2*)(Y + (size_t)(r0 + i) * 1024 + 256 + col) = w; } }
}
__device__ __forceinline__ f32x16 mfma32(bf16x8 a, bf16x8 b, f32x16 c) { return __builtin_amdgcn_mfma_f32_32x32x16_bf16(a, b, c, 0, 0, 0); }
__device__ __forceinline__ bf16x8 pack8(float a0, float a1, float a2, float a3, float a4, float a5, float a6, float a7) {
    u32x4 w; w.x = pg8::cvt_pk_bf16(a0, a1); w.y = pg8::cvt_pk_bf16(a2, a3); w.z = pg8::cvt_pk_bf16(a4, a5); w.w = pg8::cvt_pk_bf16(a6, a7); return __builtin_bit_cast(bf16x8, w); }

constexpr int AT_KROW = 104, AT_VROW = 72, AT_KB = 64 * AT_KROW * 2, AT_VB = 64 * AT_VROW * 2;
__device__ __forceinline__ void attn_unit(const Frame& F, int b, int h, int qrow0, int key0, int ntile) {
    LAS unsigned char* L = F.lds;
    const bf16* Kg = (const bf16*)(F.ws + WS_K) + ((size_t)(b * 4 + h) * NKEY + key0) * 96;
    const bf16* Vg = (const bf16*)(F.ws + WS_VT) + (size_t)(b * 4 + h) * 64 * NKEY + key0;
    const bf16* Q = (const bf16*)(F.ws + WS_Q);
    const int lane = F.lane, hi = lane >> 5, l31 = lane & 31;
    const int qrow = qrow0 + F.wave * 32 + l31;
    bf16x8 qf[6];
#pragma unroll
    for (int ks = 0; ks < 6; ++ks) qf[ks] = *(const bf16x8*)(Q + (size_t)qrow * 384 + h * 96 + ks * 16 + hi * 8);
    const int kr0 = F.tid / 12, kc0 = F.tid % 12, kr1 = (F.tid + 512) / 12, kc1 = (F.tid + 512) % 12; const bool k2 = F.tid < 256;
    const int vd = F.tid >> 3, vc = F.tid & 7;
    u32x4 sk0, sk1 = (u32x4){0u, 0u, 0u, 0u}, sv;
    __syncthreads();
    sk0 = *(const u32x4*)(Kg + (size_t)kr0 * 96 + kc0 * 8); if (k2) sk1 = *(const u32x4*)(Kg + (size_t)kr1 * 96 + kc1 * 8); sv = *(const u32x4*)(Vg + (size_t)vd * NKEY + vc * 8);
    *(LAS u32x4*)(L + kr0 * (AT_KROW * 2) + kc0 * 16) = sk0; if (k2) *(LAS u32x4*)(L + kr1 * (AT_KROW * 2) + kc1 * 16) = sk1; *(LAS u32x4*)(L + 2 * AT_KB + vd * (AT_VROW * 2) + vc * 16) = sv;
    __syncthreads();
    const int prow = (l31 & ~12) | ((l31 & 4) << 1) | ((l31 & 8) >> 1);
    const int koff = prow * (AT_KROW * 2) + hi * 16, voff = l31 * (AT_VROW * 2) + hi * 16;
    f32x16 O0, O1;
#pragma unroll
    for (int r = 0; r < 16; ++r) { O0[r] = 0.f; O1[r] = 0.f; }
    float m = -1e30f, l = 0.f;
    for (int j = 0; j < ntile; ++j) {
        const int buf = j & 1; const bool pre = j + 1 < ntile;
        if (pre) { const bf16* kg = Kg + (size_t)(j + 1) * 64 * 96; const bf16* vg = Vg + (j + 1) * 64;
            sk0 = *(const u32x4*)(kg + (size_t)kr0 * 96 + kc0 * 8); if (k2) sk1 = *(const u32x4*)(kg + (size_t)kr1 * 96 + kc1 * 8); sv = *(const u32x4*)(vg + (size_t)vd * NKEY + vc * 8); }
        const LAS unsigned char* Kt = L + buf * AT_KB; const LAS unsigned char* Vt = L + 2 * AT_KB + buf * AT_VB;
        f32x16 S0, S1;
#pragma unroll
        for (int r = 0; r < 16; ++r) { S0[r] = 0.f; S1[r] = 0.f; }
#pragma unroll
        for (int ks = 0; ks < 6; ++ks) { const bf16x8 k0 = *(const LAS bf16x8*)(Kt + koff + ks * 32), k1 = *(const LAS bf16x8*)(Kt + 32 * (AT_KROW * 2) + koff + ks * 32);
            S0 = mfma32(k0, qf[ks], S0); S1 = mfma32(k1, qf[ks], S1); }
        float mx = S0[0];
#pragma unroll
        for (int r = 1; r < 16; ++r) mx = fmaxf(mx, S0[r]);
#pragma unroll
        for (int r = 0; r < 16; ++r) mx = fmaxf(mx, S1[r]);
        mx = fmaxf(mx, __shfl_xor(mx, 32));
        const float mn = fmaxf(m, mx), alpha = __builtin_amdgcn_exp2f(m - mn); m = mn;
        float sum = 0.f;
#pragma unroll
        for (int r = 0; r < 16; ++r) { S0[r] = __builtin_amdgcn_exp2f(S0[r] - mn); S1[r] = __builtin_amdgcn_exp2f(S1[r] - mn); sum += S0[r] + S1[r]; }
        sum += __shfl_xor(sum, 32); l = l * alpha + sum;
#pragma unroll
        for (int r = 0; r < 16; ++r) { O0[r] *= alpha; O1[r] *= alpha; }
        bf16x8 pf[4];
        pf[0] = pack8(S0[0], S0[1], S0[2], S0[3], S0[4], S0[5], S0[6], S0[7]); pf[1] = pack8(S0[8], S0[9], S0[10], S0[11], S0[12], S0[13], S0[14], S0[15]);
        pf[2] = pack8(S1[0], S1[1], S1[2], S1[3], S1[4], S1[5], S1[6], S1[7]); pf[3] = pack8(S1[8], S1[9], S1[10], S1[11], S1[12], S1[13], S1[14], S1[15]);
#pragma unroll
        for (int s = 0; s < 4; ++s) { const bf16x8 v0 = *(const LAS bf16x8*)(Vt + voff + s * 32), v1 = *(const LAS bf16x8*)(Vt + 32 * (AT_VROW * 2) + voff + s * 32);
            O0 = mfma32(v0, pf[s], O0); O1 = mfma32(v1, pf[s], O1); }
        if (pre) { LAS unsigned char* Kn = L + (buf ^ 1) * AT_KB; LAS unsigned char* Vn = L + 2 * AT_KB + (buf ^ 1) * AT_VB;
            *(LAS u32x4*)(Kn + kr0 * (AT_KROW * 2) + kc0 * 16) = sk0; if (k2) *(LAS u32x4*)(Kn + kr1 * (AT_KROW * 2) + kc1 * 16) = sk1; *(LAS u32x4*)(Vn + vd * (AT_VROW * 2) + vc * 16) = sv; }
        __syncthreads();
    }
    const float inv = 1.f / l;
    bf16* Y = (bf16*)(F.ws + WS_YAT) + (size_t)qrow * 256 + h * 64;
#pragma unroll
    for (int g = 0; g < 4; ++g) {
        u32x2 w0, w1; w0.x = pk2(O0[4 * g] * inv, O0[4 * g + 1] * inv); w0.y = pk2(O0[4 * g + 2] * inv, O0[4 * g + 3] * inv);
        w1.x = pk2(O1[4 * g] * inv, O1[4 * g + 1] * inv); w1.y = pk2(O1[4 * g + 2] * inv, O1[4 * g + 3] * inv);
        *(u32x2*)(Y + 8 * g + 4 * hi) = w0; *(u32x2*)(Y + 32 + 8 * g + 4 * hi) = w1; }
}

__device__ __forceinline__ float filt_inv_norm(const Frame& F, int set, int ntile, int o, int c) {
    const float* fsp = (const float*)(F.ws + WS_FS) + (size_t)set * 128 * 1024 + o * 512 + c;
    float s = 0.f;
    for (int t = F.lane; t < ntile; t += 64) s += fsp[(size_t)t * 1024] + fsp[(size_t)t * 1024 + 256];
    return 1.f / wave_sum(s);
}
constexpr int HY_UROW = 4384, HY_UB = 8 * HY_UROW * 2, HY_G0 = HY_UB, HY_G1 = HY_G0 + GLEN * 2 + 64;
static_assert((HY_G0 / 4) % 32 == 0 && (HY_G1 / 4) % 32 == 16, "G copies on opposite bank halves");
__device__ __forceinline__ bf16x8 lds_rd8_a4(const LAS unsigned char* p) { const LAS unsigned* q = (const LAS unsigned*)p; u32x4 w; w.x = q[0]; w.y = q[1]; w.z = q[2]; w.w = q[3]; return __builtin_bit_cast(bf16x8, w); }
__device__ __forceinline__ void hyena_unit(const Frame& F, const Args& a, int layer, int c) {
    LAS unsigned char* L = F.lds; LAS bf16* U = (LAS bf16*)L;
    bf16* hyT = (bf16*)(F.ws + WS_HYT);
    const float* sw = a.in[I_HSW] + (size_t)layer * 3 * 768; const float* sb = a.in[I_HSB] + layer * 768;
    const int lane = F.lane, w = F.wave, hi = lane >> 5, l31 = lane & 31;
    __syncthreads();
    {
        const bf16* vrow = hyT + (size_t)(512 + c) * NTOK; const float w0 = sw[512 + c], w1 = sw[768 + 512 + c], w2 = sw[1536 + 512 + c], bb = sb[512 + c];
        for (int i = F.tid; i < 8 * 512; i += 512) { const int b = i >> 9, t0 = (i & 511) * 8; const bf16* p = vrow + b * 4096 + t0; const u32x4 x = *(const u32x4*)p;
            float v[10]; v[0] = t0 > 0 ? bf2f(p[-1]) : 0.f; v[9] = t0 + 8 < 4096 ? bf2f(p[8]) : 0.f;
            v[1] = lo_bf(x.x); v[2] = hi_bf(x.x); v[3] = lo_bf(x.y); v[4] = hi_bf(x.y); v[5] = lo_bf(x.z); v[6] = hi_bf(x.z); v[7] = lo_bf(x.w); v[8] = hi_bf(x.w);
            float o[8];
#pragma unroll
            for (int k = 0; k < 8; ++k) o[k] = w0 * v[k] + w1 * v[k + 1] + w2 * v[k + 2] + bb;
            u32x4 ww; ww.x = pk2(o[0], o[1]); ww.y = pk2(o[2], o[3]); ww.z = pk2(o[4], o[5]); ww.w = pk2(o[6], o[7]);
            *(LAS u32x4*)(U + b * HY_UROW + t0 + 8 * (t0 >> 7)) = ww; }
    }
    const int sel = l31 & 1;
    const int abase = (sel ? HY_G1 : HY_G0) + (GC - l31 + 8 * hi + sel) * 2;
    const int nb = l31 & 7, qq = l31 >> 3, qsb = 16 * w + 4 * qq;
    const int ubase = (nb * HY_UROW + 8 * hi) * 2;
#pragma unroll 1
    for (int o = 0; o < 2; ++o) {
        {
            const bf16* Gg = (const bf16*)(F.ws + WS_G) + ((size_t)(layer * 2 + o) * 256 + c) * GLEN;
            for (int i = F.tid; i < GLEN / 8; i += 512) { u32x4 x = *(const u32x4*)(Gg + i * 8);
                if (i < 5 || i >= 1027) { const int m0 = i * 8; unsigned* xp = (unsigned*)&x;
#pragma unroll
                    for (int k = 0; k < 4; ++k) { const int ma = m0 + 2 * k, mb = ma + 1; unsigned v = xp[k]; if (ma < 33 || ma > 8223) v &= 0xffff0000u; if (mb < 33 || mb > 8223) v &= 0x0000ffffu; xp[k] = v; } }
                *(LAS u32x4*)(L + HY_G0 + i * 16) = x; }
            __syncthreads();
            const LAS unsigned* g0 = (const LAS unsigned*)(L + HY_G0); LAS unsigned* g1 = (LAS unsigned*)(L + HY_G1);
            for (int i = F.tid; i <= GLEN / 2; i += 512) { const unsigned dp = i > 0 ? g0[i - 1] : 0u, d = i < GLEN / 2 ? g0[i] : 0u; g1[i] = (dp >> 16) | (d << 16); }
            __syncthreads();
        }
        f32x16 acc[4];
#pragma unroll
        for (int j = 0; j < 4; ++j)
#pragma unroll
            for (int r = 0; r < 16; ++r) acc[j][r] = 0.f;
        bf16x8 A[4][2];
        const int e0 = 16 * w - 127;
#define HY_LOADA(slot, delta) do { const LAS unsigned char* _p = L + abase - 64 * (delta); A[slot][0] = lds_rd8_a4(_p); A[slot][1] = lds_rd8_a4(_p + 32); } while (0)
        HY_LOADA(0, e0); HY_LOADA(1, e0 + 1); HY_LOADA(2, e0 + 2);
#define HY_STEP(g) do { const int e = eb + (g); const int qs = qsb - e; const bool ok = (unsigned)qs < 128u; const int qc = qs < 0 ? 0 : (qs > 127 ? 127 : qs); \
            const LAS unsigned char* _u = L + ubase + (32 * qc + 8 * (qc >> 2)) * 2; bf16x8 f0 = *(const LAS bf16x8*)_u, f1 = *(const LAS bf16x8*)(_u + 32); \
            if (!ok) { f0 = (bf16x8){0, 0, 0, 0, 0, 0, 0, 0}; f1 = f0; } \
            HY_LOADA(((g) + 3) & 3, e + 3); \
            _Pragma("unroll") for (int j = 0; j < 4; ++j) { acc[j] = mfma32(A[((g) + j) & 3][0], f0, acc[j]); acc[j] = mfma32(A[((g) + j) & 3][1], f1, acc[j]); } } while (0)
#pragma unroll 1
        for (int eb = e0; eb < e0 + 140; eb += 4) { HY_STEP(0); HY_STEP(1); HY_STEP(2); HY_STEP(3); }
#undef HY_STEP
#undef HY_LOADA
        __syncthreads();
        const float inv = filt_inv_norm(F, layer, 128, o, c);
        const float hb = a.in[I_HBIAS][(size_t)(layer * 2 + o) * 256 + c];
        const int gcol = o == 0 ? c : 256 + c; const bf16* grow = hyT + (size_t)gcol * NTOK + nb * 4096;
        const float w0 = sw[gcol], w1 = sw[768 + gcol], w2 = sw[1536 + gcol], bb = sb[gcol];
        bf16* yrow = (bf16*)(F.ws + WS_YT) + (size_t)c * NTOK + nb * 4096;
#pragma unroll
        for (int j = 0; j < 4; ++j) { const int q = 16 * w + 4 * qq + j;
#pragma unroll
            for (int g4 = 0; g4 < 4; ++g4) { const int t = 32 * q + 8 * g4 + 4 * hi; const bf16* p = grow + t; const u32x2 x = *(const u32x2*)p;
                float v[6]; v[0] = t > 0 ? bf2f(p[-1]) : 0.f; v[5] = t + 4 < 4096 ? bf2f(p[4]) : 0.f; v[1] = lo_bf(x.x); v[2] = hi_bf(x.x); v[3] = lo_bf(x.y); v[4] = hi_bf(x.y);
                LAS bf16* up = U + nb * HY_UROW + t + 8 * (t >> 7); const u32x2 uu = *(const LAS u32x2*)up;
                const float u0 = lo_bf(uu.x), u1 = hi_bf(uu.x), u2 = lo_bf(uu.y), u3 = hi_bf(uu.y);
                const float y0 = (w0 * v[0] + w1 * v[1] + w2 * v[2] + bb) * (acc[j][4 * g4] * inv + hb * u0);
                const float y1 = (w0 * v[1] + w1 * v[2] + w2 * v[3] + bb) * (acc[j][4 * g4 + 1] * inv + hb * u1);
                const float y2 = (w0 * v[2] + w1 * v[3] + w2 * v[4] + bb) * (acc[j][4 * g4 + 2] * inv + hb * u2);
                const float y3 = (w0 * v[3] + w1 * v[4] + w2 * v[5] + bb) * (acc[j][4 * g4 + 3] * inv + hb * u3);
                u32x2 wv; wv.x = pk2(y0, y1); wv.y = pk2(y2, y3);
                if (o == 0) *(LAS u32x2*)up = wv; else *(u32x2*)(yrow + t) = wv; } }
        __syncthreads();
    }
}

__device__ __forceinline__ void hyena_ctx_unit(const Frame& F, const Args& a, int c) {
    LAS float* u = (LAS float*)F.lds;
    LAS float* y1 = u + 2048;
    LAS float* T = y1 + 2048;
    bf16* hyT = (bf16*)(F.ws + WS_HYT);
    const float* sw = a.in[I_HSW]; const float* sb = a.in[I_HSB];
    __syncthreads();
    for (int i = F.tid; i < 1024; i += 512) T[i] = ((const float*)(F.ws + WS_TC))[((size_t)(i >> 9) * 256 + c) * 512 + (i & 511)];
    if (F.tid < 2) T[F.tid * 512] = 0.f;
    {
        const bf16* vrow = hyT + (size_t)(512 + c) * NTOK + NLAT; const float w0 = sw[512 + c], w1 = sw[768 + 512 + c], w2 = sw[1536 + 512 + c], bb = sb[512 + c];
        for (int i = F.tid; i < 2048; i += 512) { const int t = i & 255; const float vm = t > 0 ? bf2f(vrow[i - 1]) : 0.f, v0 = bf2f(vrow[i]), vp = t < 255 ? bf2f(vrow[i + 1]) : 0.f; u[i] = w0 * vm + w1 * v0 + w2 * vp + bb; }
    }
    __syncthreads();
#pragma unroll 1
    for (int o = 0; o < 2; ++o) {
        const LAS float* in = o == 0 ? u : y1; const float inv = filt_inv_norm(F, 2, 8, o, c); const float hb = a.in[I_HBIAS][(size_t)o * 256 + c];
        const int gcol = o == 0 ? c : 256 + c; const bf16* grow = hyT + (size_t)gcol * NTOK + NLAT; const float w0 = sw[gcol], w1 = sw[768 + gcol], w2 = sw[1536 + gcol], bb = sb[gcol];
        for (int i = F.tid; i < 2048; i += 512) { const int b = i >> 8, t = i & 255; float s = 0.f;
            for (int sidx = 0; sidx < 256; ++sidx) s += T[o * 512 + 256 + t - sidx] * in[b * 256 + sidx];
            const float gm = t > 0 ? bf2f(grow[i - 1]) : 0.f, g0 = bf2f(grow[i]), gp = t < 255 ? bf2f(grow[i + 1]) : 0.f;
            const float y = (w0 * gm + w1 * g0 + w2 * gp + bb) * (s * inv + hb * in[i]);
            if (o == 0) y1[i] = y; else ((bf16*)(F.ws + WS_YT))[(size_t)c * NTOK + NLAT + i] = (bf16)f2bf(y); }
        __syncthreads();
    }
}

__device__ __forceinline__ void p5_unit(const Frame& F, const Args& a, int layer, int r0) {
    LAS bf16* T = (LAS bf16*)F.lds;
    const bf16* yT = (const bf16*)(F.ws + WS_YT); const bf16* yat = (const bf16*)(F.ws + WS_YAT); bf16* Y = (bf16*)(F.ws + WS_H);
    const float* mg = a.in[I_MIXG] + layer * 1024;
    __syncthreads();
    for (int i = F.tid; i < 1024; i += 512) { const int c = i >> 2, q = i & 3; *(LAS u32x4*)(T + c * 40 + q * 8) = *(const u32x4*)(yT + (size_t)c * NTOK + r0 + q * 8); }
    __syncthreads();
    for (int r = F.wave; r < 32; r += 8) {
        f32x4 v; v.x = bf2f(T[(4 * F.lane) * 40 + r]); v.y = bf2f(T[(4 * F.lane + 1) * 40 + r]); v.z = bf2f(T[(4 * F.lane + 2) * 40 + r]); v.w = bf2f(T[(4 * F.lane + 3) * 40 + r]);
        float rn = 1.f / sqrtf(wave_sum((v.x * v.x + v.y * v.y) + (v.z * v.z + v.w * v.w)) * (1.f / 256.f) + EPS);
        f32x4 m4 = *(const f32x4*)(mg + 4 * F.lane); f32x4 y = v * rn * m4; u32x2 w; w.x = pk2(y.x, y.y); w.y = pk2(y.z, y.w);
        *(u32x2*)(Y + (size_t)(r0 + r) * 1024 + 4 * F.lane) = w;
        bf16* ya = Y + (size_t)(r0 + r) * 1024 + 768 + 4 * F.lane; const u32x2 x = *(const u32x2*)(yat + (size_t)(r0 + r) * 256 + 4 * F.lane);
        v.x = lo_bf(x.x); v.y = hi_bf(x.x); v.z = lo_bf(x.y); v.w = hi_bf(x.y);
        rn = 1.f / sqrtf(wave_sum((v.x * v.x + v.y * v.y) + (v.z * v.z + v.w * v.w)) * (1.f / 256.f) + EPS);
        m4 = *(const f32x4*)(mg + 768 + 4 * F.lane); y = v * rn * m4; w.x = pk2(y.x, y.y); w.y = pk2(y.z, y.w); *(u32x2*)ya = w;
    }
}
#ifndef MK_DUP
#define MK_DUP 0u
#endif
#define DUPN(k) (((MK_DUP >> (k)) & 1u) ? 2 : 1)
#ifndef MK_PHASES
#define MK_PHASES 0xFFFFFu
#endif
template <int LAYER>
__device__ __forceinline__ void layer_phases(const Frame& F, const Args& a, const XcdBarrier& bar, int lo, int hi) {
    constexpr int PB = 1 + 9 * LAYER;
    unsigned char* ws = F.ws;
    const float* modl = (const float*)(ws + WS_MOD) + (size_t)LAYER * 9 * 6144;
    float* xc = (float*)(ws + WS_XC);
#define IN(k) (((MK_PHASES >> (k)) & 1u) && lo <= (k) && (k) < hi)
#define SEAM(k) do { if (IN(k) && IN((k) + 1)) xcd_barrier(bar); } while (0)
#define BODY_P1 { if (LAYER == 0) p1_norm(F, a, 0, a.in[I_X], a.in[I_CTX]); else p1_norm(F, a, 1, a.out, xc); }
    if (IN(PB + 0)) { BODY_P1 if (DUPN(0) == 2) BODY_P1 }
    SEAM(PB + 0);
#define BODY_P2 { OpIn op{(const bf16*)(ws + WS_H), (const bf16*)(ws + WS_WIN) + (size_t)LAYER * NIN_PAD * 1024, (bf16*)(ws + WS_PROJ), (bf16*)(ws + WS_HYT), LAYER, F.G, F.vcu}; \
        pg8::gemm_phase<OpIn, true>(F.lds, op, 1024); }
    if (IN(PB + 1)) { BODY_P2 if (DUPN(1) == 2) BODY_P2 }
    SEAM(PB + 1);
    if (IN(PB + 2)) for (int rep = 0; rep < DUPN(2); ++rep) {
        constexpr int NGM = LAYER == 0 ? NTOK / 128 : NLAT / 128, NCV = LAYER == 0 ? NTOK / 64 : NLAT / 64, NML = NTOK / 64;
        for (int u = F.vcu; u < NGM + NCV + NML; u += F.G) {
            if (u < NGM) p3_gmlp_unit(F, a, LAYER, u * 128);
            else if (u < NGM + NCV) p3_conv_unit(F, a, LAYER, (u - NGM) * 64);
            else p3_mla_unit(F, a, LAYER, (u - NGM - NCV) * 64);
        }
    }
    SEAM(PB + 2);
    if (IN(PB + 3)) {
        constexpr int NU = LAYER == 0 ? 256 + 512 + 32 + 256 : 256 + 512;
        for (int u = F.vcu; u < NU; u += F.G) {
            if (u < 256) { for (int rep = 0; rep < DUPN(17); ++rep) hyena_unit(F, a, LAYER, u); }
            else if (u < 768) { const int id = u - 256; for (int rep = 0; rep < DUPN(16); ++rep) attn_unit(F, id >> 6, (id >> 4) & 3, (id >> 6) * 4096 + (id & 15) * 256, 0, NKEY / 64); }
            else if (u < 800) { const int id = u - 768; attn_unit(F, id >> 2, id & 3, NLAT + (id >> 2) * 256, 4096, 4); }
            else hyena_ctx_unit(F, a, u - 800);
        }
    }
    SEAM(PB + 3);
    if (IN(PB + 4)) for (int rep = 0; rep < DUPN(4); ++rep) {
        constexpr int NU = (LAYER == 0 ? NTOK : NLAT) / 32;
        for (int u = F.vcu; u < NU; u += F.G) p5_unit(F, a, LAYER, u * 32);
    }
    SEAM(PB + 4);
    if (IN(PB + 5)) {
        OpOut op{(const bf16*)(ws + WS_H), (const bf16*)(ws + WS_WOUT) + (size_t)LAYER * 1024 * 1024, LAYER == 0 ? a.in[I_X] : a.out, LAYER == 0 ? a.in[I_CTX] : xc, a.out, xc, modl, LAYER, F.G, F.vcu};
        pg8::gemm_phase<OpOut, true>(F.lds, op, 1024);
    }
    SEAM(PB + 5);
    if (IN(PB + 6)) p7_router(F, a, LAYER, a.out, xc, LAYER == 0 ? NTOK : NLAT);
    SEAM(PB + 6);
    LAS int* tab = (LAS int*)(F.lds + 131072 + 4096);
    if (IN(PB + 7) || IN(PB + 8)) {
        __syncthreads();
        if (F.tid == 0) { int acc = 0; for (int k = 0; k < NBUCKET; ++k) { const int c = (int)__hip_atomic_load(F.ctl + CW_CNT + LAYER * 32 + k, __ATOMIC_RELAXED, __HIP_MEMORY_SCOPE_AGENT); tab[k] = acc; tab[32 + k] = c; acc += (c + 255) >> 8; } tab[NBUCKET] = acc; }
        __syncthreads();
    }
#define BODY_P8 { OpMoe1 op{(const bf16*)(ws + WS_H), (const bf16*)(ws + WS_W1), (bf16*)(ws + WS_PROJ), (const int*)(ws + WS_TOK), (const float*)(ws + WS_WLO), (const float*)(ws + WS_WHI), tab, LAYER, F.G, F.vcu}; \
        pg8::gemm_phase<OpMoe1, true>(F.lds, op, 1024); }
    if (IN(PB + 7)) { BODY_P8 if (DUPN(7) == 2) BODY_P8 }
    SEAM(PB + 7);
    if (IN(PB + 8)) {
        OpMoe2 op{(const bf16*)(ws + WS_PROJ), (const bf16*)(ws + WS_W2), a.out, xc, modl, (const int*)(ws + WS_TOK), tab, LAYER, F.G, F.vcu};
        pg8::gemm_phase<OpMoe2, true>(F.lds, op, 1024);
    }
    SEAM(PB + 8);
#undef IN
#undef SEAM
}

constexpr int N_PHASES = 20;
__global__ void __launch_bounds__(512, 2) mk_fwd(Args a) {
    extern __shared__ __attribute__((aligned(16))) unsigned char lds_raw[];
    Frame F;
    F.lds = (LAS unsigned char*)lds_raw; F.ws = a.ws; F.ctl = (unsigned*)(a.ws + WS_CTL);
    F.tid = threadIdx.x; F.lane = F.tid & 63; F.wave = __builtin_amdgcn_readfirstlane(F.tid >> 6);
    F.G = gridDim.x; { const int bx = blockIdx.x; F.vcu = (F.G % 8 == 0) ? (bx % 8) * (F.G / 8) + bx / 8 : bx; }
    F.gw = F.vcu * 8 + F.wave; F.NGW = F.G * 8;
    volatile LAS unsigned* misc = (volatile LAS unsigned*)(F.lds + LDS_MISC);
    if (F.tid < 64) misc[F.tid] = 0u;
    __syncthreads();
    const int lo = a.ph_lo, hi = a.ph_hi;
    XcdBarrier bar; bar.bar = F.ctl + CW_BAR; bar.x = 0; bar.st = misc;
    if (hi - lo > 1) bar = xcd_barrier_post(F.ctl + CW_BAR, misc);
    if ((MK_PHASES & 1u) && lo <= 0 && 0 < hi) { p0_weights(F, a); p0_mod(F, a); p0_filters(F, a); if (hi > 1) xcd_barrier(bar); }
    layer_phases<0>(F, a, bar, lo, hi);
    layer_phases<1>(F, a, bar, lo, hi);
    if (((MK_PHASES >> 19) & 1u) && lo <= 19 && 19 < hi) p_final(F, a);
}

#ifndef MK_SPLIT
#define MK_SPLIT 0
#endif
extern "C" void kernel_launch(void* const* d_in, const int* in_sizes, int n_in, void* d_out, int out_size, void* d_ws, size_t ws_size, hipStream_t stream) {
    static int grid = 0;
    if (grid == 0) {
        if (n_in != 38 || out_size != NLAT * 1024 || ws_size < WS_END) { fprintf(stderr, "kernel_launch: unexpected shapes (n_in %d out %d ws %zu, need %zu)\n", n_in, out_size, ws_size, (size_t)WS_END); grid = -1; return; }
        int dev = 0, cus = 0, per_cu = 0;
        hipGetDevice(&dev); hipDeviceGetAttribute(&cus, hipDeviceAttributeMultiprocessorCount, dev);
        if (hipFuncSetAttribute((const void*)mk_fwd, hipFuncAttributeMaxDynamicSharedMemorySize, LDS_BYTES) != hipSuccess) { fprintf(stderr, "kernel_launch: hipFuncSetAttribute failed\n"); grid = -1; return; }
        if (hipOccupancyMaxActiveBlocksPerMultiprocessor(&per_cu, (const void*)mk_fwd, 512, LDS_BYTES) != hipSuccess || per_cu < 1) { fprintf(stderr, "kernel_launch: occupancy query says %d\n", per_cu); }
        (void)hipGetLastError();
        grid = cus;
    }
    if (grid < 0) return;
    hipMemsetAsync((char*)d_ws + WS_CTL, 0, CTL_BYTES, stream);
    Args a{};
    for (int i = 0; i < 38; ++i) a.in[i] = (const float*)d_in[i];
    a.out = (float*)d_out; a.ws = (unsigned char*)d_ws;
#if MK_SPLIT
    for (int p = 0; p < N_PHASES; ++p) { a.ph_lo = p; a.ph_hi = p + 1; hipLaunchKernelGGL(mk_fwd, dim3(grid), dim3(512), LDS_BYTES, stream, a); }
#else
    a.ph_lo = 0; a.ph_hi = N_PHASES; hipLaunchKernelGGL(mk_fwd, dim3(grid), dim3(512), LDS_BYTES, stream, a);
#endif
}
```

```cpp
#include <hip/hip_runtime.h>
#include <cstdio>
#include <cstdint>
#include <cmath>

#define LAS __attribute__((address_space(3)))
#define GAS __attribute__((address_space(1)))
typedef unsigned short bf16;
typedef short bf16x8 __attribute__((ext_vector_type(8)));
typedef short bf16x4 __attribute__((ext_vector_type(4)));
typedef float f32x4 __attribute__((ext_vector_type(4)));
typedef float f32x2 __attribute__((ext_vector_type(2)));
typedef float f32x16 __attribute__((ext_vector_type(16)));
typedef unsigned u32x4 __attribute__((ext_vector_type(4)));
typedef unsigned u32x2 __attribute__((ext_vector_type(2)));

constexpr int NB = 8, SEQ = 4096, CTXL = 256, DM = 1024, DEPTH = 2;
constexpr int NLAT = NB * SEQ, NCTX = NB * CTXL, NTOK = NLAT + NCTX;
constexpr int IN_COLS = 2144, NIN_PAD = 2304;
constexpr int HY_OFF = 0, GM_OFF = 768, CV_OFF = 1280, MQ_OFF = 1792, MKV_OFF = 1984;
constexpr int PROJ_LD = 1536;
constexpr int PJ_GM = 0, PJ_CV = 512, PJ_MKV = 1024, PJ_MQ = 1184;
constexpr int NKEY = SEQ + CTXL;
constexpr int NEXP = 16, DEXP = 512, NBUCKET = 24;
constexpr int A_ROWS = 41216;
constexpr float EPS = 1e-6f;
constexpr int GC = 4128, GLEN = 8256;
constexpr float QSCALE = 0.10206207261596577f * 1.4426950408889634f;

constexpr size_t al256(size_t x) { return (x + 255) & ~(size_t)255; }
constexpr size_t WS_CTL = 0, CTL_BYTES = 1u << 20;
constexpr size_t WS_MOD = WS_CTL + CTL_BYTES;
constexpr size_t WS_ROPE = al256(WS_MOD + (size_t)2 * 9 * 6144 * 4);
constexpr size_t WS_WIN = al256(WS_ROPE + (size_t)2 * 4096 * 16 * 4);
constexpr size_t WS_WOUT = al256(WS_WIN + (size_t)2 * NIN_PAD * 1024 * 2);
constexpr size_t WS_W1 = al256(WS_WOUT + (size_t)2 * 1024 * 1024 * 2);
constexpr size_t WS_W2 = al256(WS_W1 + (size_t)2 * 16 * 1024 * 1024 * 2);
constexpr size_t WS_WUQ = al256(WS_W2 + (size_t)2 * 16 * 1024 * 512 * 2);
constexpr size_t WS_WUKV = al256(WS_WUQ + (size_t)2 * 384 * 192 * 2);
constexpr size_t WS_GMWS = al256(WS_WUKV + (size_t)2 * 512 * 128 * 2);
constexpr size_t WS_G = al256(WS_GMWS + (size_t)2 * 4 * 128 * 128 * 2);
constexpr size_t WS_TC = al256(WS_G + (size_t)2 * 2 * 256 * GLEN * 2);
constexpr size_t WS_H = al256(WS_TC + (size_t)2 * 256 * 512 * 4);
constexpr size_t WS_PROJ = al256(WS_H + (size_t)NTOK * 1024 * 2);
constexpr size_t WS_HYT = al256(WS_PROJ + (size_t)NTOK * PROJ_LD * 2);
constexpr size_t WS_Q = al256(WS_HYT + (size_t)768 * NTOK * 2);
constexpr size_t WS_K = al256(WS_Q + (size_t)NTOK * 384 * 2);
constexpr size_t WS_VT = al256(WS_K + (size_t)NB * 4 * NKEY * 96 * 2);
constexpr size_t WS_XC = al256(WS_VT + (size_t)NB * 4 * 64 * NKEY * 2);
constexpr size_t WS_TOK = al256(WS_XC + (size_t)NCTX * 1024 * 4);
constexpr size_t WS_WLO = al256(WS_TOK + (size_t)NBUCKET * NTOK * 4);
constexpr size_t WS_WHI = al256(WS_WLO + (size_t)NBUCKET * NTOK * 4);
constexpr size_t WS_YT = al256(WS_WHI + (size_t)NBUCKET * NTOK * 4);
constexpr size_t WS_YAT = al256(WS_YT + (size_t)256 * NTOK * 2);
constexpr size_t WS_FS = al256(WS_YAT + (size_t)NTOK * 256 * 2);
constexpr size_t WS_END = al256(WS_FS + (size_t)3 * 128 * 1024 * 4);
static_assert((size_t)A_ROWS * 1024 * 2 <= (size_t)NTOK * PROJ_LD * 2, "a overlays proj");
static_assert(WS_END <= (size_t)512 * 1024 * 1024, "workspace");
constexpr int CW_BAR = 1024;
constexpr int CW_CNT = 8192;

constexpr int LDS_BYTES = 160 * 1024;
constexpr int LDS_MISC = 131072 + 28672;

__device__ __forceinline__ float bf2f(bf16 v) { return __builtin_bit_cast(float, (unsigned)v << 16); }
__device__ __forceinline__ unsigned f2bf(float f) { unsigned u = __builtin_bit_cast(unsigned, f); return (u + 0x7fffu + ((u >> 16) & 1u)) >> 16; }
__device__ __forceinline__ unsigned pk2(float lo, float hi) { return f2bf(lo) | (f2bf(hi) << 16); }
__device__ __forceinline__ float lo_bf(unsigned w) { return __builtin_bit_cast(float, w << 16); }
__device__ __forceinline__ float hi_bf(unsigned w) { return __builtin_bit_cast(float, w & 0xffff0000u); }
__device__ __forceinline__ float wave_sum(float v) {
#pragma unroll
    for (int o = 1; o < 64; o <<= 1) v += __shfl_xor(v, o);
    return v;
}
__device__ __forceinline__ float siluf(float x) { return x / (1.f + __expf(-x)); }
__device__ __forceinline__ float sigmf(float x) { return 1.f / (1.f + __expf(-x)); }
__device__ __forceinline__ float gelu_tanh(float x) { const float u = 0.7978845608028654f * (x + 0.044715f * x * x * x); const float e = __expf(2.f * u); return x * (1.f - 1.f / (e + 1.f)); }
__device__ __forceinline__ int mod_idx(int r) { return r < NLAT ? (r >> 12) : 8; }

#define XB_TMO      128
#define XB_XCNT(j)  (256  + 64 * (j))
#define XB_XSUB(j)  (1280 + 64 * (j))
#define XB_XGEN(j)  (2304 + 64 * (j))
#define XB_TOP      3328
#define XB_TOPGEN   3392
#define XCD_BAR_WORDS 3456
#define XB_SPIN_CAP (1u << 22)
__device__ __forceinline__ unsigned xb_ld(unsigned* p)              { return __hip_atomic_load(p, __ATOMIC_RELAXED, __HIP_MEMORY_SCOPE_AGENT); }
__device__ __forceinline__ unsigned xb_add(unsigned* p, unsigned v) { return __hip_atomic_fetch_add(p, v, __ATOMIC_RELAXED, __HIP_MEMORY_SCOPE_AGENT); }
__device__ __forceinline__ unsigned xb_xcc_id() { return (unsigned)__builtin_amdgcn_s_getreg((3 << 11) | 20) & 0xFu; }
#define XB_SPIN(cond, bar) do { unsigned _sp = 0; while (cond) { __builtin_amdgcn_s_sleep(1); \
    if ((++_sp & 255u) == 0u) { if (xb_ld(&(bar)[XB_TMO])) break; if (_sp > XB_SPIN_CAP) { atomicAdd(&(bar)[XB_TMO], 1u); break; } } } } while (0)
struct XcdBarrier { unsigned* bar; unsigned x; volatile LAS unsigned* st; };
__device__ __forceinline__ XcdBarrier xcd_barrier_post(unsigned* bar, volatile LAS unsigned* st) {
    XcdBarrier b; b.bar = bar; b.x = xb_xcc_id(); b.st = st;
    if (threadIdx.x == 0) (void)xb_add(&bar[XB_XCNT(b.x)], 1u);
    return b;
}
__device__ __forceinline__ void xcd_barrier_complete(unsigned* bar, unsigned x, unsigned& nloc, unsigned& nx) {
    const unsigned G = gridDim.x * gridDim.y * gridDim.z;
    unsigned sum, cnt, mine, sp = 0u;
    for (;;) {
        sum = 0u; cnt = 0u; mine = 0u;
#pragma unroll
        for (unsigned j = 0; j < 16; ++j) { const unsigned c = xb_ld(&bar[XB_XCNT(j)]); sum += c; cnt += (c > 0u) ? 1u : 0u; mine = (j == x) ? c : mine; }
        if (sum == G) break;
        __builtin_amdgcn_s_sleep(1);
        if ((++sp & 255u) == 0u) { if (xb_ld(&bar[XB_TMO])) break; if (sp > XB_SPIN_CAP) { atomicAdd(&bar[XB_TMO], 1u); break; } }
    }
    nloc = mine > 0u ? mine : 1u; nx = cnt > 0u ? cnt : 1u;
}
__device__ __forceinline__ void xcd_barrier(const XcdBarrier& b) {
    asm volatile("s_waitcnt vmcnt(0)" ::: "memory");
    __syncthreads();
    if (threadIdx.x == 0) {
        unsigned* bar = b.bar;
        __builtin_amdgcn_s_waitcnt(0);
        unsigned nloc = b.st[0], nx = b.st[1];
        if (nloc == 0u) { xcd_barrier_complete(bar, b.x, nloc, nx); b.st[0] = nloc; b.st[1] = nx; }
        const unsigned old = xb_add(&bar[XB_XSUB(b.x)], 1u);
        const unsigned gen = old / nloc;
        if (old + 1u == (gen + 1u) * nloc) {
            __builtin_amdgcn_fence(__ATOMIC_RELEASE, "agent");
            asm volatile("s_waitcnt vmcnt(0)" ::: "memory");
            const unsigned og = xb_add(&bar[XB_TOP], 1u);
            const unsigned tg = og / nx;
            if (og + 1u == (tg + 1u) * nx) xb_add(&bar[XB_TOPGEN], 1u);
            else XB_SPIN(xb_ld(&bar[XB_TOPGEN]) == tg, bar);
            __builtin_amdgcn_fence(__ATOMIC_ACQUIRE, "agent");
            xb_add(&bar[XB_XGEN(b.x)], 1u);
            asm volatile("s_waitcnt vmcnt(0)" ::: "memory");
        } else {
            XB_SPIN(xb_ld(&bar[XB_XGEN(b.x)]) == gen, bar);
            __builtin_amdgcn_fence(__ATOMIC_ACQUIRE, "agent");
            asm volatile("s_waitcnt vmcnt(0)" ::: "memory");
        }
    }
    __syncthreads();
}

struct Args {
    const float* in[38]; float* out; unsigned char* ws; int ph_lo, ph_hi;
};
typedef const __attribute__((address_space(4))) Args* KArgs;
__device__ __forceinline__ KArgs kargs() { KArgs p = (KArgs)__builtin_amdgcn_kernarg_segment_ptr(); asm volatile("" : "+s"(p)); return p; }
struct Frame {
    LAS unsigned char* lds; unsigned char* ws; unsigned* ctl;
    int tid, lane, wave, G, vcu, gw, NGW;
};
__device__ __forceinline__ void relaunder(Frame& F) {
    int t = threadIdx.x; asm volatile("" : "+v"(t));
    F.tid = t; F.lane = t & 63; F.wave = __builtin_amdgcn_readfirstlane(t >> 6); F.gw = F.vcu * 8 + F.wave;
}
enum { I_X = 0, I_C, I_CTX, I_CCTX, I_ADAW, I_ADAB, I_N1G, I_N2G, I_WIN, I_HSW, I_HSB, I_HFW1, I_HFB1, I_HFFREQ, I_HFW2, I_HFB2, I_HFW3, I_HBIAS,
       I_GMLNG, I_GMLNB, I_GMWS, I_GMBS, I_CVW, I_CVB, I_CVLNG, I_CVLNB, I_QANORM, I_WUQ, I_KVANORM, I_WUKV, I_MIXG, I_WOUT, I_WROUTER, I_RBIAS,
       I_EWG, I_EWU, I_EWD, I_FNG };

namespace pg8 {
constexpr int BM = 256, BK = 64, HALF = 128, HTB = HALF * BK * 2, STAGE_BYTES = 8 * HTB;
__host__ __device__ __forceinline__ int lds_byte(int r, int c) { const int st = (r >> 4) * 2 + (c >> 5), rr = r & 15, cc = c & 31, ob = rr * 64 + cc * 2; return st * 1024 + (ob ^ (((ob >> 9) & 1) << 5)); }
__host__ __device__ __forceinline__ void stage_rc(int b, int& R, int& C) { const int st = b / 1024, sb = b % 1024, swz = sb ^ (((sb >> 9) & 1) << 5); R = (st >> 1) * 16 + swz / 64; C = (st & 1) * 32 + (swz % 64) / 2; }
__host__ __device__ __forceinline__ int perm32(int rho) { const int n = rho >> 4, i = rho & 15; return 8 * (i >> 2) + 4 * n + (i & 3); }
struct Unit { int pm, pn, k, aux; };
__device__ __forceinline__ unsigned cvt_pk_bf16(float lo, float hi) { unsigned r; asm volatile("v_cvt_pk_bf16_f32 %0, %1, %2" : "=v"(r) : "v"(lo), "v"(hi)); return r; }

template <class Op, bool ALIGN_EPI>
__device__ __forceinline__ void gemm_phase(LAS unsigned char* lds, const Op& op, const int K) {
    const int tid = threadIdx.x, wid = __builtin_amdgcn_readfirstlane(tid >> 6), lane = tid & 63, wr = wid >> 2, wc = wid & 3, fr = lane & 15, fq = lane >> 4;
    const int nt = K / BK;
    int Rs[2], Cs[2]; unsigned voffB[2];
#pragma unroll
    for (int i = 0; i < 2; ++i) { stage_rc(tid * 16 + i * 8192, Rs[i], Cs[i]); const int Rb = (Rs[i] & ~31) + perm32(Rs[i] & 31); voffB[i] = (unsigned)(Rb * op.ldb() + Cs[i]) * 2u; }
    const unsigned hstepB = (unsigned)HALF * op.ldb() * 2u;
    const unsigned ldsw = (unsigned)wid * 1024u;
    const int aoff = lds_byte(wr * 64 + fr, fq * 8), boff = lds_byte(wc * 32 + fr, fq * 8);
    const char* const Ab = (const char*)op.A();
#define PG8_SA(b, h) (((b) * 2 + (h)) * HTB)
#define PG8_SB(b, h) ((4 + (b) * 2 + (h)) * HTB)
#define PG8_STAGE_A(bufoff, offs, h, kb) do { _Pragma("unroll") for (int _i = 0; _i < 2; ++_i) \
        __builtin_amdgcn_global_load_lds((const unsigned*)(Ab + (size_t)(offs)[h][_i] + (kb)), (LAS unsigned*)(lds + (bufoff) + ldsw + _i * 8192), 16, 0, 0); } while (0)
#define PG8_STAGE_B(bufoff, gbase) do { _Pragma("unroll") for (int _i = 0; _i < 2; ++_i) \
        __builtin_amdgcn_global_load_lds((const unsigned*)((const char*)(gbase) + voffB[_i]), (LAS unsigned*)(lds + (bufoff) + ldsw + _i * 8192), 16, 0, 0); } while (0)
#define PG8_LDA(dst, b, h) do { _Pragma("unroll") for (int m = 0; m < 4; ++m) _Pragma("unroll") for (int k = 0; k < 2; ++k) dst[m][k] = *(const LAS bf16x8*)(lds + PG8_SA(b, h) + aoff + m * 2048 + k * 1024); } while (0)
#define PG8_LDB(dst, b, h) do { _Pragma("unroll") for (int n = 0; n < 2; ++n) _Pragma("unroll") for (int k = 0; k < 2; ++k) dst[n][k] = *(const LAS bf16x8*)(lds + PG8_SB(b, h) + boff + n * 2048 + k * 1024); } while (0)
#define PG8_MMA(ai, bj, At, Bt) do { __builtin_amdgcn_s_setprio(1); _Pragma("unroll") for (int m = 0; m < 4; ++m) _Pragma("unroll") for (int n = 0; n < 2; ++n) _Pragma("unroll") for (int k = 0; k < 2; ++k) \
        acc[ai][bj][m][n] = __builtin_amdgcn_mfma_f32_16x16x32_bf16(Bt[n][k], At[m][k], acc[ai][bj][m][n], 0, 0, 0); __builtin_amdgcn_s_setprio(0); } while (0)
#define PG8_WAIT_V(n) asm volatile("s_waitcnt vmcnt(" #n ")" ::: "memory")
#define PG8_WAIT_L(n) asm volatile("s_waitcnt lgkmcnt(" #n ")" ::: "memory")
#define PG8_BAR __builtin_amdgcn_s_barrier()
#define PG8_SCHED __builtin_amdgcn_sched_barrier(0)
    Unit cur, nxt; int ui = 0;
    if (!op.next(0, cur)) return;
    f32x4 acc[2][2][4][2];
#pragma unroll
    for (int a = 0; a < 2; ++a)
#pragma unroll
        for (int b = 0; b < 2; ++b)
#pragma unroll
            for (int m = 0; m < 4; ++m)
#pragma unroll
                for (int n = 0; n < 2; ++n) acc[a][b][m][n] = (f32x4){0.f, 0.f, 0.f, 0.f};
    bf16x8 At[4][2], B0[2][2], B1[2][2];
    constexpr int NAO = Op::GATHER ? 2 : 1;
    unsigned caoff[2][2], naoff[NAO][2];
    size_t cbase = 0, nbase = 0;
#pragma unroll
    for (int h = 0; h < 2; ++h)
#pragma unroll
        for (int i = 0; i < 2; ++i) { if constexpr (Op::GATHER) caoff[h][i] = op.arow(cur, h * HALF + Rs[i]) + (unsigned)Cs[i] * 2u; else caoff[h][i] = (unsigned)(h * HALF + Rs[i]) * 2048u + (unsigned)Cs[i] * 2u; }
    if constexpr (!Op::GATHER) cbase = op.abase(cur);
    {
        const char* b0 = op.bptr(cur, 0); const char* b1 = op.bptr(cur, 1);
        PG8_STAGE_B(PG8_SB(0, 0), b0); PG8_STAGE_B(PG8_SB(0, 1), b0 + hstepB); PG8_STAGE_A(PG8_SA(0, 0), caoff, 0, cbase); PG8_STAGE_A(PG8_SA(0, 1), caoff, 1, cbase);
        if (wr == 1) PG8_BAR;
        PG8_WAIT_V(2); PG8_BAR;
        PG8_STAGE_B(PG8_SB(1, 0), b1); PG8_STAGE_A(PG8_SA(1, 0), caoff, 0, cbase + 128); PG8_STAGE_B(PG8_SB(1, 1), b1 + hstepB);
        PG8_WAIT_V(6); PG8_BAR;
    }
    for (;;) {
        const bool has_next = op.next(ui + 1, nxt);
        if (!has_next) nxt = cur;
        if constexpr (Op::GATHER) {
#pragma unroll
            for (int h = 0; h < 2; ++h)
#pragma unroll
                for (int i = 0; i < 2; ++i) naoff[h][i] = has_next ? op.arow(nxt, h * HALF + Rs[i]) + (unsigned)Cs[i] * 2u : caoff[h][i];
        } else nbase = op.abase(nxt);
        for (int t = 0; t < nt; t += 2) {
            const bool last = (t == nt - 2);
            const size_t ka1 = cbase + (size_t)(t + 1) * 128u;
            const size_t ka2 = last ? nbase : cbase + (size_t)(t + 2) * 128u, ka3 = ka2 + 128u;
            unsigned a2off[2][2];
#pragma unroll
            for (int h = 0; h < 2; ++h)
#pragma unroll
                for (int i = 0; i < 2; ++i) { if constexpr (Op::GATHER) a2off[h][i] = last ? naoff[h][i] : caoff[h][i]; else a2off[h][i] = caoff[h][i]; }
            const char* b2 = last ? op.bptr(nxt, 0) : op.bptr(cur, t + 2);
            const char* b3 = last ? op.bptr(nxt, 1) : op.bptr(cur, t + 3);
            PG8_LDB(B0, 0, 0); PG8_LDB(B1, 0, 1); PG8_SCHED; PG8_LDA(At, 0, 0); PG8_STAGE_A(PG8_SA(1, 1), caoff, 1, ka1);
            PG8_WAIT_V(8); PG8_WAIT_L(0); PG8_BAR; PG8_MMA(0, 0, At, B0); PG8_MMA(0, 1, At, B1); PG8_BAR; PG8_SCHED;
            PG8_LDA(At, 0, 1); PG8_STAGE_B(PG8_SB(0, 0), b2); PG8_STAGE_B(PG8_SB(0, 1), b2 + hstepB); PG8_STAGE_A(PG8_SA(0, 0), a2off, 0, ka2);
            PG8_WAIT_V(8); PG8_WAIT_L(0); PG8_BAR; PG8_MMA(1, 0, At, B0); PG8_MMA(1, 1, At, B1); PG8_BAR; PG8_SCHED;
            PG8_LDB(B0, 1, 0); PG8_LDB(B1, 1, 1); PG8_SCHED; PG8_LDA(At, 1, 0); PG8_STAGE_A(PG8_SA(0, 1), a2off, 1, ka2);
            PG8_WAIT_V(8); PG8_WAIT_L(0); PG8_BAR; PG8_MMA(0, 0, At, B0); PG8_MMA(0, 1, At, B1); PG8_BAR; PG8_SCHED;
            PG8_LDA(At, 1, 1); PG8_STAGE_B(PG8_SB(1, 0), b3); PG8_STAGE_B(PG8_SB(1, 1), b3 + hstepB); PG8_STAGE_A(PG8_SA(1, 0), a2off, 0, ka3);
            PG8_WAIT_V(8); PG8_WAIT_L(0); PG8_BAR; PG8_MMA(1, 0, At, B0); PG8_MMA(1, 1, At, B1); PG8_BAR; PG8_SCHED;
        }
        if constexpr (ALIGN_EPI) { if (wr == 0) PG8_BAR; }
        op.epi(acc, cur, wr, wc, fr, fq);
        if (!has_next) break;
#pragma unroll
        for (int a = 0; a < 2; ++a)
#pragma unroll
            for (int b = 0; b < 2; ++b)
#pragma unroll
                for (int m = 0; m < 4; ++m)
#pragma unroll
                    for (int n = 0; n < 2; ++n) acc[a][b][m][n] = (f32x4){0.f, 0.f, 0.f, 0.f};
        cur = nxt; ++ui;
        if constexpr (Op::GATHER) {
#pragma unroll
            for (int h = 0; h < 2; ++h)
#pragma unroll
                for (int i = 0; i < 2; ++i) caoff[h][i] = naoff[h][i];
        } else cbase = nbase;
        if constexpr (ALIGN_EPI) { if (wr == 1) PG8_BAR; }
    }
    PG8_WAIT_V(0);
    if constexpr (!ALIGN_EPI) { if (wr == 0) PG8_BAR; }
    PG8_BAR;
#undef PG8_SA
#undef PG8_SB
#undef PG8_STAGE_A
#undef PG8_STAGE_B
#undef PG8_LDA
#undef PG8_LDB
#undef PG8_MMA
#undef PG8_WAIT_V
#undef PG8_WAIT_L
#undef PG8_BAR
#undef PG8_SCHED
}
}
struct OpIn {
    const bf16* A_; const bf16* Bt; bf16* proj; bf16* hyT; int layer, G, vcu;
    __device__ __forceinline__ const bf16* A() const { return A_; }
    __device__ __forceinline__ int ldb() const { return 1024; }
    __device__ __forceinline__ bool next(int i, pg8::Unit& u) const {
        const int L = i * G + vcu; const int nlat = 128 * 9, total = layer == 0 ? 136 * 9 : nlat + 8;
        if (L >= total) return false;
        if (layer == 0 || L < nlat) { u.pm = L / 9; u.pn = L % 9; } else { u.pm = 128 + (L - nlat); u.pn = 7; }
        u.k = 0; u.aux = 0; return true;
    }
    static constexpr bool GATHER = false;
    __device__ __forceinline__ size_t abase(const pg8::Unit& u) const { return (size_t)u.pm * 256 * 2048; }
    __device__ __forceinline__ const char* bptr(const pg8::Unit& u, int t) const { return (const char*)Bt + (size_t)u.pn * 256 * 2048 + (size_t)t * 128; }
    __device__ __forceinline__ void epi(const f32x4 (&acc)[2][2][4][2], const pg8::Unit& u, int wr, int wc, int fr, int fq) const {
        const int row0 = u.pm * 256 + wr * 64 + fr, lc0 = wc * 32 + 8 * fq;
        if (u.pn >= 3) {
            bf16* base = proj + (size_t)row0 * PROJ_LD + (u.pn - 3) * 256 + lc0;
#pragma unroll
            for (int ai = 0; ai < 2; ++ai)
#pragma unroll
                for (int m = 0; m < 4; ++m) { bf16* rowp = base + (size_t)(ai * 128 + m * 16) * PROJ_LD;
#pragma unroll
                    for (int bj = 0; bj < 2; ++bj) { const f32x4 v0 = acc[ai][bj][m][0], v1 = acc[ai][bj][m][1]; u32x4 w;
                        w.x = pg8::cvt_pk_bf16(v0[0], v0[1]); w.y = pg8::cvt_pk_bf16(v0[2], v0[3]); w.z = pg8::cvt_pk_bf16(v1[0], v1[1]); w.w = pg8::cvt_pk_bf16(v1[2], v1[3]);
                        *(u32x4*)(rowp + bj * 128) = w; } }
        } else {
            bf16* base = hyT + (size_t)(u.pn * 256 + lc0) * NTOK + row0;
#pragma unroll
            for (int ai = 0; ai < 2; ++ai)
#pragma unroll
                for (int m = 0; m < 4; ++m)
#pragma unroll
                    for (int bj = 0; bj < 2; ++bj)
#pragma unroll
                        for (int n = 0; n < 2; ++n)
#pragma unroll
                            for (int j = 0; j < 4; ++j)
                                base[(size_t)(bj * 128 + 4 * n + j) * NTOK + ai * 128 + m * 16] = (bf16)f2bf(acc[ai][bj][m][n][j]);
        }
    }
};

struct OpOut {
    const bf16* A_; const bf16* Bt; const float* xin_lat; const float* xin_ctx; float* xo_lat; float* xo_ctx; const float* mod; int layer, G, vcu; float scale;
    __device__ __forceinline__ const bf16* A() const { return A_; }
    __device__ __forceinline__ int ldb() const { return 1024; }
    __device__ __forceinline__ bool next(int i, pg8::Unit& u) const {
        const int L = i * G + vcu; const int total = (layer == 0 ? 136 : 128) * 4;
        if (L >= total) return false;
        u.pm = L >> 2; u.pn = L & 3; u.k = 0; u.aux = 0; return true;
    }
    static constexpr bool GATHER = false;
    __device__ __forceinline__ size_t abase(const pg8::Unit& u) const { return (size_t)u.pm * 256 * 2048; }
    __device__ __forceinline__ const char* bptr(const pg8::Unit& u, int t) const { return (const char*)Bt + (size_t)u.pn * 256 * 2048 + (size_t)t * 128; }
    __device__ __forceinline__ void epi(const f32x4 (&acc)[2][2][4][2], const pg8::Unit& u, int wr, int wc, int fr, int fq) const {
        const int grow0 = u.pm * 256; const bool isl = grow0 < NLAT;
        const float* xi = isl ? xin_lat + (size_t)grow0 * 1024 : xin_ctx + (size_t)(grow0 - NLAT) * 1024;
        float* xo = isl ? xo_lat + (size_t)grow0 * 1024 : xo_ctx + (size_t)(grow0 - NLAT) * 1024;
        const float* g1 = mod + (size_t)mod_idx(grow0) * 6144 + 2 * 1024;
        const int lr0 = wr * 64 + fr, c0 = u.pn * 256 + wc * 32 + 8 * fq;
#pragma unroll
        for (int bj = 0; bj < 2; ++bj)
#pragma unroll
            for (int n = 0; n < 2; ++n) { const int col = c0 + bj * 128 + 4 * n; const f32x4 gv = *(const f32x4*)(g1 + col) * scale;
#pragma unroll
                for (int ai = 0; ai < 2; ++ai)
#pragma unroll
                    for (int m = 0; m < 4; ++m) { const size_t o = (size_t)(lr0 + ai * 128 + m * 16) * 1024 + col;
                        const f32x4 xv = *(const f32x4*)(xi + o); *(f32x4*)(xo + o) = xv + gv * acc[ai][bj][m][n]; } }
    }
};

struct MoeTab { const LAS int* t; };
__device__ __forceinline__ void moe_decode(const LAS int* tab, int mi, int& k, int& j) {
    int kk = 0;
#pragma unroll 1
    for (int q = 1; q < NBUCKET; ++q) if (tab[q] <= mi) kk = q;
    k = kk; j = mi - tab[kk];
}
__device__ __forceinline__ void pair_of(int k, int& elo, int& ehi) {
    const int g = k / 6, p = k - g * 6;
    const int lo = p < 3 ? 0 : (p < 5 ? 1 : 2), hi = p < 3 ? p + 1 : (p < 5 ? p - 1 : 3);
    elo = g * 4 + lo; ehi = g * 4 + hi;
}
struct OpMoe1 {
    const bf16* A_; const bf16* W1; bf16* abuf; const int* TOK; const float* WLO; const float* WHI; const LAS int* tab; int layer, G, vcu;
    __device__ __forceinline__ const bf16* A() const { return A_; }
    __device__ __forceinline__ int ldb() const { return 1024; }
    __device__ __forceinline__ bool next(int i, pg8::Unit& u) const {
        const int L = i * G + vcu; const int MT = tab[NBUCKET];
        if (L >= MT * 8) return false;
        u.pm = L >> 3; u.pn = L & 7; moe_decode(tab, u.pm, u.k, u.aux); return true;
    }
    static constexpr bool GATHER = true;
    __device__ __forceinline__ size_t abase(const pg8::Unit&) const { return 0; }
    __device__ __forceinline__ unsigned arow(const pg8::Unit& u, int lr) const {
        const int cnt = tab[32 + u.k]; int p = u.aux * 256 + lr; p = p < cnt ? p : cnt - 1;
        return (unsigned)TOK[(size_t)u.k * NTOK + p] * 2048u;
    }
    __device__ __forceinline__ const char* bptr(const pg8::Unit& u, int t) const {
        int elo, ehi; pair_of(u.k, elo, ehi); const int e = u.pn < 4 ? elo : ehi;
        return (const char*)W1 + ((size_t)(layer * 16 + e) * 1024 + (u.pn & 3) * 256) * 2048 + (size_t)t * 128;
    }
    __device__ __forceinline__ void epi(const f32x4 (&acc)[2][2][4][2], const pg8::Unit& u, int wr, int wc, int fr, int fq) const {
        const int cnt = tab[32 + u.k]; const float* WW = (u.pn < 4 ? WLO : WHI) + (size_t)u.k * NTOK;
        const int lr0 = wr * 64 + fr, c0 = (u.pn >= 4 ? 512 : 0) + (u.pn & 3) * 128 + wc * 32 + 8 * fq;
#pragma unroll
        for (int ai = 0; ai < 2; ++ai)
#pragma unroll
            for (int m = 0; m < 4; ++m) { const int lr = lr0 + ai * 128 + m * 16; int p = u.aux * 256 + lr; p = p < cnt ? p : cnt - 1; const float w = WW[p];
                const f32x4 g0 = acc[ai][0][m][0], g1 = acc[ai][0][m][1], u0 = acc[ai][1][m][0], u1 = acc[ai][1][m][1]; float o[8];
#pragma unroll
                for (int j = 0; j < 4; ++j) { o[j] = siluf(g0[j]) * u0[j] * w; o[4 + j] = siluf(g1[j]) * u1[j] * w; }
                u32x4 ww; ww.x = pg8::cvt_pk_bf16(o[0], o[1]); ww.y = pg8::cvt_pk_bf16(o[2], o[3]); ww.z = pg8::cvt_pk_bf16(o[4], o[5]); ww.w = pg8::cvt_pk_bf16(o[6], o[7]);
                *(u32x4*)(abuf + (size_t)(u.pm * 256 + lr) * 1024 + c0) = ww; }
    }
};
struct OpMoe2 {
    const bf16* A_; const bf16* W2; float* x_lat; float* x_ctx; const float* mod; const int* TOK; const LAS int* tab; int layer, G, vcu; float scale;
    __device__ __forceinline__ const bf16* A() const { return A_; }
    __device__ __forceinline__ int ldb() const { return 512; }
    __device__ __forceinline__ bool next(int i, pg8::Unit& u) const {
        const int L = i * G + vcu; const int MT = tab[NBUCKET];
        if (L >= MT * 4) return false;
        u.pm = L >> 2; u.pn = L & 3; moe_decode(tab, u.pm, u.k, u.aux); return true;
    }
    static constexpr bool GATHER = false;
    __device__ __forceinline__ size_t abase(const pg8::Unit& u) const { return (size_t)u.pm * 256 * 2048; }
    __device__ __forceinline__ const char* bptr(const pg8::Unit& u, int t) const {
        int elo, ehi; pair_of(u.k, elo, ehi); const int e = t < 8 ? elo : ehi;
        return (const char*)W2 + ((size_t)(layer * 16 + e) * 1024 + u.pn * 256) * 1024 + (size_t)(t & 7) * 128;
    }
    __device__ __forceinline__ void epi(const f32x4 (&acc)[2][2][4][2], const pg8::Unit& u, int wr, int wc, int fr, int fq) const {
        const int cnt = tab[32 + u.k]; const int lr0 = wr * 64 + fr, c0 = u.pn * 256 + wc * 32 + 8 * fq;
#pragma unroll
        for (int ai = 0; ai < 2; ++ai)
#pragma unroll
            for (int m = 0; m < 4; ++m) { const int p = u.aux * 256 + lr0 + ai * 128 + m * 16;
                if (p < cnt) { const int tok = TOK[(size_t)u.k * NTOK + p];
                    float* xr = tok < NLAT ? x_lat + (size_t)tok * 1024 : x_ctx + (size_t)(tok - NLAT) * 1024; const float* g2 = mod + (size_t)mod_idx(tok) * 6144 + 5 * 1024;
#pragma unroll
                    for (int bj = 0; bj < 2; ++bj)
#pragma unroll
                        for (int n = 0; n < 2; ++n) { const int col = c0 + bj * 128 + 4 * n; const f32x4 gv = *(const f32x4*)(g2 + col) * scale; const f32x4 xv = *(const f32x4*)(xr + col);
                            *(f32x4*)(xr + col) = xv + gv * acc[ai][bj][m][n]; } } }
    }
};
__device__ __forceinline__ void transpose_item(const float* W, int N, int k0, int n0, bf16* WT, int ldk, int dst_row0, LAS float* scr, int lane) {
#pragma unroll 8
    for (int i = 0; i < 32; ++i) { const int kk = 2 * i + (lane >> 5); scr[kk * 33 + (lane & 31)] = W[(size_t)(k0 + kk) * N + n0 + (lane & 31)]; }
    asm volatile("s_waitcnt lgkmcnt(0)" ::: "memory");
    const int c = lane & 7;
#pragma unroll
    for (int j = 0; j < 4; ++j) { const int n = (lane >> 3) + 8 * j; const LAS float* s = scr + (8 * c) * 33 + n;
        u32x4 o; o.x = pk2(s[0 * 33], s[1 * 33]); o.y = pk2(s[2 * 33], s[3 * 33]); o.z = pk2(s[4 * 33], s[5 * 33]); o.w = pk2(s[6 * 33], s[7 * 33]);
        *(u32x4*)(WT + (size_t)(dst_row0 + n) * ldk + k0 + 8 * c) = o; }
    asm volatile("s_waitcnt lgkmcnt(0)" ::: "memory");
}
__device__ __forceinline__ int win_dst(int n0) { return n0 < 1792 ? n0 : (n0 < 1984 ? 1952 + (n0 - 1792) : 1792 + (n0 - 1984)); }

__device__ __forceinline__ void p0_weights(const Frame& F, KArgs a) {
    LAS float* scr = (LAS float*)(F.lds + F.wave * 16384);
    constexpr int N_WIN = 2 * 16 * 67, N_WOUT = 2 * 16 * 32, N_G = 2 * 16 * 16 * 16, N_U = N_G, N_D = 2 * 16 * 8 * 32, N_UQ = 2 * 3 * 12, N_UKV = 2 * 2 * 16;
    constexpr int NIT = N_WIN + N_WOUT + N_G + N_U + N_D + N_UQ + N_UKV;
    unsigned char* ws = F.ws;
    for (int it = F.gw; it < NIT; it += F.NGW) {
        int r = it;
        if (r < N_WIN) { const int l = r / (16 * 67), q = r % (16 * 67), kb = q / 67, nb = q % 67;
            transpose_item(a->in[I_WIN] + (size_t)l * 1024 * IN_COLS, IN_COLS, kb * 64, nb * 32, (bf16*)(ws + WS_WIN) + (size_t)l * NIN_PAD * 1024, 1024, win_dst(nb * 32) - 0, scr, F.lane); continue; } r -= N_WIN;
        if (r < N_WOUT) { const int l = r / 512, q = r % 512, kb = q / 32, nb = q % 32;
            transpose_item(a->in[I_WOUT] + (size_t)l * 1024 * 1024, 1024, kb * 64, nb * 32, (bf16*)(ws + WS_WOUT) + (size_t)l * 1024 * 1024, 1024, nb * 32, scr, F.lane); continue; } r -= N_WOUT;
        if (r < N_G + N_U) { const bool up = r >= N_G; if (up) r -= N_G; const int le = r / 256, q = r % 256, kb = q / 16, nb = q % 16; const int f0 = nb * 32;
            transpose_item(a->in[up ? I_EWU : I_EWG] + (size_t)le * 1024 * 512, 512, kb * 64, f0, (bf16*)(ws + WS_W1) + (size_t)le * 1024 * 1024, 1024, (f0 >> 7) * 256 + (up ? 128 : 0) + (f0 & 127), scr, F.lane); continue; } r -= N_G + N_U;
        if (r < N_D) { const int le = r / 256, q = r % 256, kb = q / 32, nb = q % 32;
            transpose_item(a->in[I_EWD] + (size_t)le * 512 * 1024, 1024, kb * 64, nb * 32, (bf16*)(ws + WS_W2) + (size_t)le * 1024 * 512, 512, nb * 32, scr, F.lane); continue; } r -= N_D;
        if (r < N_UQ) { const int l = r / 36, q = r % 36, kb = q / 12, nb = q % 12;
            transpose_item(a->in[I_WUQ] + (size_t)l * 192 * 384, 384, kb * 64, nb * 32, (bf16*)(ws + WS_WUQ) + (size_t)l * 384 * 192, 192, nb * 32, scr, F.lane); continue; } r -= N_UQ;
        { const int l = r / 32, q = r % 32, kb = q / 16, nb = q % 16;
            transpose_item(a->in[I_WUKV] + (size_t)l * 128 * 512, 512, kb * 64, nb * 32, (bf16*)(ws + WS_WUKV) + (size_t)l * 512 * 128, 128, nb * 32, scr, F.lane); }
    }
    const int gt = (F.vcu * 512 + F.tid), NGT = F.G * 512;
    for (int i = gt; i < 2 * 160 * 128; i += NGT) { const int l = i / (160 * 128), q = i % (160 * 128);
        *(u32x4*)((bf16*)(ws + WS_WIN) + ((size_t)l * NIN_PAD + 2144) * 1024 + (size_t)q * 8) = (u32x4){0u, 0u, 0u, 0u}; }
    for (int i = gt; i < 2 * 4 * 128 * 128 / 4; i += NGT) { const f32x4 v = *(const f32x4*)(a->in[I_GMWS] + (size_t)i * 4); u32x2 o; o.x = pk2(v[0], v[1]); o.y = pk2(v[2], v[3]);
        *(u32x2*)((bf16*)(ws + WS_GMWS) + (size_t)i * 4) = o; }
    for (int i = gt; i < 4096 * 16; i += NGT) { const int t = i >> 4, j = i & 15; const float pos = (float)(j < 8 ? (t >> 6) : (t & 63));
        const float inv = powf(10000.0f, -(float)(j & 7) / 8.0f); const float ang = pos * inv;
        ((float*)(ws + WS_ROPE))[i] = cosf(ang); ((float*)(ws + WS_ROPE))[4096 * 16 + i] = sinf(ang); }
}

__device__ __forceinline__ void p0_mod(const Frame& F, KArgs a) {
    LAS float* sc = (LAS float*)F.lds;
    LAS float* part = sc + 9 * 1024;
    float* mod = (float*)(F.ws + WS_MOD);
    bool have = false;
    __syncthreads();
    for (int it = blockIdx.x; it < 2 * 96; it += F.G) {
        if (!have) { for (int i = F.tid; i < 9 * 1024; i += 512) { const int j = i >> 10, k = i & 1023; const float c = j < 8 ? a->in[I_C][j * 1024 + k] : a->in[I_CCTX][k]; sc[i] = siluf(c); } have = true; }
        __syncthreads();
        const int l = it / 96, cb = it % 96, col = F.tid & 63, kq = F.tid >> 6;
        const float* W = a->in[I_ADAW] + (size_t)l * 1024 * 6144 + cb * 64 + col;
        float acc[9];
#pragma unroll
        for (int j = 0; j < 9; ++j) acc[j] = 0.f;
        for (int k = kq * 128; k < kq * 128 + 128; ++k) { const float w = W[(size_t)k * 6144];
#pragma unroll
            for (int j = 0; j < 9; ++j) acc[j] += sc[j * 1024 + k] * w; }
#pragma unroll
        for (int j = 0; j < 9; ++j) part[(kq * 9 + j) * 64 + col] = acc[j];
        __syncthreads();
        for (int i = F.tid; i < 9 * 64; i += 512) { const int j = i >> 6, c2 = i & 63; float s = a->in[I_ADAB][l * 6144 + cb * 64 + c2];
#pragma unroll
            for (int q = 0; q < 8; ++q) s += part[(q * 9 + j) * 64 + c2];
            mod[((size_t)l * 9 + j) * 6144 + cb * 64 + c2] = s; }
    }
    __syncthreads();
}

__device__ __forceinline__ void p0_filters(const Frame& F, KArgs a) {
    LAS float* z = (LAS float*)F.lds;
    LAS float* h1 = z + 32 * 36;
    LAS float* h2 = h1 + 32 * 64;
    float* fsp = (float*)(F.ws + WS_FS);
    for (int it = blockIdx.x; it < 128 + 128 + 8; it += F.G) {
        const int set = it < 128 ? 0 : (it < 256 ? 1 : 2), tt = it < 256 ? (it & 127) : it - 256;
        const int l = set == 2 ? 0 : set, L = set == 2 ? 256 : 4096, t0 = tt * 32;
        const float* w1 = a->in[I_HFW1] + l * 33 * 64; const float* b1 = a->in[I_HFB1] + l * 64; const float* fr = a->in[I_HFFREQ] + l * 64;
        const float* w2 = a->in[I_HFW2] + l * 64 * 64; const float* b2 = a->in[I_HFB2] + l * 64; const float* w3 = a->in[I_HFW3] + (size_t)l * 64 * 1024;
        __syncthreads();
        { const int tl = F.tid >> 4, f = F.tid & 15, tg = t0 + tl;
          const float fb = 1e-4f + (float)f * ((15.0f - 1e-4f) / 15.0f); const float w = 6.283185307179586f * (float)tg / (float)L;
          const float ang = fb * w; z[tl * 36 + 1 + f] = cosf(ang); z[tl * 36 + 17 + f] = -sinf(ang);
          if (f == 0) z[tl * 36] = (float)tg / (float)(L - 1); }
        __syncthreads();
        { const int tl = F.tid >> 4, j0 = (F.tid & 15) * 4;
#pragma unroll
          for (int jj = 0; jj < 4; ++jj) { const int j = j0 + jj; float s = b1[j]; for (int i = 0; i < 33; ++i) s += z[tl * 36 + i] * w1[i * 64 + j]; h1[tl * 64 + j] = sinf(fr[j] * s); } }
        __syncthreads();
        { const int tl = F.tid >> 4, j0 = (F.tid & 15) * 4;
#pragma unroll
          for (int jj = 0; jj < 4; ++jj) { const int j = j0 + jj; float s = b2[j]; for (int i = 0; i < 64; ++i) s += h1[tl * 64 + i] * w2[i * 64 + j]; h2[tl * 64 + j] = sinf(fr[j] * s); } }
        __syncthreads();
#pragma unroll 1
        for (int o = 0; o < 2; ++o) {
            const int col = o * 512 + F.tid, dir = F.tid >> 8, c = F.tid & 255;
            float acc[32];
#pragma unroll
            for (int t = 0; t < 32; ++t) acc[t] = 0.f;
            for (int k = 0; k < 64; ++k) { const float w = w3[(size_t)k * 1024 + col];
#pragma unroll
                for (int t = 0; t < 32; ++t) acc[t] += h2[t * 64 + k] * w; }
            const float lo = -3.0701134573253945f, hi = -15.350567286626972f;
            const float delta = fabsf(lo + (float)c * ((hi - lo) / 255.0f));
            float asum = 0.f;
            if (set < 2) {
                bf16* Gp = (bf16*)(F.ws + WS_G) + ((size_t)(set * 2 + o) * 256 + c) * GLEN;
#pragma unroll
                for (int t = 0; t < 32; ++t) { const int tg = t0 + t; const float v = acc[t] * __expf(-z[t * 36] * delta);
                    if (dir == 0) { asum += fabsf(v); Gp[GC - tg] = (bf16)f2bf(v); } else if (tg >= 1) { asum += fabsf(v); Gp[GC + tg] = (bf16)f2bf(v); } }
            } else {
                float* Tp = (float*)(F.ws + WS_TC) + ((size_t)o * 256 + c) * 512;
#pragma unroll
                for (int t = 0; t < 32; ++t) { const int tg = t0 + t; const float v = acc[t] * __expf(-z[t * 36] * delta);
                    if (dir == 0) { asum += fabsf(v); Tp[256 + tg] = v; } else if (tg >= 1) { asum += fabsf(v); Tp[256 - tg] = v; } }
            }
            fsp[((size_t)set * 128 + tt) * 1024 + col] = asum;
        }
    }
    __syncthreads();
}
__device__ __forceinline__ void norm_mod_row(const float* xrow, const float* g, const float* sc, const float* sh, bf16* orow, int lane) {
    const f32x4* xr = (const f32x4*)xrow + lane;
    f32x4 v[4]; float s = 0.f;
#pragma unroll
    for (int j = 0; j < 4; ++j) { v[j] = xr[64 * j]; s += (v[j].x * v[j].x + v[j].y * v[j].y) + (v[j].z * v[j].z + v[j].w * v[j].w); }
    const float rstd = 1.f / sqrtf(wave_sum(s) * (1.f / 1024.f) + EPS);
    unsigned long long* o8 = (unsigned long long*)orow + lane;
#pragma unroll
    for (int j = 0; j < 4; ++j) { const int k = 4 * lane + 256 * j; const f32x4 gg = *(const f32x4*)(g + k), cc = *(const f32x4*)(sc + k), hh = *(const f32x4*)(sh + k);
        const f32x4 y = v[j] * rstd * gg * (cc + 1.f) + hh;
        o8[64 * j] = (unsigned long long)pk2(y.x, y.y) | ((unsigned long long)pk2(y.z, y.w) << 32); }
}
__device__ __forceinline__ void p1_norm(const Frame& F, KArgs a, int layer, const float* xlat, const float* xctx) {
    const float* mod = (const float*)(F.ws + WS_MOD) + (size_t)layer * 9 * 6144; const float* g = a->in[I_N1G] + layer * 1024; bf16* H = (bf16*)(F.ws + WS_H);
    for (int r = F.gw; r < NTOK; r += F.NGW) {
        const float* xr = r < NLAT ? xlat + (size_t)r * 1024 : xctx + (size_t)(r - NLAT) * 1024; const float* m = mod + (size_t)mod_idx(r) * 6144;
        norm_mod_row(xr, g, m + 1024, m, H + (size_t)r * 1024, F.lane);
    }
}

__device__ __forceinline__ void p7_router(const Frame& F, KArgs a, int layer, const float* xlat, const float* xctx, int nrows, bool dry = false) {
    const float* mod = (const float*)(F.ws + WS_MOD) + (size_t)layer * 9 * 6144; const float* g = a->in[I_N2G] + layer * 1024; bf16* H = (bf16*)(F.ws + WS_H);
    LAS float* wr = (LAS float*)F.lds;
    LAS float* ys = (LAS float*)(F.lds + 65536) + F.wave * 1024;
    LAS int* rb = (LAS int*)(F.lds + 98304);
    LAS float* rlo = (LAS float*)(F.lds + 98304 + 1024);
    LAS float* rhi = (LAS float*)(F.lds + 98304 + 2048);
    LAS int* bcnt = (LAS int*)(F.lds + 98304 + 3072);
    __syncthreads();
    for (int i = F.tid; i < 1024 * 16 / 4; i += 512) ((LAS f32x4*)wr)[i] = ((const f32x4*)a->in[I_WROUTER])[i];
    if (F.tid < 64) bcnt[F.tid] = 0;
    __syncthreads();
    const int per = (nrows + F.G - 1) / F.G;
    const int r0 = blockIdx.x * per, r1 = min(r0 + per, nrows);
    const int eq = F.lane & 3, ks = F.lane >> 2;
    const float rbias0 = a->in[I_RBIAS][4 * eq], rbias1 = a->in[I_RBIAS][4 * eq + 1], rbias2 = a->in[I_RBIAS][4 * eq + 2], rbias3 = a->in[I_RBIAS][4 * eq + 3];
#pragma unroll 1
    for (int r = r0 + F.wave; r < r1; r += 8) {
        const float* xr = r < NLAT ? xlat + (size_t)r * 1024 : xctx + (size_t)(r - NLAT) * 1024; const float* m = mod + (size_t)mod_idx(r) * 6144;
        const f32x4* x4 = (const f32x4*)xr + F.lane;
        f32x4 v[4]; float s = 0.f;
#pragma unroll
        for (int j = 0; j < 4; ++j) { v[j] = x4[64 * j]; s += (v[j].x * v[j].x + v[j].y * v[j].y) + (v[j].z * v[j].z + v[j].w * v[j].w); }
        const float rstd = 1.f / sqrtf(wave_sum(s) * (1.f / 1024.f) + EPS);
        unsigned long long* o8 = (unsigned long long*)(H + (size_t)r * 1024) + F.lane;
#pragma unroll
        for (int j = 0; j < 4; ++j) { const int k = 4 * F.lane + 256 * j; const f32x4 gg = *(const f32x4*)(g + k), cc = *(const f32x4*)(m + 4 * 1024 + k), hh = *(const f32x4*)(m + 3 * 1024 + k);
            const f32x4 y = v[j] * rstd * gg * (cc + 1.f) + hh;
            o8[64 * j] = (unsigned long long)pk2(y.x, y.y) | ((unsigned long long)pk2(y.z, y.w) << 32);
            *(LAS f32x4*)(ys + k) = y; }
        asm volatile("s_waitcnt lgkmcnt(0)" ::: "memory");
        f32x4 lg = (f32x4){0.f, 0.f, 0.f, 0.f};
#pragma unroll 8
        for (int i = 0; i < 64; ++i) { const int k = ks + 16 * i; const float yv = ys[k]; const f32x4 w = *(const LAS f32x4*)(wr + k * 16 + 4 * eq); lg += w * yv; }
#pragma unroll
        for (int o2 = 4; o2 < 64; o2 <<= 1) { lg.x += __shfl_xor(lg.x, o2); lg.y += __shfl_xor(lg.y, o2); lg.z += __shfl_xor(lg.z, o2); lg.w += __shfl_xor(lg.w, o2); }
        const float s0 = sigmf(lg.x), s1 = sigmf(lg.y), s2 = sigmf(lg.z), s3 = sigmf(lg.w);
        const float e0 = s0 + rbias0, e1 = s1 + rbias1, e2 = s2 + rbias2, e3 = s3 + rbias3;
        int i1 = 0, i2 = 0; float m1 = -1e30f, m2 = -1e30f, w1 = 0.f, w2 = 0.f;
        { const float ee[4] = {e0, e1, e2, e3}; const float ss[4] = {s0, s1, s2, s3};
#pragma unroll
          for (int q = 0; q < 4; ++q) { const float x = ee[q]; if (x > m1) { m2 = m1; i2 = i1; w2 = w1; m1 = x; i1 = q; w1 = ss[q]; } else if (x > m2) { m2 = x; i2 = q; w2 = ss[q]; } } }
        const float gs = m1 + m2;
        const float g0 = __shfl(gs, 0), g1 = __shfl(gs, 1), g2 = __shfl(gs, 2), g3 = __shfl(gs, 3);
        int best = 0; float bs = g0; if (g1 > bs) { bs = g1; best = 1; } if (g2 > bs) { bs = g2; best = 2; } if (g3 > bs) { bs = g3; best = 3; }
        if (F.lane == best) {
            const float inv = 1.f / (w1 + w2); const float a1 = w1 * inv, a2 = w2 * inv;
            const int lo = i1 < i2 ? i1 : i2, hi = i1 < i2 ? i2 : i1; const float wl = i1 < i2 ? a1 : a2, wh = i1 < i2 ? a2 : a1;
            const int p = lo == 0 ? hi - 1 : (lo == 1 ? hi + 1 : 5);
            const int lr = r - r0; rb[lr] = best * 6 + p; rlo[lr] = wl; rhi[lr] = wh;
        }
    }
    __syncthreads();
    const int n = dry ? 0 : (r1 > r0 ? r1 - r0 : 0);
    int myslot = -1, myb = 0;
    if (F.tid < n) { myb = rb[F.tid]; myslot = atomicAdd((int*)&bcnt[myb], 1); }
    __syncthreads();
    if (F.tid < NBUCKET && !dry) { const int c = bcnt[F.tid]; bcnt[32 + F.tid] = c > 0 ? (int)atomicAdd(F.ctl + CW_CNT + layer * 32 + F.tid, (unsigned)c) : 0; }
    __syncthreads();
    if (F.tid < n) { const size_t p = (size_t)myb * NTOK + bcnt[32 + myb] + myslot;
        ((int*)(F.ws + WS_TOK))[p] = r0 + F.tid; ((float*)(F.ws + WS_WLO))[p] = rlo[F.tid]; ((float*)(F.ws + WS_WHI))[p] = rhi[F.tid]; }
    __syncthreads();
}

__device__ __forceinline__ void p_final(const Frame& F, KArgs a) {
    const float* g = a->in[I_FNG];
    for (int r = F.gw; r < NLAT; r += F.NGW) {
        f32x4* xr = (f32x4*)(a->out + (size_t)r * 1024) + F.lane;
        f32x4 v[4]; float s = 0.f;
#pragma unroll
        for (int j = 0; j < 4; ++j) { v[j] = xr[64 * j]; s += (v[j].x * v[j].x + v[j].y * v[j].y) + (v[j].z * v[j].z + v[j].w * v[j].w); }
        const float rstd = 1.f / sqrtf(wave_sum(s) * (1.f / 1024.f) + EPS);
#pragma unroll
        for (int j = 0; j < 4; ++j) { const f32x4 gg = *(const f32x4*)(g + 4 * F.lane + 256 * j); xr[64 * j] = v[j] * rstd * gg; }
    }
}
__device__ __forceinline__ f32x4 mfma16(bf16x8 a, bf16x8 b, f32x4 c) { return __builtin_amdgcn_mfma_f32_16x16x32_bf16(a, b, c, 0, 0, 0); }
__device__ __forceinline__ void row_bk(int r, int& b, int& key, bool& lat) { lat = r < NLAT; if (lat) { b = r >> 12; key = r & 4095; } else { const int rc = r - NLAT; b = rc >> 8; key = 4096 + (rc & 255); } }

__device__ __forceinline__ void p3_mla_unit(const Frame& F, KArgs a, int layer, int r0) {
    LAS float* Xq = (LAS float*)F.lds;
    LAS float* Xkv = (LAS float*)(F.lds + 49152);
    LAS bf16* Aq = (LAS bf16*)(F.lds + 90112);
    LAS bf16* Akv = (LAS bf16*)(F.lds + 115712);
    LAS bf16* Kr = (LAS bf16*)(F.lds + 133120);
    const bf16* proj = (const bf16*)(F.ws + WS_PROJ);
    int b0, key0; bool lat; row_bk(r0, b0, key0, lat);
    __syncthreads();
    for (int i = F.tid; i < 64 * 24; i += 512) { const int r = i / 24, c8 = i % 24; const u32x4 w = *(const u32x4*)(proj + (size_t)(r0 + r) * PROJ_LD + PJ_MQ + c8 * 8); LAS float* d = Xq + r * 192 + c8 * 8;
        d[0] = lo_bf(w.x); d[1] = hi_bf(w.x); d[2] = lo_bf(w.y); d[3] = hi_bf(w.y); d[4] = lo_bf(w.z); d[5] = hi_bf(w.z); d[6] = lo_bf(w.w); d[7] = hi_bf(w.w); }
    for (int i = F.tid; i < 64 * 20; i += 512) { const int r = i / 20, c8 = i % 20; const u32x4 w = *(const u32x4*)(proj + (size_t)(r0 + r) * PROJ_LD + PJ_MKV + c8 * 8); LAS float* d = Xkv + r * 160 + c8 * 8;
        d[0] = lo_bf(w.x); d[1] = hi_bf(w.x); d[2] = lo_bf(w.y); d[3] = hi_bf(w.y); d[4] = lo_bf(w.z); d[5] = hi_bf(w.z); d[6] = lo_bf(w.w); d[7] = hi_bf(w.w); }
    __syncthreads();
    const float* qg = a->in[I_QANORM] + layer * 192; const float* kg = a->in[I_KVANORM] + layer * 128;
    for (int r = F.wave; r < 64; r += 8) {
        const float q0 = Xq[r * 192 + F.lane], q1 = Xq[r * 192 + 64 + F.lane], q2 = Xq[r * 192 + 128 + F.lane];
        const float rq = 1.f / sqrtf(wave_sum(q0 * q0 + q1 * q1 + q2 * q2) * (1.f / 192.f) + EPS);
        Aq[r * 200 + F.lane] = (bf16)f2bf(q0 * rq * qg[F.lane]); Aq[r * 200 + 64 + F.lane] = (bf16)f2bf(q1 * rq * qg[64 + F.lane]); Aq[r * 200 + 128 + F.lane] = (bf16)f2bf(q2 * rq * qg[128 + F.lane]);
        const float k0 = Xkv[r * 160 + F.lane], k1 = Xkv[r * 160 + 64 + F.lane];
        const float rk = 1.f / sqrtf(wave_sum(k0 * k0 + k1 * k1) * (1.f / 128.f) + EPS);
        Akv[r * 136 + F.lane] = (bf16)f2bf(k0 * rk * kg[F.lane]); Akv[r * 136 + 64 + F.lane] = (bf16)f2bf(k1 * rk * kg[64 + F.lane]);
    }
    const float* ropec = (const float*)(F.ws + WS_ROPE); const float* ropes = ropec + 4096 * 16;
    for (int i = F.tid; i < 64 * 16; i += 512) { const int r = i >> 4, j = i & 15; const float x1 = Xkv[r * 160 + 128 + j], x2 = Xkv[r * 160 + 144 + j];
        float cs = 1.f, sn = 0.f; if (lat) { cs = ropec[(key0 + r) * 16 + j]; sn = ropes[(key0 + r) * 16 + j]; }
        Kr[r * 32 + j] = (bf16)f2bf(x1 * cs - x2 * sn); Kr[r * 32 + 16 + j] = (bf16)f2bf(x1 * sn + x2 * cs); }
    __syncthreads();
    const int h = F.wave >> 1, rh = F.wave & 1, lr = F.lane & 15, lq = F.lane >> 4;
    {
        const bf16* W = (const bf16*)(F.ws + WS_WUQ) + (size_t)layer * 384 * 192;
        f32x4 acc[2][6];
#pragma unroll
        for (int mt = 0; mt < 2; ++mt)
#pragma unroll
            for (int nt = 0; nt < 6; ++nt) acc[mt][nt] = (f32x4){0.f, 0.f, 0.f, 0.f};
#pragma unroll 1
        for (int ks = 0; ks < 6; ++ks) {
            bf16x8 af[2], bfr[6];
#pragma unroll
            for (int mt = 0; mt < 2; ++mt) af[mt] = *(const LAS bf16x8*)(Aq + (rh * 32 + mt * 16 + lr) * 200 + ks * 32 + lq * 8);
#pragma unroll
            for (int nt = 0; nt < 6; ++nt) bfr[nt] = *(const bf16x8*)(W + (size_t)(h * 96 + nt * 16 + lr) * 192 + ks * 32 + lq * 8);
#pragma unroll
            for (int mt = 0; mt < 2; ++mt)
#pragma unroll
                for (int nt = 0; nt < 6; ++nt) acc[mt][nt] = mfma16(bfr[nt], af[mt], acc[mt][nt]);
        }
        bf16* Q = (bf16*)(F.ws + WS_Q);
#pragma unroll
        for (int mt = 0; mt < 2; ++mt) { const int tl = rh * 32 + mt * 16 + lr;
            if (lat) {
#pragma unroll
                for (int j = 0; j < 4; ++j) { const float cs = ropec[(key0 + tl) * 16 + lq * 4 + j], sn = ropes[(key0 + tl) * 16 + lq * 4 + j]; const float x1 = acc[mt][4][j], x2 = acc[mt][5][j];
                    acc[mt][4][j] = x1 * cs - x2 * sn; acc[mt][5][j] = x1 * sn + x2 * cs; } }
#pragma unroll
            for (int nt = 0; nt < 6; ++nt) { u32x2 w; w.x = pk2(acc[mt][nt][0] * QSCALE, acc[mt][nt][1] * QSCALE); w.y = pk2(acc[mt][nt][2] * QSCALE, acc[mt][nt][3] * QSCALE);
                *(u32x2*)(Q + (size_t)(r0 + tl) * 384 + h * 96 + nt * 16 + lq * 4) = w; } }
    }
    {
        const bf16* W = (const bf16*)(F.ws + WS_WUKV) + (size_t)layer * 512 * 128;
        f32x4 ak[2][4], av[2][4];
#pragma unroll
        for (int mt = 0; mt < 2; ++mt)
#pragma unroll
            for (int nt = 0; nt < 4; ++nt) { ak[mt][nt] = (f32x4){0.f, 0.f, 0.f, 0.f}; av[mt][nt] = (f32x4){0.f, 0.f, 0.f, 0.f}; }
#pragma unroll 1
        for (int ks = 0; ks < 4; ++ks) {
            bf16x8 af[2], bk[4], bv[4];
#pragma unroll
            for (int mt = 0; mt < 2; ++mt) af[mt] = *(const LAS bf16x8*)(Akv + (rh * 32 + mt * 16 + lr) * 136 + ks * 32 + lq * 8);
#pragma unroll
            for (int nt = 0; nt < 4; ++nt) { bk[nt] = *(const bf16x8*)(W + (size_t)(h * 128 + nt * 16 + lr) * 128 + ks * 32 + lq * 8); bv[nt] = *(const bf16x8*)(W + (size_t)(h * 128 + 64 + nt * 16 + lr) * 128 + ks * 32 + lq * 8); }
#pragma unroll
            for (int mt = 0; mt < 2; ++mt)
#pragma unroll
                for (int nt = 0; nt < 4; ++nt) { ak[mt][nt] = mfma16(bk[nt], af[mt], ak[mt][nt]); av[mt][nt] = mfma16(af[mt], bv[nt], av[mt][nt]); }
        }
        bf16* Kg = (bf16*)(F.ws + WS_K) + ((size_t)(b0 * 4 + h) * NKEY + key0) * 96;
        bf16* Vt = (bf16*)(F.ws + WS_VT) + (size_t)(b0 * 4 + h) * 64 * NKEY + key0;
#pragma unroll
        for (int mt = 0; mt < 2; ++mt)
#pragma unroll
            for (int nt = 0; nt < 4; ++nt) {
                u32x2 w; w.x = pk2(ak[mt][nt][0], ak[mt][nt][1]); w.y = pk2(ak[mt][nt][2], ak[mt][nt][3]);
                *(u32x2*)(Kg + (size_t)(rh * 32 + mt * 16 + lr) * 96 + nt * 16 + lq * 4) = w;
                u32x2 v; v.x = pk2(av[mt][nt][0], av[mt][nt][1]); v.y = pk2(av[mt][nt][2], av[mt][nt][3]);
                *(u32x2*)(Vt + (size_t)(nt * 16 + lr) * NKEY + rh * 32 + mt * 16 + lq * 4) = v; }
    }
    {
        for (int i = F.tid; i < 64 * 4 * 4; i += 512) { const int r = i >> 4, hh = (i >> 2) & 3, c8 = i & 3;
            *(u32x4*)((bf16*)(F.ws + WS_K) + ((size_t)(b0 * 4 + hh) * NKEY + key0 + r) * 96 + 64 + c8 * 8) = *(const LAS u32x4*)(Kr + r * 32 + c8 * 8); }
    }
}

__device__ __forceinline__ void p3_conv_unit(const Frame& F, KArgs a, int layer, int r0) {
    LAS float* U = (LAS float*)F.lds;
    const bf16* proj = (const bf16*)(F.ws + WS_PROJ);
    const bool lat = r0 < NLAT; const int Ls = lat ? SEQ : CTXL; const int t0 = lat ? (r0 & 4095) : ((r0 - NLAT) & 255);
    __syncthreads();
    for (int i = F.tid; i < 94 * 32; i += 512) { const int rr = i >> 5, c8 = i & 31; const int t = t0 - 15 + rr; LAS float* d = U + rr * 256 + c8 * 8;
        if (t >= 0 && t < Ls) { const bf16* p = proj + (size_t)(r0 - 15 + rr) * PROJ_LD + PJ_CV + c8 * 8; const u32x4 wa = *(const u32x4*)p, wb = *(const u32x4*)(p + 256);
            d[0] = lo_bf(wa.x) * sigmf(lo_bf(wb.x)); d[1] = hi_bf(wa.x) * sigmf(hi_bf(wb.x)); d[2] = lo_bf(wa.y) * sigmf(lo_bf(wb.y)); d[3] = hi_bf(wa.y) * sigmf(hi_bf(wb.y));
            d[4] = lo_bf(wa.z) * sigmf(lo_bf(wb.z)); d[5] = hi_bf(wa.z) * sigmf(hi_bf(wb.z)); d[6] = lo_bf(wa.w) * sigmf(lo_bf(wb.w)); d[7] = hi_bf(wa.w) * sigmf(hi_bf(wb.w)); }
        else {
#pragma unroll
            for (int j = 0; j < 8; ++j) d[j] = 0.f; } }
    __syncthreads();
    const int c = F.tid & 255, th = F.tid >> 8;
    float o[32];
    { const float* w = a->in[I_CVW] + (size_t)layer * 31 * 256 + c; const float bias = a->in[I_CVB][layer * 256 + c];
#pragma unroll
      for (int t = 0; t < 32; ++t) o[t] = bias;
#pragma unroll 1
      for (int k = 0; k < 31; ++k) { const float wk = w[k * 256];
#pragma unroll
          for (int t = 0; t < 32; ++t) o[t] += U[(th * 32 + t + k) * 256 + c] * wk; } }
    __syncthreads();
#pragma unroll
    for (int t = 0; t < 32; ++t) U[(th * 32 + t) * 256 + c] = o[t];
    __syncthreads();
    const float* lg = a->in[I_CVLNG] + layer * 256; const float* lb = a->in[I_CVLNB] + layer * 256; const float* mg = a->in[I_MIXG] + layer * 1024 + 512;
    bf16* Y = (bf16*)(F.ws + WS_H);
    for (int r = F.wave; r < 64; r += 8) {
        const f32x4 v = *(const LAS f32x4*)(U + r * 256 + 4 * F.lane);
        float s = (v.x + v.y) + (v.z + v.w);
#pragma unroll
        for (int o2 = 1; o2 < 16; o2 <<= 1) s += __shfl_xor(s, o2);
        const float mean = s * (1.f / 64.f); const f32x4 d = v - mean; float q = (d.x * d.x + d.y * d.y) + (d.z * d.z + d.w * d.w);
#pragma unroll
        for (int o2 = 1; o2 < 16; o2 <<= 1) q += __shfl_xor(q, o2);
        const float rstd = 1.f / sqrtf(q * (1.f / 64.f) + EPS);
        const f32x4 gg = *(const f32x4*)(lg + 4 * F.lane), bb = *(const f32x4*)(lb + 4 * F.lane);
        f32x4 y = d * rstd * gg + bb; y.x = siluf(y.x); y.y = siluf(y.y); y.z = siluf(y.z); y.w = siluf(y.w);
        const float ss = wave_sum((y.x * y.x + y.y * y.y) + (y.z * y.z + y.w * y.w)); const float rn = 1.f / sqrtf(ss * (1.f / 256.f) + EPS);
        const f32x4 m4 = *(const f32x4*)(mg + 4 * F.lane); y = y * rn * m4;
        u32x2 w; w.x = pk2(y.x, y.y); w.y = pk2(y.z, y.w);
        *(u32x2*)(Y + (size_t)(r0 + r) * 1024 + 512 + 4 * F.lane) = w;
    }
}

__device__ __forceinline__ void p3_gmlp_unit(const Frame& F, KArgs a, int layer, int r0) {
    LAS bf16* vT = (LAS bf16*)F.lds;
    LAS float* red = (LAS float*)(F.lds + 69632);
    const bf16* proj = (const bf16*)(F.ws + WS_PROJ);
    const float* lg = a->in[I_GMLNG] + layer * 256; const float* lb = a->in[I_GMLNB] + layer * 256;
    __syncthreads();
    for (int r = F.wave; r < 128; r += 8) {
        const u32x2 w = *(const u32x2*)(proj + (size_t)(r0 + r) * PROJ_LD + PJ_GM + 256 + 4 * F.lane);
        f32x4 v; v.x = gelu_tanh(lo_bf(w.x)); v.y = gelu_tanh(hi_bf(w.x)); v.z = gelu_tanh(lo_bf(w.y)); v.w = gelu_tanh(hi_bf(w.y));
        const float mean = wave_sum((v.x + v.y) + (v.z + v.w)) * (1.f / 256.f); const f32x4 d = v - mean;
        const float rstd = 1.f / sqrtf(wave_sum((d.x * d.x + d.y * d.y) + (d.z * d.z + d.w * d.w)) * (1.f / 256.f) + EPS);
        const f32x4 gg = *(const f32x4*)(lg + 4 * F.lane), bb = *(const f32x4*)(lb + 4 * F.lane); const f32x4 y = d * rstd * gg + bb;
        vT[(4 * F.lane + 0) * 136 + r] = (bf16)f2bf(y.x); vT[(4 * F.lane + 1) * 136 + r] = (bf16)f2bf(y.y); vT[(4 * F.lane + 2) * 136 + r] = (bf16)f2bf(y.z); vT[(4 * F.lane + 3) * 136 + r] = (bf16)f2bf(y.w);
    }
    __syncthreads();
    const int g = F.wave >> 1, ih = F.wave & 1, lr = F.lane & 15, lq = F.lane >> 4;
    const bf16* W = (const bf16*)(F.ws + WS_GMWS) + (size_t)(layer * 4 + g) * 128 * 128;
    f32x4 acc[4][4];
#pragma unroll
    for (int dt = 0; dt < 4; ++dt)
#pragma unroll
        for (int it = 0; it < 4; ++it) acc[dt][it] = (f32x4){0.f, 0.f, 0.f, 0.f};
#pragma unroll 1
    for (int ks = 0; ks < 4; ++ks) {
        bf16x8 af[4], bfr[4];
#pragma unroll
        for (int dt = 0; dt < 4; ++dt) af[dt] = *(const LAS bf16x8*)(vT + (g * 64 + dt * 16 + lr) * 136 + ks * 32 + lq * 8);
#pragma unroll
        for (int it = 0; it < 4; ++it) bfr[it] = *(const bf16x8*)(W + (size_t)(ih * 64 + it * 16 + lr) * 128 + ks * 32 + lq * 8);
#pragma unroll
        for (int dt = 0; dt < 4; ++dt)
#pragma unroll
            for (int it = 0; it < 4; ++it) acc[dt][it] = mfma16(af[dt], bfr[it], acc[dt][it]);
    }
    const float* bs = a->in[I_GMBS] + (size_t)(layer * 4 + g) * 128;
#pragma unroll
    for (int it = 0; it < 4; ++it) { const int i = ih * 64 + it * 16 + lr; const float bsi = bs[i]; float ss = 0.f;
#pragma unroll
        for (int dt = 0; dt < 4; ++dt) { const u32x2 w = *(const u32x2*)(proj + (size_t)(r0 + i) * PROJ_LD + PJ_GM + g * 64 + dt * 16 + 4 * lq);
            f32x4 u; u.x = gelu_tanh(lo_bf(w.x)); u.y = gelu_tanh(hi_bf(w.x)); u.z = gelu_tanh(lo_bf(w.y)); u.w = gelu_tanh(hi_bf(w.y));
            const f32x4 y = u * (acc[dt][it] + bsi); acc[dt][it] = y; ss += (y.x * y.x + y.y * y.y) + (y.z * y.z + y.w * y.w); }
        ss += __shfl_xor(ss, 16); ss += __shfl_xor(ss, 32);
        if (lq == 0) red[g * 128 + i] = ss; }
    __syncthreads();
    const float* mg = a->in[I_MIXG] + layer * 1024 + 256; bf16* Y = (bf16*)(F.ws + WS_H);
#pragma unroll
    for (int it = 0; it < 4; ++it) { const int i = ih * 64 + it * 16 + lr; const float rn = 1.f / sqrtf((red[i] + red[128 + i] + red[256 + i] + red[384 + i]) * (1.f / 256.f) + EPS);
#pragma unroll
        for (int dt = 0; dt < 4; ++dt) { const int col = g * 64 + dt * 16 + 4 * lq; const f32x4 m4 = *(const f32x4*)(mg + col); const f32x4 y = acc[dt][it] * rn * m4;
            u32x2 w; w.x = pk2(y.x, y.y); w.y = pk2(y.z, y.w); *(u32x2*)(Y + (size_t)(r0 + i) * 1024 + 256 + col) = w; } }
}
__device__ __forceinline__ f32x16 mfma32(bf16x8 a, bf16x8 b, f32x16 c) { return __builtin_amdgcn_mfma_f32_32x32x16_bf16(a, b, c, 0, 0, 0); }
__device__ __forceinline__ bf16x8 pack8(float a0, float a1, float a2, float a3, float a4, float a5, float a6, float a7) {
    u32x4 w; w.x = pg8::cvt_pk_bf16(a0, a1); w.y = pg8::cvt_pk_bf16(a2, a3); w.z = pg8::cvt_pk_bf16(a4, a5); w.w = pg8::cvt_pk_bf16(a6, a7); return __builtin_bit_cast(bf16x8, w); }

constexpr int AT_KROW = 104, AT_VROW = 72, AT_KB = 64 * AT_KROW * 2, AT_VB = 64 * AT_VROW * 2;
__device__ __forceinline__ void attn_unit(const Frame& F, int b, int h, int qrow0, int key0, int ntile) {
    LAS unsigned char* L = F.lds;
    const bf16* Kg = (const bf16*)(F.ws + WS_K) + ((size_t)(b * 4 + h) * NKEY + key0) * 96;
    const bf16* Vg = (const bf16*)(F.ws + WS_VT) + (size_t)(b * 4 + h) * 64 * NKEY + key0;
    const bf16* Q = (const bf16*)(F.ws + WS_Q);
    const int lane = F.lane, hi = lane >> 5, l31 = lane & 31;
    const int qrow = qrow0 + F.wave * 32 + l31;
    bf16x8 qf[6];
#pragma unroll
    for (int ks = 0; ks < 6; ++ks) qf[ks] = *(const bf16x8*)(Q + (size_t)qrow * 384 + h * 96 + ks * 16 + hi * 8);
    const int kr0 = F.tid / 12, kc0 = F.tid % 12, kr1 = (F.tid + 512) / 12, kc1 = (F.tid + 512) % 12; const bool k2 = F.tid < 256;
    const int vd = F.tid >> 3, vc = F.tid & 7;
    u32x4 sk0, sk1 = (u32x4){0u, 0u, 0u, 0u}, sv;
    __syncthreads();
    sk0 = *(const u32x4*)(Kg + (size_t)kr0 * 96 + kc0 * 8); if (k2) sk1 = *(const u32x4*)(Kg + (size_t)kr1 * 96 + kc1 * 8); sv = *(const u32x4*)(Vg + (size_t)vd * NKEY + vc * 8);
    *(LAS u32x4*)(L + kr0 * (AT_KROW * 2) + kc0 * 16) = sk0; if (k2) *(LAS u32x4*)(L + kr1 * (AT_KROW * 2) + kc1 * 16) = sk1; *(LAS u32x4*)(L + 2 * AT_KB + vd * (AT_VROW * 2) + vc * 16) = sv;
    __syncthreads();
    const int prow = (l31 & ~12) | ((l31 & 4) << 1) | ((l31 & 8) >> 1);
    const int koff = prow * (AT_KROW * 2) + hi * 16, voff = l31 * (AT_VROW * 2) + hi * 16;
    f32x16 O0, O1;
#pragma unroll
    for (int r = 0; r < 16; ++r) { O0[r] = 0.f; O1[r] = 0.f; }
    float m = -1e30f, l = 0.f;
    for (int j = 0; j < ntile; ++j) {
        const int buf = j & 1; const bool pre = j + 1 < ntile;
        if (pre) { const bf16* kg = Kg + (size_t)(j + 1) * 64 * 96; const bf16* vg = Vg + (j + 1) * 64;
            sk0 = *(const u32x4*)(kg + (size_t)kr0 * 96 + kc0 * 8); if (k2) sk1 = *(const u32x4*)(kg + (size_t)kr1 * 96 + kc1 * 8); sv = *(const u32x4*)(vg + (size_t)vd * NKEY + vc * 8); }
        const LAS unsigned char* Kt = L + buf * AT_KB; const LAS unsigned char* Vt = L + 2 * AT_KB + buf * AT_VB;
        f32x16 S0, S1;
#pragma unroll
        for (int r = 0; r < 16; ++r) { S0[r] = 0.f; S1[r] = 0.f; }
#pragma unroll
        for (int ks = 0; ks < 6; ++ks) { const bf16x8 k0 = *(const LAS bf16x8*)(Kt + koff + ks * 32), k1 = *(const LAS bf16x8*)(Kt + 32 * (AT_KROW * 2) + koff + ks * 32);
            S0 = mfma32(k0, qf[ks], S0); S1 = mfma32(k1, qf[ks], S1); }
        float mx = S0[0];
#pragma unroll
        for (int r = 1; r < 16; ++r) mx = fmaxf(mx, S0[r]);
#pragma unroll
        for (int r = 0; r < 16; ++r) mx = fmaxf(mx, S1[r]);
        mx = fmaxf(mx, __shfl_xor(mx, 32));
        const float mn = fmaxf(m, mx), alpha = __builtin_amdgcn_exp2f(m - mn); m = mn;
        float sum = 0.f;
#pragma unroll
        for (int r = 0; r < 16; ++r) { S0[r] = __builtin_amdgcn_exp2f(S0[r] - mn); S1[r] = __builtin_amdgcn_exp2f(S1[r] - mn); sum += S0[r] + S1[r]; }
        sum += __shfl_xor(sum, 32); l = l * alpha + sum;
#pragma unroll
        for (int r = 0; r < 16; ++r) { O0[r] *= alpha; O1[r] *= alpha; }
        bf16x8 pf[4];
        pf[0] = pack8(S0[0], S0[1], S0[2], S0[3], S0[4], S0[5], S0[6], S0[7]); pf[1] = pack8(S0[8], S0[9], S0[10], S0[11], S0[12], S0[13], S0[14], S0[15]);
        pf[2] = pack8(S1[0], S1[1], S1[2], S1[3], S1[4], S1[5], S1[6], S1[7]); pf[3] = pack8(S1[8], S1[9], S1[10], S1[11], S1[12], S1[13], S1[14], S1[15]);
#pragma unroll
        for (int s = 0; s < 4; ++s) { const bf16x8 v0 = *(const LAS bf16x8*)(Vt + voff + s * 32), v1 = *(const LAS bf16x8*)(Vt + 32 * (AT_VROW * 2) + voff + s * 32);
            O0 = mfma32(v0, pf[s], O0); O1 = mfma32(v1, pf[s], O1); }
        if (pre) { LAS unsigned char* Kn = L + (buf ^ 1) * AT_KB; LAS unsigned char* Vn = L + 2 * AT_KB + (buf ^ 1) * AT_VB;
            *(LAS u32x4*)(Kn + kr0 * (AT_KROW * 2) + kc0 * 16) = sk0; if (k2) *(LAS u32x4*)(Kn + kr1 * (AT_KROW * 2) + kc1 * 16) = sk1; *(LAS u32x4*)(Vn + vd * (AT_VROW * 2) + vc * 16) = sv; }
        __syncthreads();
    }
    const float inv = 1.f / l;
    bf16* Y = (bf16*)(F.ws + WS_YAT) + (size_t)qrow * 256 + h * 64;
#pragma unroll
    for (int g = 0; g < 4; ++g) {
        u32x2 w0, w1; w0.x = pk2(O0[4 * g] * inv, O0[4 * g + 1] * inv); w0.y = pk2(O0[4 * g + 2] * inv, O0[4 * g + 3] * inv);
        w1.x = pk2(O1[4 * g] * inv, O1[4 * g + 1] * inv); w1.y = pk2(O1[4 * g + 2] * inv, O1[4 * g + 3] * inv);
        *(u32x2*)(Y + 8 * g + 4 * hi) = w0; *(u32x2*)(Y + 32 + 8 * g + 4 * hi) = w1; }
}

__device__ __forceinline__ float filt_inv_norm(const Frame& F, int set, int ntile, int o, int c) {
    const float* fsp = (const float*)(F.ws + WS_FS) + (size_t)set * 128 * 1024 + o * 512 + c;
    float s = 0.f;
    for (int t = F.lane; t < ntile; t += 64) s += fsp[(size_t)t * 1024] + fsp[(size_t)t * 1024 + 256];
    return 1.f / wave_sum(s);
}
constexpr int HY_UROW = 4384, HY_UB = 8 * HY_UROW * 2, HY_G0 = HY_UB, HY_G1 = HY_G0 + GLEN * 2 + 64;
static_assert((HY_G0 / 4) % 32 == 0 && (HY_G1 / 4) % 32 == 16, "G copies on opposite bank halves");
__device__ __forceinline__ bf16x8 lds_rd8_a4(const LAS unsigned char* p) { const LAS unsigned* q = (const LAS unsigned*)p; u32x4 w; w.x = q[0]; w.y = q[1]; w.z = q[2]; w.w = q[3]; return __builtin_bit_cast(bf16x8, w); }
__device__ __forceinline__ void hyena_unit(const Frame& F, KArgs a, int layer, int c) {
    LAS unsigned char* L = F.lds; LAS bf16* U = (LAS bf16*)L;
    bf16* hyT = (bf16*)(F.ws + WS_HYT);
    const float* sw = a->in[I_HSW] + (size_t)layer * 3 * 768; const float* sb = a->in[I_HSB] + layer * 768;
    const int lane = F.lane, w = F.wave, hi = lane >> 5, l31 = lane & 31;
    __syncthreads();
    {
        const bf16* vrow = hyT + (size_t)(512 + c) * NTOK; const float w0 = sw[512 + c], w1 = sw[768 + 512 + c], w2 = sw[1536 + 512 + c], bb = sb[512 + c];
        for (int i = F.tid; i < 8 * 512; i += 512) { const int b = i >> 9, t0 = (i & 511) * 8; const bf16* p = vrow + b * 4096 + t0; const u32x4 x = *(const u32x4*)p;
            float v[10]; v[0] = t0 > 0 ? bf2f(p[-1]) : 0.f; v[9] = t0 + 8 < 4096 ? bf2f(p[8]) : 0.f;
            v[1] = lo_bf(x.x); v[2] = hi_bf(x.x); v[3] = lo_bf(x.y); v[4] = hi_bf(x.y); v[5] = lo_bf(x.z); v[6] = hi_bf(x.z); v[7] = lo_bf(x.w); v[8] = hi_bf(x.w);
            float o[8];
#pragma unroll
            for (int k = 0; k < 8; ++k) o[k] = w0 * v[k] + w1 * v[k + 1] + w2 * v[k + 2] + bb;
            u32x4 ww; ww.x = pk2(o[0], o[1]); ww.y = pk2(o[2], o[3]); ww.z = pk2(o[4], o[5]); ww.w = pk2(o[6], o[7]);
            *(LAS u32x4*)(U + b * HY_UROW + t0 + 8 * (t0 >> 7)) = ww; }
    }
    const int sel = l31 & 1;
    const int abase = (sel ? HY_G1 : HY_G0) + (GC - l31 + 8 * hi + sel) * 2;
    const int nb = l31 & 7, qq = l31 >> 3, qsb = 16 * w + 4 * qq;
    const int ubase = (nb * HY_UROW + 8 * hi) * 2;
#pragma unroll 1
    for (int o = 0; o < 2; ++o) {
        {
            const bf16* Gg = (const bf16*)(F.ws + WS_G) + ((size_t)(layer * 2 + o) * 256 + c) * GLEN;
            for (int i = F.tid; i < GLEN / 8; i += 512) { u32x4 x = *(const u32x4*)(Gg + i * 8);
                if (i < 5 || i >= 1027) { const int m0 = i * 8; unsigned* xp = (unsigned*)&x;
#pragma unroll
                    for (int k = 0; k < 4; ++k) { const int ma = m0 + 2 * k, mb = ma + 1; unsigned v = xp[k]; if (ma < 33 || ma > 8223) v &= 0xffff0000u; if (mb < 33 || mb > 8223) v &= 0x0000ffffu; xp[k] = v; } }
                *(LAS u32x4*)(L + HY_G0 + i * 16) = x; }
            __syncthreads();
            const LAS unsigned* g0 = (const LAS unsigned*)(L + HY_G0); LAS unsigned* g1 = (LAS unsigned*)(L + HY_G1);
            for (int i = F.tid; i <= GLEN / 2; i += 512) { const unsigned dp = i > 0 ? g0[i - 1] : 0u, d = i < GLEN / 2 ? g0[i] : 0u; g1[i] = (dp >> 16) | (d << 16); }
            __syncthreads();
        }
        f32x16 acc[4];
#pragma unroll
        for (int j = 0; j < 4; ++j)
#pragma unroll
            for (int r = 0; r < 16; ++r) acc[j][r] = 0.f;
        bf16x8 A[4][2];
        const int e0 = 16 * w - 127;
#define HY_LOADA(slot, delta) do { const LAS unsigned char* _p = L + abase - 64 * (delta); A[slot][0] = lds_rd8_a4(_p); A[slot][1] = lds_rd8_a4(_p + 32); } while (0)
        HY_LOADA(0, e0); HY_LOADA(1, e0 + 1); HY_LOADA(2, e0 + 2);
#define HY_STEP(g) do { const int e = eb + (g); const int qs = qsb - e; const bool ok = (unsigned)qs < 128u; const int qc = qs < 0 ? 0 : (qs > 127 ? 127 : qs); \
            const LAS unsigned char* _u = L + ubase + (32 * qc + 8 * (qc >> 2)) * 2; bf16x8 f0 = *(const LAS bf16x8*)_u, f1 = *(const LAS bf16x8*)(_u + 32); \
            if (!ok) { f0 = (bf16x8){0, 0, 0, 0, 0, 0, 0, 0}; f1 = f0; } \
            HY_LOADA(((g) + 3) & 3, e + 3); \
            _Pragma("unroll") for (int j = 0; j < 4; ++j) { acc[j] = mfma32(A[((g) + j) & 3][0], f0, acc[j]); acc[j] = mfma32(A[((g) + j) & 3][1], f1, acc[j]); } } while (0)
#pragma unroll 1
        for (int eb = e0; eb < e0 + 140; eb += 4) { HY_STEP(0); HY_STEP(1); HY_STEP(2); HY_STEP(3); }
#undef HY_STEP
#undef HY_LOADA
        __syncthreads();
        const float inv = filt_inv_norm(F, layer, 128, o, c);
        const float hb = a->in[I_HBIAS][(size_t)(layer * 2 + o) * 256 + c];
        const int gcol = o == 0 ? c : 256 + c; const bf16* grow = hyT + (size_t)gcol * NTOK + nb * 4096;
        const float w0 = sw[gcol], w1 = sw[768 + gcol], w2 = sw[1536 + gcol], bb = sb[gcol];
        bf16* yrow = (bf16*)(F.ws + WS_YT) + (size_t)c * NTOK + nb * 4096;
#pragma unroll
        for (int j = 0; j < 4; ++j) { const int q = 16 * w + 4 * qq + j;
#pragma unroll
            for (int g4 = 0; g4 < 4; ++g4) { const int t = 32 * q + 8 * g4 + 4 * hi; const bf16* p = grow + t; const u32x2 x = *(const u32x2*)p;
                float v[6]; v[0] = t > 0 ? bf2f(p[-1]) : 0.f; v[5] = t + 4 < 4096 ? bf2f(p[4]) : 0.f; v[1] = lo_bf(x.x); v[2] = hi_bf(x.x); v[3] = lo_bf(x.y); v[4] = hi_bf(x.y);
                LAS bf16* up = U + nb * HY_UROW + t + 8 * (t >> 7); const u32x2 uu = *(const LAS u32x2*)up;
                const float u0 = lo_bf(uu.x), u1 = hi_bf(uu.x), u2 = lo_bf(uu.y), u3 = hi_bf(uu.y);
                const float y0 = (w0 * v[0] + w1 * v[1] + w2 * v[2] + bb) * (acc[j][4 * g4] * inv + hb * u0);
                const float y1 = (w0 * v[1] + w1 * v[2] + w2 * v[3] + bb) * (acc[j][4 * g4 + 1] * inv + hb * u1);
                const float y2 = (w0 * v[2] + w1 * v[3] + w2 * v[4] + bb) * (acc[j][4 * g4 + 2] * inv + hb * u2);
                const float y3 = (w0 * v[3] + w1 * v[4] + w2 * v[5] + bb) * (acc[j][4 * g4 + 3] * inv + hb * u3);
                u32x2 wv; wv.x = pk2(y0, y1); wv.y = pk2(y2, y3);
                if (o == 0) *(LAS u32x2*)up = wv; else *(u32x2*)(yrow + t) = wv; } }
        __syncthreads();
    }
}

__device__ __forceinline__ void hyena_ctx_unit(const Frame& F, KArgs a, int c) {
    LAS float* u = (LAS float*)F.lds;
    LAS float* y1 = u + 2048;
    LAS float* T = y1 + 2048;
    bf16* hyT = (bf16*)(F.ws + WS_HYT);
    const float* sw = a->in[I_HSW]; const float* sb = a->in[I_HSB];
    __syncthreads();
    for (int i = F.tid; i < 1024; i += 512) T[i] = ((const float*)(F.ws + WS_TC))[((size_t)(i >> 9) * 256 + c) * 512 + (i & 511)];
    if (F.tid < 2) T[F.tid * 512] = 0.f;
    {
        const bf16* vrow = hyT + (size_t)(512 + c) * NTOK + NLAT; const float w0 = sw[512 + c], w1 = sw[768 + 512 + c], w2 = sw[1536 + 512 + c], bb = sb[512 + c];
        for (int i = F.tid; i < 2048; i += 512) { const int t = i & 255; const float vm = t > 0 ? bf2f(vrow[i - 1]) : 0.f, v0 = bf2f(vrow[i]), vp = t < 255 ? bf2f(vrow[i + 1]) : 0.f; u[i] = w0 * vm + w1 * v0 + w2 * vp + bb; }
    }
    __syncthreads();
#pragma unroll 1
    for (int o = 0; o < 2; ++o) {
        const LAS float* in = o == 0 ? u : y1; const float inv = filt_inv_norm(F, 2, 8, o, c); const float hb = a->in[I_HBIAS][(size_t)o * 256 + c];
        const int gcol = o == 0 ? c : 256 + c; const bf16* grow = hyT + (size_t)gcol * NTOK + NLAT; const float w0 = sw[gcol], w1 = sw[768 + gcol], w2 = sw[1536 + gcol], bb = sb[gcol];
        for (int i = F.tid; i < 2048; i += 512) { const int b = i >> 8, t = i & 255; float s = 0.f;
            for (int sidx = 0; sidx < 256; ++sidx) s += T[o * 512 + 256 + t - sidx] * in[b * 256 + sidx];
            const float gm = t > 0 ? bf2f(grow[i - 1]) : 0.f, g0 = bf2f(grow[i]), gp = t < 255 ? bf2f(grow[i + 1]) : 0.f;
            const float y = (w0 * gm + w1 * g0 + w2 * gp + bb) * (s * inv + hb * in[i]);
            if (o == 0) y1[i] = y; else ((bf16*)(F.ws + WS_YT))[(size_t)c * NTOK + NLAT + i] = (bf16)f2bf(y); }
        __syncthreads();
    }
}

__device__ __forceinline__ void p5_unit(const Frame& F, KArgs a, int layer, int r0) {
    LAS bf16* T = (LAS bf16*)F.lds;
    const bf16* yT = (const bf16*)(F.ws + WS_YT); const bf16* yat = (const bf16*)(F.ws + WS_YAT); bf16* Y = (bf16*)(F.ws + WS_H);
    const float* mg = a->in[I_MIXG] + layer * 1024;
    __syncthreads();
    for (int i = F.tid; i < 1024; i += 512) { const int c = i >> 2, q = i & 3; *(LAS u32x4*)(T + c * 40 + q * 8) = *(const u32x4*)(yT + (size_t)c * NTOK + r0 + q * 8); }
    __syncthreads();
    for (int r = F.wave; r < 32; r += 8) {
        f32x4 v; v.x = bf2f(T[(4 * F.lane) * 40 + r]); v.y = bf2f(T[(4 * F.lane + 1) * 40 + r]); v.z = bf2f(T[(4 * F.lane + 2) * 40 + r]); v.w = bf2f(T[(4 * F.lane + 3) * 40 + r]);
        float rn = 1.f / sqrtf(wave_sum((v.x * v.x + v.y * v.y) + (v.z * v.z + v.w * v.w)) * (1.f / 256.f) + EPS);
        f32x4 m4 = *(const f32x4*)(mg + 4 * F.lane); f32x4 y = v * rn * m4; u32x2 w; w.x = pk2(y.x, y.y); w.y = pk2(y.z, y.w);
        *(u32x2*)(Y + (size_t)(r0 + r) * 1024 + 4 * F.lane) = w;
        bf16* ya = Y + (size_t)(r0 + r) * 1024 + 768 + 4 * F.lane; const u32x2 x = *(const u32x2*)(yat + (size_t)(r0 + r) * 256 + 4 * F.lane);
        v.x = lo_bf(x.x); v.y = hi_bf(x.x); v.z = lo_bf(x.y); v.w = hi_bf(x.y);
        rn = 1.f / sqrtf(wave_sum((v.x * v.x + v.y * v.y) + (v.z * v.z + v.w * v.w)) * (1.f / 256.f) + EPS);
        m4 = *(const f32x4*)(mg + 768 + 4 * F.lane); y = v * rn * m4; w.x = pk2(y.x, y.y); w.y = pk2(y.z, y.w); *(u32x2*)ya = w;
    }
}
#ifndef MK_DUP
#define MK_DUP 0u
#endif
#define DUPN(k) (((MK_DUP >> (k)) & 1u) ? 2 : 1)
#ifndef MK_PHASES
#define MK_PHASES 0xFFFFFu
#endif
template <int LAYER>
__device__ __forceinline__ void layer_phases(Frame F, const XcdBarrier& bar, int lo, int hi) {
    constexpr int PB = 1 + 9 * LAYER;
    unsigned char* ws = F.ws;
    const float* modl = (const float*)(ws + WS_MOD) + (size_t)LAYER * 9 * 6144;
    float* xc = (float*)(ws + WS_XC);
#define IN(k) (((MK_PHASES >> (k)) & 1u) && lo <= (k) && (k) < hi)
#define SEAM(k) do { if (IN(k) && IN((k) + 1)) xcd_barrier(bar); } while (0)
#define BODY_P1 { if (LAYER == 0) p1_norm(F, kargs(), 0, kargs()->in[I_X], kargs()->in[I_CTX]); else p1_norm(F, kargs(), 1, kargs()->out, xc); }
    relaunder(F);
    if (IN(PB + 0)) { BODY_P1 if (DUPN(0) == 2) BODY_P1 }
    SEAM(PB + 0);
#define BODY_P2 { OpIn op{(const bf16*)(ws + WS_H), (const bf16*)(ws + WS_WIN) + (size_t)LAYER * NIN_PAD * 1024, (bf16*)(ws + WS_PROJ), (bf16*)(ws + WS_HYT), LAYER, F.G, F.vcu}; \
        pg8::gemm_phase<OpIn, true>(F.lds, op, 1024); }
    relaunder(F);
    if (IN(PB + 1)) { BODY_P2 if (DUPN(1) == 2) BODY_P2 }
    SEAM(PB + 1);
    relaunder(F);
    if (IN(PB + 2)) for (int rep = 0; rep < DUPN(2); ++rep) {
        constexpr int NGM = LAYER == 0 ? NTOK / 128 : NLAT / 128, NCV = LAYER == 0 ? NTOK / 64 : NLAT / 64, NML = NTOK / 64;
        for (int u = F.vcu; u < NGM + NCV + NML; u += F.G) {
            if (u < NGM) p3_gmlp_unit(F, kargs(), LAYER, u * 128);
            else if (u < NGM + NCV) p3_conv_unit(F, kargs(), LAYER, (u - NGM) * 64);
            else p3_mla_unit(F, kargs(), LAYER, (u - NGM - NCV) * 64);
        }
    }
    SEAM(PB + 2);
    relaunder(F);
    if (IN(PB + 3)) {
        constexpr int NU = LAYER == 0 ? 256 + 512 + 32 + 256 : 256 + 512;
        for (int u = F.vcu; u < NU; u += F.G) {
            if (u < 256) { for (int rep = 0; rep < DUPN(17); ++rep) hyena_unit(F, kargs(), LAYER, u); }
            else if (u < 768) { const int id = u - 256; for (int rep = 0; rep < DUPN(16); ++rep) attn_unit(F, id >> 6, (id >> 4) & 3, (id >> 6) * 4096 + (id & 15) * 256, 0, NKEY / 64); }
            else if (u < 800) { const int id = u - 768; attn_unit(F, id >> 2, id & 3, NLAT + (id >> 2) * 256, 4096, 4); }
            else hyena_ctx_unit(F, kargs(), u - 800);
        }
    }
    SEAM(PB + 3);
    relaunder(F);
    if (IN(PB + 4)) for (int rep = 0; rep < DUPN(4); ++rep) {
        constexpr int NU = (LAYER == 0 ? NTOK : NLAT) / 32;
        for (int u = F.vcu; u < NU; u += F.G) p5_unit(F, kargs(), LAYER, u * 32);
    }
    SEAM(PB + 4);
    relaunder(F);
    if (IN(PB + 5)) {
        OpOut op{(const bf16*)(ws + WS_H), (const bf16*)(ws + WS_WOUT) + (size_t)LAYER * 1024 * 1024, LAYER == 0 ? kargs()->in[I_X] : kargs()->out, LAYER == 0 ? kargs()->in[I_CTX] : xc, kargs()->out, xc, modl, LAYER, F.G, F.vcu, 1.f};
        pg8::gemm_phase<OpOut, true>(F.lds, op, 1024);
        if (DUPN(5) == 2) { OpOut op2{(const bf16*)(ws + WS_H), (const bf16*)(ws + WS_WOUT) + (size_t)LAYER * 1024 * 1024, kargs()->out, xc, kargs()->out, xc, modl, LAYER, F.G, F.vcu, 0.f}; pg8::gemm_phase<OpOut, true>(F.lds, op2, 1024); }
    }
    SEAM(PB + 5);
    relaunder(F);
    if (IN(PB + 6)) for (int rep = 0; rep < DUPN(6); ++rep) p7_router(F, kargs(), LAYER, kargs()->out, xc, LAYER == 0 ? NTOK : NLAT, rep > 0);
    SEAM(PB + 6);
    LAS int* tab = (LAS int*)(F.lds + 131072 + 4096);
    relaunder(F);
    if (IN(PB + 7) || IN(PB + 8)) {
        __syncthreads();
        if (F.tid == 0) { int acc = 0; for (int k = 0; k < NBUCKET; ++k) { const int c = (int)__hip_atomic_load(F.ctl + CW_CNT + LAYER * 32 + k, __ATOMIC_RELAXED, __HIP_MEMORY_SCOPE_AGENT); tab[k] = acc; tab[32 + k] = c; acc += (c + 255) >> 8; } tab[NBUCKET] = acc; }
        __syncthreads();
    }
#define BODY_P8 { OpMoe1 op{(const bf16*)(ws + WS_H), (const bf16*)(ws + WS_W1), (bf16*)(ws + WS_PROJ), (const int*)(ws + WS_TOK), (const float*)(ws + WS_WLO), (const float*)(ws + WS_WHI), tab, LAYER, F.G, F.vcu}; \
        pg8::gemm_phase<OpMoe1, true>(F.lds, op, 1024); }
    relaunder(F);
    if (IN(PB + 7)) { BODY_P8 if (DUPN(7) == 2) BODY_P8 }
    SEAM(PB + 7);
    relaunder(F);
    if (IN(PB + 8)) {
        OpMoe2 op{(const bf16*)(ws + WS_PROJ), (const bf16*)(ws + WS_W2), kargs()->out, xc, modl, (const int*)(ws + WS_TOK), tab, LAYER, F.G, F.vcu, 1.f};
        pg8::gemm_phase<OpMoe2, true>(F.lds, op, 1024);
        if (DUPN(8) == 2) { OpMoe2 op2{(const bf16*)(ws + WS_PROJ), (const bf16*)(ws + WS_W2), kargs()->out, xc, modl, (const int*)(ws + WS_TOK), tab, LAYER, F.G, F.vcu, 0.f}; pg8::gemm_phase<OpMoe2, true>(F.lds, op2, 1024); }
    }
    SEAM(PB + 8);
#undef IN
#undef SEAM
}

constexpr int N_PHASES = 20;
__global__ void __launch_bounds__(512, 2) mk_fwd(Args a_) {
    extern __shared__ __attribute__((aligned(16))) unsigned char lds_raw[];
    Frame F;
    F.lds = (LAS unsigned char*)lds_raw; F.ws = a_.ws; F.ctl = (unsigned*)(a_.ws + WS_CTL);
    F.tid = threadIdx.x; F.lane = F.tid & 63; F.wave = __builtin_amdgcn_readfirstlane(F.tid >> 6);
    F.G = gridDim.x; { const int bx = blockIdx.x; F.vcu = (F.G % 8 == 0) ? (bx % 8) * (F.G / 8) + bx / 8 : bx; }
    F.gw = F.vcu * 8 + F.wave; F.NGW = F.G * 8;
    volatile LAS unsigned* misc = (volatile LAS unsigned*)(F.lds + LDS_MISC);
    if (F.tid < 64) misc[F.tid] = 0u;
    __syncthreads();
    const int lo = a_.ph_lo, hi = a_.ph_hi;
    XcdBarrier bar; bar.bar = F.ctl + CW_BAR; bar.x = 0; bar.st = misc;
    if (hi - lo > 1) bar = xcd_barrier_post(F.ctl + CW_BAR, misc);
    if ((MK_PHASES & 1u) && lo <= 0 && 0 < hi) { p0_weights(F, kargs()); relaunder(F); p0_mod(F, kargs()); relaunder(F); p0_filters(F, kargs());
        if ((MK_DUP >> 18) & 1u) p0_weights(F, kargs()); if ((MK_DUP >> 19) & 1u) p0_mod(F, kargs()); if ((MK_DUP >> 20) & 1u) p0_filters(F, kargs());
        if (hi > 1) xcd_barrier(bar); }
    layer_phases<0>(F, bar, lo, hi);
    layer_phases<1>(F, bar, lo, hi);
    relaunder(F);
    if (((MK_PHASES >> 19) & 1u) && lo <= 19 && 19 < hi) p_final(F, kargs());
}

#ifndef MK_SPLIT
#define MK_SPLIT 0
#endif
extern "C" void kernel_launch(void* const* d_in, const int* in_sizes, int n_in, void* d_out, int out_size, void* d_ws, size_t ws_size, hipStream_t stream) {
    static int grid = 0;
    if (grid == 0) {
        if (n_in != 38 || out_size != NLAT * 1024 || ws_size < WS_END) { fprintf(stderr, "kernel_launch: unexpected shapes (n_in %d out %d ws %zu, need %zu)\n", n_in, out_size, ws_size, (size_t)WS_END); grid = -1; return; }
        int dev = 0, cus = 0, per_cu = 0;
        hipGetDevice(&dev); hipDeviceGetAttribute(&cus, hipDeviceAttributeMultiprocessorCount, dev);
        if (hipFuncSetAttribute((const void*)mk_fwd, hipFuncAttributeMaxDynamicSharedMemorySize, LDS_BYTES) != hipSuccess) { fprintf(stderr, "kernel_launch: hipFuncSetAttribute failed\n"); grid = -1; return; }
        if (hipOccupancyMaxActiveBlocksPerMultiprocessor(&per_cu, (const void*)mk_fwd, 512, LDS_BYTES) != hipSuccess || per_cu < 1) { fprintf(stderr, "kernel_launch: occupancy query says %d\n", per_cu); }
        (void)hipGetLastError();
        grid = cus;
    }
    if (grid < 0) return;
    hipMemsetAsync((char*)d_ws + WS_CTL, 0, CTL_BYTES, stream);
    Args a{};
    for (int i = 0; i < 38; ++i) a.in[i] = (const float*)d_in[i];
    a.out = (float*)d_out; a.ws = (unsigned char*)d_ws;
#if MK_SPLIT
    for (int p = 0; p < N_PHASES; ++p) { a.ph_lo = p; a.ph_hi = p + 1; hipLaunchKernelGGL(mk_fwd, dim3(grid), dim3(512), LDS_BYTES, stream, a); }
#else
    a.ph_lo = 0; a.ph_hi = N_PHASES; hipLaunchKernelGGL(mk_fwd, dim3(grid), dim3(512), LDS_BYTES, stream, a);
#endif
}
```

```cpp
#include <hip/hip_runtime.h>
#include <cstdio>
#include <cstdint>
#include <cmath>

#define LAS __attribute__((address_space(3)))
#define GAS __attribute__((address_space(1)))
typedef unsigned short bf16;
typedef short bf16x8 __attribute__((ext_vector_type(8)));
typedef short bf16x4 __attribute__((ext_vector_type(4)));
typedef float f32x4 __attribute__((ext_vector_type(4)));
typedef float f32x2 __attribute__((ext_vector_type(2)));
typedef float f32x16 __attribute__((ext_vector_type(16)));
typedef unsigned u32x4 __attribute__((ext_vector_type(4)));
typedef unsigned u32x2 __attribute__((ext_vector_type(2)));

constexpr int NB = 8, SEQ = 4096, CTXL = 256, DM = 1024, DEPTH = 2;
constexpr int NLAT = NB * SEQ, NCTX = NB * CTXL, NTOK = NLAT + NCTX;
constexpr int IN_COLS = 2144, NIN_PAD = 2304;
constexpr int HY_OFF = 0, GM_OFF = 768, CV_OFF = 1280, MQ_OFF = 1792, MKV_OFF = 1984;
constexpr int PROJ_LD = 1536;
constexpr int PJ_GM = 0, PJ_CV = 512, PJ_MKV = 1024, PJ_MQ = 1184;
constexpr int NKEY = SEQ + CTXL;
constexpr int NEXP = 16, DEXP = 512, NBUCKET = 24;
constexpr int A_ROWS = 41216;
constexpr float EPS = 1e-6f;
constexpr int GC = 4128, GLEN = 8256;
constexpr float QSCALE = 0.10206207261596577f * 1.4426950408889634f;

constexpr size_t al256(size_t x) { return (x + 255) & ~(size_t)255; }
constexpr size_t WS_CTL = 0, CTL_BYTES = 1u << 20;
constexpr size_t WS_MOD = WS_CTL + CTL_BYTES;
constexpr size_t WS_ROPE = al256(WS_MOD + (size_t)2 * 9 * 6144 * 4);
constexpr size_t WS_WIN = al256(WS_ROPE + (size_t)2 * 4096 * 16 * 4);
constexpr size_t WS_WOUT = al256(WS_WIN + (size_t)2 * NIN_PAD * 1024 * 2);
constexpr size_t WS_W1 = al256(WS_WOUT + (size_t)2 * 1024 * 1024 * 2);
constexpr size_t WS_W2 = al256(WS_W1 + (size_t)2 * 16 * 1024 * 1024 * 2);
constexpr size_t WS_WUQ = al256(WS_W2 + (size_t)2 * 16 * 1024 * 512 * 2);
constexpr size_t WS_WUKV = al256(WS_WUQ + (size_t)2 * 384 * 192 * 2);
constexpr size_t WS_GMWS = al256(WS_WUKV + (size_t)2 * 512 * 128 * 2);
constexpr size_t WS_G = al256(WS_GMWS + (size_t)2 * 4 * 128 * 128 * 2);
constexpr size_t WS_TC = al256(WS_G + (size_t)2 * 2 * 256 * GLEN * 2);
constexpr size_t WS_H = al256(WS_TC + (size_t)2 * 256 * 512 * 4);
constexpr size_t WS_PROJ = al256(WS_H + (size_t)NTOK * 1024 * 2);
constexpr size_t WS_HYT = al256(WS_PROJ + (size_t)NTOK * PROJ_LD * 2);
constexpr size_t WS_Q = al256(WS_HYT + (size_t)768 * NTOK * 2);
constexpr size_t WS_K = al256(WS_Q + (size_t)NTOK * 384 * 2);
constexpr size_t WS_VT = al256(WS_K + (size_t)NB * 4 * NKEY * 96 * 2);
constexpr size_t WS_XC = al256(WS_VT + (size_t)NB * 4 * 64 * NKEY * 2);
constexpr size_t WS_TOK = al256(WS_XC + (size_t)NCTX * 1024 * 4);
constexpr size_t WS_WLO = al256(WS_TOK + (size_t)NBUCKET * NTOK * 4);
constexpr size_t WS_WHI = al256(WS_WLO + (size_t)NBUCKET * NTOK * 4);
constexpr size_t WS_YT = al256(WS_WHI + (size_t)NBUCKET * NTOK * 4);
constexpr size_t WS_YAT = al256(WS_YT + (size_t)256 * NTOK * 2);
constexpr size_t WS_FS = al256(WS_YAT + (size_t)NTOK * 256 * 2);
constexpr size_t WS_END = al256(WS_FS + (size_t)3 * 128 * 1024 * 4);
static_assert((size_t)A_ROWS * 1024 * 2 <= (size_t)NTOK * PROJ_LD * 2, "a overlays proj");
static_assert(WS_END <= (size_t)512 * 1024 * 1024, "workspace");
constexpr int CW_BAR = 1024;
constexpr int CW_CNT = 8192;
constexpr int CW_P0Q = 8192 + 128;

constexpr int LDS_BYTES = 160 * 1024;
constexpr int LDS_MISC = 131072 + 28672;

__device__ __forceinline__ float bf2f(bf16 v) { return __builtin_bit_cast(float, (unsigned)v << 16); }
__device__ __forceinline__ unsigned f2bf(float f) { unsigned u = __builtin_bit_cast(unsigned, f); return (u + 0x7fffu + ((u >> 16) & 1u)) >> 16; }
__device__ __forceinline__ unsigned pk2(float lo, float hi) { return f2bf(lo) | (f2bf(hi) << 16); }
__device__ __forceinline__ float lo_bf(unsigned w) { return __builtin_bit_cast(float, w << 16); }
__device__ __forceinline__ float hi_bf(unsigned w) { return __builtin_bit_cast(float, w & 0xffff0000u); }
__device__ __forceinline__ float wave_sum(float v) {
#pragma unroll
    for (int o = 1; o < 64; o <<= 1) v += __shfl_xor(v, o);
    return v;
}
__device__ __forceinline__ float siluf(float x) { return x / (1.f + __expf(-x)); }
__device__ __forceinline__ float sigmf(float x) { return 1.f / (1.f + __expf(-x)); }
__device__ __forceinline__ float gelu_tanh(float x) { const float u = 0.7978845608028654f * (x + 0.044715f * x * x * x); const float e = __expf(2.f * u); return x * (1.f - 1.f / (e + 1.f)); }
__device__ __forceinline__ int mod_idx(int r) { return r < NLAT ? (r >> 12) : 8; }

#define XB_TMO      128
#define XB_XCNT(j)  (256  + 64 * (j))
#define XB_XSUB(j)  (1280 + 64 * (j))
#define XB_XGEN(j)  (2304 + 64 * (j))
#define XB_TOP      3328
#define XB_TOPGEN   3392
#define XCD_BAR_WORDS 3456
#define XB_SPIN_CAP (1u << 22)
__device__ __forceinline__ unsigned xb_ld(unsigned* p)              { return __hip_atomic_load(p, __ATOMIC_RELAXED, __HIP_MEMORY_SCOPE_AGENT); }
__device__ __forceinline__ unsigned xb_add(unsigned* p, unsigned v) { return __hip_atomic_fetch_add(p, v, __ATOMIC_RELAXED, __HIP_MEMORY_SCOPE_AGENT); }
__device__ __forceinline__ unsigned xb_xcc_id() { return (unsigned)__builtin_amdgcn_s_getreg((3 << 11) | 20) & 0xFu; }
#define XB_SPIN(cond, bar) do { unsigned _sp = 0; while (cond) { __builtin_amdgcn_s_sleep(1); \
    if ((++_sp & 255u) == 0u) { if (xb_ld(&(bar)[XB_TMO])) break; if (_sp > XB_SPIN_CAP) { atomicAdd(&(bar)[XB_TMO], 1u); break; } } } } while (0)
struct XcdBarrier { unsigned* bar; unsigned x; volatile LAS unsigned* st; };
__device__ __forceinline__ XcdBarrier xcd_barrier_post(unsigned* bar, volatile LAS unsigned* st) {
    XcdBarrier b; b.bar = bar; b.x = xb_xcc_id(); b.st = st;
    if (threadIdx.x == 0) (void)xb_add(&bar[XB_XCNT(b.x)], 1u);
    return b;
}
__device__ __forceinline__ void xcd_barrier_complete(unsigned* bar, unsigned x, unsigned& nloc, unsigned& nx) {
    const unsigned G = gridDim.x * gridDim.y * gridDim.z;
    unsigned sum, cnt, mine, sp = 0u;
    for (;;) {
        sum = 0u; cnt = 0u; mine = 0u;
#pragma unroll
        for (unsigned j = 0; j < 16; ++j) { const unsigned c = xb_ld(&bar[XB_XCNT(j)]); sum += c; cnt += (c > 0u) ? 1u : 0u; mine = (j == x) ? c : mine; }
        if (sum == G) break;
        __builtin_amdgcn_s_sleep(1);
        if ((++sp & 255u) == 0u) { if (xb_ld(&bar[XB_TMO])) break; if (sp > XB_SPIN_CAP) { atomicAdd(&bar[XB_TMO], 1u); break; } }
    }
    nloc = mine > 0u ? mine : 1u; nx = cnt > 0u ? cnt : 1u;
}
__device__ __forceinline__ void xcd_barrier(const XcdBarrier& b) {
    asm volatile("s_waitcnt vmcnt(0)" ::: "memory");
    __syncthreads();
    if (threadIdx.x == 0) {
        unsigned* bar = b.bar;
        __builtin_amdgcn_s_waitcnt(0);
        unsigned nloc = b.st[0], nx = b.st[1];
        if (nloc == 0u) { xcd_barrier_complete(bar, b.x, nloc, nx); b.st[0] = nloc; b.st[1] = nx; }
        const unsigned old = xb_add(&bar[XB_XSUB(b.x)], 1u);
        const unsigned gen = old / nloc;
        if (old + 1u == (gen + 1u) * nloc) {
            __builtin_amdgcn_fence(__ATOMIC_RELEASE, "agent");
            asm volatile("s_waitcnt vmcnt(0)" ::: "memory");
            const unsigned og = xb_add(&bar[XB_TOP], 1u);
            const unsigned tg = og / nx;
            if (og + 1u == (tg + 1u) * nx) xb_add(&bar[XB_TOPGEN], 1u);
            else XB_SPIN(xb_ld(&bar[XB_TOPGEN]) == tg, bar);
            __builtin_amdgcn_fence(__ATOMIC_ACQUIRE, "agent");
            xb_add(&bar[XB_XGEN(b.x)], 1u);
            asm volatile("s_waitcnt vmcnt(0)" ::: "memory");
        } else {
            XB_SPIN(xb_ld(&bar[XB_XGEN(b.x)]) == gen, bar);
            __builtin_amdgcn_fence(__ATOMIC_ACQUIRE, "agent");
            asm volatile("s_waitcnt vmcnt(0)" ::: "memory");
        }
    }
    __syncthreads();
}

struct Args {
    const float* in[38]; float* out; unsigned char* ws; int ph_lo, ph_hi;
};
typedef const __attribute__((address_space(4))) Args* KArgs;
__device__ __forceinline__ KArgs kargs() { KArgs p = (KArgs)__builtin_amdgcn_kernarg_segment_ptr(); asm volatile("" : "+s"(p)); return p; }
struct Frame {
    LAS unsigned char* lds; unsigned char* ws; unsigned* ctl;
    int tid, lane, wave, G, vcu, gw, NGW;
};
__device__ __forceinline__ void relaunder(Frame& F) {
    int t = threadIdx.x; asm volatile("" : "+v"(t));
    F.tid = t; F.lane = t & 63; F.wave = __builtin_amdgcn_readfirstlane(t >> 6); F.gw = F.vcu * 8 + F.wave;
}
enum { I_X = 0, I_C, I_CTX, I_CCTX, I_ADAW, I_ADAB, I_N1G, I_N2G, I_WIN, I_HSW, I_HSB, I_HFW1, I_HFB1, I_HFFREQ, I_HFW2, I_HFB2, I_HFW3, I_HBIAS,
       I_GMLNG, I_GMLNB, I_GMWS, I_GMBS, I_CVW, I_CVB, I_CVLNG, I_CVLNB, I_QANORM, I_WUQ, I_KVANORM, I_WUKV, I_MIXG, I_WOUT, I_WROUTER, I_RBIAS,
       I_EWG, I_EWU, I_EWD, I_FNG };

namespace pg8 {
constexpr int BM = 256, BK = 64, HALF = 128, HTB = HALF * BK * 2, STAGE_BYTES = 8 * HTB;
__host__ __device__ __forceinline__ int lds_byte(int r, int c) { const int st = (r >> 4) * 2 + (c >> 5), rr = r & 15, cc = c & 31, ob = rr * 64 + cc * 2; return st * 1024 + (ob ^ (((ob >> 9) & 1) << 5)); }
__host__ __device__ __forceinline__ void stage_rc(int b, int& R, int& C) { const int st = b / 1024, sb = b % 1024, swz = sb ^ (((sb >> 9) & 1) << 5); R = (st >> 1) * 16 + swz / 64; C = (st & 1) * 32 + (swz % 64) / 2; }
__host__ __device__ __forceinline__ int perm32(int rho) { const int n = rho >> 4, i = rho & 15; return 8 * (i >> 2) + 4 * n + (i & 3); }
struct Unit { int pm, pn, k, aux; };
__device__ __forceinline__ unsigned cvt_pk_bf16(float lo, float hi) { unsigned r; asm volatile("v_cvt_pk_bf16_f32 %0, %1, %2" : "=v"(r) : "v"(lo), "v"(hi)); return r; }

template <class Op, bool ALIGN_EPI>
__device__ __forceinline__ void gemm_phase(LAS unsigned char* lds, const Op& op, const int K) {
    const int tid = threadIdx.x, wid = __builtin_amdgcn_readfirstlane(tid >> 6), lane = tid & 63, wr = wid >> 2, wc = wid & 3, fr = lane & 15, fq = lane >> 4;
    const int nt = K / BK;
    int Rs[2], Cs[2]; unsigned voffB[2];
#pragma unroll
    for (int i = 0; i < 2; ++i) { stage_rc(tid * 16 + i * 8192, Rs[i], Cs[i]); const int Rb = (Rs[i] & ~31) + perm32(Rs[i] & 31); voffB[i] = (unsigned)(Rb * op.ldb() + Cs[i]) * 2u; }
    const unsigned hstepB = (unsigned)HALF * op.ldb() * 2u;
    const unsigned ldsw = (unsigned)wid * 1024u;
    const int aoff = lds_byte(wr * 64 + fr, fq * 8), boff = lds_byte(wc * 32 + fr, fq * 8);
    const char* const Ab = (const char*)op.A();
#define PG8_SA(b, h) (((b) * 2 + (h)) * HTB)
#define PG8_SB(b, h) ((4 + (b) * 2 + (h)) * HTB)
#define PG8_STAGE_A(bufoff, offs, h, kb) do { _Pragma("unroll") for (int _i = 0; _i < 2; ++_i) \
        __builtin_amdgcn_global_load_lds((const unsigned*)(Ab + (size_t)(offs)[h][_i] + (kb)), (LAS unsigned*)(lds + (bufoff) + ldsw + _i * 8192), 16, 0, 0); } while (0)
#define PG8_STAGE_B(bufoff, gbase) do { _Pragma("unroll") for (int _i = 0; _i < 2; ++_i) \
        __builtin_amdgcn_global_load_lds((const unsigned*)((const char*)(gbase) + voffB[_i]), (LAS unsigned*)(lds + (bufoff) + ldsw + _i * 8192), 16, 0, 0); } while (0)
#define PG8_LDA(dst, b, h) do { _Pragma("unroll") for (int m = 0; m < 4; ++m) _Pragma("unroll") for (int k = 0; k < 2; ++k) dst[m][k] = *(const LAS bf16x8*)(lds + PG8_SA(b, h) + aoff + m * 2048 + k * 1024); } while (0)
#define PG8_LDB(dst, b, h) do { _Pragma("unroll") for (int n = 0; n < 2; ++n) _Pragma("unroll") for (int k = 0; k < 2; ++k) dst[n][k] = *(const LAS bf16x8*)(lds + PG8_SB(b, h) + boff + n * 2048 + k * 1024); } while (0)
#define PG8_MMA(ai, bj, At, Bt) do { __builtin_amdgcn_s_setprio(1); _Pragma("unroll") for (int m = 0; m < 4; ++m) _Pragma("unroll") for (int n = 0; n < 2; ++n) _Pragma("unroll") for (int k = 0; k < 2; ++k) \
        acc[ai][bj][m][n] = __builtin_amdgcn_mfma_f32_16x16x32_bf16(Bt[n][k], At[m][k], acc[ai][bj][m][n], 0, 0, 0); __builtin_amdgcn_s_setprio(0); } while (0)
#define PG8_WAIT_V(n) asm volatile("s_waitcnt vmcnt(" #n ")" ::: "memory")
#define PG8_WAIT_L(n) asm volatile("s_waitcnt lgkmcnt(" #n ")" ::: "memory")
#define PG8_BAR __builtin_amdgcn_s_barrier()
#define PG8_SCHED __builtin_amdgcn_sched_barrier(0)
    Unit cur, nxt; int ui = 0;
    if (!op.next(0, cur)) return;
    f32x4 acc[2][2][4][2];
#pragma unroll
    for (int a = 0; a < 2; ++a)
#pragma unroll
        for (int b = 0; b < 2; ++b)
#pragma unroll
            for (int m = 0; m < 4; ++m)
#pragma unroll
                for (int n = 0; n < 2; ++n) acc[a][b][m][n] = (f32x4){0.f, 0.f, 0.f, 0.f};
    bf16x8 At[4][2], B0[2][2], B1[2][2];
    constexpr int NAO = Op::GATHER ? 2 : 1;
    unsigned caoff[2][2], naoff[NAO][2];
    size_t cbase = 0, nbase = 0;
#pragma unroll
    for (int h = 0; h < 2; ++h)
#pragma unroll
        for (int i = 0; i < 2; ++i) { if constexpr (Op::GATHER) caoff[h][i] = op.arow(cur, h * HALF + Rs[i]) + (unsigned)Cs[i] * 2u; else caoff[h][i] = (unsigned)(h * HALF + Rs[i]) * 2048u + (unsigned)Cs[i] * 2u; }
    if constexpr (!Op::GATHER) cbase = op.abase(cur);
    {
        const char* b0 = op.bptr(cur, 0); const char* b1 = op.bptr(cur, 1);
        PG8_STAGE_B(PG8_SB(0, 0), b0); PG8_STAGE_B(PG8_SB(0, 1), b0 + hstepB); PG8_STAGE_A(PG8_SA(0, 0), caoff, 0, cbase); PG8_STAGE_A(PG8_SA(0, 1), caoff, 1, cbase);
        if (wr == 1) PG8_BAR;
        PG8_WAIT_V(2); PG8_BAR;
        PG8_STAGE_B(PG8_SB(1, 0), b1); PG8_STAGE_A(PG8_SA(1, 0), caoff, 0, cbase + 128); PG8_STAGE_B(PG8_SB(1, 1), b1 + hstepB);
        PG8_WAIT_V(6); PG8_BAR;
    }
    for (;;) {
        const bool has_next = op.next(ui + 1, nxt);
        if (!has_next) nxt = cur;
        if constexpr (Op::GATHER) {
#pragma unroll
            for (int h = 0; h < 2; ++h)
#pragma unroll
                for (int i = 0; i < 2; ++i) naoff[h][i] = has_next ? op.arow(nxt, h * HALF + Rs[i]) + (unsigned)Cs[i] * 2u : caoff[h][i];
        } else nbase = op.abase(nxt);
        for (int t = 0; t < nt; t += 2) {
            const bool last = (t == nt - 2);
            const size_t ka1 = cbase + (size_t)(t + 1) * 128u;
            const size_t ka2 = last ? nbase : cbase + (size_t)(t + 2) * 128u, ka3 = ka2 + 128u;
            unsigned a2off[2][2];
#pragma unroll
            for (int h = 0; h < 2; ++h)
#pragma unroll
                for (int i = 0; i < 2; ++i) { if constexpr (Op::GATHER) a2off[h][i] = last ? naoff[h][i] : caoff[h][i]; else a2off[h][i] = caoff[h][i]; }
            const char* b2 = last ? op.bptr(nxt, 0) : op.bptr(cur, t + 2);
            const char* b3 = last ? op.bptr(nxt, 1) : op.bptr(cur, t + 3);
            PG8_LDB(B0, 0, 0); PG8_LDB(B1, 0, 1); PG8_SCHED; PG8_LDA(At, 0, 0); PG8_STAGE_A(PG8_SA(1, 1), caoff, 1, ka1);
            PG8_WAIT_V(8); PG8_WAIT_L(0); PG8_BAR; PG8_MMA(0, 0, At, B0); PG8_MMA(0, 1, At, B1); PG8_BAR; PG8_SCHED;
            PG8_LDA(At, 0, 1); PG8_STAGE_B(PG8_SB(0, 0), b2); PG8_STAGE_B(PG8_SB(0, 1), b2 + hstepB); PG8_STAGE_A(PG8_SA(0, 0), a2off, 0, ka2);
            PG8_WAIT_V(8); PG8_WAIT_L(0); PG8_BAR; PG8_MMA(1, 0, At, B0); PG8_MMA(1, 1, At, B1); PG8_BAR; PG8_SCHED;
            PG8_LDB(B0, 1, 0); PG8_LDB(B1, 1, 1); PG8_SCHED; PG8_LDA(At, 1, 0); PG8_STAGE_A(PG8_SA(0, 1), a2off, 1, ka2);
            PG8_WAIT_V(8); PG8_WAIT_L(0); PG8_BAR; PG8_MMA(0, 0, At, B0); PG8_MMA(0, 1, At, B1); PG8_BAR; PG8_SCHED;
            PG8_LDA(At, 1, 1); PG8_STAGE_B(PG8_SB(1, 0), b3); PG8_STAGE_B(PG8_SB(1, 1), b3 + hstepB); PG8_STAGE_A(PG8_SA(1, 0), a2off, 0, ka3);
            PG8_WAIT_V(8); PG8_WAIT_L(0); PG8_BAR; PG8_MMA(1, 0, At, B0); PG8_MMA(1, 1, At, B1); PG8_BAR; PG8_SCHED;
        }
        if constexpr (ALIGN_EPI) { if (wr == 0) PG8_BAR; }
        op.epi(acc, cur, wr, wc, fr, fq);
        if (!has_next) break;
#pragma unroll
        for (int a = 0; a < 2; ++a)
#pragma unroll
            for (int b = 0; b < 2; ++b)
#pragma unroll
                for (int m = 0; m < 4; ++m)
#pragma unroll
                    for (int n = 0; n < 2; ++n) acc[a][b][m][n] = (f32x4){0.f, 0.f, 0.f, 0.f};
        cur = nxt; ++ui;
        if constexpr (Op::GATHER) {
#pragma unroll
            for (int h = 0; h < 2; ++h)
#pragma unroll
                for (int i = 0; i < 2; ++i) caoff[h][i] = naoff[h][i];
        } else cbase = nbase;
        if constexpr (ALIGN_EPI) { if (wr == 1) PG8_BAR; }
    }
    PG8_WAIT_V(0);
    if constexpr (!ALIGN_EPI) { if (wr == 0) PG8_BAR; }
    PG8_BAR;
#undef PG8_SA
#undef PG8_SB
#undef PG8_STAGE_A
#undef PG8_STAGE_B
#undef PG8_LDA
#undef PG8_LDB
#undef PG8_MMA
#undef PG8_WAIT_V
#undef PG8_WAIT_L
#undef PG8_BAR
#undef PG8_SCHED
}
}
struct OpIn {
    const bf16* A_; const bf16* Bt; bf16* proj; bf16* hyT; int layer, G, vcu;
    __device__ __forceinline__ const bf16* A() const { return A_; }
    __device__ __forceinline__ int ldb() const { return 1024; }
    __device__ __forceinline__ bool next(int i, pg8::Unit& u) const {
        const int L = i * G + vcu; const int nlat = 128 * 9, total = layer == 0 ? 136 * 9 : nlat + 8;
        if (L >= total) return false;
        if (layer == 0 || L < nlat) { u.pm = L / 9; u.pn = L % 9; } else { u.pm = 128 + (L - nlat); u.pn = 7; }
        u.k = 0; u.aux = 0; return true;
    }
    static constexpr bool GATHER = false;
    __device__ __forceinline__ size_t abase(const pg8::Unit& u) const { return (size_t)u.pm * 256 * 2048; }
    __device__ __forceinline__ const char* bptr(const pg8::Unit& u, int t) const { return (const char*)Bt + (size_t)u.pn * 256 * 2048 + (size_t)t * 128; }
    __device__ __forceinline__ void epi(const f32x4 (&acc)[2][2][4][2], const pg8::Unit& u, int wr, int wc, int fr, int fq) const {
        const int row0 = u.pm * 256 + wr * 64 + fr, lc0 = wc * 32 + 8 * fq;
        if (u.pn >= 3) {
            bf16* base = proj + (size_t)row0 * PROJ_LD + (u.pn - 3) * 256 + lc0;
#pragma unroll
            for (int ai = 0; ai < 2; ++ai)
#pragma unroll
                for (int m = 0; m < 4; ++m) { bf16* rowp = base + (size_t)(ai * 128 + m * 16) * PROJ_LD;
#pragma unroll
                    for (int bj = 0; bj < 2; ++bj) { const f32x4 v0 = acc[ai][bj][m][0], v1 = acc[ai][bj][m][1]; u32x4 w;
                        w.x = pg8::cvt_pk_bf16(v0[0], v0[1]); w.y = pg8::cvt_pk_bf16(v0[2], v0[3]); w.z = pg8::cvt_pk_bf16(v1[0], v1[1]); w.w = pg8::cvt_pk_bf16(v1[2], v1[3]);
                        *(u32x4*)(rowp + bj * 128) = w; } }
        } else {
            bf16* base = hyT + (size_t)(u.pn * 256 + lc0) * NTOK + row0;
#pragma unroll
            for (int ai = 0; ai < 2; ++ai)
#pragma unroll
                for (int m = 0; m < 4; ++m)
#pragma unroll
                    for (int bj = 0; bj < 2; ++bj)
#pragma unroll
                        for (int n = 0; n < 2; ++n)
#pragma unroll
                            for (int j = 0; j < 4; ++j)
                                base[(size_t)(bj * 128 + 4 * n + j) * NTOK + ai * 128 + m * 16] = (bf16)f2bf(acc[ai][bj][m][n][j]);
        }
    }
};

struct OpOut {
    const bf16* A_; const bf16* Bt; const float* xin_lat; const float* xin_ctx; float* xo_lat; float* xo_ctx; const float* mod; int layer, G, vcu; float scale;
    __device__ __forceinline__ const bf16* A() const { return A_; }
    __device__ __forceinline__ int ldb() const { return 1024; }
    __device__ __forceinline__ bool next(int i, pg8::Unit& u) const {
        const int L = i * G + vcu; const int total = (layer == 0 ? 136 : 128) * 4;
        if (L >= total) return false;
        u.pm = L >> 2; u.pn = L & 3; u.k = 0; u.aux = 0; return true;
    }
    static constexpr bool GATHER = false;
    __device__ __forceinline__ size_t abase(const pg8::Unit& u) const { return (size_t)u.pm * 256 * 2048; }
    __device__ __forceinline__ const char* bptr(const pg8::Unit& u, int t) const { return (const char*)Bt + (size_t)u.pn * 256 * 2048 + (size_t)t * 128; }
    __device__ __forceinline__ void epi(const f32x4 (&acc)[2][2][4][2], const pg8::Unit& u, int wr, int wc, int fr, int fq) const {
        const int grow0 = u.pm * 256; const bool isl = grow0 < NLAT;
        const float* xi = isl ? xin_lat + (size_t)grow0 * 1024 : xin_ctx + (size_t)(grow0 - NLAT) * 1024;
        float* xo = isl ? xo_lat + (size_t)grow0 * 1024 : xo_ctx + (size_t)(grow0 - NLAT) * 1024;
        const float* g1 = mod + (size_t)mod_idx(grow0) * 6144 + 2 * 1024;
        const int lr0 = wr * 64 + fr, c0 = u.pn * 256 + wc * 32 + 8 * fq;
#pragma unroll
        for (int bj = 0; bj < 2; ++bj)
#pragma unroll
            for (int n = 0; n < 2; ++n) { const int col = c0 + bj * 128 + 4 * n; const f32x4 gv = *(const f32x4*)(g1 + col) * scale;
#pragma unroll
                for (int ai = 0; ai < 2; ++ai)
#pragma unroll
                    for (int m = 0; m < 4; ++m) { const size_t o = (size_t)(lr0 + ai * 128 + m * 16) * 1024 + col;
                        const f32x4 xv = *(const f32x4*)(xi + o); *(f32x4*)(xo + o) = xv + gv * acc[ai][bj][m][n]; } }
    }
};

struct MoeTab { const LAS int* t; };
__device__ __forceinline__ void moe_decode(const LAS int* tab, int mi, int& k, int& j) {
    int kk = 0;
#pragma unroll 1
    for (int q = 1; q < NBUCKET; ++q) if (tab[q] <= mi) kk = q;
    k = kk; j = mi - tab[kk];
}
__device__ __forceinline__ void pair_of(int k, int& elo, int& ehi) {
    const int g = k / 6, p = k - g * 6;
    const int lo = p < 3 ? 0 : (p < 5 ? 1 : 2), hi = p < 3 ? p + 1 : (p < 5 ? p - 1 : 3);
    elo = g * 4 + lo; ehi = g * 4 + hi;
}
struct OpMoe1 {
    const bf16* A_; const bf16* W1; bf16* abuf; const int* TOK; const float* WLO; const float* WHI; const LAS int* tab; int layer, G, vcu;
    __device__ __forceinline__ const bf16* A() const { return A_; }
    __device__ __forceinline__ int ldb() const { return 1024; }
    __device__ __forceinline__ bool next(int i, pg8::Unit& u) const {
        const int L = i * G + vcu; const int MT = tab[NBUCKET];
        if (L >= MT * 8) return false;
        u.pm = L >> 3; u.pn = L & 7; moe_decode(tab, u.pm, u.k, u.aux); return true;
    }
    static constexpr bool GATHER = true;
    __device__ __forceinline__ size_t abase(const pg8::Unit&) const { return 0; }
    __device__ __forceinline__ unsigned arow(const pg8::Unit& u, int lr) const {
        const int cnt = tab[32 + u.k]; int p = u.aux * 256 + lr; p = p < cnt ? p : cnt - 1;
        return (unsigned)TOK[(size_t)u.k * NTOK + p] * 2048u;
    }
    __device__ __forceinline__ const char* bptr(const pg8::Unit& u, int t) const {
        int elo, ehi; pair_of(u.k, elo, ehi); const int e = u.pn < 4 ? elo : ehi;
        return (const char*)W1 + ((size_t)(layer * 16 + e) * 1024 + (u.pn & 3) * 256) * 2048 + (size_t)t * 128;
    }
    __device__ __forceinline__ void epi(const f32x4 (&acc)[2][2][4][2], const pg8::Unit& u, int wr, int wc, int fr, int fq) const {
        const int cnt = tab[32 + u.k]; const float* WW = (u.pn < 4 ? WLO : WHI) + (size_t)u.k * NTOK;
        const int lr0 = wr * 64 + fr, c0 = (u.pn >= 4 ? 512 : 0) + (u.pn & 3) * 128 + wc * 32 + 8 * fq;
#pragma unroll
        for (int ai = 0; ai < 2; ++ai)
#pragma unroll
            for (int m = 0; m < 4; ++m) { const int lr = lr0 + ai * 128 + m * 16; int p = u.aux * 256 + lr; p = p < cnt ? p : cnt - 1; const float w = WW[p];
                const f32x4 g0 = acc[ai][0][m][0], g1 = acc[ai][0][m][1], u0 = acc[ai][1][m][0], u1 = acc[ai][1][m][1]; float o[8];
#pragma unroll
                for (int j = 0; j < 4; ++j) { o[j] = siluf(g0[j]) * u0[j] * w; o[4 + j] = siluf(g1[j]) * u1[j] * w; }
                u32x4 ww; ww.x = pg8::cvt_pk_bf16(o[0], o[1]); ww.y = pg8::cvt_pk_bf16(o[2], o[3]); ww.z = pg8::cvt_pk_bf16(o[4], o[5]); ww.w = pg8::cvt_pk_bf16(o[6], o[7]);
                *(u32x4*)(abuf + (size_t)(u.pm * 256 + lr) * 1024 + c0) = ww; }
    }
};
struct OpMoe2 {
    const bf16* A_; const bf16* W2; float* x_lat; float* x_ctx; const float* mod; const int* TOK; const LAS int* tab; int layer, G, vcu; float scale;
    __device__ __forceinline__ const bf16* A() const { return A_; }
    __device__ __forceinline__ int ldb() const { return 512; }
    __device__ __forceinline__ bool next(int i, pg8::Unit& u) const {
        const int L = i * G + vcu; const int MT = tab[NBUCKET];
        if (L >= MT * 4) return false;
        u.pm = L >> 2; u.pn = L & 3; moe_decode(tab, u.pm, u.k, u.aux); return true;
    }
    static constexpr bool GATHER = false;
    __device__ __forceinline__ size_t abase(const pg8::Unit& u) const { return (size_t)u.pm * 256 * 2048; }
    __device__ __forceinline__ const char* bptr(const pg8::Unit& u, int t) const {
        int elo, ehi; pair_of(u.k, elo, ehi); const int e = t < 8 ? elo : ehi;
        return (const char*)W2 + ((size_t)(layer * 16 + e) * 1024 + u.pn * 256) * 1024 + (size_t)(t & 7) * 128;
    }
    __device__ __forceinline__ void epi(const f32x4 (&acc)[2][2][4][2], const pg8::Unit& u, int wr, int wc, int fr, int fq) const {
        const int cnt = tab[32 + u.k]; const int lr0 = wr * 64 + fr, c0 = u.pn * 256 + wc * 32 + 8 * fq;
#pragma unroll
        for (int ai = 0; ai < 2; ++ai)
#pragma unroll
            for (int m = 0; m < 4; ++m) { const int p = u.aux * 256 + lr0 + ai * 128 + m * 16;
                if (p < cnt) { const int tok = TOK[(size_t)u.k * NTOK + p];
                    float* xr = tok < NLAT ? x_lat + (size_t)tok * 1024 : x_ctx + (size_t)(tok - NLAT) * 1024; const float* g2 = mod + (size_t)mod_idx(tok) * 6144 + 5 * 1024;
#pragma unroll
                    for (int bj = 0; bj < 2; ++bj)
#pragma unroll
                        for (int n = 0; n < 2; ++n) { const int col = c0 + bj * 128 + 4 * n; const f32x4 gv = *(const f32x4*)(g2 + col) * scale; const f32x4 xv = *(const f32x4*)(xr + col);
                            *(f32x4*)(xr + col) = xv + gv * acc[ai][bj][m][n]; } } }
    }
};
__device__ __forceinline__ void transpose_item(const float* W, int N, int k0, int n0, bf16* WT, int ldk, int dst_row0, LAS float* scr, int lane) {
float tv[32];
#pragma unroll
    for (int i = 0; i < 32; ++i) { const int kk = 2 * i + (lane >> 5); tv[i] = W[(size_t)(k0 + kk) * N + n0 + (lane & 31)]; }
#pragma unroll
    for (int i = 0; i < 32; ++i) { const int kk = 2 * i + (lane >> 5); scr[kk * 33 + (lane & 31)] = tv[i]; }
    asm volatile("s_waitcnt lgkmcnt(0)" ::: "memory");
    const int c = lane & 7;
#pragma unroll
    for (int j = 0; j < 4; ++j) { const int n = (lane >> 3) + 8 * j; const LAS float* s = scr + (8 * c) * 33 + n;
        u32x4 o; o.x = pk2(s[0 * 33], s[1 * 33]); o.y = pk2(s[2 * 33], s[3 * 33]); o.z = pk2(s[4 * 33], s[5 * 33]); o.w = pk2(s[6 * 33], s[7 * 33]);
        *(u32x4*)(WT + (size_t)(dst_row0 + n) * ldk + k0 + 8 * c) = o; }
    asm volatile("s_waitcnt lgkmcnt(0)" ::: "memory");
}
__device__ __forceinline__ int win_dst(int n0) { return n0 < 1792 ? n0 : (n0 < 1984 ? 1952 + (n0 - 1792) : 1792 + (n0 - 1984)); }

constexpr int N_WIN = 2 * 16 * 67, N_WOUT = 2 * 16 * 32, N_G = 2 * 16 * 16 * 16, N_U = N_G, N_D = 2 * 16 * 8 * 32, N_UQ = 2 * 3 * 12, N_UKV = 2 * 2 * 16;
constexpr int NIT_W = N_WIN + N_WOUT + N_G + N_U + N_D + N_UQ + N_UKV;
struct MiniF { LAS unsigned char* lds; unsigned char* ws; int tid, lane, wave; };
__device__ __forceinline__ MiniF minif(LAS unsigned char* lds, unsigned char* ws) { MiniF F; F.lds = lds; F.ws = ws; F.tid = threadIdx.x; F.lane = F.tid & 63; F.wave = __builtin_amdgcn_readfirstlane(F.tid >> 6); return F; }
__device__ __attribute__((noinline)) void p0_weight_item(LAS unsigned char* lds_, unsigned char* ws_, KArgs a, int it) {
    const MiniF F = minif(lds_, ws_);
    LAS float* scr = (LAS float*)(F.lds + F.wave * 16384);
    unsigned char* ws = F.ws;
    int r = it;
    if (r < N_WIN) { const int l = r / (16 * 67), q = r % (16 * 67), kb = q / 67, nb = q % 67;
        transpose_item(a->in[I_WIN] + (size_t)l * 1024 * IN_COLS, IN_COLS, kb * 64, nb * 32, (bf16*)(ws + WS_WIN) + (size_t)l * NIN_PAD * 1024, 1024, win_dst(nb * 32), scr, F.lane); return; } r -= N_WIN;
    if (r < N_WOUT) { const int l = r / 512, q = r % 512, kb = q / 32, nb = q % 32;
        transpose_item(a->in[I_WOUT] + (size_t)l * 1024 * 1024, 1024, kb * 64, nb * 32, (bf16*)(ws + WS_WOUT) + (size_t)l * 1024 * 1024, 1024, nb * 32, scr, F.lane); return; } r -= N_WOUT;
    if (r < N_G + N_U) { const bool up = r >= N_G; if (up) r -= N_G; const int le = r / 256, q = r % 256, kb = q / 16, nb = q % 16; const int f0 = nb * 32;
        transpose_item(a->in[up ? I_EWU : I_EWG] + (size_t)le * 1024 * 512, 512, kb * 64, f0, (bf16*)(ws + WS_W1) + (size_t)le * 1024 * 1024, 1024, (f0 >> 7) * 256 + (up ? 128 : 0) + (f0 & 127), scr, F.lane); return; } r -= N_G + N_U;
    if (r < N_D) { const int le = r / 256, q = r % 256, kb = q / 32, nb = q % 32;
        transpose_item(a->in[I_EWD] + (size_t)le * 512 * 1024, 1024, kb * 64, nb * 32, (bf16*)(ws + WS_W2) + (size_t)le * 1024 * 512, 512, nb * 32, scr, F.lane); return; } r -= N_D;
    if (r < N_UQ) { const int l = r / 36, q = r % 36, kb = q / 12, nb = q % 12;
        transpose_item(a->in[I_WUQ] + (size_t)l * 192 * 384, 384, kb * 64, nb * 32, (bf16*)(ws + WS_WUQ) + (size_t)l * 384 * 192, 192, nb * 32, scr, F.lane); return; } r -= N_UQ;
    { const int l = r / 32, q = r % 32, kb = q / 16, nb = q % 16;
        transpose_item(a->in[I_WUKV] + (size_t)l * 128 * 512, 512, kb * 64, nb * 32, (bf16*)(ws + WS_WUKV) + (size_t)l * 512 * 128, 128, nb * 32, scr, F.lane); }
}
constexpr int N_MISC_PAD = 2 * 160 * 128, N_MISC_GM = 2 * 4 * 128 * 128 / 4, N_MISC_ROPE = 4096 * 16, N_MISC = N_MISC_PAD + N_MISC_GM + N_MISC_ROPE;
__device__ __attribute__((noinline)) void p0_misc_op(unsigned char* ws, KArgs a, int i) {
    if (i < N_MISC_PAD) { const int l = i / (160 * 128), q = i % (160 * 128);
        *(u32x4*)((bf16*)(ws + WS_WIN) + ((size_t)l * NIN_PAD + 2144) * 1024 + (size_t)q * 8) = (u32x4){0u, 0u, 0u, 0u}; return; } i -= N_MISC_PAD;
    if (i < N_MISC_GM) { const f32x4 v = *(const f32x4*)(a->in[I_GMWS] + (size_t)i * 4); u32x2 o; o.x = pk2(v[0], v[1]); o.y = pk2(v[2], v[3]);
        *(u32x2*)((bf16*)(ws + WS_GMWS) + (size_t)i * 4) = o; return; } i -= N_MISC_GM;
    if (i < N_MISC_ROPE) { const int t = i >> 4, j = i & 15; const float pos = (float)(j < 8 ? (t >> 6) : (t & 63));
        const float inv = powf(10000.0f, -(float)(j & 7) / 8.0f); const float ang = pos * inv;
        ((float*)(ws + WS_ROPE))[i] = cosf(ang); ((float*)(ws + WS_ROPE))[4096 * 16 + i] = sinf(ang); }
}

__device__ __attribute__((noinline)) void p0_mod_item(LAS unsigned char* lds_, unsigned char* ws_, KArgs a, int it) {
    const MiniF F = minif(lds_, ws_);
    LAS float* sc = (LAS float*)F.lds;
    LAS float* part = sc + 9 * 1024;
    float* mod = (float*)(F.ws + WS_MOD);
    for (int i = F.tid; i < 9 * 1024; i += 512) { const int j = i >> 10, k = i & 1023; const float c = j < 8 ? a->in[I_C][j * 1024 + k] : a->in[I_CCTX][k]; sc[i] = siluf(c); }
    __syncthreads();
    const int l = it / 96, cb = it % 96, col = F.tid & 63, kq = F.tid >> 6;
    const float* W = a->in[I_ADAW] + (size_t)l * 1024 * 6144 + cb * 64 + col;
    float acc[9];
#pragma unroll
    for (int j = 0; j < 9; ++j) acc[j] = 0.f;
#pragma unroll 1
    for (int k0 = kq * 128; k0 < kq * 128 + 128; k0 += 16) { float w[16];
#pragma unroll
        for (int q = 0; q < 16; ++q) w[q] = W[(size_t)(k0 + q) * 6144];
#pragma unroll
        for (int q = 0; q < 16; ++q)
#pragma unroll
            for (int j = 0; j < 9; ++j) acc[j] += sc[j * 1024 + k0 + q] * w[q]; }
#pragma unroll
    for (int j = 0; j < 9; ++j) part[(kq * 9 + j) * 64 + col] = acc[j];
    __syncthreads();
    for (int i = F.tid; i < 9 * 64; i += 512) { const int j = i >> 6, c2 = i & 63; float s = a->in[I_ADAB][l * 6144 + cb * 64 + c2];
#pragma unroll
        for (int q = 0; q < 8; ++q) s += part[(q * 9 + j) * 64 + c2];
        mod[((size_t)l * 9 + j) * 6144 + cb * 64 + c2] = s; }
}

__device__ __attribute__((noinline)) void p0_filter_item(LAS unsigned char* lds_, unsigned char* ws_, KArgs a, int it) {
    const MiniF F = minif(lds_, ws_);
    LAS float* z = (LAS float*)F.lds;
    LAS float* h1 = z + 32 * 36;
    LAS float* h2T = h1 + 32 * 64;
    float* fsp = (float*)(F.ws + WS_FS);
    const int set = it < 128 ? 0 : (it < 256 ? 1 : 2), tt = it < 256 ? (it & 127) : it - 256;
    const int l = set == 2 ? 0 : set, L = set == 2 ? 256 : 4096, t0 = tt * 32;
    const float* w1 = a->in[I_HFW1] + l * 33 * 64; const float* b1 = a->in[I_HFB1] + l * 64; const float* fr = a->in[I_HFFREQ] + l * 64;
    const float* w2 = a->in[I_HFW2] + l * 64 * 64; const float* b2 = a->in[I_HFB2] + l * 64; const float* w3 = a->in[I_HFW3] + (size_t)l * 64 * 1024;
    { const int tl = F.tid >> 4, f = F.tid & 15, tg = t0 + tl;
      const float fb = 1e-4f + (float)f * ((15.0f - 1e-4f) / 15.0f); const float w = 6.283185307179586f * (float)tg / (float)L;
      const float ang = fb * w; z[tl * 36 + 1 + f] = cosf(ang); z[tl * 36 + 17 + f] = -sinf(ang);
      if (f == 0) z[tl * 36] = (float)tg / (float)(L - 1); }
    __syncthreads();
    { const int tl = F.tid >> 4, j0 = (F.tid & 15) * 4; f32x4 s = *(const f32x4*)(b1 + j0);
      for (int i = 0; i < 33; ++i) s += *(const f32x4*)(w1 + i * 64 + j0) * z[tl * 36 + i];
      const f32x4 f4 = *(const f32x4*)(fr + j0); h1[tl * 64 + j0] = sinf(f4.x * s.x); h1[tl * 64 + j0 + 1] = sinf(f4.y * s.y); h1[tl * 64 + j0 + 2] = sinf(f4.z * s.z); h1[tl * 64 + j0 + 3] = sinf(f4.w * s.w); }
    __syncthreads();
    { const int tl = F.tid >> 4, j0 = (F.tid & 15) * 4; f32x4 s = *(const f32x4*)(b2 + j0);
      for (int i = 0; i < 64; ++i) s += *(const f32x4*)(w2 + i * 64 + j0) * h1[tl * 64 + i];
      const f32x4 f4 = *(const f32x4*)(fr + j0); h2T[(j0) * 32 + tl] = sinf(f4.x * s.x); h2T[(j0 + 1) * 32 + tl] = sinf(f4.y * s.y); h2T[(j0 + 2) * 32 + tl] = sinf(f4.z * s.z); h2T[(j0 + 3) * 32 + tl] = sinf(f4.w * s.w); }
    __syncthreads();
    const int dir = F.tid >> 8, c = F.tid & 255;
    float acc0[32], acc1[32];
#pragma unroll
    for (int t = 0; t < 32; ++t) { acc0[t] = 0.f; acc1[t] = 0.f; }
#pragma unroll 2
    for (int k = 0; k < 64; ++k) { const float wa = w3[(size_t)k * 1024 + F.tid], wb = w3[(size_t)k * 1024 + 512 + F.tid];
#pragma unroll
        for (int t4 = 0; t4 < 8; ++t4) { const f32x4 h = *(const LAS f32x4*)(h2T + k * 32 + t4 * 4);
#pragma unroll
            for (int j = 0; j < 4; ++j) { acc0[t4 * 4 + j] += h[j] * wa; acc1[t4 * 4 + j] += h[j] * wb; } } }
    const float lo = -3.0701134573253945f, hi = -15.350567286626972f;
    const float delta = fabsf(lo + (float)c * ((hi - lo) / 255.0f));
    float as0 = 0.f, as1 = 0.f;
#pragma unroll
    for (int t = 0; t < 32; ++t) { const float e = __expf(-z[t * 36] * delta); acc0[t] *= e; acc1[t] *= e; if (dir == 0 || t0 + t >= 1) { as0 += fabsf(acc0[t]); as1 += fabsf(acc1[t]); } }
    fsp[((size_t)set * 128 + tt) * 1024 + F.tid] = as0; fsp[((size_t)set * 128 + tt) * 1024 + 512 + F.tid] = as1;
    if (set < 2) {
        bf16* G0 = (bf16*)(F.ws + WS_G) + ((size_t)(set * 2 + 0) * 256 + c) * GLEN; bf16* G1 = G0 + (size_t)256 * GLEN;
        if (dir == 0) {
            G0[GC - t0] = (bf16)f2bf(acc0[0]); G1[GC - t0] = (bf16)f2bf(acc1[0]); G0[GC - t0 - 31] = (bf16)f2bf(acc0[31]); G1[GC - t0 - 31] = (bf16)f2bf(acc1[31]);
#pragma unroll
            for (int t = 1; t < 31; t += 2) { *(unsigned*)(G0 + GC - t0 - t - 1) = pk2(acc0[t + 1], acc0[t]); *(unsigned*)(G1 + GC - t0 - t - 1) = pk2(acc1[t + 1], acc1[t]); }
        } else {
            if (t0 == 0) { G0[GC + 1] = (bf16)f2bf(acc0[1]); G1[GC + 1] = (bf16)f2bf(acc1[1]); }
            else { *(unsigned*)(G0 + GC + t0) = pk2(acc0[0], acc0[1]); *(unsigned*)(G1 + GC + t0) = pk2(acc1[0], acc1[1]); }
#pragma unroll
            for (int t = 2; t < 32; t += 2) { *(unsigned*)(G0 + GC + t0 + t) = pk2(acc0[t], acc0[t + 1]); *(unsigned*)(G1 + GC + t0 + t) = pk2(acc1[t], acc1[t + 1]); }
        }
    } else {
        float* T0 = (float*)(F.ws + WS_TC) + (size_t)c * 512; float* T1 = T0 + (size_t)256 * 512;
#pragma unroll
        for (int t = 0; t < 32; ++t) { const int tg = t0 + t; if (dir == 0) { T0[256 + tg] = acc0[t]; T1[256 + tg] = acc1[t]; } else if (tg >= 1) { T0[256 - tg] = acc0[t]; T1[256 - tg] = acc1[t]; } }
    }
}

constexpr int P0_NF = 264, P0_NM = 192, P0_NW = (NIT_W + 7) / 8, P0_NX = (N_MISC + 511) / 512, P0_NITEMS = P0_NF + P0_NM + P0_NW + P0_NX;
__device__ __forceinline__ void p0_all(const Frame& F, KArgs a) {
    volatile LAS int* slot = (volatile LAS int*)(F.lds + LDS_MISC + 64);
    for (;;) {
        __syncthreads();
        if (F.tid == 0) *slot = (int)atomicAdd(F.ctl + CW_P0Q, 1u);
        __syncthreads();
        const int it = *slot;
        if (it >= P0_NITEMS) break;
        if (it < P0_NF) p0_filter_item(F.lds, F.ws, a, it);
        else if (it < P0_NF + P0_NM) p0_mod_item(F.lds, F.ws, a, it - P0_NF);
        else if (it < P0_NF + P0_NM + P0_NW) { const int wi = (it - P0_NF - P0_NM) * 8 + F.wave; if (wi < NIT_W) p0_weight_item(F.lds, F.ws, a, wi); }
        else { const int i = (it - P0_NF - P0_NM - P0_NW) * 512 + F.tid; if (i < N_MISC) p0_misc_op(F.ws, a, i); }
    }
    __syncthreads();
}
__device__ __forceinline__ void norm_mod_row(const float* xrow, const float* g, const float* sc, const float* sh, bf16* orow, int lane) {
    const f32x4* xr = (const f32x4*)xrow + lane;
    f32x4 v[4]; float s = 0.f;
#pragma unroll
    for (int j = 0; j < 4; ++j) { v[j] = xr[64 * j]; s += (v[j].x * v[j].x + v[j].y * v[j].y) + (v[j].z * v[j].z + v[j].w * v[j].w); }
    const float rstd = 1.f / sqrtf(wave_sum(s) * (1.f / 1024.f) + EPS);
    unsigned long long* o8 = (unsigned long long*)orow + lane;
#pragma unroll
    for (int j = 0; j < 4; ++j) { const int k = 4 * lane + 256 * j; const f32x4 gg = *(const f32x4*)(g + k), cc = *(const f32x4*)(sc + k), hh = *(const f32x4*)(sh + k);
        const f32x4 y = v[j] * rstd * gg * (cc + 1.f) + hh;
        o8[64 * j] = (unsigned long long)pk2(y.x, y.y) | ((unsigned long long)pk2(y.z, y.w) << 32); }
}
__device__ __forceinline__ void p1_norm(const Frame& F, KArgs a, int layer, const float* xlat, const float* xctx) {
    const float* mod = (const float*)(F.ws + WS_MOD) + (size_t)layer * 9 * 6144; const float* g = a->in[I_N1G] + layer * 1024; bf16* H = (bf16*)(F.ws + WS_H);
    for (int r = F.gw; r < NTOK; r += F.NGW) {
        const float* xr = r < NLAT ? xlat + (size_t)r * 1024 : xctx + (size_t)(r - NLAT) * 1024; const float* m = mod + (size_t)mod_idx(r) * 6144;
        norm_mod_row(xr, g, m + 1024, m, H + (size_t)r * 1024, F.lane);
    }
}

__device__ __forceinline__ void p7_router(const Frame& F, KArgs a, int layer, const float* xlat, const float* xctx, int nrows, bool dry = false) {
    const float* mod = (const float*)(F.ws + WS_MOD) + (size_t)layer * 9 * 6144; const float* g = a->in[I_N2G] + layer * 1024; bf16* H = (bf16*)(F.ws + WS_H);
    LAS float* wr = (LAS float*)F.lds;
    LAS float* ys = (LAS float*)(F.lds + 65536) + F.wave * 1024;
    LAS int* rb = (LAS int*)(F.lds + 98304);
    LAS float* rlo = (LAS float*)(F.lds + 98304 + 1024);
    LAS float* rhi = (LAS float*)(F.lds + 98304 + 2048);
    LAS int* bcnt = (LAS int*)(F.lds + 98304 + 3072);
    __syncthreads();
    for (int i = F.tid; i < 1024 * 16 / 4; i += 512) ((LAS f32x4*)wr)[i] = ((const f32x4*)a->in[I_WROUTER])[i];
    if (F.tid < 64) bcnt[F.tid] = 0;
    __syncthreads();
    const int per = (nrows + F.G - 1) / F.G;
    const int r0 = blockIdx.x * per, r1 = min(r0 + per, nrows);
    const int eq = F.lane & 3, ks = F.lane >> 2;
    const float rbias0 = a->in[I_RBIAS][4 * eq], rbias1 = a->in[I_RBIAS][4 * eq + 1], rbias2 = a->in[I_RBIAS][4 * eq + 2], rbias3 = a->in[I_RBIAS][4 * eq + 3];
#pragma unroll 1
    for (int r = r0 + F.wave; r < r1; r += 8) {
        const float* xr = r < NLAT ? xlat + (size_t)r * 1024 : xctx + (size_t)(r - NLAT) * 1024; const float* m = mod + (size_t)mod_idx(r) * 6144;
        const f32x4* x4 = (const f32x4*)xr + F.lane;
        f32x4 v[4]; float s = 0.f;
#pragma unroll
        for (int j = 0; j < 4; ++j) { v[j] = x4[64 * j]; s += (v[j].x * v[j].x + v[j].y * v[j].y) + (v[j].z * v[j].z + v[j].w * v[j].w); }
        const float rstd = 1.f / sqrtf(wave_sum(s) * (1.f / 1024.f) + EPS);
        unsigned long long* o8 = (unsigned long long*)(H + (size_t)r * 1024) + F.lane;
#pragma unroll
        for (int j = 0; j < 4; ++j) { const int k = 4 * F.lane + 256 * j; const f32x4 gg = *(const f32x4*)(g + k), cc = *(const f32x4*)(m + 4 * 1024 + k), hh = *(const f32x4*)(m + 3 * 1024 + k);
            const f32x4 y = v[j] * rstd * gg * (cc + 1.f) + hh;
            o8[64 * j] = (unsigned long long)pk2(y.x, y.y) | ((unsigned long long)pk2(y.z, y.w) << 32);
            *(LAS f32x4*)(ys + k) = y; }
        asm volatile("s_waitcnt lgkmcnt(0)" ::: "memory");
        f32x4 lg = (f32x4){0.f, 0.f, 0.f, 0.f};
#pragma unroll 8
        for (int i = 0; i < 64; ++i) { const int k = ks + 16 * i; const float yv = ys[k]; const f32x4 w = *(const LAS f32x4*)(wr + k * 16 + 4 * eq); lg += w * yv; }
#pragma unroll
        for (int o2 = 4; o2 < 64; o2 <<= 1) { lg.x += __shfl_xor(lg.x, o2); lg.y += __shfl_xor(lg.y, o2); lg.z += __shfl_xor(lg.z, o2); lg.w += __shfl_xor(lg.w, o2); }
        const float s0 = sigmf(lg.x), s1 = sigmf(lg.y), s2 = sigmf(lg.z), s3 = sigmf(lg.w);
        const float e0 = s0 + rbias0, e1 = s1 + rbias1, e2 = s2 + rbias2, e3 = s3 + rbias3;
        int i1 = 0, i2 = 0; float m1 = -1e30f, m2 = -1e30f, w1 = 0.f, w2 = 0.f;
        { const float ee[4] = {e0, e1, e2, e3}; const float ss[4] = {s0, s1, s2, s3};
#pragma unroll
          for (int q = 0; q < 4; ++q) { const float x = ee[q]; if (x > m1) { m2 = m1; i2 = i1; w2 = w1; m1 = x; i1 = q; w1 = ss[q]; } else if (x > m2) { m2 = x; i2 = q; w2 = ss[q]; } } }
        const float gs = m1 + m2;
        const float g0 = __shfl(gs, 0), g1 = __shfl(gs, 1), g2 = __shfl(gs, 2), g3 = __shfl(gs, 3);
        int best = 0; float bs = g0; if (g1 > bs) { bs = g1; best = 1; } if (g2 > bs) { bs = g2; best = 2; } if (g3 > bs) { bs = g3; best = 3; }
        if (F.lane == best) {
            const float inv = 1.f / (w1 + w2); const float a1 = w1 * inv, a2 = w2 * inv;
            const int lo = i1 < i2 ? i1 : i2, hi = i1 < i2 ? i2 : i1; const float wl = i1 < i2 ? a1 : a2, wh = i1 < i2 ? a2 : a1;
            const int p = lo == 0 ? hi - 1 : (lo == 1 ? hi + 1 : 5);
            const int lr = r - r0; rb[lr] = best * 6 + p; rlo[lr] = wl; rhi[lr] = wh;
        }
    }
    __syncthreads();
    const int n = dry ? 0 : (r1 > r0 ? r1 - r0 : 0);
    int myslot = -1, myb = 0;
    if (F.tid < n) { myb = rb[F.tid]; myslot = atomicAdd((int*)&bcnt[myb], 1); }
    __syncthreads();
    if (F.tid < NBUCKET && !dry) { const int c = bcnt[F.tid]; bcnt[32 + F.tid] = c > 0 ? (int)atomicAdd(F.ctl + CW_CNT + layer * 32 + F.tid, (unsigned)c) : 0; }
    __syncthreads();
    if (F.tid < n) { const size_t p = (size_t)myb * NTOK + bcnt[32 + myb] + myslot;
        ((int*)(F.ws + WS_TOK))[p] = r0 + F.tid; ((float*)(F.ws + WS_WLO))[p] = rlo[F.tid]; ((float*)(F.ws + WS_WHI))[p] = rhi[F.tid]; }
    __syncthreads();
}

__device__ __forceinline__ void p_final(const Frame& F, KArgs a) {
    const float* g = a->in[I_FNG];
    for (int r = F.gw; r < NLAT; r += F.NGW) {
        f32x4* xr = (f32x4*)(a->out + (size_t)r * 1024) + F.lane;
        f32x4 v[4]; float s = 0.f;
#pragma unroll
        for (int j = 0; j < 4; ++j) { v[j] = xr[64 * j]; s += (v[j].x * v[j].x + v[j].y * v[j].y) + (v[j].z * v[j].z + v[j].w * v[j].w); }
        const float rstd = 1.f / sqrtf(wave_sum(s) * (1.f / 1024.f) + EPS);
#pragma unroll
        for (int j = 0; j < 4; ++j) { const f32x4 gg = *(const f32x4*)(g + 4 * F.lane + 256 * j); xr[64 * j] = v[j] * rstd * gg; }
    }
}
__device__ __forceinline__ f32x4 mfma16(bf16x8 a, bf16x8 b, f32x4 c) { return __builtin_amdgcn_mfma_f32_16x16x32_bf16(a, b, c, 0, 0, 0); }
__device__ __forceinline__ void row_bk(int r, int& b, int& key, bool& lat) { lat = r < NLAT; if (lat) { b = r >> 12; key = r & 4095; } else { const int rc = r - NLAT; b = rc >> 8; key = 4096 + (rc & 255); } }

__device__ __forceinline__ void p3_mla_unit(const Frame& F, KArgs a, int layer, int r0) {
    LAS float* Xq = (LAS float*)F.lds;
    LAS float* Xkv = (LAS float*)(F.lds + 49152);
    LAS bf16* Aq = (LAS bf16*)(F.lds + 90112);
    LAS bf16* Akv = (LAS bf16*)(F.lds + 115712);
    LAS bf16* Kr = (LAS bf16*)(F.lds + 133120);
    const bf16* proj = (const bf16*)(F.ws + WS_PROJ);
    int b0, key0; bool lat; row_bk(r0, b0, key0, lat);
    __syncthreads();
    {
        u32x4 wq[3], wk[3];
#pragma unroll
        for (int it = 0; it < 3; ++it) { const int i = F.tid + it * 512; const int r = i / 24, c8 = i % 24; wq[it] = *(const u32x4*)(proj + (size_t)(r0 + r) * PROJ_LD + PJ_MQ + c8 * 8); }
#pragma unroll
        for (int it = 0; it < 3; ++it) { const int i = F.tid + it * 512; const int r = i / 20, c8 = i % 20; if (i < 64 * 20) wk[it] = *(const u32x4*)(proj + (size_t)(r0 + r) * PROJ_LD + PJ_MKV + c8 * 8); }
#pragma unroll
        for (int it = 0; it < 3; ++it) { const int i = F.tid + it * 512; const int r = i / 24, c8 = i % 24; const u32x4 w = wq[it]; LAS float* d = Xq + r * 192 + c8 * 8;
            d[0] = lo_bf(w.x); d[1] = hi_bf(w.x); d[2] = lo_bf(w.y); d[3] = hi_bf(w.y); d[4] = lo_bf(w.z); d[5] = hi_bf(w.z); d[6] = lo_bf(w.w); d[7] = hi_bf(w.w); }
#pragma unroll
        for (int it = 0; it < 3; ++it) { const int i = F.tid + it * 512; const int r = i / 20, c8 = i % 20; if (i < 64 * 20) { const u32x4 w = wk[it]; LAS float* d = Xkv + r * 160 + c8 * 8;
            d[0] = lo_bf(w.x); d[1] = hi_bf(w.x); d[2] = lo_bf(w.y); d[3] = hi_bf(w.y); d[4] = lo_bf(w.z); d[5] = hi_bf(w.z); d[6] = lo_bf(w.w); d[7] = hi_bf(w.w); } }
    }
    __syncthreads();
    const float* qg = a->in[I_QANORM] + layer * 192; const float* kg = a->in[I_KVANORM] + layer * 128;
    for (int r = F.wave; r < 64; r += 8) {
        const float q0 = Xq[r * 192 + F.lane], q1 = Xq[r * 192 + 64 + F.lane], q2 = Xq[r * 192 + 128 + F.lane];
        const float rq = 1.f / sqrtf(wave_sum(q0 * q0 + q1 * q1 + q2 * q2) * (1.f / 192.f) + EPS);
        Aq[r * 200 + F.lane] = (bf16)f2bf(q0 * rq * qg[F.lane]); Aq[r * 200 + 64 + F.lane] = (bf16)f2bf(q1 * rq * qg[64 + F.lane]); Aq[r * 200 + 128 + F.lane] = (bf16)f2bf(q2 * rq * qg[128 + F.lane]);
        const float k0 = Xkv[r * 160 + F.lane], k1 = Xkv[r * 160 + 64 + F.lane];
        const float rk = 1.f / sqrtf(wave_sum(k0 * k0 + k1 * k1) * (1.f / 128.f) + EPS);
        Akv[r * 136 + F.lane] = (bf16)f2bf(k0 * rk * kg[F.lane]); Akv[r * 136 + 64 + F.lane] = (bf16)f2bf(k1 * rk * kg[64 + F.lane]);
    }
    const float* ropec = (const float*)(F.ws + WS_ROPE); const float* ropes = ropec + 4096 * 16;
    for (int i = F.tid; i < 64 * 16; i += 512) { const int r = i >> 4, j = i & 15; const float x1 = Xkv[r * 160 + 128 + j], x2 = Xkv[r * 160 + 144 + j];
        float cs = 1.f, sn = 0.f; if (lat) { cs = ropec[(key0 + r) * 16 + j]; sn = ropes[(key0 + r) * 16 + j]; }
        Kr[r * 32 + j] = (bf16)f2bf(x1 * cs - x2 * sn); Kr[r * 32 + 16 + j] = (bf16)f2bf(x1 * sn + x2 * cs); }
    __syncthreads();
    const int h = F.wave >> 1, rh = F.wave & 1, lr = F.lane & 15, lq = F.lane >> 4;
    {
        const bf16* W = (const bf16*)(F.ws + WS_WUQ) + (size_t)layer * 384 * 192;
        f32x4 acc[2][6];
#pragma unroll
        for (int mt = 0; mt < 2; ++mt)
#pragma unroll
            for (int nt = 0; nt < 6; ++nt) acc[mt][nt] = (f32x4){0.f, 0.f, 0.f, 0.f};
#pragma unroll 3
        for (int ks = 0; ks < 6; ++ks) {
            bf16x8 af[2], bfr[6];
#pragma unroll
            for (int mt = 0; mt < 2; ++mt) af[mt] = *(const LAS bf16x8*)(Aq + (rh * 32 + mt * 16 + lr) * 200 + ks * 32 + lq * 8);
#pragma unroll
            for (int nt = 0; nt < 6; ++nt) bfr[nt] = *(const bf16x8*)(W + (size_t)(h * 96 + nt * 16 + lr) * 192 + ks * 32 + lq * 8);
#pragma unroll
            for (int mt = 0; mt < 2; ++mt)
#pragma unroll
                for (int nt = 0; nt < 6; ++nt) acc[mt][nt] = mfma16(bfr[nt], af[mt], acc[mt][nt]);
        }
        bf16* Q = (bf16*)(F.ws + WS_Q);
#pragma unroll
        for (int mt = 0; mt < 2; ++mt) { const int tl = rh * 32 + mt * 16 + lr;
            if (lat) {
#pragma unroll
                for (int j = 0; j < 4; ++j) { const float cs = ropec[(key0 + tl) * 16 + lq * 4 + j], sn = ropes[(key0 + tl) * 16 + lq * 4 + j]; const float x1 = acc[mt][4][j], x2 = acc[mt][5][j];
                    acc[mt][4][j] = x1 * cs - x2 * sn; acc[mt][5][j] = x1 * sn + x2 * cs; } }
#pragma unroll
            for (int nt = 0; nt < 6; ++nt) { u32x2 w; w.x = pk2(acc[mt][nt][0] * QSCALE, acc[mt][nt][1] * QSCALE); w.y = pk2(acc[mt][nt][2] * QSCALE, acc[mt][nt][3] * QSCALE);
                *(u32x2*)(Q + (size_t)(r0 + tl) * 384 + h * 96 + nt * 16 + lq * 4) = w; } }
    }
    {
        const bf16* W = (const bf16*)(F.ws + WS_WUKV) + (size_t)layer * 512 * 128;
        f32x4 ak[2][4], av[2][4];
#pragma unroll
        for (int mt = 0; mt < 2; ++mt)
#pragma unroll
            for (int nt = 0; nt < 4; ++nt) { ak[mt][nt] = (f32x4){0.f, 0.f, 0.f, 0.f}; av[mt][nt] = (f32x4){0.f, 0.f, 0.f, 0.f}; }
#pragma unroll 2
        for (int ks = 0; ks < 4; ++ks) {
            bf16x8 af[2], bk[4], bv[4];
#pragma unroll
            for (int mt = 0; mt < 2; ++mt) af[mt] = *(const LAS bf16x8*)(Akv + (rh * 32 + mt * 16 + lr) * 136 + ks * 32 + lq * 8);
#pragma unroll
            for (int nt = 0; nt < 4; ++nt) { bk[nt] = *(const bf16x8*)(W + (size_t)(h * 128 + nt * 16 + lr) * 128 + ks * 32 + lq * 8); bv[nt] = *(const bf16x8*)(W + (size_t)(h * 128 + 64 + nt * 16 + lr) * 128 + ks * 32 + lq * 8); }
#pragma unroll
            for (int mt = 0; mt < 2; ++mt)
#pragma unroll
                for (int nt = 0; nt < 4; ++nt) { ak[mt][nt] = mfma16(bk[nt], af[mt], ak[mt][nt]); av[mt][nt] = mfma16(af[mt], bv[nt], av[mt][nt]); }
        }
        bf16* Kg = (bf16*)(F.ws + WS_K) + ((size_t)(b0 * 4 + h) * NKEY + key0) * 96;
        bf16* Vt = (bf16*)(F.ws + WS_VT) + (size_t)(b0 * 4 + h) * 64 * NKEY + key0;
#pragma unroll
        for (int mt = 0; mt < 2; ++mt)
#pragma unroll
            for (int nt = 0; nt < 4; ++nt) {
                u32x2 w; w.x = pk2(ak[mt][nt][0], ak[mt][nt][1]); w.y = pk2(ak[mt][nt][2], ak[mt][nt][3]);
                *(u32x2*)(Kg + (size_t)(rh * 32 + mt * 16 + lr) * 96 + nt * 16 + lq * 4) = w;
                u32x2 v; v.x = pk2(av[mt][nt][0], av[mt][nt][1]); v.y = pk2(av[mt][nt][2], av[mt][nt][3]);
                *(u32x2*)(Vt + (size_t)(nt * 16 + lr) * NKEY + rh * 32 + mt * 16 + lq * 4) = v; }
    }
    {
        for (int i = F.tid; i < 64 * 4 * 4; i += 512) { const int r = i >> 4, hh = (i >> 2) & 3, c8 = i & 3;
            *(u32x4*)((bf16*)(F.ws + WS_K) + ((size_t)(b0 * 4 + hh) * NKEY + key0 + r) * 96 + 64 + c8 * 8) = *(const LAS u32x4*)(Kr + r * 32 + c8 * 8); }
    }
}

__device__ __forceinline__ void p3_conv_unit(const Frame& F, KArgs a, int layer, int r0) {
    LAS float* U = (LAS float*)F.lds;
    const bf16* proj = (const bf16*)(F.ws + WS_PROJ);
    const bool lat = r0 < NLAT; const int Ls = lat ? SEQ : CTXL; const int t0 = lat ? (r0 & 4095) : ((r0 - NLAT) & 255);
    __syncthreads();
    u32x4 cwa[6], cwb[6];
#pragma unroll
    for (int it = 0; it < 6; ++it) { const int i = F.tid + it * 512; const int rr = i >> 5, c8 = i & 31; const int t = t0 - 15 + rr;
        if (i < 94 * 32 && t >= 0 && t < Ls) { const bf16* p = proj + (size_t)(r0 - 15 + rr) * PROJ_LD + PJ_CV + c8 * 8; cwa[it] = *(const u32x4*)p; cwb[it] = *(const u32x4*)(p + 256); } }
#pragma unroll
    for (int it = 0; it < 6; ++it) { const int i = F.tid + it * 512; if (i >= 94 * 32) break; const int rr = i >> 5, c8 = i & 31; const int t = t0 - 15 + rr; LAS float* d = U + rr * 256 + c8 * 8;
        if (t >= 0 && t < Ls) { const u32x4 wa = cwa[it], wb = cwb[it];
            d[0] = lo_bf(wa.x) * sigmf(lo_bf(wb.x)); d[1] = hi_bf(wa.x) * sigmf(hi_bf(wb.x)); d[2] = lo_bf(wa.y) * sigmf(lo_bf(wb.y)); d[3] = hi_bf(wa.y) * sigmf(hi_bf(wb.y));
            d[4] = lo_bf(wa.z) * sigmf(lo_bf(wb.z)); d[5] = hi_bf(wa.z) * sigmf(hi_bf(wb.z)); d[6] = lo_bf(wa.w) * sigmf(lo_bf(wb.w)); d[7] = hi_bf(wa.w) * sigmf(hi_bf(wb.w)); }
        else {
#pragma unroll
            for (int j = 0; j < 8; ++j) d[j] = 0.f; } }
    __syncthreads();
    const int c = F.tid & 255, th = F.tid >> 8;
    float o[32];
    { const float* w = a->in[I_CVW] + (size_t)layer * 31 * 256 + c; const float bias = a->in[I_CVB][layer * 256 + c];
#pragma unroll
      for (int t = 0; t < 32; ++t) o[t] = bias;
#pragma unroll 1
      for (int k = 0; k < 31; ++k) { const float wk = w[k * 256];
#pragma unroll
          for (int t = 0; t < 32; ++t) o[t] += U[(th * 32 + t + k) * 256 + c] * wk; } }
    __syncthreads();
#pragma unroll
    for (int t = 0; t < 32; ++t) U[(th * 32 + t) * 256 + c] = o[t];
    __syncthreads();
    const float* lg = a->in[I_CVLNG] + layer * 256; const float* lb = a->in[I_CVLNB] + layer * 256; const float* mg = a->in[I_MIXG] + layer * 1024 + 512;
    bf16* Y = (bf16*)(F.ws + WS_H);
    for (int r = F.wave; r < 64; r += 8) {
        const f32x4 v = *(const LAS f32x4*)(U + r * 256 + 4 * F.lane);
        float s = (v.x + v.y) + (v.z + v.w);
#pragma unroll
        for (int o2 = 1; o2 < 16; o2 <<= 1) s += __shfl_xor(s, o2);
        const float mean = s * (1.f / 64.f); const f32x4 d = v - mean; float q = (d.x * d.x + d.y * d.y) + (d.z * d.z + d.w * d.w);
#pragma unroll
        for (int o2 = 1; o2 < 16; o2 <<= 1) q += __shfl_xor(q, o2);
        const float rstd = 1.f / sqrtf(q * (1.f / 64.f) + EPS);
        const f32x4 gg = *(const f32x4*)(lg + 4 * F.lane), bb = *(const f32x4*)(lb + 4 * F.lane);
        f32x4 y = d * rstd * gg + bb; y.x = siluf(y.x); y.y = siluf(y.y); y.z = siluf(y.z); y.w = siluf(y.w);
        const float ss = wave_sum((y.x * y.x + y.y * y.y) + (y.z * y.z + y.w * y.w)); const float rn = 1.f / sqrtf(ss * (1.f / 256.f) + EPS);
        const f32x4 m4 = *(const f32x4*)(mg + 4 * F.lane); y = y * rn * m4;
        u32x2 w; w.x = pk2(y.x, y.y); w.y = pk2(y.z, y.w);
        *(u32x2*)(Y + (size_t)(r0 + r) * 1024 + 512 + 4 * F.lane) = w;
    }
}

__device__ __forceinline__ void p3_gmlp_unit(const Frame& F, KArgs a, int layer, int r0) {
    LAS bf16* vT = (LAS bf16*)F.lds;
    LAS float* red = (LAS float*)(F.lds + 69632);
    const bf16* proj = (const bf16*)(F.ws + WS_PROJ);
    const float* lg = a->in[I_GMLNG] + layer * 256; const float* lb = a->in[I_GMLNB] + layer * 256;
    __syncthreads();
    u32x2 gw[16];
#pragma unroll
    for (int it = 0; it < 16; ++it) gw[it] = *(const u32x2*)(proj + (size_t)(r0 + F.wave + 8 * it) * PROJ_LD + PJ_GM + 256 + 4 * F.lane);
#pragma unroll
    for (int it = 0; it < 16; ++it) { const int r = F.wave + 8 * it;
        const u32x2 w = gw[it];
        f32x4 v; v.x = gelu_tanh(lo_bf(w.x)); v.y = gelu_tanh(hi_bf(w.x)); v.z = gelu_tanh(lo_bf(w.y)); v.w = gelu_tanh(hi_bf(w.y));
        const float mean = wave_sum((v.x + v.y) + (v.z + v.w)) * (1.f / 256.f); const f32x4 d = v - mean;
        const float rstd = 1.f / sqrtf(wave_sum((d.x * d.x + d.y * d.y) + (d.z * d.z + d.w * d.w)) * (1.f / 256.f) + EPS);
        const f32x4 gg = *(const f32x4*)(lg + 4 * F.lane), bb = *(const f32x4*)(lb + 4 * F.lane); const f32x4 y = d * rstd * gg + bb;
        vT[(4 * F.lane + 0) * 136 + r] = (bf16)f2bf(y.x); vT[(4 * F.lane + 1) * 136 + r] = (bf16)f2bf(y.y); vT[(4 * F.lane + 2) * 136 + r] = (bf16)f2bf(y.z); vT[(4 * F.lane + 3) * 136 + r] = (bf16)f2bf(y.w);
    }
    __syncthreads();
    const int g = F.wave >> 1, ih = F.wave & 1, lr = F.lane & 15, lq = F.lane >> 4;
    const bf16* W = (const bf16*)(F.ws + WS_GMWS) + (size_t)(layer * 4 + g) * 128 * 128;
    f32x4 acc[4][4];
#pragma unroll
    for (int dt = 0; dt < 4; ++dt)
#pragma unroll
        for (int it = 0; it < 4; ++it) acc[dt][it] = (f32x4){0.f, 0.f, 0.f, 0.f};
#pragma unroll 2
    for (int ks = 0; ks < 4; ++ks) {
        bf16x8 af[4], bfr[4];
#pragma unroll
        for (int dt = 0; dt < 4; ++dt) af[dt] = *(const LAS bf16x8*)(vT + (g * 64 + dt * 16 + lr) * 136 + ks * 32 + lq * 8);
#pragma unroll
        for (int it = 0; it < 4; ++it) bfr[it] = *(const bf16x8*)(W + (size_t)(ih * 64 + it * 16 + lr) * 128 + ks * 32 + lq * 8);
#pragma unroll
        for (int dt = 0; dt < 4; ++dt)
#pragma unroll
            for (int it = 0; it < 4; ++it) acc[dt][it] = mfma16(af[dt], bfr[it], acc[dt][it]);
    }
    const float* bs = a->in[I_GMBS] + (size_t)(layer * 4 + g) * 128;
#pragma unroll
    for (int it = 0; it < 4; ++it) { const int i = ih * 64 + it * 16 + lr; const float bsi = bs[i]; float ss = 0.f;
#pragma unroll
        for (int dt = 0; dt < 4; ++dt) { const u32x2 w = *(const u32x2*)(proj + (size_t)(r0 + i) * PROJ_LD + PJ_GM + g * 64 + dt * 16 + 4 * lq);
            f32x4 u; u.x = gelu_tanh(lo_bf(w.x)); u.y = gelu_tanh(hi_bf(w.x)); u.z = gelu_tanh(lo_bf(w.y)); u.w = gelu_tanh(hi_bf(w.y));
            const f32x4 y = u * (acc[dt][it] + bsi); acc[dt][it] = y; ss += (y.x * y.x + y.y * y.y) + (y.z * y.z + y.w * y.w); }
        ss += __shfl_xor(ss, 16); ss += __shfl_xor(ss, 32);
        if (lq == 0) red[g * 128 + i] = ss; }
    __syncthreads();
    const float* mg = a->in[I_MIXG] + layer * 1024 + 256; bf16* Y = (bf16*)(F.ws + WS_H);
#pragma unroll
    for (int it = 0; it < 4; ++it) { const int i = ih * 64 + it * 16 + lr; const float rn = 1.f / sqrtf((red[i] + red[128 + i] + red[256 + i] + red[384 + i]) * (1.f / 256.f) + EPS);
#pragma unroll
        for (int dt = 0; dt < 4; ++dt) { const int col = g * 64 + dt * 16 + 4 * lq; const f32x4 m4 = *(const f32x4*)(mg + col); const f32x4 y = acc[dt][it] * rn * m4;
            u32x2 w; w.x = pk2(y.x, y.y); w.y = pk2(y.z, y.w); *(u32x2*)(Y + (size_t)(r0 + i) * 1024 + 256 + col) = w; } }
}
__device__ __forceinline__ f32x16 mfma32(bf16x8 a, bf16x8 b, f32x16 c) { return __builtin_amdgcn_mfma_f32_32x32x16_bf16(a, b, c, 0, 0, 0); }
__device__ __forceinline__ bf16x8 pack8(float a0, float a1, float a2, float a3, float a4, float a5, float a6, float a7) {
    u32x4 w; w.x = pg8::cvt_pk_bf16(a0, a1); w.y = pg8::cvt_pk_bf16(a2, a3); w.z = pg8::cvt_pk_bf16(a4, a5); w.w = pg8::cvt_pk_bf16(a6, a7); return __builtin_bit_cast(bf16x8, w); }

constexpr int AT_KROW = 104, AT_VROW = 72, AT_KB = 64 * AT_KROW * 2, AT_VB = 64 * AT_VROW * 2;
__device__ __forceinline__ void attn_unit(const Frame& F, int b, int h, int qrow0, int key0, int ntile) {
    LAS unsigned char* L = F.lds;
    const bf16* Kg = (const bf16*)(F.ws + WS_K) + ((size_t)(b * 4 + h) * NKEY + key0) * 96;
    const bf16* Vg = (const bf16*)(F.ws + WS_VT) + (size_t)(b * 4 + h) * 64 * NKEY + key0;
    const bf16* Q = (const bf16*)(F.ws + WS_Q);
    const int lane = F.lane, hi = lane >> 5, l31 = lane & 31;
    const int qrow = qrow0 + F.wave * 32 + l31;
    bf16x8 qf[6];
#pragma unroll
    for (int ks = 0; ks < 6; ++ks) qf[ks] = *(const bf16x8*)(Q + (size_t)qrow * 384 + h * 96 + ks * 16 + hi * 8);
    const int kr0 = F.tid / 12, kc0 = F.tid % 12, kr1 = (F.tid + 512) / 12, kc1 = (F.tid + 512) % 12; const bool k2 = F.tid < 256;
    const int vd = F.tid >> 3, vc = F.tid & 7;
    u32x4 sk0, sk1 = (u32x4){0u, 0u, 0u, 0u}, sv;
    __syncthreads();
    sk0 = *(const u32x4*)(Kg + (size_t)kr0 * 96 + kc0 * 8); if (k2) sk1 = *(const u32x4*)(Kg + (size_t)kr1 * 96 + kc1 * 8); sv = *(const u32x4*)(Vg + (size_t)vd * NKEY + vc * 8);
    *(LAS u32x4*)(L + kr0 * (AT_KROW * 2) + kc0 * 16) = sk0; if (k2) *(LAS u32x4*)(L + kr1 * (AT_KROW * 2) + kc1 * 16) = sk1; *(LAS u32x4*)(L + 2 * AT_KB + vd * (AT_VROW * 2) + vc * 16) = sv;
    __syncthreads();
    const int prow = (l31 & ~12) | ((l31 & 4) << 1) | ((l31 & 8) >> 1);
    const int koff = prow * (AT_KROW * 2) + hi * 16, voff = l31 * (AT_VROW * 2) + hi * 16;
    f32x16 O0, O1;
#pragma unroll
    for (int r = 0; r < 16; ++r) { O0[r] = 0.f; O1[r] = 0.f; }
    float m = -1e30f, l = 0.f;
    for (int j = 0; j < ntile; ++j) {
        const int buf = j & 1; const bool pre = j + 1 < ntile;
        if (pre) { const bf16* kg = Kg + (size_t)(j + 1) * 64 * 96; const bf16* vg = Vg + (j + 1) * 64;
            sk0 = *(const u32x4*)(kg + (size_t)kr0 * 96 + kc0 * 8); if (k2) sk1 = *(const u32x4*)(kg + (size_t)kr1 * 96 + kc1 * 8); sv = *(const u32x4*)(vg + (size_t)vd * NKEY + vc * 8); }
        const LAS unsigned char* Kt = L + buf * AT_KB; const LAS unsigned char* Vt = L + 2 * AT_KB + buf * AT_VB;
        f32x16 S0, S1;
#pragma unroll
        for (int r = 0; r < 16; ++r) { S0[r] = 0.f; S1[r] = 0.f; }
#pragma unroll
        for (int ks = 0; ks < 6; ++ks) { const bf16x8 k0 = *(const LAS bf16x8*)(Kt + koff + ks * 32), k1 = *(const LAS bf16x8*)(Kt + 32 * (AT_KROW * 2) + koff + ks * 32);
            S0 = mfma32(k0, qf[ks], S0); S1 = mfma32(k1, qf[ks], S1); }
        float mx = S0[0];
#pragma unroll
        for (int r = 1; r < 16; ++r) mx = fmaxf(mx, S0[r]);
#pragma unroll
        for (int r = 0; r < 16; ++r) mx = fmaxf(mx, S1[r]);
        mx = fmaxf(mx, __shfl_xor(mx, 32));
        const float mn = fmaxf(m, mx), alpha = __builtin_amdgcn_exp2f(m - mn); m = mn;
        float sum = 0.f;
#pragma unroll
        for (int r = 0; r < 16; ++r) { S0[r] = __builtin_amdgcn_exp2f(S0[r] - mn); S1[r] = __builtin_amdgcn_exp2f(S1[r] - mn); sum += S0[r] + S1[r]; }
        sum += __shfl_xor(sum, 32); l = l * alpha + sum;
#pragma unroll
        for (int r = 0; r < 16; ++r) { O0[r] *= alpha; O1[r] *= alpha; }
        bf16x8 pf[4];
        pf[0] = pack8(S0[0], S0[1], S0[2], S0[3], S0[4], S0[5], S0[6], S0[7]); pf[1] = pack8(S0[8], S0[9], S0[10], S0[11], S0[12], S0[13], S0[14], S0[15]);
        pf[2] = pack8(S1[0], S1[1], S1[2], S1[3], S1[4], S1[5], S1[6], S1[7]); pf[3] = pack8(S1[8], S1[9], S1[10], S1[11], S1[12], S1[13], S1[14], S1[15]);
#pragma unroll
        for (int s = 0; s < 4; ++s) { const bf16x8 v0 = *(const LAS bf16x8*)(Vt + voff + s * 32), v1 = *(const LAS bf16x8*)(Vt + 32 * (AT_VROW * 2) + voff + s * 32);
            O0 = mfma32(v0, pf[s], O0); O1 = mfma32(v1, pf[s], O1); }
        if (pre) { LAS unsigned char* Kn = L + (buf ^ 1) * AT_KB; LAS unsigned char* Vn = L + 2 * AT_KB + (buf ^ 1) * AT_VB;
            *(LAS u32x4*)(Kn + kr0 * (AT_KROW * 2) + kc0 * 16) = sk0; if (k2) *(LAS u32x4*)(Kn + kr1 * (AT_KROW * 2) + kc1 * 16) = sk1; *(LAS u32x4*)(Vn + vd * (AT_VROW * 2) + vc * 16) = sv; }
        __syncthreads();
    }
    const float inv = 1.f / l;
    bf16* Y = (bf16*)(F.ws + WS_YAT) + (size_t)qrow * 256 + h * 64;
#pragma unroll
    for (int g = 0; g < 4; ++g) {
        u32x2 w0, w1; w0.x = pk2(O0[4 * g] * inv, O0[4 * g + 1] * inv); w0.y = pk2(O0[4 * g + 2] * inv, O0[4 * g + 3] * inv);
        w1.x = pk2(O1[4 * g] * inv, O1[4 * g + 1] * inv); w1.y = pk2(O1[4 * g + 2] * inv, O1[4 * g + 3] * inv);
        *(u32x2*)(Y + 8 * g + 4 * hi) = w0; *(u32x2*)(Y + 32 + 8 * g + 4 * hi) = w1; }
}

__device__ __forceinline__ float filt_inv_norm(const Frame& F, int set, int ntile, int o, int c) {
    const float* fsp = (const float*)(F.ws + WS_FS) + (size_t)set * 128 * 1024 + o * 512 + c;
    float s = 0.f;
    for (int t = F.lane; t < ntile; t += 64) s += fsp[(size_t)t * 1024] + fsp[(size_t)t * 1024 + 256];
    return 1.f / wave_sum(s);
}
constexpr int HY_UROW = 4384, HY_UB = 8 * HY_UROW * 2, HY_G0 = HY_UB, HY_G1 = HY_G0 + GLEN * 2 + 64;
static_assert((HY_G0 / 4) % 32 == 0 && (HY_G1 / 4) % 32 == 16, "G copies on opposite bank halves");
__device__ __forceinline__ bf16x8 lds_rd8_a4(const LAS unsigned char* p) { const LAS unsigned* q = (const LAS unsigned*)p; u32x4 w; w.x = q[0]; w.y = q[1]; w.z = q[2]; w.w = q[3]; return __builtin_bit_cast(bf16x8, w); }
__device__ __forceinline__ void hyena_unit(const Frame& F, KArgs a, int layer, int c) {
    LAS unsigned char* L = F.lds; LAS bf16* U = (LAS bf16*)L;
    bf16* hyT = (bf16*)(F.ws + WS_HYT);
    const float* sw = a->in[I_HSW] + (size_t)layer * 3 * 768; const float* sb = a->in[I_HSB] + layer * 768;
    const int lane = F.lane, w = F.wave, hi = lane >> 5, l31 = lane & 31;
    __syncthreads();
    {
        const bf16* vrow = hyT + (size_t)(512 + c) * NTOK; const float w0 = sw[512 + c], w1 = sw[768 + 512 + c], w2 = sw[1536 + 512 + c], bb = sb[512 + c];
        for (int i = F.tid; i < 8 * 512; i += 512) { const int b = i >> 9, t0 = (i & 511) * 8; const bf16* p = vrow + b * 4096 + t0; const u32x4 x = *(const u32x4*)p;
            float v[10]; v[0] = t0 > 0 ? bf2f(p[-1]) : 0.f; v[9] = t0 + 8 < 4096 ? bf2f(p[8]) : 0.f;
            v[1] = lo_bf(x.x); v[2] = hi_bf(x.x); v[3] = lo_bf(x.y); v[4] = hi_bf(x.y); v[5] = lo_bf(x.z); v[6] = hi_bf(x.z); v[7] = lo_bf(x.w); v[8] = hi_bf(x.w);
            float o[8];
#pragma unroll
            for (int k = 0; k < 8; ++k) o[k] = w0 * v[k] + w1 * v[k + 1] + w2 * v[k + 2] + bb;
            u32x4 ww; ww.x = pk2(o[0], o[1]); ww.y = pk2(o[2], o[3]); ww.z = pk2(o[4], o[5]); ww.w = pk2(o[6], o[7]);
            *(LAS u32x4*)(U + b * HY_UROW + t0 + 8 * (t0 >> 7)) = ww; }
    }
    const int sel = l31 & 1;
    const int abase = (sel ? HY_G1 : HY_G0) + (GC - l31 + 8 * hi + sel) * 2;
    const int nb = l31 & 7, qq = l31 >> 3, qsb = 16 * w + 4 * qq;
    const int ubase = (nb * HY_UROW + 8 * hi) * 2;
#pragma unroll 1
    for (int o = 0; o < 2; ++o) {
        {
            const bf16* Gg = (const bf16*)(F.ws + WS_G) + ((size_t)(layer * 2 + o) * 256 + c) * GLEN;
            for (int i = F.tid; i < GLEN / 8; i += 512) { u32x4 x = *(const u32x4*)(Gg + i * 8);
                if (i < 5 || i >= 1027) { const int m0 = i * 8; unsigned* xp = (unsigned*)&x;
#pragma unroll
                    for (int k = 0; k < 4; ++k) { const int ma = m0 + 2 * k, mb = ma + 1; unsigned v = xp[k]; if (ma < 33 || ma > 8223) v &= 0xffff0000u; if (mb < 33 || mb > 8223) v &= 0x0000ffffu; xp[k] = v; } }
                *(LAS u32x4*)(L + HY_G0 + i * 16) = x; }
            __syncthreads();
            const LAS unsigned* g0 = (const LAS unsigned*)(L + HY_G0); LAS unsigned* g1 = (LAS unsigned*)(L + HY_G1);
            for (int i = F.tid; i <= GLEN / 2; i += 512) { const unsigned dp = i > 0 ? g0[i - 1] : 0u, d = i < GLEN / 2 ? g0[i] : 0u; g1[i] = (dp >> 16) | (d << 16); }
            __syncthreads();
        }
        f32x16 acc[4];
#pragma unroll
        for (int j = 0; j < 4; ++j)
#pragma unroll
            for (int r = 0; r < 16; ++r) acc[j][r] = 0.f;
        bf16x8 A[4][2];
        const int e0 = 16 * w - 127;
#define HY_LOADA(slot, delta) do { const LAS unsigned char* _p = L + abase - 64 * (delta); A[slot][0] = lds_rd8_a4(_p); A[slot][1] = lds_rd8_a4(_p + 32); } while (0)
        HY_LOADA(0, e0); HY_LOADA(1, e0 + 1); HY_LOADA(2, e0 + 2);
#define HY_STEP(g) do { const int e = eb + (g); const int qs = qsb - e; const bool ok = (unsigned)qs < 128u; const int qc = qs < 0 ? 0 : (qs > 127 ? 127 : qs); \
            const LAS unsigned char* _u = L + ubase + (32 * qc + 8 * (qc >> 2)) * 2; bf16x8 f0 = *(const LAS bf16x8*)_u, f1 = *(const LAS bf16x8*)(_u + 32); \
            if (!ok) { f0 = (bf16x8){0, 0, 0, 0, 0, 0, 0, 0}; f1 = f0; } \
            HY_LOADA(((g) + 3) & 3, e + 3); \
            _Pragma("unroll") for (int j = 0; j < 4; ++j) { acc[j] = mfma32(A[((g) + j) & 3][0], f0, acc[j]); acc[j] = mfma32(A[((g) + j) & 3][1], f1, acc[j]); } } while (0)
#pragma unroll 1
        for (int eb = e0; eb < e0 + 140; eb += 4) { HY_STEP(0); HY_STEP(1); HY_STEP(2); HY_STEP(3); }
#undef HY_STEP
#undef HY_LOADA
        __syncthreads();
        const float inv = filt_inv_norm(F, layer, 128, o, c);
        const float hb = a->in[I_HBIAS][(size_t)(layer * 2 + o) * 256 + c];
        const int gcol = o == 0 ? c : 256 + c; const bf16* grow = hyT + (size_t)gcol * NTOK + nb * 4096;
        const float w0 = sw[gcol], w1 = sw[768 + gcol], w2 = sw[1536 + gcol], bb = sb[gcol];
        bf16* yrow = (bf16*)(F.ws + WS_YT) + (size_t)c * NTOK + nb * 4096;
#pragma unroll
        for (int j = 0; j < 4; ++j) { const int q = 16 * w + 4 * qq + j;
#pragma unroll
            for (int g4 = 0; g4 < 4; ++g4) { const int t = 32 * q + 8 * g4 + 4 * hi; const bf16* p = grow + t; const u32x2 x = *(const u32x2*)p;
                float v[6]; v[0] = t > 0 ? bf2f(p[-1]) : 0.f; v[5] = t + 4 < 4096 ? bf2f(p[4]) : 0.f; v[1] = lo_bf(x.x); v[2] = hi_bf(x.x); v[3] = lo_bf(x.y); v[4] = hi_bf(x.y);
                LAS bf16* up = U + nb * HY_UROW + t + 8 * (t >> 7); const u32x2 uu = *(const LAS u32x2*)up;
                const float u0 = lo_bf(uu.x), u1 = hi_bf(uu.x), u2 = lo_bf(uu.y), u3 = hi_bf(uu.y);
                const float y0 = (w0 * v[0] + w1 * v[1] + w2 * v[2] + bb) * (acc[j][4 * g4] * inv + hb * u0);
                const float y1 = (w0 * v[1] + w1 * v[2] + w2 * v[3] + bb) * (acc[j][4 * g4 + 1] * inv + hb * u1);
                const float y2 = (w0 * v[2] + w1 * v[3] + w2 * v[4] + bb) * (acc[j][4 * g4 + 2] * inv + hb * u2);
                const float y3 = (w0 * v[3] + w1 * v[4] + w2 * v[5] + bb) * (acc[j][4 * g4 + 3] * inv + hb * u3);
                u32x2 wv; wv.x = pk2(y0, y1); wv.y = pk2(y2, y3);
                if (o == 0) *(LAS u32x2*)up = wv; else *(u32x2*)(yrow + t) = wv; } }
        __syncthreads();
    }
}

__device__ __forceinline__ void hyena_ctx_unit(const Frame& F, KArgs a, int c) {
    LAS float* u = (LAS float*)F.lds;
    LAS float* y1 = u + 2048;
    LAS float* T = y1 + 2048;
    bf16* hyT = (bf16*)(F.ws + WS_HYT);
    const float* sw = a->in[I_HSW]; const float* sb = a->in[I_HSB];
    __syncthreads();
    for (int i = F.tid; i < 1024; i += 512) T[i] = ((const float*)(F.ws + WS_TC))[((size_t)(i >> 9) * 256 + c) * 512 + (i & 511)];
    if (F.tid < 2) T[F.tid * 512] = 0.f;
    {
        const bf16* vrow = hyT + (size_t)(512 + c) * NTOK + NLAT; const float w0 = sw[512 + c], w1 = sw[768 + 512 + c], w2 = sw[1536 + 512 + c], bb = sb[512 + c];
        for (int i = F.tid; i < 2048; i += 512) { const int t = i & 255; const float vm = t > 0 ? bf2f(vrow[i - 1]) : 0.f, v0 = bf2f(vrow[i]), vp = t < 255 ? bf2f(vrow[i + 1]) : 0.f; u[i] = w0 * vm + w1 * v0 + w2 * vp + bb; }
    }
    __syncthreads();
#pragma unroll 1
    for (int o = 0; o < 2; ++o) {
        const LAS float* in = o == 0 ? u : y1; const float inv = filt_inv_norm(F, 2, 8, o, c); const float hb = a->in[I_HBIAS][(size_t)o * 256 + c];
        const int gcol = o == 0 ? c : 256 + c; const bf16* grow = hyT + (size_t)gcol * NTOK + NLAT; const float w0 = sw[gcol], w1 = sw[768 + gcol], w2 = sw[1536 + gcol], bb = sb[gcol];
        for (int i = F.tid; i < 2048; i += 512) { const int b = i >> 8, t = i & 255; float s = 0.f;
            for (int sidx = 0; sidx < 256; ++sidx) s += T[o * 512 + 256 + t - sidx] * in[b * 256 + sidx];
            const float gm = t > 0 ? bf2f(grow[i - 1]) : 0.f, g0 = bf2f(grow[i]), gp = t < 255 ? bf2f(grow[i + 1]) : 0.f;
            const float y = (w0 * gm + w1 * g0 + w2 * gp + bb) * (s * inv + hb * in[i]);
            if (o == 0) y1[i] = y; else ((bf16*)(F.ws + WS_YT))[(size_t)c * NTOK + NLAT + i] = (bf16)f2bf(y); }
        __syncthreads();
    }
}

__device__ __forceinline__ void p5_unit(const Frame& F, KArgs a, int layer, int r0) {
    LAS bf16* T = (LAS bf16*)F.lds;
    const bf16* yT = (const bf16*)(F.ws + WS_YT); const bf16* yat = (const bf16*)(F.ws + WS_YAT); bf16* Y = (bf16*)(F.ws + WS_H);
    const float* mg = a->in[I_MIXG] + layer * 1024;
    __syncthreads();
    for (int i = F.tid; i < 1024; i += 512) { const int c = i >> 2, q = i & 3; *(LAS u32x4*)(T + c * 40 + q * 8) = *(const u32x4*)(yT + (size_t)c * NTOK + r0 + q * 8); }
    __syncthreads();
    for (int r = F.wave; r < 32; r += 8) {
        f32x4 v; v.x = bf2f(T[(4 * F.lane) * 40 + r]); v.y = bf2f(T[(4 * F.lane + 1) * 40 + r]); v.z = bf2f(T[(4 * F.lane + 2) * 40 + r]); v.w = bf2f(T[(4 * F.lane + 3) * 40 + r]);
        float rn = 1.f / sqrtf(wave_sum((v.x * v.x + v.y * v.y) + (v.z * v.z + v.w * v.w)) * (1.f / 256.f) + EPS);
        f32x4 m4 = *(const f32x4*)(mg + 4 * F.lane); f32x4 y = v * rn * m4; u32x2 w; w.x = pk2(y.x, y.y); w.y = pk2(y.z, y.w);
        *(u32x2*)(Y + (size_t)(r0 + r) * 1024 + 4 * F.lane) = w;
        bf16* ya = Y + (size_t)(r0 + r) * 1024 + 768 + 4 * F.lane; const u32x2 x = *(const u32x2*)(yat + (size_t)(r0 + r) * 256 + 4 * F.lane);
        v.x = lo_bf(x.x); v.y = hi_bf(x.x); v.z = lo_bf(x.y); v.w = hi_bf(x.y);
        rn = 1.f / sqrtf(wave_sum((v.x * v.x + v.y * v.y) + (v.z * v.z + v.w * v.w)) * (1.f / 256.f) + EPS);
        m4 = *(const f32x4*)(mg + 768 + 4 * F.lane); y = v * rn * m4; w.x = pk2(y.x, y.y); w.y = pk2(y.z, y.w); *(u32x2*)ya = w;
    }
}
#ifndef MK_DUP
#define MK_DUP 0u
#endif
#define DUPN(k) (((MK_DUP >> (k)) & 1u) ? 2 : 1)
#ifndef MK_PHASES
#define MK_PHASES 0xFFFFFu
#endif
template <int LAYER>
__device__ __forceinline__ void layer_phases(Frame F, const XcdBarrier& bar, int lo, int hi) {
    constexpr int PB = 1 + 9 * LAYER;
    unsigned char* ws = F.ws;
    const float* modl = (const float*)(ws + WS_MOD) + (size_t)LAYER * 9 * 6144;
    float* xc = (float*)(ws + WS_XC);
#define IN(k) (((MK_PHASES >> (k)) & 1u) && lo <= (k) && (k) < hi)
#define SEAM(k) do { if (IN(k) && IN((k) + 1)) xcd_barrier(bar); } while (0)
#define BODY_P1 { if (LAYER == 0) p1_norm(F, kargs(), 0, kargs()->in[I_X], kargs()->in[I_CTX]); else p1_norm(F, kargs(), 1, kargs()->out, xc); }
    relaunder(F);
    if (IN(PB + 0)) { BODY_P1 if (DUPN(0) == 2) BODY_P1 }
    SEAM(PB + 0);
#define BODY_P2 { OpIn op{(const bf16*)(ws + WS_H), (const bf16*)(ws + WS_WIN) + (size_t)LAYER * NIN_PAD * 1024, (bf16*)(ws + WS_PROJ), (bf16*)(ws + WS_HYT), LAYER, F.G, F.vcu}; \
        pg8::gemm_phase<OpIn, true>(F.lds, op, 1024); }
    relaunder(F);
    if (IN(PB + 1)) { BODY_P2 if (DUPN(1) == 2) BODY_P2 }
    SEAM(PB + 1);
    relaunder(F);
    if (IN(PB + 2)) for (int rep = 0; rep < DUPN(2); ++rep) {
        constexpr int NGM = LAYER == 0 ? NTOK / 128 : NLAT / 128, NCV = LAYER == 0 ? NTOK / 64 : NLAT / 64, NML = NTOK / 64;
        for (int u = F.vcu; u < NGM + NCV + NML; u += F.G) {
            if (u < NGM) { for (int r2 = 0; r2 < DUPN(22); ++r2) p3_gmlp_unit(F, kargs(), LAYER, u * 128); }
            else if (u < NGM + NCV) { for (int r2 = 0; r2 < DUPN(23); ++r2) p3_conv_unit(F, kargs(), LAYER, (u - NGM) * 64); }
            else { for (int r2 = 0; r2 < DUPN(24); ++r2) p3_mla_unit(F, kargs(), LAYER, (u - NGM - NCV) * 64); }
        }
    }
    SEAM(PB + 2);
    relaunder(F);
    if (IN(PB + 3)) {
        constexpr int NU = LAYER == 0 ? 256 + 512 + 32 + 256 : 256 + 512;
        for (int u = F.vcu; u < NU; u += F.G) {
            if (u < 256) { for (int rep = 0; rep < DUPN(17); ++rep) hyena_unit(F, kargs(), LAYER, u); }
            else if (u < 768) { const int id = u - 256; for (int rep = 0; rep < DUPN(16); ++rep) attn_unit(F, id >> 6, (id >> 4) & 3, (id >> 6) * 4096 + (id & 15) * 256, 0, NKEY / 64); }
            else if (u < 800) { const int id = u - 768; attn_unit(F, id >> 2, id & 3, NLAT + (id >> 2) * 256, 4096, 4); }
            else hyena_ctx_unit(F, kargs(), u - 800);
        }
    }
    SEAM(PB + 3);
    relaunder(F);
    if (IN(PB + 4)) for (int rep = 0; rep < DUPN(4); ++rep) {
        constexpr int NU = (LAYER == 0 ? NTOK : NLAT) / 32;
        for (int u = F.vcu; u < NU; u += F.G) p5_unit(F, kargs(), LAYER, u * 32);
    }
    SEAM(PB + 4);
    relaunder(F);
    if (IN(PB + 5)) {
        OpOut op{(const bf16*)(ws + WS_H), (const bf16*)(ws + WS_WOUT) + (size_t)LAYER * 1024 * 1024, LAYER == 0 ? kargs()->in[I_X] : kargs()->out, LAYER == 0 ? kargs()->in[I_CTX] : xc, kargs()->out, xc, modl, LAYER, F.G, F.vcu, 1.f};
        pg8::gemm_phase<OpOut, true>(F.lds, op, 1024);
        if (DUPN(5) == 2) { OpOut op2{(const bf16*)(ws + WS_H), (const bf16*)(ws + WS_WOUT) + (size_t)LAYER * 1024 * 1024, kargs()->out, xc, kargs()->out, xc, modl, LAYER, F.G, F.vcu, 0.f}; pg8::gemm_phase<OpOut, true>(F.lds, op2, 1024); }
    }
    SEAM(PB + 5);
    relaunder(F);
    if (IN(PB + 6)) for (int rep = 0; rep < DUPN(6); ++rep) p7_router(F, kargs(), LAYER, kargs()->out, xc, LAYER == 0 ? NTOK : NLAT, rep > 0);
    SEAM(PB + 6);
    LAS int* tab = (LAS int*)(F.lds + 131072 + 4096);
    relaunder(F);
    if (IN(PB + 7) || IN(PB + 8)) {
        __syncthreads();
        if (F.tid == 0) { int acc = 0; for (int k = 0; k < NBUCKET; ++k) { const int c = (int)__hip_atomic_load(F.ctl + CW_CNT + LAYER * 32 + k, __ATOMIC_RELAXED, __HIP_MEMORY_SCOPE_AGENT); tab[k] = acc; tab[32 + k] = c; acc += (c + 255) >> 8; } tab[NBUCKET] = acc; }
        __syncthreads();
    }
#define BODY_P8 { OpMoe1 op{(const bf16*)(ws + WS_H), (const bf16*)(ws + WS_W1), (bf16*)(ws + WS_PROJ), (const int*)(ws + WS_TOK), (const float*)(ws + WS_WLO), (const float*)(ws + WS_WHI), tab, LAYER, F.G, F.vcu}; \
        pg8::gemm_phase<OpMoe1, true>(F.lds, op, 1024); }
    relaunder(F);
    if (IN(PB + 7)) { BODY_P8 if (DUPN(7) == 2) BODY_P8 }
    SEAM(PB + 7);
    relaunder(F);
    if (IN(PB + 8)) {
        OpMoe2 op{(const bf16*)(ws + WS_PROJ), (const bf16*)(ws + WS_W2), kargs()->out, xc, modl, (const int*)(ws + WS_TOK), tab, LAYER, F.G, F.vcu, 1.f};
        pg8::gemm_phase<OpMoe2, true>(F.lds, op, 1024);
        if (DUPN(8) == 2) { OpMoe2 op2{(const bf16*)(ws + WS_PROJ), (const bf16*)(ws + WS_W2), kargs()->out, xc, modl, (const int*)(ws + WS_TOK), tab, LAYER, F.G, F.vcu, 0.f}; pg8::gemm_phase<OpMoe2, true>(F.lds, op2, 1024); }
    }
    SEAM(PB + 8);
#undef IN
#undef SEAM
}

constexpr int N_PHASES = 20;
__global__ void __launch_bounds__(512, 2) mk_fwd(Args a_) {
    extern __shared__ __attribute__((aligned(16))) unsigned char lds_raw[];
    Frame F;
    F.lds = (LAS unsigned char*)lds_raw; F.ws = a_.ws; F.ctl = (unsigned*)(a_.ws + WS_CTL);
    F.tid = threadIdx.x; F.lane = F.tid & 63; F.wave = __builtin_amdgcn_readfirstlane(F.tid >> 6);
    F.G = gridDim.x; { const int bx = blockIdx.x; F.vcu = (F.G % 8 == 0) ? (bx % 8) * (F.G / 8) + bx / 8 : bx; }
    F.gw = F.vcu * 8 + F.wave; F.NGW = F.G * 8;
    volatile LAS unsigned* misc = (volatile LAS unsigned*)(F.lds + LDS_MISC);
    if (F.tid < 64) misc[F.tid] = 0u;
    __syncthreads();
    const int lo = a_.ph_lo, hi = a_.ph_hi;
    XcdBarrier bar; bar.bar = F.ctl + CW_BAR; bar.x = 0; bar.st = misc;
    if (hi - lo > 1) bar = xcd_barrier_post(F.ctl + CW_BAR, misc);
    if ((MK_PHASES & 1u) && lo <= 0 && 0 < hi) { p0_all(F, kargs());
        if (hi > 1) xcd_barrier(bar); }
    layer_phases<0>(F, bar, lo, hi);
    layer_phases<1>(F, bar, lo, hi);
    relaunder(F);
    if (((MK_PHASES >> 19) & 1u) && lo <= 19 && 19 < hi) p_final(F, kargs());
}

#ifndef MK_SPLIT
#define MK_SPLIT 0
#endif
extern "C" void kernel_launch(void* const* d_in, const int* in_sizes, int n_in, void* d_out, int out_size, void* d_ws, size_t ws_size, hipStream_t stream) {
    static int grid = 0;
    if (grid == 0) {
        if (n_in != 38 || out_size != NLAT * 1024 || ws_size < WS_END) { fprintf(stderr, "kernel_launch: unexpected shapes (n_in %d out %d ws %zu, need %zu)\n", n_in, out_size, ws_size, (size_t)WS_END); grid = -1; return; }
        int dev = 0, cus = 0, per_cu = 0;
        hipGetDevice(&dev); hipDeviceGetAttribute(&cus, hipDeviceAttributeMultiprocessorCount, dev);
        if (hipFuncSetAttribute((const void*)mk_fwd, hipFuncAttributeMaxDynamicSharedMemorySize, LDS_BYTES) != hipSuccess) { fprintf(stderr, "kernel_launch: hipFuncSetAttribute failed\n"); grid = -1; return; }
        if (hipOccupancyMaxActiveBlocksPerMultiprocessor(&per_cu, (const void*)mk_fwd, 512, LDS_BYTES) != hipSuccess || per_cu < 1) { fprintf(stderr, "kernel_launch: occupancy query says %d\n", per_cu); }
        (void)hipGetLastError();
        grid = cus;
    }
    if (grid < 0) return;
    hipMemsetAsync((char*)d_ws + WS_CTL, 0, CTL_BYTES, stream);
    Args a{};
    for (int i = 0; i < 38; ++i) a.in[i] = (const float*)d_in[i];
    a.out = (float*)d_out; a.ws = (unsigned char*)d_ws;
#if MK_SPLIT
    for (int p = 0; p < N_PHASES; ++p) { a.ph_lo = p; a.ph_hi = p + 1; hipLaunchKernelGGL(mk_fwd, dim3(grid), dim3(512), LDS_BYTES, stream, a); }
#else
    a.ph_lo = 0; a.ph_hi = N_PHASES; hipLaunchKernelGGL(mk_fwd, dim3(grid), dim3(512), LDS_BYTES, stream, a);
#endif
}
```

```cpp
#include <hip/hip_runtime.h>
#include <cstdio>
#include <cstdint>
#include <cmath>

#define LAS __attribute__((address_space(3)))
#define GAS __attribute__((address_space(1)))
typedef unsigned short bf16;
typedef short bf16x8 __attribute__((ext_vector_type(8)));
typedef short bf16x4 __attribute__((ext_vector_type(4)));
typedef float f32x4 __attribute__((ext_vector_type(4)));
typedef float f32x2 __attribute__((ext_vector_type(2)));
typedef float f32x16 __attribute__((ext_vector_type(16)));
typedef unsigned u32x4 __attribute__((ext_vector_type(4)));
typedef unsigned u32x2 __attribute__((ext_vector_type(2)));

constexpr int NB = 8, SEQ = 4096, CTXL = 256, DM = 1024, DEPTH = 2;
constexpr int NLAT = NB * SEQ, NCTX = NB * CTXL, NTOK = NLAT + NCTX;
constexpr int IN_COLS = 2144, NIN_PAD = 2304;
constexpr int HY_OFF = 0, GM_OFF = 768, CV_OFF = 1280, MQ_OFF = 1792, MKV_OFF = 1984;
constexpr int PROJ_LD = 1536;
constexpr int PJ_GM = 0, PJ_CV = 512, PJ_MKV = 1024, PJ_MQ = 1184;
constexpr int NKEY = SEQ + CTXL;
constexpr int NEXP = 16, DEXP = 512, NBUCKET = 24;
constexpr int A_ROWS = 41216;
constexpr float EPS = 1e-6f;
constexpr int GC = 4128, GLEN = 8256;
constexpr float QSCALE = 0.10206207261596577f * 1.4426950408889634f;

constexpr size_t al256(size_t x) { return (x + 255) & ~(size_t)255; }
constexpr size_t WS_CTL = 0, CTL_BYTES = 1u << 20;
constexpr size_t WS_MOD = WS_CTL + CTL_BYTES;
constexpr size_t WS_ROPE = al256(WS_MOD + (size_t)2 * 9 * 6144 * 4);
constexpr size_t WS_WIN = al256(WS_ROPE + (size_t)2 * 4096 * 16 * 4);
constexpr size_t WS_WOUT = al256(WS_WIN + (size_t)2 * NIN_PAD * 1024 * 2);
constexpr size_t WS_W1 = al256(WS_WOUT + (size_t)2 * 1024 * 1024 * 2);
constexpr size_t WS_W2 = al256(WS_W1 + (size_t)2 * 16 * 1024 * 1024 * 2);
constexpr size_t WS_WUQ = al256(WS_W2 + (size_t)2 * 16 * 1024 * 512 * 2);
constexpr size_t WS_WUKV = al256(WS_WUQ + (size_t)2 * 384 * 192 * 2);
constexpr size_t WS_GMWS = al256(WS_WUKV + (size_t)2 * 512 * 128 * 2);
constexpr size_t WS_G = al256(WS_GMWS + (size_t)2 * 4 * 128 * 128 * 2);
constexpr size_t WS_TC = al256(WS_G + (size_t)2 * 2 * 256 * GLEN * 2);
constexpr size_t WS_H = al256(WS_TC + (size_t)2 * 256 * 512 * 4);
constexpr size_t WS_PROJ = al256(WS_H + (size_t)NTOK * 1024 * 2);
constexpr size_t WS_HYT = al256(WS_PROJ + (size_t)NTOK * PROJ_LD * 2);
constexpr size_t WS_Q = al256(WS_HYT + (size_t)768 * NTOK * 2);
constexpr size_t WS_K = al256(WS_Q + (size_t)NTOK * 384 * 2);
constexpr size_t WS_VT = al256(WS_K + (size_t)NB * 4 * NKEY * 96 * 2);
constexpr size_t WS_XC = al256(WS_VT + (size_t)NB * 4 * 64 * NKEY * 2);
constexpr size_t WS_TOK = al256(WS_XC + (size_t)NCTX * 1024 * 4);
constexpr size_t WS_WLO = al256(WS_TOK + (size_t)NBUCKET * NTOK * 4);
constexpr size_t WS_WHI = al256(WS_WLO + (size_t)NBUCKET * NTOK * 4);
constexpr size_t WS_YT = al256(WS_WHI + (size_t)NBUCKET * NTOK * 4);
constexpr size_t WS_YAT = al256(WS_YT + (size_t)256 * NTOK * 2);
constexpr size_t WS_FS = al256(WS_YAT + (size_t)NTOK * 256 * 2);
constexpr size_t WS_END = al256(WS_FS + (size_t)3 * 128 * 1024 * 4);
static_assert((size_t)A_ROWS * 1024 * 2 <= (size_t)NTOK * PROJ_LD * 2, "a overlays proj");
static_assert(WS_END <= (size_t)512 * 1024 * 1024, "workspace");
constexpr int CW_BAR = 1024;
constexpr int CW_CNT = 8192;
constexpr int CW_P0Q = 8192 + 128;

constexpr int LDS_BYTES = 160 * 1024;
constexpr int LDS_MISC = 131072 + 28672;

__device__ __forceinline__ float bf2f(bf16 v) { return __builtin_bit_cast(float, (unsigned)v << 16); }
__device__ __forceinline__ unsigned f2bf(float f) { unsigned u = __builtin_bit_cast(unsigned, f); return (u + 0x7fffu + ((u >> 16) & 1u)) >> 16; }
__device__ __forceinline__ unsigned pk2(float lo, float hi) { return f2bf(lo) | (f2bf(hi) << 16); }
__device__ __forceinline__ float lo_bf(unsigned w) { return __builtin_bit_cast(float, w << 16); }
__device__ __forceinline__ float hi_bf(unsigned w) { return __builtin_bit_cast(float, w & 0xffff0000u); }
__device__ __forceinline__ float wave_sum(float v) {
#pragma unroll
    for (int o = 1; o < 64; o <<= 1) v += __shfl_xor(v, o);
    return v;
}
__device__ __forceinline__ float siluf(float x) { return x / (1.f + __expf(-x)); }
__device__ __forceinline__ float sigmf(float x) { return 1.f / (1.f + __expf(-x)); }
__device__ __forceinline__ float gelu_tanh(float x) { const float u = 0.7978845608028654f * (x + 0.044715f * x * x * x); const float e = __expf(2.f * u); return x * (1.f - 1.f / (e + 1.f)); }
__device__ __forceinline__ int mod_idx(int r) { return r < NLAT ? (r >> 12) : 8; }

#define XB_TMO      128
#define XB_XCNT(j)  (256  + 64 * (j))
#define XB_XSUB(j)  (1280 + 64 * (j))
#define XB_XGEN(j)  (2304 + 64 * (j))
#define XB_TOP      3328
#define XB_TOPGEN   3392
#define XCD_BAR_WORDS 3456
#define XB_SPIN_CAP (1u << 22)
__device__ __forceinline__ unsigned xb_ld(unsigned* p)              { return __hip_atomic_load(p, __ATOMIC_RELAXED, __HIP_MEMORY_SCOPE_AGENT); }
__device__ __forceinline__ unsigned xb_add(unsigned* p, unsigned v) { return __hip_atomic_fetch_add(p, v, __ATOMIC_RELAXED, __HIP_MEMORY_SCOPE_AGENT); }
__device__ __forceinline__ unsigned xb_xcc_id() { return (unsigned)__builtin_amdgcn_s_getreg((3 << 11) | 20) & 0xFu; }
#define XB_SPIN(cond, bar) do { unsigned _sp = 0; while (cond) { __builtin_amdgcn_s_sleep(1); \
    if ((++_sp & 255u) == 0u) { if (xb_ld(&(bar)[XB_TMO])) break; if (_sp > XB_SPIN_CAP) { atomicAdd(&(bar)[XB_TMO], 1u); break; } } } } while (0)
struct XcdBarrier { unsigned* bar; unsigned x; volatile LAS unsigned* st; };
__device__ __forceinline__ XcdBarrier xcd_barrier_post(unsigned* bar, volatile LAS unsigned* st) {
    XcdBarrier b; b.bar = bar; b.x = xb_xcc_id(); b.st = st;
    if (threadIdx.x == 0) (void)xb_add(&bar[XB_XCNT(b.x)], 1u);
    return b;
}
__device__ __forceinline__ void xcd_barrier_complete(unsigned* bar, unsigned x, unsigned& nloc, unsigned& nx) {
    const unsigned G = gridDim.x * gridDim.y * gridDim.z;
    unsigned sum, cnt, mine, sp = 0u;
    for (;;) {
        sum = 0u; cnt = 0u; mine = 0u;
#pragma unroll
        for (unsigned j = 0; j < 16; ++j) { const unsigned c = xb_ld(&bar[XB_XCNT(j)]); sum += c; cnt += (c > 0u) ? 1u : 0u; mine = (j == x) ? c : mine; }
        if (sum == G) break;
        __builtin_amdgcn_s_sleep(1);
        if ((++sp & 255u) == 0u) { if (xb_ld(&bar[XB_TMO])) break; if (sp > XB_SPIN_CAP) { atomicAdd(&bar[XB_TMO], 1u); break; } }
    }
    nloc = mine > 0u ? mine : 1u; nx = cnt > 0u ? cnt : 1u;
}
__device__ __forceinline__ void xcd_barrier(const XcdBarrier& b) {
    asm volatile("s_waitcnt vmcnt(0)" ::: "memory");
    __syncthreads();
    if (threadIdx.x == 0) {
        unsigned* bar = b.bar;
        __builtin_amdgcn_s_waitcnt(0);
        unsigned nloc = b.st[0], nx = b.st[1];
        if (nloc == 0u) { xcd_barrier_complete(bar, b.x, nloc, nx); b.st[0] = nloc; b.st[1] = nx; }
        const unsigned old = xb_add(&bar[XB_XSUB(b.x)], 1u);
        const unsigned gen = old / nloc;
        if (old + 1u == (gen + 1u) * nloc) {
            __builtin_amdgcn_fence(__ATOMIC_RELEASE, "agent");
            asm volatile("s_waitcnt vmcnt(0)" ::: "memory");
            const unsigned og = xb_add(&bar[XB_TOP], 1u);
            const unsigned tg = og / nx;
            if (og + 1u == (tg + 1u) * nx) xb_add(&bar[XB_TOPGEN], 1u);
            else XB_SPIN(xb_ld(&bar[XB_TOPGEN]) == tg, bar);
            __builtin_amdgcn_fence(__ATOMIC_ACQUIRE, "agent");
            xb_add(&bar[XB_XGEN(b.x)], 1u);
            asm volatile("s_waitcnt vmcnt(0)" ::: "memory");
        } else {
            XB_SPIN(xb_ld(&bar[XB_XGEN(b.x)]) == gen, bar);
            __builtin_amdgcn_fence(__ATOMIC_ACQUIRE, "agent");
            asm volatile("s_waitcnt vmcnt(0)" ::: "memory");
        }
    }
    __syncthreads();
}

struct Args {
    const float* in[38]; float* out; unsigned char* ws; int ph_lo, ph_hi;
};
typedef const __attribute__((address_space(4))) Args* KArgs;
__device__ __forceinline__ KArgs kargs() { KArgs p = (KArgs)__builtin_amdgcn_kernarg_segment_ptr(); asm volatile("" : "+s"(p)); return p; }
struct Frame {
    LAS unsigned char* lds; unsigned char* ws; unsigned* ctl;
    int tid, lane, wave, G, vcu, gw, NGW;
};
__device__ __forceinline__ void relaunder(Frame& F) {
    int t = threadIdx.x; asm volatile("" : "+v"(t));
    F.tid = t; F.lane = t & 63; F.wave = __builtin_amdgcn_readfirstlane(t >> 6); F.gw = F.vcu * 8 + F.wave;
}
enum { I_X = 0, I_C, I_CTX, I_CCTX, I_ADAW, I_ADAB, I_N1G, I_N2G, I_WIN, I_HSW, I_HSB, I_HFW1, I_HFB1, I_HFFREQ, I_HFW2, I_HFB2, I_HFW3, I_HBIAS,
       I_GMLNG, I_GMLNB, I_GMWS, I_GMBS, I_CVW, I_CVB, I_CVLNG, I_CVLNB, I_QANORM, I_WUQ, I_KVANORM, I_WUKV, I_MIXG, I_WOUT, I_WROUTER, I_RBIAS,
       I_EWG, I_EWU, I_EWD, I_FNG };

namespace pg8 {
constexpr int BM = 256, BK = 64, HALF = 128, HTB = HALF * BK * 2, STAGE_BYTES = 8 * HTB;
__host__ __device__ __forceinline__ int lds_byte(int r, int c) { const int st = (r >> 4) * 2 + (c >> 5), rr = r & 15, cc = c & 31, ob = rr * 64 + cc * 2; return st * 1024 + (ob ^ (((ob >> 9) & 1) << 5)); }
__host__ __device__ __forceinline__ void stage_rc(int b, int& R, int& C) { const int st = b / 1024, sb = b % 1024, swz = sb ^ (((sb >> 9) & 1) << 5); R = (st >> 1) * 16 + swz / 64; C = (st & 1) * 32 + (swz % 64) / 2; }
__host__ __device__ __forceinline__ int perm32(int rho) { const int n = rho >> 4, i = rho & 15; return 8 * (i >> 2) + 4 * n + (i & 3); }
struct Unit { int pm, pn, k, aux; };
__device__ __forceinline__ unsigned cvt_pk_bf16(float lo, float hi) { unsigned r; asm volatile("v_cvt_pk_bf16_f32 %0, %1, %2" : "=v"(r) : "v"(lo), "v"(hi)); return r; }

template <class Op, bool ALIGN_EPI>
__device__ __forceinline__ void gemm_phase(LAS unsigned char* lds, const Op& op, const int K) {
    const int tid = threadIdx.x, wid = __builtin_amdgcn_readfirstlane(tid >> 6), lane = tid & 63, wr = wid >> 2, wc = wid & 3, fr = lane & 15, fq = lane >> 4;
    const int nt = K / BK;
    int Rs[2], Cs[2]; unsigned voffB[2];
#pragma unroll
    for (int i = 0; i < 2; ++i) { stage_rc(tid * 16 + i * 8192, Rs[i], Cs[i]); const int Rb = (Rs[i] & ~31) + perm32(Rs[i] & 31); voffB[i] = (unsigned)(Rb * op.ldb() + Cs[i]) * 2u; }
    const unsigned hstepB = (unsigned)HALF * op.ldb() * 2u;
    const unsigned ldsw = (unsigned)wid * 1024u;
    const int aoff = lds_byte(wr * 64 + fr, fq * 8), boff = lds_byte(wc * 32 + fr, fq * 8);
    const char* const Ab = (const char*)op.A();
#define PG8_SA(b, h) (((b) * 2 + (h)) * HTB)
#define PG8_SB(b, h) ((4 + (b) * 2 + (h)) * HTB)
#define PG8_STAGE_A(bufoff, offs, h, kb) do { _Pragma("unroll") for (int _i = 0; _i < 2; ++_i) \
        __builtin_amdgcn_global_load_lds((const unsigned*)(Ab + (size_t)(offs)[h][_i] + (kb)), (LAS unsigned*)(lds + (bufoff) + ldsw + _i * 8192), 16, 0, 0); } while (0)
#define PG8_STAGE_B(bufoff, gbase) do { _Pragma("unroll") for (int _i = 0; _i < 2; ++_i) \
        __builtin_amdgcn_global_load_lds((const unsigned*)((const char*)(gbase) + voffB[_i]), (LAS unsigned*)(lds + (bufoff) + ldsw + _i * 8192), 16, 0, 0); } while (0)
#define PG8_LDA(dst, b, h) do { _Pragma("unroll") for (int m = 0; m < 4; ++m) _Pragma("unroll") for (int k = 0; k < 2; ++k) dst[m][k] = *(const LAS bf16x8*)(lds + PG8_SA(b, h) + aoff + m * 2048 + k * 1024); } while (0)
#define PG8_LDB(dst, b, h) do { _Pragma("unroll") for (int n = 0; n < 2; ++n) _Pragma("unroll") for (int k = 0; k < 2; ++k) dst[n][k] = *(const LAS bf16x8*)(lds + PG8_SB(b, h) + boff + n * 2048 + k * 1024); } while (0)
#define PG8_MMA(ai, bj, At, Bt) do { __builtin_amdgcn_s_setprio(1); _Pragma("unroll") for (int m = 0; m < 4; ++m) _Pragma("unroll") for (int n = 0; n < 2; ++n) _Pragma("unroll") for (int k = 0; k < 2; ++k) \
        acc[ai][bj][m][n] = __builtin_amdgcn_mfma_f32_16x16x32_bf16(Bt[n][k], At[m][k], acc[ai][bj][m][n], 0, 0, 0); __builtin_amdgcn_s_setprio(0); } while (0)
#define PG8_WAIT_V(n) asm volatile("s_waitcnt vmcnt(" #n ")" ::: "memory")
#define PG8_WAIT_L(n) asm volatile("s_waitcnt lgkmcnt(" #n ")" ::: "memory")
#define PG8_BAR __builtin_amdgcn_s_barrier()
#define PG8_SCHED __builtin_amdgcn_sched_barrier(0)
    Unit cur, nxt; int ui = 0;
    if (!op.next(0, cur)) return;
    f32x4 acc[2][2][4][2];
#pragma unroll
    for (int a = 0; a < 2; ++a)
#pragma unroll
        for (int b = 0; b < 2; ++b)
#pragma unroll
            for (int m = 0; m < 4; ++m)
#pragma unroll
                for (int n = 0; n < 2; ++n) acc[a][b][m][n] = (f32x4){0.f, 0.f, 0.f, 0.f};
    bf16x8 At[4][2], B0[2][2], B1[2][2];
    constexpr int NAO = Op::GATHER ? 2 : 1;
    unsigned caoff[2][2], naoff[NAO][2];
    size_t cbase = 0, nbase = 0;
#pragma unroll
    for (int h = 0; h < 2; ++h)
#pragma unroll
        for (int i = 0; i < 2; ++i) { if constexpr (Op::GATHER) caoff[h][i] = op.arow(cur, h * HALF + Rs[i]) + (unsigned)Cs[i] * 2u; else caoff[h][i] = (unsigned)(h * HALF + Rs[i]) * 2048u + (unsigned)Cs[i] * 2u; }
    if constexpr (!Op::GATHER) cbase = op.abase(cur);
    {
        const char* b0 = op.bptr(cur, 0); const char* b1 = op.bptr(cur, 1);
        PG8_STAGE_B(PG8_SB(0, 0), b0); PG8_STAGE_B(PG8_SB(0, 1), b0 + hstepB); PG8_STAGE_A(PG8_SA(0, 0), caoff, 0, cbase); PG8_STAGE_A(PG8_SA(0, 1), caoff, 1, cbase);
        if (wr == 1) PG8_BAR;
        PG8_WAIT_V(2); PG8_BAR;
        PG8_STAGE_B(PG8_SB(1, 0), b1); PG8_STAGE_A(PG8_SA(1, 0), caoff, 0, cbase + 128); PG8_STAGE_B(PG8_SB(1, 1), b1 + hstepB);
        PG8_WAIT_V(6); PG8_BAR;
    }
    for (;;) {
        const bool has_next = op.next(ui + 1, nxt);
        if (!has_next) nxt = cur;
        if constexpr (Op::GATHER) {
#pragma unroll
            for (int h = 0; h < 2; ++h)
#pragma unroll
                for (int i = 0; i < 2; ++i) naoff[h][i] = has_next ? op.arow(nxt, h * HALF + Rs[i]) + (unsigned)Cs[i] * 2u : caoff[h][i];
        } else nbase = op.abase(nxt);
        for (int t = 0; t < nt; t += 2) {
            const bool last = (t == nt - 2);
            const size_t ka1 = cbase + (size_t)(t + 1) * 128u;
            const size_t ka2 = last ? nbase : cbase + (size_t)(t + 2) * 128u, ka3 = ka2 + 128u;
            unsigned a2off[2][2];
#pragma unroll
            for (int h = 0; h < 2; ++h)
#pragma unroll
                for (int i = 0; i < 2; ++i) { if constexpr (Op::GATHER) a2off[h][i] = last ? naoff[h][i] : caoff[h][i]; else a2off[h][i] = caoff[h][i]; }
            const char* b2 = last ? op.bptr(nxt, 0) : op.bptr(cur, t + 2);
            const char* b3 = last ? op.bptr(nxt, 1) : op.bptr(cur, t + 3);
            PG8_LDB(B0, 0, 0); PG8_LDB(B1, 0, 1); PG8_SCHED; PG8_LDA(At, 0, 0); PG8_STAGE_A(PG8_SA(1, 1), caoff, 1, ka1);
            PG8_WAIT_V(8); PG8_WAIT_L(0); PG8_BAR; PG8_MMA(0, 0, At, B0); PG8_MMA(0, 1, At, B1); PG8_BAR; PG8_SCHED;
            PG8_LDA(At, 0, 1); PG8_STAGE_B(PG8_SB(0, 0), b2); PG8_STAGE_B(PG8_SB(0, 1), b2 + hstepB); PG8_STAGE_A(PG8_SA(0, 0), a2off, 0, ka2);
            PG8_WAIT_V(8); PG8_WAIT_L(0); PG8_BAR; PG8_MMA(1, 0, At, B0); PG8_MMA(1, 1, At, B1); PG8_BAR; PG8_SCHED;
            PG8_LDB(B0, 1, 0); PG8_LDB(B1, 1, 1); PG8_SCHED; PG8_LDA(At, 1, 0); PG8_STAGE_A(PG8_SA(0, 1), a2off, 1, ka2);
            PG8_WAIT_V(8); PG8_WAIT_L(0); PG8_BAR; PG8_MMA(0, 0, At, B0); PG8_MMA(0, 1, At, B1); PG8_BAR; PG8_SCHED;
            PG8_LDA(At, 1, 1); PG8_STAGE_B(PG8_SB(1, 0), b3); PG8_STAGE_B(PG8_SB(1, 1), b3 + hstepB); PG8_STAGE_A(PG8_SA(1, 0), a2off, 0, ka3);
            PG8_WAIT_V(8); PG8_WAIT_L(0); PG8_BAR; PG8_MMA(1, 0, At, B0); PG8_MMA(1, 1, At, B1); PG8_BAR; PG8_SCHED;
        }
        if constexpr (ALIGN_EPI) { if (wr == 0) PG8_BAR; }
        op.epi(acc, cur, wr, wc, fr, fq);
        if (!has_next) break;
#pragma unroll
        for (int a = 0; a < 2; ++a)
#pragma unroll
            for (int b = 0; b < 2; ++b)
#pragma unroll
                for (int m = 0; m < 4; ++m)
#pragma unroll
                    for (int n = 0; n < 2; ++n) acc[a][b][m][n] = (f32x4){0.f, 0.f, 0.f, 0.f};
        cur = nxt; ++ui;
        if constexpr (Op::GATHER) {
#pragma unroll
            for (int h = 0; h < 2; ++h)
#pragma unroll
                for (int i = 0; i < 2; ++i) caoff[h][i] = naoff[h][i];
        } else cbase = nbase;
        if constexpr (ALIGN_EPI) { if (wr == 1) PG8_BAR; }
    }
    PG8_WAIT_V(0);
    if constexpr (!ALIGN_EPI) { if (wr == 0) PG8_BAR; }
    PG8_BAR;
#undef PG8_SA
#undef PG8_SB
#undef PG8_STAGE_A
#undef PG8_STAGE_B
#undef PG8_LDA
#undef PG8_LDB
#undef PG8_MMA
#undef PG8_WAIT_V
#undef PG8_WAIT_L
#undef PG8_BAR
#undef PG8_SCHED
}
}
struct OpIn {
    const bf16* A_; const bf16* Bt; bf16* proj; bf16* hyT; int layer, G, vcu;
    __device__ __forceinline__ const bf16* A() const { return A_; }
    __device__ __forceinline__ int ldb() const { return 1024; }
    __device__ __forceinline__ bool next(int i, pg8::Unit& u) const {
        const int L = i * G + vcu; const int nlat = 128 * 9, total = layer == 0 ? 136 * 9 : nlat + 8;
        if (L >= total) return false;
        if (layer == 0 || L < nlat) { u.pm = L / 9; u.pn = L % 9; } else { u.pm = 128 + (L - nlat); u.pn = 7; }
        u.k = 0; u.aux = 0; return true;
    }
    static constexpr bool GATHER = false;
    __device__ __forceinline__ size_t abase(const pg8::Unit& u) const { return (size_t)u.pm * 256 * 2048; }
    __device__ __forceinline__ const char* bptr(const pg8::Unit& u, int t) const { return (const char*)Bt + (size_t)u.pn * 256 * 2048 + (size_t)t * 128; }
    __device__ __forceinline__ void epi(const f32x4 (&acc)[2][2][4][2], const pg8::Unit& u, int wr, int wc, int fr, int fq) const {
        const int row0 = u.pm * 256 + wr * 64 + fr, lc0 = wc * 32 + 8 * fq;
        if (u.pn >= 3) {
            bf16* base = proj + (size_t)row0 * PROJ_LD + (u.pn - 3) * 256 + lc0;
#pragma unroll
            for (int ai = 0; ai < 2; ++ai)
#pragma unroll
                for (int m = 0; m < 4; ++m) { bf16* rowp = base + (size_t)(ai * 128 + m * 16) * PROJ_LD;
#pragma unroll
                    for (int bj = 0; bj < 2; ++bj) { const f32x4 v0 = acc[ai][bj][m][0], v1 = acc[ai][bj][m][1]; u32x4 w;
                        w.x = pg8::cvt_pk_bf16(v0[0], v0[1]); w.y = pg8::cvt_pk_bf16(v0[2], v0[3]); w.z = pg8::cvt_pk_bf16(v1[0], v1[1]); w.w = pg8::cvt_pk_bf16(v1[2], v1[3]);
                        *(u32x4*)(rowp + bj * 128) = w; } }
        } else {
            bf16* base = hyT + (size_t)(u.pn * 256 + lc0) * NTOK + row0;
#pragma unroll
            for (int ai = 0; ai < 2; ++ai)
#pragma unroll
                for (int m = 0; m < 4; ++m)
#pragma unroll
                    for (int bj = 0; bj < 2; ++bj)
#pragma unroll
                        for (int n = 0; n < 2; ++n)
#pragma unroll
                            for (int j = 0; j < 4; ++j)
                                base[(size_t)(bj * 128 + 4 * n + j) * NTOK + ai * 128 + m * 16] = (bf16)f2bf(acc[ai][bj][m][n][j]);
        }
    }
};

struct OpOut {
    const bf16* A_; const bf16* Bt; const float* xin_lat; const float* xin_ctx; float* xo_lat; float* xo_ctx; const float* mod; int layer, G, vcu; float scale;
    __device__ __forceinline__ const bf16* A() const { return A_; }
    __device__ __forceinline__ int ldb() const { return 1024; }
    __device__ __forceinline__ bool next(int i, pg8::Unit& u) const {
        const int L = i * G + vcu; const int total = (layer == 0 ? 136 : 128) * 4;
        if (L >= total) return false;
        u.pm = L >> 2; u.pn = L & 3; u.k = 0; u.aux = 0; return true;
    }
    static constexpr bool GATHER = false;
    __device__ __forceinline__ size_t abase(const pg8::Unit& u) const { return (size_t)u.pm * 256 * 2048; }
    __device__ __forceinline__ const char* bptr(const pg8::Unit& u, int t) const { return (const char*)Bt + (size_t)u.pn * 256 * 2048 + (size_t)t * 128; }
    __device__ __forceinline__ void epi(const f32x4 (&acc)[2][2][4][2], const pg8::Unit& u, int wr, int wc, int fr, int fq) const {
        const int grow0 = u.pm * 256; const bool isl = grow0 < NLAT;
        const float* xi = isl ? xin_lat + (size_t)grow0 * 1024 : xin_ctx + (size_t)(grow0 - NLAT) * 1024;
        float* xo = isl ? xo_lat + (size_t)grow0 * 1024 : xo_ctx + (size_t)(grow0 - NLAT) * 1024;
        const float* g1 = mod + (size_t)mod_idx(grow0) * 6144 + 2 * 1024;
        const int lr0 = wr * 64 + fr, c0 = u.pn * 256 + wc * 32 + 8 * fq;
#pragma unroll
        for (int bj = 0; bj < 2; ++bj)
#pragma unroll
            for (int n = 0; n < 2; ++n) { const int col = c0 + bj * 128 + 4 * n; const f32x4 gv = *(const f32x4*)(g1 + col) * scale;
#pragma unroll
                for (int ai = 0; ai < 2; ++ai)
#pragma unroll
                    for (int m = 0; m < 4; ++m) { const size_t o = (size_t)(lr0 + ai * 128 + m * 16) * 1024 + col;
                        const f32x4 xv = *(const f32x4*)(xi + o); *(f32x4*)(xo + o) = xv + gv * acc[ai][bj][m][n]; } }
    }
};

struct MoeTab { const LAS int* t; };
__device__ __forceinline__ void moe_decode(const LAS int* tab, int mi, int& k, int& j) {
    int kk = 0;
#pragma unroll 1
    for (int q = 1; q < NBUCKET; ++q) if (tab[q] <= mi) kk = q;
    k = kk; j = mi - tab[kk];
}
__device__ __forceinline__ void pair_of(int k, int& elo, int& ehi) {
    const int g = k / 6, p = k - g * 6;
    const int lo = p < 3 ? 0 : (p < 5 ? 1 : 2), hi = p < 3 ? p + 1 : (p < 5 ? p - 1 : 3);
    elo = g * 4 + lo; ehi = g * 4 + hi;
}
struct OpMoe1 {
    const bf16* A_; const bf16* W1; bf16* abuf; const int* TOK; const float* WLO; const float* WHI; const LAS int* tab; int layer, G, vcu;
    __device__ __forceinline__ const bf16* A() const { return A_; }
    __device__ __forceinline__ int ldb() const { return 1024; }
    __device__ __forceinline__ bool next(int i, pg8::Unit& u) const {
        const int L = i * G + vcu; const int MT = tab[NBUCKET];
        if (L >= MT * 8) return false;
        u.pm = L >> 3; u.pn = L & 7; moe_decode(tab, u.pm, u.k, u.aux); return true;
    }
    static constexpr bool GATHER = true;
    __device__ __forceinline__ size_t abase(const pg8::Unit&) const { return 0; }
    __device__ __forceinline__ unsigned arow(const pg8::Unit& u, int lr) const {
        const int cnt = tab[32 + u.k]; int p = u.aux * 256 + lr; p = p < cnt ? p : cnt - 1;
        return (unsigned)TOK[(size_t)u.k * NTOK + p] * 2048u;
    }
    __device__ __forceinline__ const char* bptr(const pg8::Unit& u, int t) const {
        int elo, ehi; pair_of(u.k, elo, ehi); const int e = u.pn < 4 ? elo : ehi;
        return (const char*)W1 + ((size_t)(layer * 16 + e) * 1024 + (u.pn & 3) * 256) * 2048 + (size_t)t * 128;
    }
    __device__ __forceinline__ void epi(const f32x4 (&acc)[2][2][4][2], const pg8::Unit& u, int wr, int wc, int fr, int fq) const {
        const int cnt = tab[32 + u.k]; const float* WW = (u.pn < 4 ? WLO : WHI) + (size_t)u.k * NTOK;
        const int lr0 = wr * 64 + fr, c0 = (u.pn >= 4 ? 512 : 0) + (u.pn & 3) * 128 + wc * 32 + 8 * fq;
#pragma unroll
        for (int ai = 0; ai < 2; ++ai)
#pragma unroll
            for (int m = 0; m < 4; ++m) { const int lr = lr0 + ai * 128 + m * 16; int p = u.aux * 256 + lr; p = p < cnt ? p : cnt - 1; const float w = WW[p];
                const f32x4 g0 = acc[ai][0][m][0], g1 = acc[ai][0][m][1], u0 = acc[ai][1][m][0], u1 = acc[ai][1][m][1]; float o[8];
#pragma unroll
                for (int j = 0; j < 4; ++j) { o[j] = siluf(g0[j]) * u0[j] * w; o[4 + j] = siluf(g1[j]) * u1[j] * w; }
                u32x4 ww; ww.x = pg8::cvt_pk_bf16(o[0], o[1]); ww.y = pg8::cvt_pk_bf16(o[2], o[3]); ww.z = pg8::cvt_pk_bf16(o[4], o[5]); ww.w = pg8::cvt_pk_bf16(o[6], o[7]);
                *(u32x4*)(abuf + (size_t)(u.pm * 256 + lr) * 1024 + c0) = ww; }
    }
};
struct OpMoe2 {
    const bf16* A_; const bf16* W2; float* x_lat; float* x_ctx; const float* mod; const int* TOK; const LAS int* tab; int layer, G, vcu; float scale;
    __device__ __forceinline__ const bf16* A() const { return A_; }
    __device__ __forceinline__ int ldb() const { return 512; }
    __device__ __forceinline__ bool next(int i, pg8::Unit& u) const {
        const int L = i * G + vcu; const int MT = tab[NBUCKET];
        if (L >= MT * 4) return false;
        u.pm = L >> 2; u.pn = L & 3; moe_decode(tab, u.pm, u.k, u.aux); return true;
    }
    static constexpr bool GATHER = false;
    __device__ __forceinline__ size_t abase(const pg8::Unit& u) const { return (size_t)u.pm * 256 * 2048; }
    __device__ __forceinline__ const char* bptr(const pg8::Unit& u, int t) const {
        int elo, ehi; pair_of(u.k, elo, ehi); const int e = t < 8 ? elo : ehi;
        return (const char*)W2 + ((size_t)(layer * 16 + e) * 1024 + u.pn * 256) * 1024 + (size_t)(t & 7) * 128;
    }
    __device__ __forceinline__ void epi(const f32x4 (&acc)[2][2][4][2], const pg8::Unit& u, int wr, int wc, int fr, int fq) const {
        const int cnt = tab[32 + u.k]; const int lr0 = wr * 64 + fr, c0 = u.pn * 256 + wc * 32 + 8 * fq;
#pragma unroll
        for (int ai = 0; ai < 2; ++ai)
#pragma unroll
            for (int m = 0; m < 4; ++m) { const int p = u.aux * 256 + lr0 + ai * 128 + m * 16;
                if (p < cnt) { const int tok = TOK[(size_t)u.k * NTOK + p];
                    float* xr = tok < NLAT ? x_lat + (size_t)tok * 1024 : x_ctx + (size_t)(tok - NLAT) * 1024; const float* g2 = mod + (size_t)mod_idx(tok) * 6144 + 5 * 1024;
#pragma unroll
                    for (int bj = 0; bj < 2; ++bj)
#pragma unroll
                        for (int n = 0; n < 2; ++n) { const int col = c0 + bj * 128 + 4 * n; const f32x4 gv = *(const f32x4*)(g2 + col) * scale; const f32x4 xv = *(const f32x4*)(xr + col);
                            *(f32x4*)(xr + col) = xv + gv * acc[ai][bj][m][n]; } } }
    }
};
__device__ __forceinline__ void transpose_item(const float* W, int N, int k0, int n0, bf16* WT, int ldk, int dst_row0, LAS float* scr, int lane) {
float tv[32];
#pragma unroll
    for (int i = 0; i < 32; ++i) { const int kk = 2 * i + (lane >> 5); tv[i] = W[(size_t)(k0 + kk) * N + n0 + (lane & 31)]; }
#pragma unroll
    for (int i = 0; i < 32; ++i) { const int kk = 2 * i + (lane >> 5); scr[kk * 33 + (lane & 31)] = tv[i]; }
    asm volatile("s_waitcnt lgkmcnt(0)" ::: "memory");
    const int c = lane & 7;
#pragma unroll
    for (int j = 0; j < 4; ++j) { const int n = (lane >> 3) + 8 * j; const LAS float* s = scr + (8 * c) * 33 + n;
        u32x4 o; o.x = pk2(s[0 * 33], s[1 * 33]); o.y = pk2(s[2 * 33], s[3 * 33]); o.z = pk2(s[4 * 33], s[5 * 33]); o.w = pk2(s[6 * 33], s[7 * 33]);
        *(u32x4*)(WT + (size_t)(dst_row0 + n) * ldk + k0 + 8 * c) = o; }
    asm volatile("s_waitcnt lgkmcnt(0)" ::: "memory");
}
__device__ __forceinline__ int win_dst(int n0) { return n0 < 1792 ? n0 : (n0 < 1984 ? 1952 + (n0 - 1792) : 1792 + (n0 - 1984)); }

constexpr int N_WIN = 2 * 16 * 67, N_WOUT = 2 * 16 * 32, N_G = 2 * 16 * 16 * 16, N_U = N_G, N_D = 2 * 16 * 8 * 32, N_UQ = 2 * 3 * 12, N_UKV = 2 * 2 * 16;
constexpr int NIT_W = N_WIN + N_WOUT + N_G + N_U + N_D + N_UQ + N_UKV;
struct MiniF { LAS unsigned char* lds; unsigned char* ws; int tid, lane, wave; };
__device__ __forceinline__ MiniF minif(LAS unsigned char* lds, unsigned char* ws) { MiniF F; F.lds = lds; F.ws = ws; F.tid = threadIdx.x; F.lane = F.tid & 63; F.wave = __builtin_amdgcn_readfirstlane(F.tid >> 6); return F; }
__device__ __attribute__((noinline)) void p0_weight_item(LAS unsigned char* lds_, unsigned char* ws_, KArgs a, int it) {
    const MiniF F = minif(lds_, ws_);
    LAS float* scr = (LAS float*)(F.lds + F.wave * 16384);
    unsigned char* ws = F.ws;
    int r = it;
    if (r < N_WIN) { const int l = r / (16 * 67), q = r % (16 * 67), kb = q / 67, nb = q % 67;
        transpose_item(a->in[I_WIN] + (size_t)l * 1024 * IN_COLS, IN_COLS, kb * 64, nb * 32, (bf16*)(ws + WS_WIN) + (size_t)l * NIN_PAD * 1024, 1024, win_dst(nb * 32), scr, F.lane); return; } r -= N_WIN;
    if (r < N_WOUT) { const int l = r / 512, q = r % 512, kb = q / 32, nb = q % 32;
        transpose_item(a->in[I_WOUT] + (size_t)l * 1024 * 1024, 1024, kb * 64, nb * 32, (bf16*)(ws + WS_WOUT) + (size_t)l * 1024 * 1024, 1024, nb * 32, scr, F.lane); return; } r -= N_WOUT;
    if (r < N_G + N_U) { const bool up = r >= N_G; if (up) r -= N_G; const int le = r / 256, q = r % 256, kb = q / 16, nb = q % 16; const int f0 = nb * 32;
        transpose_item(a->in[up ? I_EWU : I_EWG] + (size_t)le * 1024 * 512, 512, kb * 64, f0, (bf16*)(ws + WS_W1) + (size_t)le * 1024 * 1024, 1024, (f0 >> 7) * 256 + (up ? 128 : 0) + (f0 & 127), scr, F.lane); return; } r -= N_G + N_U;
    if (r < N_D) { const int le = r / 256, q = r % 256, kb = q / 32, nb = q % 32;
        transpose_item(a->in[I_EWD] + (size_t)le * 512 * 1024, 1024, kb * 64, nb * 32, (bf16*)(ws + WS_W2) + (size_t)le * 1024 * 512, 512, nb * 32, scr, F.lane); return; } r -= N_D;
    if (r < N_UQ) { const int l = r / 36, q = r % 36, kb = q / 12, nb = q % 12;
        transpose_item(a->in[I_WUQ] + (size_t)l * 192 * 384, 384, kb * 64, nb * 32, (bf16*)(ws + WS_WUQ) + (size_t)l * 384 * 192, 192, nb * 32, scr, F.lane); return; } r -= N_UQ;
    { const int l = r / 32, q = r % 32, kb = q / 16, nb = q % 16;
        transpose_item(a->in[I_WUKV] + (size_t)l * 128 * 512, 512, kb * 64, nb * 32, (bf16*)(ws + WS_WUKV) + (size_t)l * 512 * 128, 128, nb * 32, scr, F.lane); }
}
constexpr int N_MISC_PAD = 2 * 160 * 128, N_MISC_GM = 2 * 4 * 128 * 128 / 4, N_MISC_ROPE = 4096 * 16, N_MISC = N_MISC_PAD + N_MISC_GM + N_MISC_ROPE;
__device__ __attribute__((noinline)) void p0_misc_op(unsigned char* ws, KArgs a, int i) {
    if (i < N_MISC_PAD) { const int l = i / (160 * 128), q = i % (160 * 128);
        *(u32x4*)((bf16*)(ws + WS_WIN) + ((size_t)l * NIN_PAD + 2144) * 1024 + (size_t)q * 8) = (u32x4){0u, 0u, 0u, 0u}; return; } i -= N_MISC_PAD;
    if (i < N_MISC_GM) { const f32x4 v = *(const f32x4*)(a->in[I_GMWS] + (size_t)i * 4); u32x2 o; o.x = pk2(v[0], v[1]); o.y = pk2(v[2], v[3]);
        *(u32x2*)((bf16*)(ws + WS_GMWS) + (size_t)i * 4) = o; return; } i -= N_MISC_GM;
    if (i < N_MISC_ROPE) { const int t = i >> 4, j = i & 15; const float pos = (float)(j < 8 ? (t >> 6) : (t & 63));
        const float inv = powf(10000.0f, -(float)(j & 7) / 8.0f); const float ang = pos * inv;
        ((float*)(ws + WS_ROPE))[i] = cosf(ang); ((float*)(ws + WS_ROPE))[4096 * 16 + i] = sinf(ang); }
}

__device__ __attribute__((noinline)) void p0_mod_item(LAS unsigned char* lds_, unsigned char* ws_, KArgs a, int it) {
    const MiniF F = minif(lds_, ws_);
    LAS float* sc = (LAS float*)F.lds;
    LAS float* part = sc + 9 * 1024;
    float* mod = (float*)(F.ws + WS_MOD);
    for (int i = F.tid; i < 9 * 1024; i += 512) { const int j = i >> 10, k = i & 1023; const float c = j < 8 ? a->in[I_C][j * 1024 + k] : a->in[I_CCTX][k]; sc[i] = siluf(c); }
    __syncthreads();
    const int l = it / 96, cb = it % 96, col = F.tid & 63, kq = F.tid >> 6;
    const float* W = a->in[I_ADAW] + (size_t)l * 1024 * 6144 + cb * 64 + col;
    float acc[9];
#pragma unroll
    for (int j = 0; j < 9; ++j) acc[j] = 0.f;
#pragma unroll 1
    for (int k0 = kq * 128; k0 < kq * 128 + 128; k0 += 16) { float w[16];
#pragma unroll
        for (int q = 0; q < 16; ++q) w[q] = W[(size_t)(k0 + q) * 6144];
#pragma unroll
        for (int q = 0; q < 16; ++q)
#pragma unroll
            for (int j = 0; j < 9; ++j) acc[j] += sc[j * 1024 + k0 + q] * w[q]; }
#pragma unroll
    for (int j = 0; j < 9; ++j) part[(kq * 9 + j) * 64 + col] = acc[j];
    __syncthreads();
    for (int i = F.tid; i < 9 * 64; i += 512) { const int j = i >> 6, c2 = i & 63; float s = a->in[I_ADAB][l * 6144 + cb * 64 + c2];
#pragma unroll
        for (int q = 0; q < 8; ++q) s += part[(q * 9 + j) * 64 + c2];
        mod[((size_t)l * 9 + j) * 6144 + cb * 64 + c2] = s; }
}

__device__ __attribute__((noinline)) void p0_filter_item(LAS unsigned char* lds_, unsigned char* ws_, KArgs a, int it) {
    const MiniF F = minif(lds_, ws_);
    LAS float* z = (LAS float*)F.lds;
    LAS float* h1 = z + 32 * 36;
    LAS float* h2T = h1 + 32 * 64;
    float* fsp = (float*)(F.ws + WS_FS);
    const int set = it < 128 ? 0 : (it < 256 ? 1 : 2), tt = it < 256 ? (it & 127) : it - 256;
    const int l = set == 2 ? 0 : set, L = set == 2 ? 256 : 4096, t0 = tt * 32;
    const float* w1 = a->in[I_HFW1] + l * 33 * 64; const float* b1 = a->in[I_HFB1] + l * 64; const float* fr = a->in[I_HFFREQ] + l * 64;
    const float* w2 = a->in[I_HFW2] + l * 64 * 64; const float* b2 = a->in[I_HFB2] + l * 64; const float* w3 = a->in[I_HFW3] + (size_t)l * 64 * 1024;
    { const int tl = F.tid >> 4, f = F.tid & 15, tg = t0 + tl;
      const float fb = 1e-4f + (float)f * ((15.0f - 1e-4f) / 15.0f); const float w = 6.283185307179586f * (float)tg / (float)L;
      const float ang = fb * w; z[tl * 36 + 1 + f] = cosf(ang); z[tl * 36 + 17 + f] = -sinf(ang);
      if (f == 0) z[tl * 36] = (float)tg / (float)(L - 1); }
    __syncthreads();
    { const int tl = F.tid >> 4, j0 = (F.tid & 15) * 4; f32x4 s = *(const f32x4*)(b1 + j0);
      for (int i = 0; i < 33; ++i) s += *(const f32x4*)(w1 + i * 64 + j0) * z[tl * 36 + i];
      const f32x4 f4 = *(const f32x4*)(fr + j0); h1[tl * 64 + j0] = sinf(f4.x * s.x); h1[tl * 64 + j0 + 1] = sinf(f4.y * s.y); h1[tl * 64 + j0 + 2] = sinf(f4.z * s.z); h1[tl * 64 + j0 + 3] = sinf(f4.w * s.w); }
    __syncthreads();
    { const int tl = F.tid >> 4, j0 = (F.tid & 15) * 4; f32x4 s = *(const f32x4*)(b2 + j0);
      for (int i = 0; i < 64; ++i) s += *(const f32x4*)(w2 + i * 64 + j0) * h1[tl * 64 + i];
      const f32x4 f4 = *(const f32x4*)(fr + j0); h2T[(j0) * 32 + tl] = sinf(f4.x * s.x); h2T[(j0 + 1) * 32 + tl] = sinf(f4.y * s.y); h2T[(j0 + 2) * 32 + tl] = sinf(f4.z * s.z); h2T[(j0 + 3) * 32 + tl] = sinf(f4.w * s.w); }
    __syncthreads();
    const int dir = F.tid >> 8, c = F.tid & 255;
    float acc0[32], acc1[32];
#pragma unroll
    for (int t = 0; t < 32; ++t) { acc0[t] = 0.f; acc1[t] = 0.f; }
#pragma unroll 2
    for (int k = 0; k < 64; ++k) { const float wa = w3[(size_t)k * 1024 + F.tid], wb = w3[(size_t)k * 1024 + 512 + F.tid];
#pragma unroll
        for (int t4 = 0; t4 < 8; ++t4) { const f32x4 h = *(const LAS f32x4*)(h2T + k * 32 + t4 * 4);
#pragma unroll
            for (int j = 0; j < 4; ++j) { acc0[t4 * 4 + j] += h[j] * wa; acc1[t4 * 4 + j] += h[j] * wb; } } }
    const float lo = -3.0701134573253945f, hi = -15.350567286626972f;
    const float delta = fabsf(lo + (float)c * ((hi - lo) / 255.0f));
    float as0 = 0.f, as1 = 0.f;
#pragma unroll
    for (int t = 0; t < 32; ++t) { const float e = __expf(-z[t * 36] * delta); acc0[t] *= e; acc1[t] *= e; if (dir == 0 || t0 + t >= 1) { as0 += fabsf(acc0[t]); as1 += fabsf(acc1[t]); } }
    fsp[((size_t)set * 128 + tt) * 1024 + F.tid] = as0; fsp[((size_t)set * 128 + tt) * 1024 + 512 + F.tid] = as1;
    if (set < 2) {
        bf16* G0 = (bf16*)(F.ws + WS_G) + ((size_t)(set * 2 + 0) * 256 + c) * GLEN; bf16* G1 = G0 + (size_t)256 * GLEN;
        if (dir == 0) {
            G0[GC - t0] = (bf16)f2bf(acc0[0]); G1[GC - t0] = (bf16)f2bf(acc1[0]); G0[GC - t0 - 31] = (bf16)f2bf(acc0[31]); G1[GC - t0 - 31] = (bf16)f2bf(acc1[31]);
#pragma unroll
            for (int t = 1; t < 31; t += 2) { *(unsigned*)(G0 + GC - t0 - t - 1) = pk2(acc0[t + 1], acc0[t]); *(unsigned*)(G1 + GC - t0 - t - 1) = pk2(acc1[t + 1], acc1[t]); }
        } else {
            if (t0 == 0) { G0[GC + 1] = (bf16)f2bf(acc0[1]); G1[GC + 1] = (bf16)f2bf(acc1[1]); }
            else { *(unsigned*)(G0 + GC + t0) = pk2(acc0[0], acc0[1]); *(unsigned*)(G1 + GC + t0) = pk2(acc1[0], acc1[1]); }
#pragma unroll
            for (int t = 2; t < 32; t += 2) { *(unsigned*)(G0 + GC + t0 + t) = pk2(acc0[t], acc0[t + 1]); *(unsigned*)(G1 + GC + t0 + t) = pk2(acc1[t], acc1[t + 1]); }
        }
    } else {
        float* T0 = (float*)(F.ws + WS_TC) + (size_t)c * 512; float* T1 = T0 + (size_t)256 * 512;
#pragma unroll
        for (int t = 0; t < 32; ++t) { const int tg = t0 + t; if (dir == 0) { T0[256 + tg] = acc0[t]; T1[256 + tg] = acc1[t]; } else if (tg >= 1) { T0[256 - tg] = acc0[t]; T1[256 - tg] = acc1[t]; } }
    }
}

constexpr int P0_NF = 264, P0_NM = 192, P0_NW = (NIT_W + 7) / 8, P0_NX = (N_MISC + 511) / 512, P0_NITEMS = P0_NF + P0_NM + P0_NW + P0_NX;
__device__ __forceinline__ void p0_all(const Frame& F, KArgs a) {
    volatile LAS int* slot = (volatile LAS int*)(F.lds + LDS_MISC + 64);
    for (;;) {
        __syncthreads();
        if (F.tid == 0) *slot = (int)atomicAdd(F.ctl + CW_P0Q, 1u);
        __syncthreads();
        const int it = *slot;
        if (it >= P0_NITEMS) break;
        if (it < P0_NF) p0_filter_item(F.lds, F.ws, a, it);
        else if (it < P0_NF + P0_NM) p0_mod_item(F.lds, F.ws, a, it - P0_NF);
        else if (it < P0_NF + P0_NM + P0_NW) { const int wi = (it - P0_NF - P0_NM) * 8 + F.wave; if (wi < NIT_W) p0_weight_item(F.lds, F.ws, a, wi); }
        else { const int i = (it - P0_NF - P0_NM - P0_NW) * 512 + F.tid; if (i < N_MISC) p0_misc_op(F.ws, a, i); }
    }
    __syncthreads();
}
__device__ __forceinline__ void norm_mod_row(const float* xrow, const float* g, const float* sc, const float* sh, bf16* orow, int lane) {
    const f32x4* xr = (const f32x4*)xrow + lane;
    f32x4 v[4]; float s = 0.f;
#pragma unroll
    for (int j = 0; j < 4; ++j) { v[j] = xr[64 * j]; s += (v[j].x * v[j].x + v[j].y * v[j].y) + (v[j].z * v[j].z + v[j].w * v[j].w); }
    const float rstd = 1.f / sqrtf(wave_sum(s) * (1.f / 1024.f) + EPS);
    unsigned long long* o8 = (unsigned long long*)orow + lane;
#pragma unroll
    for (int j = 0; j < 4; ++j) { const int k = 4 * lane + 256 * j; const f32x4 gg = *(const f32x4*)(g + k), cc = *(const f32x4*)(sc + k), hh = *(const f32x4*)(sh + k);
        const f32x4 y = v[j] * rstd * gg * (cc + 1.f) + hh;
        o8[64 * j] = (unsigned long long)pk2(y.x, y.y) | ((unsigned long long)pk2(y.z, y.w) << 32); }
}
__device__ __forceinline__ void p1_norm(const Frame& F, KArgs a, int layer, const float* xlat, const float* xctx) {
    const float* mod = (const float*)(F.ws + WS_MOD) + (size_t)layer * 9 * 6144; const float* g = a->in[I_N1G] + layer * 1024; bf16* H = (bf16*)(F.ws + WS_H);
    for (int r = F.gw; r < NTOK; r += F.NGW) {
        const float* xr = r < NLAT ? xlat + (size_t)r * 1024 : xctx + (size_t)(r - NLAT) * 1024; const float* m = mod + (size_t)mod_idx(r) * 6144;
        norm_mod_row(xr, g, m + 1024, m, H + (size_t)r * 1024, F.lane);
    }
}

__device__ __forceinline__ void p7_router(const Frame& F, KArgs a, int layer, const float* xlat, const float* xctx, int nrows, bool dry = false) {
    const float* mod = (const float*)(F.ws + WS_MOD) + (size_t)layer * 9 * 6144; const float* g = a->in[I_N2G] + layer * 1024; bf16* H = (bf16*)(F.ws + WS_H);
    LAS float* wr = (LAS float*)F.lds;
    LAS float* ys = (LAS float*)(F.lds + 65536) + F.wave * 1024;
    LAS int* rb = (LAS int*)(F.lds + 98304);
    LAS float* rlo = (LAS float*)(F.lds + 98304 + 1024);
    LAS float* rhi = (LAS float*)(F.lds + 98304 + 2048);
    LAS int* bcnt = (LAS int*)(F.lds + 98304 + 3072);
    __syncthreads();
    for (int i = F.tid; i < 1024 * 16 / 4; i += 512) ((LAS f32x4*)wr)[i] = ((const f32x4*)a->in[I_WROUTER])[i];
    if (F.tid < 64) bcnt[F.tid] = 0;
    __syncthreads();
    const int per = (nrows + F.G - 1) / F.G;
    const int r0 = blockIdx.x * per, r1 = min(r0 + per, nrows);
    const int eq = F.lane & 3, ks = F.lane >> 2;
    const float rbias0 = a->in[I_RBIAS][4 * eq], rbias1 = a->in[I_RBIAS][4 * eq + 1], rbias2 = a->in[I_RBIAS][4 * eq + 2], rbias3 = a->in[I_RBIAS][4 * eq + 3];
#pragma unroll 1
    for (int r = r0 + F.wave; r < r1; r += 8) {
        const float* xr = r < NLAT ? xlat + (size_t)r * 1024 : xctx + (size_t)(r - NLAT) * 1024; const float* m = mod + (size_t)mod_idx(r) * 6144;
        const f32x4* x4 = (const f32x4*)xr + F.lane;
        f32x4 v[4]; float s = 0.f;
#pragma unroll
        for (int j = 0; j < 4; ++j) { v[j] = x4[64 * j]; s += (v[j].x * v[j].x + v[j].y * v[j].y) + (v[j].z * v[j].z + v[j].w * v[j].w); }
        const float rstd = 1.f / sqrtf(wave_sum(s) * (1.f / 1024.f) + EPS);
        unsigned long long* o8 = (unsigned long long*)(H + (size_t)r * 1024) + F.lane;
#pragma unroll
        for (int j = 0; j < 4; ++j) { const int k = 4 * F.lane + 256 * j; const f32x4 gg = *(const f32x4*)(g + k), cc = *(const f32x4*)(m + 4 * 1024 + k), hh = *(const f32x4*)(m + 3 * 1024 + k);
            const f32x4 y = v[j] * rstd * gg * (cc + 1.f) + hh;
            o8[64 * j] = (unsigned long long)pk2(y.x, y.y) | ((unsigned long long)pk2(y.z, y.w) << 32);
            *(LAS f32x4*)(ys + k) = y; }
        asm volatile("s_waitcnt lgkmcnt(0)" ::: "memory");
        f32x4 lg = (f32x4){0.f, 0.f, 0.f, 0.f};
#pragma unroll 8
        for (int i = 0; i < 64; ++i) { const int k = ks + 16 * i; const float yv = ys[k]; const f32x4 w = *(const LAS f32x4*)(wr + k * 16 + 4 * eq); lg += w * yv; }
#pragma unroll
        for (int o2 = 4; o2 < 64; o2 <<= 1) { lg.x += __shfl_xor(lg.x, o2); lg.y += __shfl_xor(lg.y, o2); lg.z += __shfl_xor(lg.z, o2); lg.w += __shfl_xor(lg.w, o2); }
        const float s0 = sigmf(lg.x), s1 = sigmf(lg.y), s2 = sigmf(lg.z), s3 = sigmf(lg.w);
        const float e0 = s0 + rbias0, e1 = s1 + rbias1, e2 = s2 + rbias2, e3 = s3 + rbias3;
        int i1 = 0, i2 = 0; float m1 = -1e30f, m2 = -1e30f, w1 = 0.f, w2 = 0.f;
        { const float ee[4] = {e0, e1, e2, e3}; const float ss[4] = {s0, s1, s2, s3};
#pragma unroll
          for (int q = 0; q < 4; ++q) { const float x = ee[q]; if (x > m1) { m2 = m1; i2 = i1; w2 = w1; m1 = x; i1 = q; w1 = ss[q]; } else if (x > m2) { m2 = x; i2 = q; w2 = ss[q]; } } }
        const float gs = m1 + m2;
        const float g0 = __shfl(gs, 0), g1 = __shfl(gs, 1), g2 = __shfl(gs, 2), g3 = __shfl(gs, 3);
        int best = 0; float bs = g0; if (g1 > bs) { bs = g1; best = 1; } if (g2 > bs) { bs = g2; best = 2; } if (g3 > bs) { bs = g3; best = 3; }
        if (F.lane == best) {
            const float inv = 1.f / (w1 + w2); const float a1 = w1 * inv, a2 = w2 * inv;
            const int lo = i1 < i2 ? i1 : i2, hi = i1 < i2 ? i2 : i1; const float wl = i1 < i2 ? a1 : a2, wh = i1 < i2 ? a2 : a1;
            const int p = lo == 0 ? hi - 1 : (lo == 1 ? hi + 1 : 5);
            const int lr = r - r0; rb[lr] = best * 6 + p; rlo[lr] = wl; rhi[lr] = wh;
        }
    }
    __syncthreads();
    const int n = dry ? 0 : (r1 > r0 ? r1 - r0 : 0);
    int myslot = -1, myb = 0;
    if (F.tid < n) { myb = rb[F.tid]; myslot = atomicAdd((int*)&bcnt[myb], 1); }
    __syncthreads();
    if (F.tid < NBUCKET && !dry) { const int c = bcnt[F.tid]; bcnt[32 + F.tid] = c > 0 ? (int)atomicAdd(F.ctl + CW_CNT + layer * 32 + F.tid, (unsigned)c) : 0; }
    __syncthreads();
    if (F.tid < n) { const size_t p = (size_t)myb * NTOK + bcnt[32 + myb] + myslot;
        ((int*)(F.ws + WS_TOK))[p] = r0 + F.tid; ((float*)(F.ws + WS_WLO))[p] = rlo[F.tid]; ((float*)(F.ws + WS_WHI))[p] = rhi[F.tid]; }
    __syncthreads();
}

__device__ __forceinline__ void p_final(const Frame& F, KArgs a) {
    const float* g = a->in[I_FNG];
    for (int r = F.gw; r < NLAT; r += F.NGW) {
        f32x4* xr = (f32x4*)(a->out + (size_t)r * 1024) + F.lane;
        f32x4 v[4]; float s = 0.f;
#pragma unroll
        for (int j = 0; j < 4; ++j) { v[j] = xr[64 * j]; s += (v[j].x * v[j].x + v[j].y * v[j].y) + (v[j].z * v[j].z + v[j].w * v[j].w); }
        const float rstd = 1.f / sqrtf(wave_sum(s) * (1.f / 1024.f) + EPS);
#pragma unroll
        for (int j = 0; j < 4; ++j) { const f32x4 gg = *(const f32x4*)(g + 4 * F.lane + 256 * j); xr[64 * j] = v[j] * rstd * gg; }
    }
}
__device__ __forceinline__ f32x4 mfma16(bf16x8 a, bf16x8 b, f32x4 c) { return __builtin_amdgcn_mfma_f32_16x16x32_bf16(a, b, c, 0, 0, 0); }
__device__ __forceinline__ void row_bk(int r, int& b, int& key, bool& lat) { lat = r < NLAT; if (lat) { b = r >> 12; key = r & 4095; } else { const int rc = r - NLAT; b = rc >> 8; key = 4096 + (rc & 255); } }

__device__ __forceinline__ void p3_mla_unit(const Frame& F, KArgs a, int layer, int r0) {
    LAS float* Xq = (LAS float*)F.lds;
    LAS float* Xkv = (LAS float*)(F.lds + 49152);
    LAS bf16* Aq = (LAS bf16*)(F.lds + 90112);
    LAS bf16* Akv = (LAS bf16*)(F.lds + 115712);
    LAS bf16* Kr = (LAS bf16*)(F.lds + 133120);
    const bf16* proj = (const bf16*)(F.ws + WS_PROJ);
    int b0, key0; bool lat; row_bk(r0, b0, key0, lat);
    __syncthreads();
    {
        u32x4 wq[3], wk[3];
#pragma unroll
        for (int it = 0; it < 3; ++it) { const int i = F.tid + it * 512; const int r = i / 24, c8 = i % 24; wq[it] = *(const u32x4*)(proj + (size_t)(r0 + r) * PROJ_LD + PJ_MQ + c8 * 8); }
#pragma unroll
        for (int it = 0; it < 3; ++it) { const int i = F.tid + it * 512; const int r = i / 20, c8 = i % 20; if (i < 64 * 20) wk[it] = *(const u32x4*)(proj + (size_t)(r0 + r) * PROJ_LD + PJ_MKV + c8 * 8); }
#pragma unroll
        for (int it = 0; it < 3; ++it) { const int i = F.tid + it * 512; const int r = i / 24, c8 = i % 24; const u32x4 w = wq[it]; LAS float* d = Xq + r * 192 + c8 * 8;
            d[0] = lo_bf(w.x); d[1] = hi_bf(w.x); d[2] = lo_bf(w.y); d[3] = hi_bf(w.y); d[4] = lo_bf(w.z); d[5] = hi_bf(w.z); d[6] = lo_bf(w.w); d[7] = hi_bf(w.w); }
#pragma unroll
        for (int it = 0; it < 3; ++it) { const int i = F.tid + it * 512; const int r = i / 20, c8 = i % 20; if (i < 64 * 20) { const u32x4 w = wk[it]; LAS float* d = Xkv + r * 160 + c8 * 8;
            d[0] = lo_bf(w.x); d[1] = hi_bf(w.x); d[2] = lo_bf(w.y); d[3] = hi_bf(w.y); d[4] = lo_bf(w.z); d[5] = hi_bf(w.z); d[6] = lo_bf(w.w); d[7] = hi_bf(w.w); } }
    }
    __syncthreads();
    const float* qg = a->in[I_QANORM] + layer * 192; const float* kg = a->in[I_KVANORM] + layer * 128;
    for (int r = F.wave; r < 64; r += 8) {
        const float q0 = Xq[r * 192 + F.lane], q1 = Xq[r * 192 + 64 + F.lane], q2 = Xq[r * 192 + 128 + F.lane];
        const float rq = 1.f / sqrtf(wave_sum(q0 * q0 + q1 * q1 + q2 * q2) * (1.f / 192.f) + EPS);
        Aq[r * 200 + F.lane] = (bf16)f2bf(q0 * rq * qg[F.lane]); Aq[r * 200 + 64 + F.lane] = (bf16)f2bf(q1 * rq * qg[64 + F.lane]); Aq[r * 200 + 128 + F.lane] = (bf16)f2bf(q2 * rq * qg[128 + F.lane]);
        const float k0 = Xkv[r * 160 + F.lane], k1 = Xkv[r * 160 + 64 + F.lane];
        const float rk = 1.f / sqrtf(wave_sum(k0 * k0 + k1 * k1) * (1.f / 128.f) + EPS);
        Akv[r * 136 + F.lane] = (bf16)f2bf(k0 * rk * kg[F.lane]); Akv[r * 136 + 64 + F.lane] = (bf16)f2bf(k1 * rk * kg[64 + F.lane]);
    }
    const float* ropec = (const float*)(F.ws + WS_ROPE); const float* ropes = ropec + 4096 * 16;
    for (int i = F.tid; i < 64 * 16; i += 512) { const int r = i >> 4, j = i & 15; const float x1 = Xkv[r * 160 + 128 + j], x2 = Xkv[r * 160 + 144 + j];
        float cs = 1.f, sn = 0.f; if (lat) { cs = ropec[(key0 + r) * 16 + j]; sn = ropes[(key0 + r) * 16 + j]; }
        Kr[r * 32 + j] = (bf16)f2bf(x1 * cs - x2 * sn); Kr[r * 32 + 16 + j] = (bf16)f2bf(x1 * sn + x2 * cs); }
    __syncthreads();
    const int h = F.wave >> 1, rh = F.wave & 1, lr = F.lane & 15, lq = F.lane >> 4;
    {
        const bf16* W = (const bf16*)(F.ws + WS_WUQ) + (size_t)layer * 384 * 192;
        f32x4 acc[2][6];
#pragma unroll
        for (int mt = 0; mt < 2; ++mt)
#pragma unroll
            for (int nt = 0; nt < 6; ++nt) acc[mt][nt] = (f32x4){0.f, 0.f, 0.f, 0.f};
#pragma unroll 3
        for (int ks = 0; ks < 6; ++ks) {
            bf16x8 af[2], bfr[6];
#pragma unroll
            for (int mt = 0; mt < 2; ++mt) af[mt] = *(const LAS bf16x8*)(Aq + (rh * 32 + mt * 16 + lr) * 200 + ks * 32 + lq * 8);
#pragma unroll
            for (int nt = 0; nt < 6; ++nt) bfr[nt] = *(const bf16x8*)(W + (size_t)(h * 96 + nt * 16 + lr) * 192 + ks * 32 + lq * 8);
#pragma unroll
            for (int mt = 0; mt < 2; ++mt)
#pragma unroll
                for (int nt = 0; nt < 6; ++nt) acc[mt][nt] = mfma16(bfr[nt], af[mt], acc[mt][nt]);
        }
        bf16* Q = (bf16*)(F.ws + WS_Q);
#pragma unroll
        for (int mt = 0; mt < 2; ++mt) { const int tl = rh * 32 + mt * 16 + lr;
            if (lat) {
#pragma unroll
                for (int j = 0; j < 4; ++j) { const float cs = ropec[(key0 + tl) * 16 + lq * 4 + j], sn = ropes[(key0 + tl) * 16 + lq * 4 + j]; const float x1 = acc[mt][4][j], x2 = acc[mt][5][j];
                    acc[mt][4][j] = x1 * cs - x2 * sn; acc[mt][5][j] = x1 * sn + x2 * cs; } }
#pragma unroll
            for (int nt = 0; nt < 6; ++nt) { u32x2 w; w.x = pk2(acc[mt][nt][0] * QSCALE, acc[mt][nt][1] * QSCALE); w.y = pk2(acc[mt][nt][2] * QSCALE, acc[mt][nt][3] * QSCALE);
                *(u32x2*)(Q + (size_t)(r0 + tl) * 384 + h * 96 + nt * 16 + lq * 4) = w; } }
    }
    {
        const bf16* W = (const bf16*)(F.ws + WS_WUKV) + (size_t)layer * 512 * 128;
        f32x4 ak[2][4], av[2][4];
#pragma unroll
        for (int mt = 0; mt < 2; ++mt)
#pragma unroll
            for (int nt = 0; nt < 4; ++nt) { ak[mt][nt] = (f32x4){0.f, 0.f, 0.f, 0.f}; av[mt][nt] = (f32x4){0.f, 0.f, 0.f, 0.f}; }
#pragma unroll 2
        for (int ks = 0; ks < 4; ++ks) {
            bf16x8 af[2], bk[4], bv[4];
#pragma unroll
            for (int mt = 0; mt < 2; ++mt) af[mt] = *(const LAS bf16x8*)(Akv + (rh * 32 + mt * 16 + lr) * 136 + ks * 32 + lq * 8);
#pragma unroll
            for (int nt = 0; nt < 4; ++nt) { bk[nt] = *(const bf16x8*)(W + (size_t)(h * 128 + nt * 16 + lr) * 128 + ks * 32 + lq * 8); bv[nt] = *(const bf16x8*)(W + (size_t)(h * 128 + 64 + nt * 16 + lr) * 128 + ks * 32 + lq * 8); }
#pragma unroll
            for (int mt = 0; mt < 2; ++mt)
#pragma unroll
                for (int nt = 0; nt < 4; ++nt) { ak[mt][nt] = mfma16(bk[nt], af[mt], ak[mt][nt]); av[mt][nt] = mfma16(af[mt], bv[nt], av[mt][nt]); }
        }
        bf16* Kg = (bf16*)(F.ws + WS_K) + ((size_t)(b0 * 4 + h) * NKEY + key0) * 96;
        bf16* Vt = (bf16*)(F.ws + WS_VT) + (size_t)(b0 * 4 + h) * 64 * NKEY + key0;
#pragma unroll
        for (int mt = 0; mt < 2; ++mt)
#pragma unroll
            for (int nt = 0; nt < 4; ++nt) {
                u32x2 w; w.x = pk2(ak[mt][nt][0], ak[mt][nt][1]); w.y = pk2(ak[mt][nt][2], ak[mt][nt][3]);
                *(u32x2*)(Kg + (size_t)(rh * 32 + mt * 16 + lr) * 96 + nt * 16 + lq * 4) = w;
                u32x2 v; v.x = pk2(av[mt][nt][0], av[mt][nt][1]); v.y = pk2(av[mt][nt][2], av[mt][nt][3]);
                *(u32x2*)(Vt + (size_t)(nt * 16 + lr) * NKEY + rh * 32 + mt * 16 + lq * 4) = v; }
    }
    {
        for (int i = F.tid; i < 64 * 4 * 4; i += 512) { const int r = i >> 4, hh = (i >> 2) & 3, c8 = i & 3;
            *(u32x4*)((bf16*)(F.ws + WS_K) + ((size_t)(b0 * 4 + hh) * NKEY + key0 + r) * 96 + 64 + c8 * 8) = *(const LAS u32x4*)(Kr + r * 32 + c8 * 8); }
    }
}

__device__ __forceinline__ void p3_conv_unit(const Frame& F, KArgs a, int layer, int r0) {
    LAS float* U = (LAS float*)F.lds;
    const bf16* proj = (const bf16*)(F.ws + WS_PROJ);
    const bool lat = r0 < NLAT; const int Ls = lat ? SEQ : CTXL; const int t0 = lat ? (r0 & 4095) : ((r0 - NLAT) & 255);
    __syncthreads();
    u32x4 cwa[6], cwb[6];
#pragma unroll
    for (int it = 0; it < 6; ++it) { const int i = F.tid + it * 512; const int rr = i >> 5, c8 = i & 31; const int t = t0 - 15 + rr;
        if (i < 94 * 32 && t >= 0 && t < Ls) { const bf16* p = proj + (size_t)(r0 - 15 + rr) * PROJ_LD + PJ_CV + c8 * 8; cwa[it] = *(const u32x4*)p; cwb[it] = *(const u32x4*)(p + 256); } }
#pragma unroll
    for (int it = 0; it < 6; ++it) { const int i = F.tid + it * 512; if (i >= 94 * 32) break; const int rr = i >> 5, c8 = i & 31; const int t = t0 - 15 + rr; LAS float* d = U + rr * 256 + c8 * 8;
        if (t >= 0 && t < Ls) { const u32x4 wa = cwa[it], wb = cwb[it];
            d[0] = lo_bf(wa.x) * sigmf(lo_bf(wb.x)); d[1] = hi_bf(wa.x) * sigmf(hi_bf(wb.x)); d[2] = lo_bf(wa.y) * sigmf(lo_bf(wb.y)); d[3] = hi_bf(wa.y) * sigmf(hi_bf(wb.y));
            d[4] = lo_bf(wa.z) * sigmf(lo_bf(wb.z)); d[5] = hi_bf(wa.z) * sigmf(hi_bf(wb.z)); d[6] = lo_bf(wa.w) * sigmf(lo_bf(wb.w)); d[7] = hi_bf(wa.w) * sigmf(hi_bf(wb.w)); }
        else {
#pragma unroll
            for (int j = 0; j < 8; ++j) d[j] = 0.f; } }
    __syncthreads();
    const int c = F.tid & 255, th = F.tid >> 8;
    float o[32];
    { const float* w = a->in[I_CVW] + (size_t)layer * 31 * 256 + c; const float bias = a->in[I_CVB][layer * 256 + c];
#pragma unroll
      for (int t = 0; t < 32; ++t) o[t] = bias;
#pragma unroll 1
      for (int k = 0; k < 31; ++k) { const float wk = w[k * 256];
#pragma unroll
          for (int t = 0; t < 32; ++t) o[t] += U[(th * 32 + t + k) * 256 + c] * wk; } }
    __syncthreads();
#pragma unroll
    for (int t = 0; t < 32; ++t) U[(th * 32 + t) * 256 + c] = o[t];
    __syncthreads();
    const float* lg = a->in[I_CVLNG] + layer * 256; const float* lb = a->in[I_CVLNB] + layer * 256; const float* mg = a->in[I_MIXG] + layer * 1024 + 512;
    bf16* Y = (bf16*)(F.ws + WS_H);
    for (int r = F.wave; r < 64; r += 8) {
        const f32x4 v = *(const LAS f32x4*)(U + r * 256 + 4 * F.lane);
        float s = (v.x + v.y) + (v.z + v.w);
#pragma unroll
        for (int o2 = 1; o2 < 16; o2 <<= 1) s += __shfl_xor(s, o2);
        const float mean = s * (1.f / 64.f); const f32x4 d = v - mean; float q = (d.x * d.x + d.y * d.y) + (d.z * d.z + d.w * d.w);
#pragma unroll
        for (int o2 = 1; o2 < 16; o2 <<= 1) q += __shfl_xor(q, o2);
        const float rstd = 1.f / sqrtf(q * (1.f / 64.f) + EPS);
        const f32x4 gg = *(const f32x4*)(lg + 4 * F.lane), bb = *(const f32x4*)(lb + 4 * F.lane);
        f32x4 y = d * rstd * gg + bb; y.x = siluf(y.x); y.y = siluf(y.y); y.z = siluf(y.z); y.w = siluf(y.w);
        const float ss = wave_sum((y.x * y.x + y.y * y.y) + (y.z * y.z + y.w * y.w)); const float rn = 1.f / sqrtf(ss * (1.f / 256.f) + EPS);
        const f32x4 m4 = *(const f32x4*)(mg + 4 * F.lane); y = y * rn * m4;
        u32x2 w; w.x = pk2(y.x, y.y); w.y = pk2(y.z, y.w);
        *(u32x2*)(Y + (size_t)(r0 + r) * 1024 + 512 + 4 * F.lane) = w;
    }
}

__device__ __forceinline__ void p3_gmlp_unit(const Frame& F, KArgs a, int layer, int r0) {
    LAS bf16* vT = (LAS bf16*)F.lds;
    LAS float* red = (LAS float*)(F.lds + 69632);
    const bf16* proj = (const bf16*)(F.ws + WS_PROJ);
    const float* lg = a->in[I_GMLNG] + layer * 256; const float* lb = a->in[I_GMLNB] + layer * 256;
    __syncthreads();
    u32x2 gw[16];
#pragma unroll
    for (int it = 0; it < 16; ++it) gw[it] = *(const u32x2*)(proj + (size_t)(r0 + F.wave + 8 * it) * PROJ_LD + PJ_GM + 256 + 4 * F.lane);
#pragma unroll
    for (int it = 0; it < 16; ++it) { const int r = F.wave + 8 * it;
        const u32x2 w = gw[it];
        f32x4 v; v.x = gelu_tanh(lo_bf(w.x)); v.y = gelu_tanh(hi_bf(w.x)); v.z = gelu_tanh(lo_bf(w.y)); v.w = gelu_tanh(hi_bf(w.y));
        const float mean = wave_sum((v.x + v.y) + (v.z + v.w)) * (1.f / 256.f); const f32x4 d = v - mean;
        const float rstd = 1.f / sqrtf(wave_sum((d.x * d.x + d.y * d.y) + (d.z * d.z + d.w * d.w)) * (1.f / 256.f) + EPS);
        const f32x4 gg = *(const f32x4*)(lg + 4 * F.lane), bb = *(const f32x4*)(lb + 4 * F.lane); const f32x4 y = d * rstd * gg + bb;
        vT[(4 * F.lane + 0) * 136 + r] = (bf16)f2bf(y.x); vT[(4 * F.lane + 1) * 136 + r] = (bf16)f2bf(y.y); vT[(4 * F.lane + 2) * 136 + r] = (bf16)f2bf(y.z); vT[(4 * F.lane + 3) * 136 + r] = (bf16)f2bf(y.w);
    }
    __syncthreads();
    const int g = F.wave >> 1, ih = F.wave & 1, lr = F.lane & 15, lq = F.lane >> 4;
    const bf16* W = (const bf16*)(F.ws + WS_GMWS) + (size_t)(layer * 4 + g) * 128 * 128;
    f32x4 acc[4][4];
#pragma unroll
    for (int dt = 0; dt < 4; ++dt)
#pragma unroll
        for (int it = 0; it < 4; ++it) acc[dt][it] = (f32x4){0.f, 0.f, 0.f, 0.f};
#pragma unroll 2
    for (int ks = 0; ks < 4; ++ks) {
        bf16x8 af[4], bfr[4];
#pragma unroll
        for (int dt = 0; dt < 4; ++dt) af[dt] = *(const LAS bf16x8*)(vT + (g * 64 + dt * 16 + lr) * 136 + ks * 32 + lq * 8);
#pragma unroll
        for (int it = 0; it < 4; ++it) bfr[it] = *(const bf16x8*)(W + (size_t)(ih * 64 + it * 16 + lr) * 128 + ks * 32 + lq * 8);
#pragma unroll
        for (int dt = 0; dt < 4; ++dt)
#pragma unroll
            for (int it = 0; it < 4; ++it) acc[dt][it] = mfma16(af[dt], bfr[it], acc[dt][it]);
    }
    const float* bs = a->in[I_GMBS] + (size_t)(layer * 4 + g) * 128;
#pragma unroll
    for (int it = 0; it < 4; ++it) { const int i = ih * 64 + it * 16 + lr; const float bsi = bs[i]; float ss = 0.f;
#pragma unroll
        for (int dt = 0; dt < 4; ++dt) { const u32x2 w = *(const u32x2*)(proj + (size_t)(r0 + i) * PROJ_LD + PJ_GM + g * 64 + dt * 16 + 4 * lq);
            f32x4 u; u.x = gelu_tanh(lo_bf(w.x)); u.y = gelu_tanh(hi_bf(w.x)); u.z = gelu_tanh(lo_bf(w.y)); u.w = gelu_tanh(hi_bf(w.y));
            const f32x4 y = u * (acc[dt][it] + bsi); acc[dt][it] = y; ss += (y.x * y.x + y.y * y.y) + (y.z * y.z + y.w * y.w); }
        ss += __shfl_xor(ss, 16); ss += __shfl_xor(ss, 32);
        if (lq == 0) red[g * 128 + i] = ss; }
    __syncthreads();
    const float* mg = a->in[I_MIXG] + layer * 1024 + 256; bf16* Y = (bf16*)(F.ws + WS_H);
#pragma unroll
    for (int it = 0; it < 4; ++it) { const int i = ih * 64 + it * 16 + lr; const float rn = 1.f / sqrtf((red[i] + red[128 + i] + red[256 + i] + red[384 + i]) * (1.f / 256.f) + EPS);
#pragma unroll
        for (int dt = 0; dt < 4; ++dt) { const int col = g * 64 + dt * 16 + 4 * lq; const f32x4 m4 = *(const f32x4*)(mg + col); const f32x4 y = acc[dt][it] * rn * m4;
            u32x2 w; w.x = pk2(y.x, y.y); w.y = pk2(y.z, y.w); *(u32x2*)(Y + (size_t)(r0 + i) * 1024 + 256 + col) = w; } }
}
__device__ __forceinline__ f32x16 mfma32(bf16x8 a, bf16x8 b, f32x16 c) { return __builtin_amdgcn_mfma_f32_32x32x16_bf16(a, b, c, 0, 0, 0); }
__device__ __forceinline__ bf16x8 pack8(float a0, float a1, float a2, float a3, float a4, float a5, float a6, float a7) {
    u32x4 w; w.x = pg8::cvt_pk_bf16(a0, a1); w.y = pg8::cvt_pk_bf16(a2, a3); w.z = pg8::cvt_pk_bf16(a4, a5); w.w = pg8::cvt_pk_bf16(a6, a7); return __builtin_bit_cast(bf16x8, w); }

constexpr int AT_KROW = 104, AT_VROW = 72, AT_KB = 64 * AT_KROW * 2, AT_VB = 64 * AT_VROW * 2;
__device__ __forceinline__ float rowmax32(const f32x16& a, const f32x16& b) {
    float m0 = fmaxf(a[0], a[1]), m1 = fmaxf(a[2], a[3]), m2 = fmaxf(b[0], b[1]), m3 = fmaxf(b[2], b[3]);
#pragma unroll
    for (int r = 4; r < 16; r += 4) { m0 = fmaxf(m0, fmaxf(a[r], a[r + 1])); m1 = fmaxf(m1, fmaxf(a[r + 2], a[r + 3])); m2 = fmaxf(m2, fmaxf(b[r], b[r + 1])); m3 = fmaxf(m3, fmaxf(b[r + 2], b[r + 3])); }
    float m = fmaxf(fmaxf(m0, m1), fmaxf(m2, m3)); return fmaxf(m, __shfl_xor(m, 32));
}
__device__ __forceinline__ void attn_unit(const Frame& F, int b, int h, int qrow0, int key0, int ntile) {
    LAS unsigned char* L = F.lds;
    const bf16* Kg = (const bf16*)(F.ws + WS_K) + ((size_t)(b * 4 + h) * NKEY + key0) * 96;
    const bf16* Vg = (const bf16*)(F.ws + WS_VT) + (size_t)(b * 4 + h) * 64 * NKEY + key0;
    const bf16* Q = (const bf16*)(F.ws + WS_Q);
    const int lane = F.lane, hi = lane >> 5, l31 = lane & 31;
    const int qrow = qrow0 + F.wave * 32 + l31;
    bf16x8 qf[6];
#pragma unroll
    for (int ks = 0; ks < 6; ++ks) qf[ks] = *(const bf16x8*)(Q + (size_t)qrow * 384 + h * 96 + ks * 16 + hi * 8);
    const int kr0 = F.tid / 12, kc0 = F.tid % 12, kr1 = (F.tid + 512) / 12, kc1 = (F.tid + 512) % 12; const bool k2 = F.tid < 256;
    const int vd = F.tid >> 3, vc = F.tid & 7;
    const int klds0 = kr0 * (AT_KROW * 2) + kc0 * 16, klds1 = kr1 * (AT_KROW * 2) + kc1 * 16, vlds = 2 * AT_KB + vd * (AT_VROW * 2) + vc * 16;
    const size_t kg0 = (size_t)kr0 * 96 + kc0 * 8, kg1 = (size_t)kr1 * 96 + kc1 * 8, vg0 = (size_t)vd * NKEY + vc * 8;
    u32x4 sk0, sk1 = (u32x4){0u, 0u, 0u, 0u}, sv;
    __syncthreads();
    {
        const u32x4 a0 = *(const u32x4*)(Kg + kg0), b0 = *(const u32x4*)(Kg + 64 * 96 + kg0); u32x4 a1 = sk1, b1 = sk1; if (k2) { a1 = *(const u32x4*)(Kg + kg1); b1 = *(const u32x4*)(Kg + 64 * 96 + kg1); }
        sv = *(const u32x4*)(Vg + vg0);
        *(LAS u32x4*)(L + klds0) = a0; *(LAS u32x4*)(L + AT_KB + klds0) = b0; if (k2) { *(LAS u32x4*)(L + klds1) = a1; *(LAS u32x4*)(L + AT_KB + klds1) = b1; }
        *(LAS u32x4*)(L + vlds) = sv;
    }
    __syncthreads();
    const int prow = (l31 & ~12) | ((l31 & 4) << 1) | ((l31 & 8) >> 1);
    const int koff = prow * (AT_KROW * 2) + hi * 16, voff = 2 * AT_KB + l31 * (AT_VROW * 2) + hi * 16;
    f32x16 O0, O1, SA0, SA1, SB0, SB1;
#pragma unroll
    for (int r = 0; r < 16; ++r) { O0[r] = 0.f; O1[r] = 0.f; SA0[r] = 0.f; SA1[r] = 0.f; }
#pragma unroll
    for (int ks = 0; ks < 6; ++ks) { const bf16x8 k0 = *(const LAS bf16x8*)(L + koff + ks * 32), k1 = *(const LAS bf16x8*)(L + 32 * (AT_KROW * 2) + koff + ks * 32);
        SA0 = mfma32(k0, qf[ks], SA0); SA1 = mfma32(k1, qf[ks], SA1); }
    float m = rowmax32(SA0, SA1), l = 0.f;
#define AT_EXP(S0, S1, r) do { S0[r] = __builtin_amdgcn_exp2f(S0[r] - m); S1[r] = __builtin_amdgcn_exp2f(S1[r] - m); s0 += S0[r]; s1 += S1[r]; } while (0)
#define AT_KRD(dst0, dst1, ks) do { dst0 = *(const LAS bf16x8*)(Kt + koff + (ks) * 32); dst1 = *(const LAS bf16x8*)(Kt + 32 * (AT_KROW * 2) + koff + (ks) * 32); } while (0)
#define AT_VRD(dst0, dst1, s) do { dst0 = *(const LAS bf16x8*)(Vt + voff + (s) * 32); dst1 = *(const LAS bf16x8*)(Vt + 32 * (AT_VROW * 2) + voff + (s) * 32); } while (0)
#define AT_SB() __builtin_amdgcn_sched_barrier(0)
#define AT_TILE(S0, S1, T0, T1, J, NX) do { const int j_ = (J); constexpr bool nx = (NX); const bool nx2 = j_ + 2 < ntile; \
        if (nx) sv = *(const u32x4*)(Vg + (size_t)(j_ + 1) * 64 + vg0); \
        if (nx2) { const bf16* kg = Kg + (size_t)(j_ + 2) * 64 * 96; sk0 = *(const u32x4*)(kg + kg0); if (k2) sk1 = *(const u32x4*)(kg + kg1); } \
        const LAS unsigned char* Kt = L + ((j_ + 1) & 1) * AT_KB; const LAS unsigned char* Vt = L + (j_ & 1) * AT_VB; \
        _Pragma("unroll") for (int r = 0; r < 16; ++r) { T0[r] = 0.f; T1[r] = 0.f; } \
        float s0 = 0.f, s1 = 0.f; bf16x8 ka0, ka1, kb0, kb1, va0, va1, vb0, vb1; \
        AT_KRD(ka0, ka1, 0); AT_SB(); \
          \
        AT_KRD(kb0, kb1, 1); if (nx) { T0 = mfma32(ka0, qf[0], T0); T1 = mfma32(ka1, qf[0], T1); } AT_EXP(S0, S1, 0); AT_EXP(S0, S1, 1); AT_EXP(S0, S1, 2); AT_SB(); \
        AT_KRD(ka0, ka1, 2); if (nx) { T0 = mfma32(kb0, qf[1], T0); T1 = mfma32(kb1, qf[1], T1); } AT_EXP(S0, S1, 3); AT_EXP(S0, S1, 4); AT_EXP(S0, S1, 5); AT_SB(); \
        AT_KRD(kb0, kb1, 3); if (nx) { T0 = mfma32(ka0, qf[2], T0); T1 = mfma32(ka1, qf[2], T1); } AT_EXP(S0, S1, 6); AT_EXP(S0, S1, 7); AT_EXP(S0, S1, 8); AT_SB(); \
        AT_KRD(ka0, ka1, 4); if (nx) { T0 = mfma32(kb0, qf[3], T0); T1 = mfma32(kb1, qf[3], T1); } AT_EXP(S0, S1, 9); AT_EXP(S0, S1, 10); AT_EXP(S0, S1, 11); AT_SB(); \
        AT_KRD(kb0, kb1, 5); if (nx) { T0 = mfma32(ka0, qf[4], T0); T1 = mfma32(ka1, qf[4], T1); } AT_EXP(S0, S1, 12); AT_EXP(S0, S1, 13); AT_SB(); \
        AT_VRD(va0, va1, 0); if (nx) { T0 = mfma32(kb0, qf[5], T0); T1 = mfma32(kb1, qf[5], T1); } AT_EXP(S0, S1, 14); AT_EXP(S0, S1, 15); \
        bf16x8 pf0 = pack8(S0[0], S0[1], S0[2], S0[3], S0[4], S0[5], S0[6], S0[7]), pf1 = pack8(S0[8], S0[9], S0[10], S0[11], S0[12], S0[13], S0[14], S0[15]); AT_SB(); \
          \
        float x0, x1, x2, x3; \
        AT_VRD(vb0, vb1, 1); O0 = mfma32(va0, pf0, O0); O1 = mfma32(va1, pf0, O1); \
        bf16x8 pf2 = pack8(S1[0], S1[1], S1[2], S1[3], S1[4], S1[5], S1[6], S1[7]), pf3 = pack8(S1[8], S1[9], S1[10], S1[11], S1[12], S1[13], S1[14], S1[15]); \
        float sum = s0 + s1; sum += __shfl_xor(sum, 32); l += sum; AT_SB(); \
        AT_VRD(va0, va1, 2); O0 = mfma32(vb0, pf1, O0); O1 = mfma32(vb1, pf1, O1); \
        x0 = fmaxf(fmaxf(T0[0], T0[1]), fmaxf(T0[2], T0[3])); x1 = fmaxf(fmaxf(T0[4], T0[5]), fmaxf(T0[6], T0[7])); x0 = fmaxf(x0, fmaxf(fmaxf(T0[8], T0[9]), fmaxf(T0[10], T0[11]))); x1 = fmaxf(x1, fmaxf(fmaxf(T0[12], T0[13]), fmaxf(T0[14], T0[15]))); AT_SB(); \
        AT_VRD(vb0, vb1, 3); O0 = mfma32(va0, pf2, O0); O1 = mfma32(va1, pf2, O1); \
        x2 = fmaxf(fmaxf(T1[0], T1[1]), fmaxf(T1[2], T1[3])); x3 = fmaxf(fmaxf(T1[4], T1[5]), fmaxf(T1[6], T1[7])); x2 = fmaxf(x2, fmaxf(fmaxf(T1[8], T1[9]), fmaxf(T1[10], T1[11]))); x3 = fmaxf(x3, fmaxf(fmaxf(T1[12], T1[13]), fmaxf(T1[14], T1[15]))); AT_SB(); \
        O0 = mfma32(vb0, pf3, O0); O1 = mfma32(vb1, pf3, O1); \
        if (nx) { float mx = fmaxf(fmaxf(x0, x1), fmaxf(x2, x3)); mx = fmaxf(mx, __shfl_xor(mx, 32)); \
            if (__any(mx > m + 8.f)) { const float mn = fmaxf(m, mx), alpha = __builtin_amdgcn_exp2f(m - mn); m = mn; l *= alpha; \
                _Pragma("unroll") for (int r = 0; r < 16; ++r) { O0[r] *= alpha; O1[r] *= alpha; } } \
            *(LAS u32x4*)(L + 2 * AT_KB + ((j_ + 1) & 1) * AT_VB + (vlds - 2 * AT_KB)) = sv; \
            if (nx2) { LAS unsigned char* Kn = L + (j_ & 1) * AT_KB; *(LAS u32x4*)(Kn + klds0) = sk0; if (k2) *(LAS u32x4*)(Kn + klds1) = sk1; } } \
        __syncthreads(); } while (0)
#pragma unroll 1
    for (int j = 0; j < ntile - 2; j += 2) { AT_TILE(SA0, SA1, SB0, SB1, j, true); AT_TILE(SB0, SB1, SA0, SA1, j + 1, true); }
    AT_TILE(SA0, SA1, SB0, SB1, ntile - 2, true); AT_TILE(SB0, SB1, SA0, SA1, ntile - 1, false);
#undef AT_TILE
#undef AT_EXP
#undef AT_KRD
#undef AT_VRD
#undef AT_SB
    const float inv = 1.f / l;
    bf16* Y = (bf16*)(F.ws + WS_YAT) + (size_t)qrow * 256 + h * 64;
#pragma unroll
    for (int g = 0; g < 4; ++g) {
        u32x2 w0, w1; w0.x = pk2(O0[4 * g] * inv, O0[4 * g + 1] * inv); w0.y = pk2(O0[4 * g + 2] * inv, O0[4 * g + 3] * inv);
        w1.x = pk2(O1[4 * g] * inv, O1[4 * g + 1] * inv); w1.y = pk2(O1[4 * g + 2] * inv, O1[4 * g + 3] * inv);
        *(u32x2*)(Y + 8 * g + 4 * hi) = w0; *(u32x2*)(Y + 32 + 8 * g + 4 * hi) = w1; }
}

__device__ __forceinline__ float filt_inv_norm(const Frame& F, int set, int ntile, int o, int c) {
    const float* fsp = (const float*)(F.ws + WS_FS) + (size_t)set * 128 * 1024 + o * 512 + c;
    float s = 0.f;
    for (int t = F.lane; t < ntile; t += 64) s += fsp[(size_t)t * 1024] + fsp[(size_t)t * 1024 + 256];
    return 1.f / wave_sum(s);
}
constexpr int HY_UROW = 4384, HY_UB = 8 * HY_UROW * 2, HY_G0 = HY_UB, HY_G1 = HY_G0 + GLEN * 2 + 64;
static_assert((HY_G0 / 4) % 32 == 0 && (HY_G1 / 4) % 32 == 16, "G copies on opposite bank halves");
__device__ __forceinline__ bf16x8 lds_rd8_a4(const LAS unsigned char* p) { const LAS unsigned* q = (const LAS unsigned*)p; u32x4 w; w.x = q[0]; w.y = q[1]; w.z = q[2]; w.w = q[3]; return __builtin_bit_cast(bf16x8, w); }
__device__ __forceinline__ void hyena_unit(const Frame& F, KArgs a, int layer, int c) {
    LAS unsigned char* L = F.lds; LAS bf16* U = (LAS bf16*)L;
    bf16* hyT = (bf16*)(F.ws + WS_HYT);
    const float* sw = a->in[I_HSW] + (size_t)layer * 3 * 768; const float* sb = a->in[I_HSB] + layer * 768;
    const int lane = F.lane, w = F.wave, hi = lane >> 5, l31 = lane & 31;
    __syncthreads();
    {
        const bf16* vrow = hyT + (size_t)(512 + c) * NTOK; const float w0 = sw[512 + c], w1 = sw[768 + 512 + c], w2 = sw[1536 + 512 + c], bb = sb[512 + c];
        for (int i = F.tid; i < 8 * 512; i += 512) { const int b = i >> 9, t0 = (i & 511) * 8; const bf16* p = vrow + b * 4096 + t0; const u32x4 x = *(const u32x4*)p;
            float v[10]; v[0] = t0 > 0 ? bf2f(p[-1]) : 0.f; v[9] = t0 + 8 < 4096 ? bf2f(p[8]) : 0.f;
            v[1] = lo_bf(x.x); v[2] = hi_bf(x.x); v[3] = lo_bf(x.y); v[4] = hi_bf(x.y); v[5] = lo_bf(x.z); v[6] = hi_bf(x.z); v[7] = lo_bf(x.w); v[8] = hi_bf(x.w);
            float o[8];
#pragma unroll
            for (int k = 0; k < 8; ++k) o[k] = w0 * v[k] + w1 * v[k + 1] + w2 * v[k + 2] + bb;
            u32x4 ww; ww.x = pk2(o[0], o[1]); ww.y = pk2(o[2], o[3]); ww.z = pk2(o[4], o[5]); ww.w = pk2(o[6], o[7]);
            *(LAS u32x4*)(U + b * HY_UROW + t0 + 8 * (t0 >> 7)) = ww; }
    }
    const int sel = l31 & 1;
    const int abase = (sel ? HY_G1 : HY_G0) + (GC - l31 + 8 * hi + sel) * 2;
    const int nb = l31 & 7, qq = l31 >> 3, qsb = 16 * w + 4 * qq;
    const int ubase = (nb * HY_UROW + 8 * hi) * 2;
#pragma unroll 1
    for (int o = 0; o < 2; ++o) {
        {
            const bf16* Gg = (const bf16*)(F.ws + WS_G) + ((size_t)(layer * 2 + o) * 256 + c) * GLEN;
            for (int i = F.tid; i < GLEN / 8; i += 512) { u32x4 x = *(const u32x4*)(Gg + i * 8);
                if (i < 5 || i >= 1027) { const int m0 = i * 8; unsigned* xp = (unsigned*)&x;
#pragma unroll
                    for (int k = 0; k < 4; ++k) { const int ma = m0 + 2 * k, mb = ma + 1; unsigned v = xp[k]; if (ma < 33 || ma > 8223) v &= 0xffff0000u; if (mb < 33 || mb > 8223) v &= 0x0000ffffu; xp[k] = v; } }
                *(LAS u32x4*)(L + HY_G0 + i * 16) = x; }
            __syncthreads();
            const LAS unsigned* g0 = (const LAS unsigned*)(L + HY_G0); LAS unsigned* g1 = (LAS unsigned*)(L + HY_G1);
            for (int i = F.tid; i <= GLEN / 2; i += 512) { const unsigned dp = i > 0 ? g0[i - 1] : 0u, d = i < GLEN / 2 ? g0[i] : 0u; g1[i] = (dp >> 16) | (d << 16); }
            __syncthreads();
        }
        f32x16 acc[4];
#pragma unroll
        for (int j = 0; j < 4; ++j)
#pragma unroll
            for (int r = 0; r < 16; ++r) acc[j][r] = 0.f;
        bf16x8 A[4][2];
        const int e0 = 16 * w - 127;
#define HY_LOADA(slot, delta) do { const LAS unsigned char* _p = L + abase - 64 * (delta); A[slot][0] = lds_rd8_a4(_p); A[slot][1] = lds_rd8_a4(_p + 32); } while (0)
        HY_LOADA(0, e0); HY_LOADA(1, e0 + 1); HY_LOADA(2, e0 + 2);
#define HY_STEP(g) do { const int e = eb + (g); const int qs = qsb - e; const bool ok = (unsigned)qs < 128u; const int qc = qs < 0 ? 0 : (qs > 127 ? 127 : qs); \
            const LAS unsigned char* _u = L + ubase + (32 * qc + 8 * (qc >> 2)) * 2; bf16x8 f0 = *(const LAS bf16x8*)_u, f1 = *(const LAS bf16x8*)(_u + 32); \
            if (!ok) { f0 = (bf16x8){0, 0, 0, 0, 0, 0, 0, 0}; f1 = f0; } \
            HY_LOADA(((g) + 3) & 3, e + 3); \
            _Pragma("unroll") for (int j = 0; j < 4; ++j) { acc[j] = mfma32(A[((g) + j) & 3][0], f0, acc[j]); acc[j] = mfma32(A[((g) + j) & 3][1], f1, acc[j]); } } while (0)
#pragma unroll 1
        for (int eb = e0; eb < e0 + 140; eb += 4) { HY_STEP(0); HY_STEP(1); HY_STEP(2); HY_STEP(3); }
#undef HY_STEP
#undef HY_LOADA
        __syncthreads();
        const float inv = filt_inv_norm(F, layer, 128, o, c);
        const float hb = a->in[I_HBIAS][(size_t)(layer * 2 + o) * 256 + c];
        const int gcol = o == 0 ? c : 256 + c; const bf16* grow = hyT + (size_t)gcol * NTOK + nb * 4096;
        const float w0 = sw[gcol], w1 = sw[768 + gcol], w2 = sw[1536 + gcol], bb = sb[gcol];
        bf16* yrow = (bf16*)(F.ws + WS_YT) + (size_t)c * NTOK + nb * 4096;
#pragma unroll
        for (int j = 0; j < 4; ++j) { const int q = 16 * w + 4 * qq + j;
#pragma unroll
            for (int g4 = 0; g4 < 4; ++g4) { const int t = 32 * q + 8 * g4 + 4 * hi; const bf16* p = grow + t; const u32x2 x = *(const u32x2*)p;
                float v[6]; v[0] = t > 0 ? bf2f(p[-1]) : 0.f; v[5] = t + 4 < 4096 ? bf2f(p[4]) : 0.f; v[1] = lo_bf(x.x); v[2] = hi_bf(x.x); v[3] = lo_bf(x.y); v[4] = hi_bf(x.y);
                LAS bf16* up = U + nb * HY_UROW + t + 8 * (t >> 7); const u32x2 uu = *(const LAS u32x2*)up;
                const float u0 = lo_bf(uu.x), u1 = hi_bf(uu.x), u2 = lo_bf(uu.y), u3 = hi_bf(uu.y);
                const float y0 = (w0 * v[0] + w1 * v[1] + w2 * v[2] + bb) * (acc[j][4 * g4] * inv + hb * u0);
                const float y1 = (w0 * v[1] + w1 * v[2] + w2 * v[3] + bb) * (acc[j][4 * g4 + 1] * inv + hb * u1);
                const float y2 = (w0 * v[2] + w1 * v[3] + w2 * v[4] + bb) * (acc[j][4 * g4 + 2] * inv + hb * u2);
                const float y3 = (w0 * v[3] + w1 * v[4] + w2 * v[5] + bb) * (acc[j][4 * g4 + 3] * inv + hb * u3);
                u32x2 wv; wv.x = pk2(y0, y1); wv.y = pk2(y2, y3);
                if (o == 0) *(LAS u32x2*)up = wv; else *(u32x2*)(yrow + t) = wv; } }
        __syncthreads();
    }
}

__device__ __forceinline__ void hyena_ctx_unit(const Frame& F, KArgs a, int c) {
    LAS float* u = (LAS float*)F.lds;
    LAS float* y1 = u + 2048;
    LAS float* T = y1 + 2048;
    bf16* hyT = (bf16*)(F.ws + WS_HYT);
    const float* sw = a->in[I_HSW]; const float* sb = a->in[I_HSB];
    __syncthreads();
    for (int i = F.tid; i < 1024; i += 512) T[i] = ((const float*)(F.ws + WS_TC))[((size_t)(i >> 9) * 256 + c) * 512 + (i & 511)];
    if (F.tid < 2) T[F.tid * 512] = 0.f;
    {
        const bf16* vrow = hyT + (size_t)(512 + c) * NTOK + NLAT; const float w0 = sw[512 + c], w1 = sw[768 + 512 + c], w2 = sw[1536 + 512 + c], bb = sb[512 + c];
        for (int i = F.tid; i < 2048; i += 512) { const int t = i & 255; const float vm = t > 0 ? bf2f(vrow[i - 1]) : 0.f, v0 = bf2f(vrow[i]), vp = t < 255 ? bf2f(vrow[i + 1]) : 0.f; u[i] = w0 * vm + w1 * v0 + w2 * vp + bb; }
    }
    __syncthreads();
#pragma unroll 1
    for (int o = 0; o < 2; ++o) {
        const LAS float* in = o == 0 ? u : y1; const float inv = filt_inv_norm(F, 2, 8, o, c); const float hb = a->in[I_HBIAS][(size_t)o * 256 + c];
        const int gcol = o == 0 ? c : 256 + c; const bf16* grow = hyT + (size_t)gcol * NTOK + NLAT; const float w0 = sw[gcol], w1 = sw[768 + gcol], w2 = sw[1536 + gcol], bb = sb[gcol];
        for (int i = F.tid; i < 2048; i += 512) { const int b = i >> 8, t = i & 255; float s = 0.f;
            for (int sidx = 0; sidx < 256; ++sidx) s += T[o * 512 + 256 + t - sidx] * in[b * 256 + sidx];
            const float gm = t > 0 ? bf2f(grow[i - 1]) : 0.f, g0 = bf2f(grow[i]), gp = t < 255 ? bf2f(grow[i + 1]) : 0.f;
            const float y = (w0 * gm + w1 * g0 + w2 * gp + bb) * (s * inv + hb * in[i]);
            if (o == 0) y1[i] = y; else ((bf16*)(F.ws + WS_YT))[(size_t)c * NTOK + NLAT + i] = (bf16)f2bf(y); }
        __syncthreads();
    }
}

__device__ __forceinline__ void p5_unit(const Frame& F, KArgs a, int layer, int r0) {
    LAS bf16* T = (LAS bf16*)F.lds;
    const bf16* yT = (const bf16*)(F.ws + WS_YT); const bf16* yat = (const bf16*)(F.ws + WS_YAT); bf16* Y = (bf16*)(F.ws + WS_H);
    const float* mg = a->in[I_MIXG] + layer * 1024;
    __syncthreads();
    for (int i = F.tid; i < 1024; i += 512) { const int c = i >> 2, q = i & 3; *(LAS u32x4*)(T + c * 40 + q * 8) = *(const u32x4*)(yT + (size_t)c * NTOK + r0 + q * 8); }
    __syncthreads();
    for (int r = F.wave; r < 32; r += 8) {
        f32x4 v; v.x = bf2f(T[(4 * F.lane) * 40 + r]); v.y = bf2f(T[(4 * F.lane + 1) * 40 + r]); v.z = bf2f(T[(4 * F.lane + 2) * 40 + r]); v.w = bf2f(T[(4 * F.lane + 3) * 40 + r]);
        float rn = 1.f / sqrtf(wave_sum((v.x * v.x + v.y * v.y) + (v.z * v.z + v.w * v.w)) * (1.f / 256.f) + EPS);
        f32x4 m4 = *(const f32x4*)(mg + 4 * F.lane); f32x4 y = v * rn * m4; u32x2 w; w.x = pk2(y.x, y.y); w.y = pk2(y.z, y.w);
        *(u32x2*)(Y + (size_t)(r0 + r) * 1024 + 4 * F.lane) = w;
        bf16* ya = Y + (size_t)(r0 + r) * 1024 + 768 + 4 * F.lane; const u32x2 x = *(const u32x2*)(yat + (size_t)(r0 + r) * 256 + 4 * F.lane);
        v.x = lo_bf(x.x); v.y = hi_bf(x.x); v.z = lo_bf(x.y); v.w = hi_bf(x.y);
        rn = 1.f / sqrtf(wave_sum((v.x * v.x + v.y * v.y) + (v.z * v.z + v.w * v.w)) * (1.f / 256.f) + EPS);
        m4 = *(const f32x4*)(mg + 768 + 4 * F.lane); y = v * rn * m4; w.x = pk2(y.x, y.y); w.y = pk2(y.z, y.w); *(u32x2*)ya = w;
    }
}
#ifndef MK_DUP
#define MK_DUP 0u
#endif
#define DUPN(k) (((MK_DUP >> (k)) & 1u) ? 2 : 1)
#ifndef MK_PHASES
#define MK_PHASES 0xFFFFFu
#endif
template <int LAYER>
__device__ __forceinline__ void layer_phases(Frame F, const XcdBarrier& bar, int lo, int hi) {
    constexpr int PB = 1 + 9 * LAYER;
    unsigned char* ws = F.ws;
    const float* modl = (const float*)(ws + WS_MOD) + (size_t)LAYER * 9 * 6144;
    float* xc = (float*)(ws + WS_XC);
#define IN(k) (((MK_PHASES >> (k)) & 1u) && lo <= (k) && (k) < hi)
#define SEAM(k) do { if (IN(k) && IN((k) + 1)) xcd_barrier(bar); } while (0)
#define BODY_P1 { if (LAYER == 0) p1_norm(F, kargs(), 0, kargs()->in[I_X], kargs()->in[I_CTX]); else p1_norm(F, kargs(), 1, kargs()->out, xc); }
    relaunder(F);
    if (IN(PB + 0)) { BODY_P1 if (DUPN(0) == 2) BODY_P1 }
    SEAM(PB + 0);
#define BODY_P2 { OpIn op{(const bf16*)(ws + WS_H), (const bf16*)(ws + WS_WIN) + (size_t)LAYER * NIN_PAD * 1024, (bf16*)(ws + WS_PROJ), (bf16*)(ws + WS_HYT), LAYER, F.G, F.vcu}; \
        pg8::gemm_phase<OpIn, true>(F.lds, op, 1024); }
    relaunder(F);
    if (IN(PB + 1)) { BODY_P2 if (DUPN(1) == 2) BODY_P2 }
    SEAM(PB + 1);
    relaunder(F);
    if (IN(PB + 2)) for (int rep = 0; rep < DUPN(2); ++rep) {
        constexpr int NGM = LAYER == 0 ? NTOK / 128 : NLAT / 128, NCV = LAYER == 0 ? NTOK / 64 : NLAT / 64, NML = NTOK / 64;
        for (int u = F.vcu; u < NGM + NCV + NML; u += F.G) {
            if (u < NGM) { for (int r2 = 0; r2 < DUPN(22); ++r2) p3_gmlp_unit(F, kargs(), LAYER, u * 128); }
            else if (u < NGM + NCV) { for (int r2 = 0; r2 < DUPN(23); ++r2) p3_conv_unit(F, kargs(), LAYER, (u - NGM) * 64); }
            else { for (int r2 = 0; r2 < DUPN(24); ++r2) p3_mla_unit(F, kargs(), LAYER, (u - NGM - NCV) * 64); }
        }
    }
    SEAM(PB + 2);
    relaunder(F);
    if (IN(PB + 3)) {
        constexpr int NU = LAYER == 0 ? 256 + 512 + 32 + 256 : 256 + 512;
        for (int u = F.vcu; u < NU; u += F.G) {
            if (u < 256) { for (int rep = 0; rep < DUPN(17); ++rep) hyena_unit(F, kargs(), LAYER, u); }
            else if (u < 768) { const int id = u - 256; for (int rep = 0; rep < DUPN(16); ++rep) attn_unit(F, id >> 6, (id >> 4) & 3, (id >> 6) * 4096 + (id & 15) * 256, 0, NKEY / 64); }
            else if (u < 800) { const int id = u - 768; attn_unit(F, id >> 2, id & 3, NLAT + (id >> 2) * 256, 4096, 4); }
            else hyena_ctx_unit(F, kargs(), u - 800);
        }
    }
    SEAM(PB + 3);
    relaunder(F);
    if (IN(PB + 4)) for (int rep = 0; rep < DUPN(4); ++rep) {
        constexpr int NU = (LAYER == 0 ? NTOK : NLAT) / 32;
        for (int u = F.vcu; u < NU; u += F.G) p5_unit(F, kargs(), LAYER, u * 32);
    }
    SEAM(PB + 4);
    relaunder(F);
    if (IN(PB + 5)) {
        OpOut op{(const bf16*)(ws + WS_H), (const bf16*)(ws + WS_WOUT) + (size_t)LAYER * 1024 * 1024, LAYER == 0 ? kargs()->in[I_X] : kargs()->out, LAYER == 0 ? kargs()->in[I_CTX] : xc, kargs()->out, xc, modl, LAYER, F.G, F.vcu, 1.f};
        pg8::gemm_phase<OpOut, true>(F.lds, op, 1024);
        if (DUPN(5) == 2) { OpOut op2{(const bf16*)(ws + WS_H), (const bf16*)(ws + WS_WOUT) + (size_t)LAYER * 1024 * 1024, kargs()->out, xc, kargs()->out, xc, modl, LAYER, F.G, F.vcu, 0.f}; pg8::gemm_phase<OpOut, true>(F.lds, op2, 1024); }
    }
    SEAM(PB + 5);
    relaunder(F);
    if (IN(PB + 6)) for (int rep = 0; rep < DUPN(6); ++rep) p7_router(F, kargs(), LAYER, kargs()->out, xc, LAYER == 0 ? NTOK : NLAT, rep > 0);
    SEAM(PB + 6);
    LAS int* tab = (LAS int*)(F.lds + 131072 + 4096);
    relaunder(F);
    if (IN(PB + 7) || IN(PB + 8)) {
        __syncthreads();
        if (F.tid == 0) { int acc = 0; for (int k = 0; k < NBUCKET; ++k) { const int c = (int)__hip_atomic_load(F.ctl + CW_CNT + LAYER * 32 + k, __ATOMIC_RELAXED, __HIP_MEMORY_SCOPE_AGENT); tab[k] = acc; tab[32 + k] = c; acc += (c + 255) >> 8; } tab[NBUCKET] = acc; }
        __syncthreads();
    }
#define BODY_P8 { OpMoe1 op{(const bf16*)(ws + WS_H), (const bf16*)(ws + WS_W1), (bf16*)(ws + WS_PROJ), (const int*)(ws + WS_TOK), (const float*)(ws + WS_WLO), (const float*)(ws + WS_WHI), tab, LAYER, F.G, F.vcu}; \
        pg8::gemm_phase<OpMoe1, true>(F.lds, op, 1024); }
    relaunder(F);
    if (IN(PB + 7)) { BODY_P8 if (DUPN(7) == 2) BODY_P8 }
    SEAM(PB + 7);
    relaunder(F);
    if (IN(PB + 8)) {
        OpMoe2 op{(const bf16*)(ws + WS_PROJ), (const bf16*)(ws + WS_W2), kargs()->out, xc, modl, (const int*)(ws + WS_TOK), tab, LAYER, F.G, F.vcu, 1.f};
        pg8::gemm_phase<OpMoe2, true>(F.lds, op, 1024);
        if (DUPN(8) == 2) { OpMoe2 op2{(const bf16*)(ws + WS_PROJ), (const bf16*)(ws + WS_W2), kargs()->out, xc, modl, (const int*)(ws + WS_TOK), tab, LAYER, F.G, F.vcu, 0.f}; pg8::gemm_phase<OpMoe2, true>(F.lds, op2, 1024); }
    }
    SEAM(PB + 8);
#undef IN
#undef SEAM
}

constexpr int N_PHASES = 20;
__global__ void __launch_bounds__(512, 2) mk_fwd(Args a_) {
    extern __shared__ __attribute__((aligned(16))) unsigned char lds_raw[];
    Frame F;
    F.lds = (LAS unsigned char*)lds_raw; F.ws = a_.ws; F.ctl = (unsigned*)(a_.ws + WS_CTL);
    F.tid = threadIdx.x; F.lane = F.tid & 63; F.wave = __builtin_amdgcn_readfirstlane(F.tid >> 6);
    F.G = gridDim.x; { const int bx = blockIdx.x; F.vcu = (F.G % 8 == 0) ? (bx % 8) * (F.G / 8) + bx / 8 : bx; }
    F.gw = F.vcu * 8 + F.wave; F.NGW = F.G * 8;
    volatile LAS unsigned* misc = (volatile LAS unsigned*)(F.lds + LDS_MISC);
    if (F.tid < 64) misc[F.tid] = 0u;
    __syncthreads();
    const int lo = a_.ph_lo, hi = a_.ph_hi;
    XcdBarrier bar; bar.bar = F.ctl + CW_BAR; bar.x = 0; bar.st = misc;
    if (hi - lo > 1) bar = xcd_barrier_post(F.ctl + CW_BAR, misc);
    if ((MK_PHASES & 1u) && lo <= 0 && 0 < hi) { p0_all(F, kargs());
        if (hi > 1) xcd_barrier(bar); }
    layer_phases<0>(F, bar, lo, hi);
    layer_phases<1>(F, bar, lo, hi);
    relaunder(F);
    if (((MK_PHASES >> 19) & 1u) && lo <= 19 && 19 < hi) p_final(F, kargs());
}

#ifndef MK_SPLIT
#define MK_SPLIT 0
#endif
extern "C" void kernel_launch(void* const* d_in, const int* in_sizes, int n_in, void* d_out, int out_size, void* d_ws, size_t ws_size, hipStream_t stream) {
    static int grid = 0;
    if (grid == 0) {
        if (n_in != 38 || out_size != NLAT * 1024 || ws_size < WS_END) { fprintf(stderr, "kernel_launch: unexpected shapes (n_in %d out %d ws %zu, need %zu)\n", n_in, out_size, ws_size, (size_t)WS_END); grid = -1; return; }
        int dev = 0, cus = 0, per_cu = 0;
        hipGetDevice(&dev); hipDeviceGetAttribute(&cus, hipDeviceAttributeMultiprocessorCount, dev);
        if (hipFuncSetAttribute((const void*)mk_fwd, hipFuncAttributeMaxDynamicSharedMemorySize, LDS_BYTES) != hipSuccess) { fprintf(stderr, "kernel_launch: hipFuncSetAttribute failed\n"); grid = -1; return; }
        if (hipOccupancyMaxActiveBlocksPerMultiprocessor(&per_cu, (const void*)mk_fwd, 512, LDS_BYTES) != hipSuccess || per_cu < 1) { fprintf(stderr, "kernel_launch: occupancy query says %d\n", per_cu); }
        (void)hipGetLastError();
        grid = cus;
    }
    if (grid < 0) return;
    hipMemsetAsync((char*)d_ws + WS_CTL, 0, CTL_BYTES, stream);
    Args a{};
    for (int i = 0; i < 38; ++i) a.in[i] = (const float*)d_in[i];
    a.out = (float*)d_out; a.ws = (unsigned char*)d_ws;
#if MK_SPLIT
    for (int p = 0; p < N_PHASES; ++p) { a.ph_lo = p; a.ph_hi = p + 1; hipLaunchKernelGGL(mk_fwd, dim3(grid), dim3(512), LDS_BYTES, stream, a); }
#else
    a.ph_lo = 0; a.ph_hi = N_PHASES; hipLaunchKernelGGL(mk_fwd, dim3(grid), dim3(512), LDS_BYTES, stream, a);
#endif
}
```

```cpp
#include <hip/hip_runtime.h>
#include <cstdio>
#include <cstdint>
#include <cmath>

#define LAS __attribute__((address_space(3)))
#define GAS __attribute__((address_space(1)))
typedef unsigned short bf16;
typedef short bf16x8 __attribute__((ext_vector_type(8)));
typedef short bf16x4 __attribute__((ext_vector_type(4)));
typedef float f32x4 __attribute__((ext_vector_type(4)));
typedef float f32x2 __attribute__((ext_vector_type(2)));
typedef float f32x16 __attribute__((ext_vector_type(16)));
typedef unsigned u32x4 __attribute__((ext_vector_type(4)));
typedef unsigned u32x2 __attribute__((ext_vector_type(2)));

constexpr int NB = 8, SEQ = 4096, CTXL = 256, DM = 1024, DEPTH = 2;
constexpr int NLAT = NB * SEQ, NCTX = NB * CTXL, NTOK = NLAT + NCTX;
constexpr int IN_COLS = 2144, NIN_PAD = 2304;
constexpr int HY_OFF = 0, GM_OFF = 768, CV_OFF = 1280, MQ_OFF = 1792, MKV_OFF = 1984;
constexpr int PROJ_LD = 1536;
constexpr int PJ_GM = 0, PJ_CV = 512, PJ_MKV = 1024, PJ_MQ = 1184;
constexpr int NKEY = SEQ + CTXL;
constexpr int NEXP = 16, DEXP = 512, NBUCKET = 24;
constexpr int A_ROWS = 41216;
constexpr float EPS = 1e-6f;
constexpr int GC = 4128, GLEN = 8256;
constexpr float QSCALE = 0.10206207261596577f * 1.4426950408889634f;

constexpr size_t al256(size_t x) { return (x + 255) & ~(size_t)255; }
constexpr size_t WS_CTL = 0, CTL_BYTES = 1u << 20;
constexpr size_t WS_MOD = WS_CTL + CTL_BYTES;
constexpr size_t WS_ROPE = al256(WS_MOD + (size_t)2 * 9 * 6144 * 4);
constexpr size_t WS_WIN = al256(WS_ROPE + (size_t)2 * 4096 * 16 * 4);
constexpr size_t WS_WOUT = al256(WS_WIN + (size_t)2 * NIN_PAD * 1024 * 2);
constexpr size_t WS_W1 = al256(WS_WOUT + (size_t)2 * 1024 * 1024 * 2);
constexpr size_t WS_W2 = al256(WS_W1 + (size_t)2 * 16 * 1024 * 1024 * 2);
constexpr size_t WS_WUQ = al256(WS_W2 + (size_t)2 * 16 * 1024 * 512 * 2);
constexpr size_t WS_WUKV = al256(WS_WUQ + (size_t)2 * 384 * 192 * 2);
constexpr size_t WS_GMWS = al256(WS_WUKV + (size_t)2 * 512 * 128 * 2);
constexpr size_t WS_G = al256(WS_GMWS + (size_t)2 * 4 * 128 * 128 * 2);
constexpr size_t WS_TC = al256(WS_G + (size_t)2 * 2 * 256 * GLEN * 2);
constexpr size_t WS_H = al256(WS_TC + (size_t)2 * 256 * 512 * 4);
constexpr size_t WS_PROJ = al256(WS_H + (size_t)NTOK * 1024 * 2);
constexpr size_t WS_HYT = al256(WS_PROJ + (size_t)NTOK * PROJ_LD * 2);
constexpr size_t WS_Q = al256(WS_HYT + (size_t)768 * NTOK * 2);
constexpr size_t WS_K = al256(WS_Q + (size_t)NTOK * 384 * 2);
constexpr size_t WS_VT = al256(WS_K + (size_t)NB * 4 * NKEY * 96 * 2);
constexpr size_t WS_TOK = al256(WS_VT + (size_t)NB * 4 * 64 * NKEY * 2);
constexpr size_t WS_WLO = al256(WS_TOK + (size_t)NBUCKET * NTOK * 4);
constexpr size_t WS_WHI = al256(WS_WLO + (size_t)NBUCKET * NTOK * 4);
constexpr size_t WS_YT = WS_PROJ;
constexpr size_t WS_YAT = al256(WS_YT + (size_t)256 * NTOK * 2);
static_assert(WS_YAT + (size_t)NTOK * 256 * 2 <= WS_PROJ + (size_t)NTOK * PROJ_LD * 2, "yt/yat overlay");
constexpr size_t WS_FS = al256(WS_WHI + (size_t)NBUCKET * NTOK * 4);
constexpr size_t WS_POS = al256(WS_FS + (size_t)3 * 128 * 1024 * 4);
constexpr size_t WS_XB = al256(WS_POS + (size_t)NTOK * 4);
constexpr size_t WS_END = al256(WS_XB + (size_t)NTOK * 1024 * 2);
constexpr size_t WS_YM = WS_HYT;
static_assert(WS_YM + (size_t)A_ROWS * 1024 * 2 <= WS_VT, "ym overlay");
static_assert((size_t)A_ROWS * 1024 * 2 <= (size_t)NTOK * PROJ_LD * 2, "a overlays proj");
static_assert(WS_END <= (size_t)512 * 1024 * 1024, "workspace");
constexpr int CW_BAR = 1024;
constexpr int CW_CNT = 8192;
constexpr int CW_P0Q = 8192 + 128;
constexpr int CW_DQ = 8192 + 192;
constexpr int CW_P3Q = 8192 + 320;
constexpr int CW_TMO = 8192 + 256;
constexpr int CW_RDY = 16384;

constexpr int LDS_BYTES = 160 * 1024;
constexpr int LDS_MISC = 131072 + 28672;

__device__ __forceinline__ float bf2f(bf16 v) { return __builtin_bit_cast(float, (unsigned)v << 16); }
typedef __bf16 hw_bf16x2 __attribute__((ext_vector_type(2)));
__device__ __forceinline__ unsigned pk2(float lo, float hi) { const f32x2 v = {lo, hi}; const hw_bf16x2 b = __builtin_convertvector(v, hw_bf16x2); return __builtin_bit_cast(unsigned, b); }
__device__ __forceinline__ unsigned f2bf(float f) { return pk2(f, 0.f) & 0xffffu; }
__device__ __forceinline__ float lo_bf(unsigned w) { return __builtin_bit_cast(float, w << 16); }
__device__ __forceinline__ float hi_bf(unsigned w) { return __builtin_bit_cast(float, w & 0xffff0000u); }
template <int CTRL> __device__ __forceinline__ float dpp_f(float v) { return __builtin_bit_cast(float, __builtin_amdgcn_update_dpp(0, __builtin_bit_cast(int, v), CTRL, 0xF, 0xF, true)); }
__device__ __forceinline__ float xsum_step(float v, int o) {
    switch (o) { case 1: return v + dpp_f<0xB1>(v); case 2: return v + dpp_f<0x4E>(v); case 4: return v + dpp_f<0x141>(v); case 8: return v + dpp_f<0x140>(v); default: return v + __shfl_xor(v, o); }
}
__device__ __forceinline__ float wave_sum(float v) {
#pragma unroll
    for (int o = 1; o < 64; o <<= 1) v = xsum_step(v, o);
    return v;
}
__device__ __forceinline__ float frsq(float x) { return __builtin_amdgcn_rsqf(x); }
__device__ __forceinline__ float siluf(float x) { return x * __builtin_amdgcn_rcpf(1.f + __expf(-x)); }
__device__ __forceinline__ float sigmf(float x) { return __builtin_amdgcn_rcpf(1.f + __expf(-x)); }
__device__ __forceinline__ float gelu_tanh(float x) { constexpr float K0 = -2.3022081967f, K1 = -2.3022081967f * 0.044715f; const float q = x * __builtin_fmaf(x * x, K1, K0); return x * __builtin_amdgcn_rcpf(1.f + __builtin_amdgcn_exp2f(q)); }
__device__ __forceinline__ int mod_idx(int r) { return r < NLAT ? (r >> 12) : 8; }

#define XB_TMO      128
#define XB_XCNT(j)  (256  + 64 * (j))
#define XB_XSUB(j)  (1280 + 64 * (j))
#define XB_XGEN(j)  (2304 + 64 * (j))
#define XB_TOP      3328
#define XB_TOPGEN   3392
#define XCD_BAR_WORDS 3456
#define XB_SPIN_CAP (1u << 22)
__device__ __forceinline__ unsigned xb_ld(unsigned* p)              { return __hip_atomic_load(p, __ATOMIC_RELAXED, __HIP_MEMORY_SCOPE_AGENT); }
__device__ __forceinline__ unsigned xb_add(unsigned* p, unsigned v) { return __hip_atomic_fetch_add(p, v, __ATOMIC_RELAXED, __HIP_MEMORY_SCOPE_AGENT); }
__device__ __forceinline__ unsigned xb_xcc_id() { return (unsigned)__builtin_amdgcn_s_getreg((3 << 11) | 20) & 0xFu; }
#define XB_SPIN(cond, bar) do { unsigned _sp = 0; while (cond) { __builtin_amdgcn_s_sleep(1); \
    if ((++_sp & 255u) == 0u) { if (xb_ld(&(bar)[XB_TMO])) break; if (_sp > XB_SPIN_CAP) { atomicAdd(&(bar)[XB_TMO], 1u); break; } } } } while (0)
struct XcdBarrier { unsigned* bar; unsigned x; volatile LAS unsigned* st; };
__device__ __forceinline__ XcdBarrier xcd_barrier_post(unsigned* bar, volatile LAS unsigned* st) {
    XcdBarrier b; b.bar = bar; b.x = xb_xcc_id(); b.st = st;
    if (threadIdx.x == 0) (void)xb_add(&bar[XB_XCNT(b.x)], 1u);
    return b;
}
__device__ __forceinline__ void xcd_barrier_complete(unsigned* bar, unsigned x, unsigned& nloc, unsigned& nx) {
    const unsigned G = gridDim.x * gridDim.y * gridDim.z;
    unsigned sum, cnt, mine, sp = 0u;
    for (;;) {
        sum = 0u; cnt = 0u; mine = 0u;
#pragma unroll
        for (unsigned j = 0; j < 16; ++j) { const unsigned c = xb_ld(&bar[XB_XCNT(j)]); sum += c; cnt += (c > 0u) ? 1u : 0u; mine = (j == x) ? c : mine; }
        if (sum == G) break;
        __builtin_amdgcn_s_sleep(1);
        if ((++sp & 255u) == 0u) { if (xb_ld(&bar[XB_TMO])) break; if (sp > XB_SPIN_CAP) { atomicAdd(&bar[XB_TMO], 1u); break; } }
    }
    nloc = mine > 0u ? mine : 1u; nx = cnt > 0u ? cnt : 1u;
}
__device__ __forceinline__ void xcd_barrier(const XcdBarrier& b) {
    asm volatile("s_waitcnt vmcnt(0)" ::: "memory");
    __syncthreads();
    if (threadIdx.x == 0) {
        unsigned* bar = b.bar;
        __builtin_amdgcn_s_waitcnt(0);
        unsigned nloc = b.st[0], nx = b.st[1];
        if (nloc == 0u) { xcd_barrier_complete(bar, b.x, nloc, nx); b.st[0] = nloc; b.st[1] = nx; }
        const unsigned mygen = b.st[2]; b.st[2] = mygen + 1u;
        const unsigned old = xb_add(&bar[XB_XSUB(b.x)], 1u);
        const unsigned gen = old / nloc;
        if (old + 1u == (gen + 1u) * nloc) {
            __builtin_amdgcn_fence(__ATOMIC_RELEASE, "agent");
            asm volatile("s_waitcnt vmcnt(0)" ::: "memory");
            const unsigned og = xb_add(&bar[XB_TOP], 1u);
            const unsigned tg = og / nx;
            if (og + 1u == (tg + 1u) * nx) xb_add(&bar[XB_TOPGEN], 1u);
            else XB_SPIN(xb_ld(&bar[XB_TOPGEN]) == tg, bar);
            __builtin_amdgcn_fence(__ATOMIC_ACQUIRE, "agent");
            asm volatile("s_waitcnt vmcnt(0)" ::: "memory");
        } else {
            XB_SPIN(xb_ld(&bar[XB_TOPGEN]) == mygen, bar);
            __builtin_amdgcn_fence(__ATOMIC_ACQUIRE, "agent");
            asm volatile("s_waitcnt vmcnt(0)" ::: "memory");
        }
    }
    __syncthreads();
}

struct Args {
    const float* in[38]; float* out; unsigned char* ws; int ph_lo, ph_hi;
};
typedef const __attribute__((address_space(4))) Args* KArgs;
__device__ __forceinline__ KArgs kargs() { KArgs p = (KArgs)__builtin_amdgcn_kernarg_segment_ptr(); asm volatile("" : "+s"(p)); return p; }
struct Frame {
    LAS unsigned char* lds; unsigned char* ws; unsigned* ctl;
    int tid, lane, wave, G, vcu, gw, NGW;
};
__device__ __forceinline__ void relaunder(Frame& F) {
    int t = threadIdx.x; asm volatile("" : "+v"(t));
    F.tid = t; F.lane = t & 63; F.wave = __builtin_amdgcn_readfirstlane(t >> 6); F.gw = F.vcu * 8 + F.wave;
}
enum { I_X = 0, I_C, I_CTX, I_CCTX, I_ADAW, I_ADAB, I_N1G, I_N2G, I_WIN, I_HSW, I_HSB, I_HFW1, I_HFB1, I_HFFREQ, I_HFW2, I_HFB2, I_HFW3, I_HBIAS,
       I_GMLNG, I_GMLNB, I_GMWS, I_GMBS, I_CVW, I_CVB, I_CVLNG, I_CVLNB, I_QANORM, I_WUQ, I_KVANORM, I_WUKV, I_MIXG, I_WOUT, I_WROUTER, I_RBIAS,
       I_EWG, I_EWU, I_EWD, I_FNG };

__device__ __forceinline__ f32x4 mfma16(bf16x8 a, bf16x8 b, f32x4 c) { return __builtin_amdgcn_mfma_f32_16x16x32_bf16(a, b, c, 0, 0, 0); }
__device__ __forceinline__ __amdgpu_buffer_rsrc_t wt_rsrc(const void* base, size_t bytes) { return __builtin_amdgcn_make_buffer_rsrc((void*)base, 0, (int)bytes, 0x00020000); }
__device__ __forceinline__ void wt_st128(__amdgpu_buffer_rsrc_t rs, unsigned byteoff, u32x4 v) { __builtin_amdgcn_raw_buffer_store_b128(v, rs, (int)byteoff, 0, 16); }
__device__ __forceinline__ void wt_st64(__amdgpu_buffer_rsrc_t rs, unsigned byteoff, u32x2 v) { __builtin_amdgcn_raw_buffer_store_b64(v, rs, (int)byteoff, 0, 16); }
#ifndef MK_AT16
#define MK_AT16 0
#endif
namespace pg8 {
constexpr int BM = 256, BK = 64, HALF = 128, HTB = HALF * BK * 2, STAGE_BYTES = 8 * HTB;
__host__ __device__ __forceinline__ int lds_byte(int r, int c) { const int st = (r >> 4) * 2 + (c >> 5), rr = r & 15, cc = c & 31, ob = rr * 64 + cc * 2; return st * 1024 + (ob ^ (((ob >> 9) & 1) << 5)); }
__host__ __device__ __forceinline__ void stage_rc(int b, int& R, int& C) { const int st = b / 1024, sb = b % 1024, swz = sb ^ (((sb >> 9) & 1) << 5); R = (st >> 1) * 16 + swz / 64; C = (st & 1) * 32 + (swz % 64) / 2; }
__host__ __device__ __forceinline__ int perm32(int rho) { const int n = rho >> 4, i = rho & 15; return 8 * (i >> 2) + 4 * n + (i & 3); }
struct Unit { int pm, pn, k, aux; };
__device__ __forceinline__ unsigned cvt_pk_bf16(float lo, float hi) { unsigned r; asm volatile("v_cvt_pk_bf16_f32 %0, %1, %2" : "=v"(r) : "v"(lo), "v"(hi)); return r; }

template <class Op, bool ALIGN_EPI>
__device__ __forceinline__ void gemm_phase(LAS unsigned char* lds, const Op& op, const int K) {
    const int tid = threadIdx.x, wid = __builtin_amdgcn_readfirstlane(tid >> 6), lane = tid & 63, wr = wid >> 2, wc = wid & 3, fr = lane & 15, fq = lane >> 4;
    const int nt = K / BK;
    int Rs[2], Cs[2]; constexpr int NTY = Op::NTYPES; unsigned voffB[NTY][2], hstepB[NTY];
#pragma unroll
    for (int ty = 0; ty < NTY; ++ty) { hstepB[ty] = (unsigned)HALF * op.ldb(ty) * 2u;
#pragma unroll
        for (int i = 0; i < 2; ++i) { stage_rc(tid * 16 + i * 8192, Rs[i], Cs[i]); const int Rb = (Rs[i] & ~31) + perm32(Rs[i] & 31); voffB[ty][i] = (unsigned)(Rb * op.ldb(ty) + Cs[i]) * 2u; } }
    const unsigned ldsw = (unsigned)wid * 1024u;
    const int aoff = lds_byte(wr * 64 + fr, fq * 8), boff = lds_byte(wc * 32 + fr, fq * 8);
    const char* const Ab = (const char*)op.A();
#define PG8_SA(b, h) (((b) * 2 + (h)) * HTB)
#define PG8_SB(b, h) ((4 + (b) * 2 + (h)) * HTB)
#define PG8_STAGE_A(bufoff, offs, h, kb) do { _Pragma("unroll") for (int _i = 0; _i < 2; ++_i) \
        __builtin_amdgcn_global_load_lds((const unsigned*)(Ab + (size_t)(offs)[h][_i] + (kb)), (LAS unsigned*)(lds + (bufoff) + ldsw + _i * 8192), 16, 0, 0); } while (0)
#define PG8_STAGE_B(bufoff, gbase, ty) do { _Pragma("unroll") for (int _i = 0; _i < 2; ++_i) \
        __builtin_amdgcn_global_load_lds((const unsigned*)((const char*)(gbase) + (NTY == 1 ? voffB[0][_i] : ((ty) ? voffB[NTY - 1][_i] : voffB[0][_i]))), (LAS unsigned*)(lds + (bufoff) + ldsw + _i * 8192), 16, 0, 0); } while (0)
#define PG8_HS(ty) (NTY == 1 ? hstepB[0] : ((ty) ? hstepB[NTY - 1] : hstepB[0]))
#define PG8_LDA(dst, b, h) do { _Pragma("unroll") for (int m = 0; m < 4; ++m) _Pragma("unroll") for (int k = 0; k < 2; ++k) dst[m][k] = *(const LAS bf16x8*)(lds + PG8_SA(b, h) + aoff + m * 2048 + k * 1024); } while (0)
#define PG8_LDB(dst, b, h) do { _Pragma("unroll") for (int n = 0; n < 2; ++n) _Pragma("unroll") for (int k = 0; k < 2; ++k) dst[n][k] = *(const LAS bf16x8*)(lds + PG8_SB(b, h) + boff + n * 2048 + k * 1024); } while (0)
#define PG8_MMA(ai, bj, At, Bt) do { __builtin_amdgcn_s_setprio(1); _Pragma("unroll") for (int m = 0; m < 4; ++m) _Pragma("unroll") for (int n = 0; n < 2; ++n) _Pragma("unroll") for (int k = 0; k < 2; ++k) \
        acc[ai][bj][m][n] = __builtin_amdgcn_mfma_f32_16x16x32_bf16(Bt[n][k], At[m][k], acc[ai][bj][m][n], 0, 0, 0); __builtin_amdgcn_s_setprio(0); } while (0)
#define PG8_WAIT_V(n) asm volatile("s_waitcnt vmcnt(" #n ")" ::: "memory")
#define PG8_WAIT_L(n) asm volatile("s_waitcnt lgkmcnt(" #n ")" ::: "memory")
#define PG8_BAR __builtin_amdgcn_s_barrier()
#define PG8_SCHED __builtin_amdgcn_sched_barrier(0)
    Unit cur, nxt; int ui = 0;
    if (!op.next(0, cur)) return;
    f32x4 acc[2][2][4][2];
#pragma unroll
    for (int a = 0; a < 2; ++a)
#pragma unroll
        for (int b = 0; b < 2; ++b)
#pragma unroll
            for (int m = 0; m < 4; ++m)
#pragma unroll
                for (int n = 0; n < 2; ++n) acc[a][b][m][n] = (f32x4){0.f, 0.f, 0.f, 0.f};
    bf16x8 At[4][2], B0[2][2], B1[2][2];
    constexpr int NAO = Op::GATHER ? 2 : 1;
    unsigned caoff[2][2], naoff[NAO][2];
    size_t cbase = 0, nbase = 0;
#pragma unroll
    for (int h = 0; h < 2; ++h)
#pragma unroll
        for (int i = 0; i < 2; ++i) { if constexpr (Op::GATHER) caoff[h][i] = op.arow(cur, h * HALF + Rs[i]) + (unsigned)Cs[i] * 2u; else caoff[h][i] = (unsigned)(h * HALF + Rs[i]) * 2048u + (unsigned)Cs[i] * 2u; }
    if constexpr (!Op::GATHER) cbase = op.abase(cur);
    {
        if constexpr (Op::HOOKS) op.a_ready(cur);
        const char* b0 = op.bptr(cur, 0); const char* b1 = op.bptr(cur, 1); const int tyc = op.utype(cur);
        PG8_STAGE_B(PG8_SB(0, 0), b0, tyc); PG8_STAGE_B(PG8_SB(0, 1), b0 + PG8_HS(tyc), tyc); PG8_STAGE_A(PG8_SA(0, 0), caoff, 0, cbase); PG8_STAGE_A(PG8_SA(0, 1), caoff, 1, cbase);
        if (wr == 1) PG8_BAR;
        PG8_WAIT_V(2); PG8_BAR;
        PG8_STAGE_B(PG8_SB(1, 0), b1, tyc); PG8_STAGE_A(PG8_SA(1, 0), caoff, 0, cbase + 128); PG8_STAGE_B(PG8_SB(1, 1), b1 + PG8_HS(tyc), tyc);
        PG8_WAIT_V(6); PG8_BAR;
    }
    for (;;) {
        const bool has_next = op.next(ui + 1, nxt);
        bool skip1 = false; if constexpr (Op::HALFSKIP) skip1 = op.half_only(cur);
        if (!has_next) nxt = cur;
        if constexpr (Op::HOOKS) { if (has_next) op.a_ready(nxt); }
        const int tycur = op.utype(cur), tynxt = op.utype(nxt);
        if constexpr (Op::GATHER) {
#pragma unroll
            for (int h = 0; h < 2; ++h)
#pragma unroll
                for (int i = 0; i < 2; ++i) naoff[h][i] = has_next ? op.arow(nxt, h * HALF + Rs[i]) + (unsigned)Cs[i] * 2u : caoff[h][i];
        } else nbase = op.abase(nxt);
        asm volatile(".p2align 8");
        for (int t = 0; t < nt; t += 2) {
            const bool last = (t == nt - 2);
            const size_t ka1 = cbase + (size_t)(t + 1) * 128u;
            const size_t ka2 = last ? nbase : cbase + (size_t)(t + 2) * 128u, ka3 = ka2 + 128u;
            unsigned a2off[2][2];
#pragma unroll
            for (int h = 0; h < 2; ++h)
#pragma unroll
                for (int i = 0; i < 2; ++i) { if constexpr (Op::GATHER) a2off[h][i] = last ? naoff[h][i] : caoff[h][i]; else a2off[h][i] = caoff[h][i]; }
            const char* b2 = last ? op.bptr(nxt, 0) : op.bptr(cur, t + 2);
            const char* b3 = last ? op.bptr(nxt, 1) : op.bptr(cur, t + 3); const int ty2 = last ? tynxt : tycur;
            PG8_LDB(B0, 0, 0); PG8_LDB(B1, 0, 1); PG8_SCHED; PG8_LDA(At, 0, 0); PG8_STAGE_A(PG8_SA(1, 1), caoff, 1, ka1);
            PG8_WAIT_V(8); PG8_WAIT_L(0); PG8_BAR; PG8_MMA(0, 0, At, B0); PG8_MMA(0, 1, At, B1); PG8_BAR; PG8_SCHED;
            PG8_LDA(At, 0, 1); PG8_STAGE_B(PG8_SB(0, 0), b2, ty2); PG8_STAGE_B(PG8_SB(0, 1), b2 + PG8_HS(ty2), ty2); PG8_STAGE_A(PG8_SA(0, 0), a2off, 0, ka2);
            PG8_WAIT_V(8); PG8_WAIT_L(0); PG8_BAR; if (!skip1) { PG8_MMA(1, 0, At, B0); PG8_MMA(1, 1, At, B1); } PG8_BAR; PG8_SCHED;
            PG8_LDB(B0, 1, 0); PG8_LDB(B1, 1, 1); PG8_SCHED; PG8_LDA(At, 1, 0); PG8_STAGE_A(PG8_SA(0, 1), a2off, 1, ka2);
            PG8_WAIT_V(8); PG8_WAIT_L(0); PG8_BAR; PG8_MMA(0, 0, At, B0); PG8_MMA(0, 1, At, B1); PG8_BAR; PG8_SCHED;
            PG8_LDA(At, 1, 1); PG8_STAGE_B(PG8_SB(1, 0), b3, ty2); PG8_STAGE_B(PG8_SB(1, 1), b3 + PG8_HS(ty2), ty2); PG8_STAGE_A(PG8_SA(1, 0), a2off, 0, ka3);
            PG8_WAIT_V(8); PG8_WAIT_L(0); PG8_BAR; if (!skip1) { PG8_MMA(1, 0, At, B0); PG8_MMA(1, 1, At, B1); } PG8_BAR; PG8_SCHED;
        }
        if constexpr (ALIGN_EPI) { if (wr == 0) PG8_BAR; }
        op.epi(acc, cur, wr, wc, fr, fq);
        if constexpr (Op::HOOKS) op.done(cur);
        if (!has_next) break;
#pragma unroll
        for (int a = 0; a < 2; ++a)
#pragma unroll
            for (int b = 0; b < 2; ++b)
#pragma unroll
                for (int m = 0; m < 4; ++m)
#pragma unroll
                    for (int n = 0; n < 2; ++n) acc[a][b][m][n] = (f32x4){0.f, 0.f, 0.f, 0.f};
        cur = nxt; ++ui;
        if constexpr (Op::GATHER) {
#pragma unroll
            for (int h = 0; h < 2; ++h)
#pragma unroll
                for (int i = 0; i < 2; ++i) caoff[h][i] = naoff[h][i];
        } else cbase = nbase;
        if constexpr (ALIGN_EPI) { if (wr == 1) PG8_BAR; }
    }
    PG8_WAIT_V(0);
    if constexpr (!ALIGN_EPI) { if (wr == 0) PG8_BAR; }
    PG8_BAR;
#undef PG8_SA
#undef PG8_SB
#undef PG8_STAGE_A
#undef PG8_STAGE_B
#undef PG8_HS
#undef PG8_LDA
#undef PG8_LDB
#undef PG8_MMA
#undef PG8_WAIT_V
#undef PG8_WAIT_L
#undef PG8_BAR
#undef PG8_SCHED
}
}
struct OpIn {
    const bf16* A_; const bf16* Bt; bf16* proj; bf16* hyT; int layer, G, vcu;
    __device__ __forceinline__ const bf16* A() const { return A_; }
    static constexpr int NTYPES = 1; static constexpr bool HOOKS = false;
    __device__ __forceinline__ int utype(const pg8::Unit&) const { return 0; }
    __device__ __forceinline__ int ldb(int) const { return 1024; }
    __device__ __forceinline__ bool next(int i, pg8::Unit& u) const {
        const int L = i * G + vcu; const int nlat = 128 * 9, total = layer == 0 ? 136 * 9 : nlat + 8;
        if (L >= total) return false;
        if (layer == 0 || L < nlat) { u.pm = L / 9; u.pn = L % 9; } else { u.pm = 128 + (L - nlat); u.pn = 7; }
        u.k = 0; u.aux = 0; return true;
    }
    static constexpr bool GATHER = false; static constexpr bool HALFSKIP = false;
    __device__ __forceinline__ size_t abase(const pg8::Unit& u) const { return (size_t)u.pm * 256 * 2048; }
    __device__ __forceinline__ const char* bptr(const pg8::Unit& u, int t) const { return (const char*)Bt + (size_t)u.pn * 256 * 2048 + (size_t)t * 128; }
    __device__ __forceinline__ void epi(const f32x4 (&acc)[2][2][4][2], const pg8::Unit& u, int wr, int wc, int fr, int fq) const {
        const int row0 = u.pm * 256 + wr * 64 + fr, lc0 = wc * 32 + 8 * fq;
        if (u.pn >= 3) {
            const __amdgpu_buffer_rsrc_t rs = wt_rsrc(proj, (size_t)NTOK * PROJ_LD * 2); const unsigned base = ((unsigned)row0 * PROJ_LD + (unsigned)((u.pn - 3) * 256 + lc0)) * 2u;
#pragma unroll
            for (int ai = 0; ai < 2; ++ai)
#pragma unroll
                for (int m = 0; m < 4; ++m) { const unsigned rowp = base + (unsigned)(ai * 128 + m * 16) * (PROJ_LD * 2);
#pragma unroll
                    for (int bj = 0; bj < 2; ++bj) { const f32x4 v0 = acc[ai][bj][m][0], v1 = acc[ai][bj][m][1]; u32x4 w;
                        w.x = pg8::cvt_pk_bf16(v0[0], v0[1]); w.y = pg8::cvt_pk_bf16(v0[2], v0[3]); w.z = pg8::cvt_pk_bf16(v1[0], v1[1]); w.w = pg8::cvt_pk_bf16(v1[2], v1[3]);
                        wt_st128(rs, rowp + bj * 256, w); } }
        } else {
            bf16* base = hyT + (size_t)(u.pn * 256 + lc0) * NTOK + row0;
#pragma unroll
            for (int ai = 0; ai < 2; ++ai)
#pragma unroll
                for (int m = 0; m < 4; ++m)
#pragma unroll
                    for (int bj = 0; bj < 2; ++bj)
#pragma unroll
                        for (int n = 0; n < 2; ++n)
#pragma unroll
                            for (int j = 0; j < 4; j += 2) { const unsigned w = pk2(acc[ai][bj][m][n][j], acc[ai][bj][m][n][j + 1]);
                                base[(size_t)(bj * 128 + 4 * n + j) * NTOK + ai * 128 + m * 16] = (bf16)(w & 0xffffu); base[(size_t)(bj * 128 + 4 * n + j + 1) * NTOK + ai * 128 + m * 16] = (bf16)(w >> 16); }
        }
    }
};

struct OpOut {
    const bf16* A_; const bf16* Bt; const float* xin_lat; const float* xin_ctx; bf16* xb; const float* mod; int layer, G, vcu; float scale;
    __device__ __forceinline__ const bf16* A() const { return A_; }
    static constexpr int NTYPES = 1; static constexpr bool HOOKS = false;
    __device__ __forceinline__ int utype(const pg8::Unit&) const { return 0; }
    __device__ __forceinline__ int ldb(int) const { return 1024; }
    __device__ __forceinline__ bool next(int i, pg8::Unit& u) const {
        const int L = i * G + vcu; const int total = (layer == 0 ? 136 : 128) * 4;
        if (L >= total) return false;
        u.pm = L >> 2; u.pn = L & 3; u.k = 0; u.aux = 0; return true;
    }
    static constexpr bool GATHER = false; static constexpr bool HALFSKIP = false;
    __device__ __forceinline__ size_t abase(const pg8::Unit& u) const { return (size_t)u.pm * 256 * 2048; }
    __device__ __forceinline__ const char* bptr(const pg8::Unit& u, int t) const { return (const char*)Bt + (size_t)u.pn * 256 * 2048 + (size_t)t * 128; }
    __device__ __forceinline__ void epi(const f32x4 (&acc)[2][2][4][2], const pg8::Unit& u, int wr, int wc, int fr, int fq) const {
        const int grow0 = u.pm * 256; const bool isl = grow0 < NLAT;
        const float* xi = isl ? xin_lat + (size_t)grow0 * 1024 : xin_ctx + (size_t)(grow0 - NLAT) * 1024;
        const float* g1 = mod + (size_t)mod_idx(grow0) * 6144 + 2 * 1024;
        const int lr0 = wr * 64 + fr, c0 = u.pn * 256 + wc * 32 + 8 * fq;
        const __amdgpu_buffer_rsrc_t rsx = wt_rsrc(xb, (size_t)NTOK * 2048);
#pragma unroll
        for (int bj = 0; bj < 2; ++bj) { const int col = c0 + bj * 128; const f32x4 ga = *(const f32x4*)(g1 + col) * scale, gb = *(const f32x4*)(g1 + col + 4) * scale;
            u32x4 xw[8];
            if (layer != 0) {
#pragma unroll
                for (int ai = 0; ai < 2; ++ai)
#pragma unroll
                    for (int m = 0; m < 4; ++m) xw[ai * 4 + m] = *(const u32x4*)(xb + (size_t)(grow0 + lr0 + ai * 128 + m * 16) * 1024 + col); }
#pragma unroll
            for (int ai = 0; ai < 2; ++ai) {
                f32x4 xfa[4], xfb[4];
                if (layer == 0) {
#pragma unroll
                    for (int m = 0; m < 4; ++m) { const float* xp = xi + (size_t)(lr0 + ai * 128 + m * 16) * 1024 + col; xfa[m] = *(const f32x4*)xp; xfb[m] = *(const f32x4*)(xp + 4); } }
#pragma unroll
                for (int m = 0; m < 4; ++m) { const int lr = lr0 + ai * 128 + m * 16; bf16* xo = xb + (size_t)(grow0 + lr) * 1024 + col;
                    f32x4 xa, xv;
                    if (layer == 0) { xa = xfa[m]; xv = xfb[m]; }
                    else { const u32x4 w = xw[ai * 4 + m]; xa = (f32x4){lo_bf(w.x), hi_bf(w.x), lo_bf(w.y), hi_bf(w.y)}; xv = (f32x4){lo_bf(w.z), hi_bf(w.z), lo_bf(w.w), hi_bf(w.w)}; }
                    const f32x4 r0 = xa + ga * acc[ai][bj][m][0], r1 = xv + gb * acc[ai][bj][m][1]; u32x4 w;
                    w.x = pg8::cvt_pk_bf16(r0[0], r0[1]); w.y = pg8::cvt_pk_bf16(r0[2], r0[3]); w.z = pg8::cvt_pk_bf16(r1[0], r1[1]); w.w = pg8::cvt_pk_bf16(r1[2], r1[3]);
                    wt_st128(rsx, ((unsigned)(grow0 + lr) * 1024u + (unsigned)col) * 2u, w); } } }
    }
};

struct MoeTab { const LAS int* t; };
__device__ __forceinline__ void moe_decode(const LAS int* tab, int mi, int& k, int& j) { const int v = tab[64 + mi]; k = v >> 16; j = v & 0xffff; }
__device__ __forceinline__ void moe_tile_map(LAS int* tab, int tid) {
    for (int mi = tid; mi < tab[NBUCKET]; mi += 512) { int kk = 0;
#pragma unroll
        for (int q = 1; q < NBUCKET; ++q) if (tab[q] <= mi) kk = q;
        tab[64 + mi] = (kk << 16) | (mi - tab[kk]); }
}
__device__ __forceinline__ void pair_of(int k, int& elo, int& ehi) {
    const int g = k / 6, p = k - g * 6;
    const int lo = p < 3 ? 0 : (p < 5 ? 1 : 2), hi = p < 3 ? p + 1 : (p < 5 ? p - 1 : 3);
    elo = g * 4 + lo; ehi = g * 4 + hi;
}
struct OpMoe1 {
    const bf16* A_; const bf16* W1; bf16* abuf; const int* TOK; const float* WLO; const float* WHI; const LAS int* tab; int layer, G, vcu;
    __device__ __forceinline__ const bf16* A() const { return A_; }
    static constexpr int NTYPES = 1; static constexpr bool HOOKS = false;
    __device__ __forceinline__ int utype(const pg8::Unit&) const { return 0; }
    __device__ __forceinline__ int ldb(int) const { return 1024; }
    __device__ __forceinline__ bool next(int i, pg8::Unit& u) const {
        const int L = i * G + vcu; const int MT = tab[NBUCKET];
        if (L >= MT * 8) return false;
        u.pm = L >> 3; u.pn = L & 7; moe_decode(tab, u.pm, u.k, u.aux); return true;
    }
    static constexpr bool GATHER = true; static constexpr bool HALFSKIP = false;
    __device__ __forceinline__ size_t abase(const pg8::Unit&) const { return 0; }
    __device__ __forceinline__ unsigned arow(const pg8::Unit& u, int lr) const {
        const int cnt = tab[32 + u.k]; int p = u.aux * 256 + lr; p = p < cnt ? p : cnt - 1;
        return (unsigned)TOK[(size_t)u.k * NTOK + p] * 2048u;
    }
    __device__ __forceinline__ const char* bptr(const pg8::Unit& u, int t) const {
        int elo, ehi; pair_of(u.k, elo, ehi); const int e = u.pn < 4 ? elo : ehi;
        return (const char*)W1 + ((size_t)(layer * 16 + e) * 1024 + (u.pn & 3) * 256) * 2048 + (size_t)t * 128;
    }
    __device__ __forceinline__ void epi(const f32x4 (&acc)[2][2][4][2], const pg8::Unit& u, int wr, int wc, int fr, int fq) const {
        const int cnt = tab[32 + u.k]; const float* WW = (u.pn < 4 ? WLO : WHI) + (size_t)u.k * NTOK;
        const int lr0 = wr * 64 + fr, c0 = (u.pn >= 4 ? 512 : 0) + (u.pn & 3) * 128 + wc * 32 + 8 * fq;
#pragma unroll
        for (int ai = 0; ai < 2; ++ai)
#pragma unroll
            for (int m = 0; m < 4; ++m) { const int lr = lr0 + ai * 128 + m * 16; int p = u.aux * 256 + lr; p = p < cnt ? p : cnt - 1; const float w = WW[p];
                const f32x4 g0 = acc[ai][0][m][0], g1 = acc[ai][0][m][1], u0 = acc[ai][1][m][0], u1 = acc[ai][1][m][1]; float o[8];
#pragma unroll
                for (int j = 0; j < 4; ++j) { o[j] = siluf(g0[j]) * u0[j] * w; o[4 + j] = siluf(g1[j]) * u1[j] * w; }
                u32x4 ww; ww.x = pg8::cvt_pk_bf16(o[0], o[1]); ww.y = pg8::cvt_pk_bf16(o[2], o[3]); ww.z = pg8::cvt_pk_bf16(o[4], o[5]); ww.w = pg8::cvt_pk_bf16(o[6], o[7]);
                *(u32x4*)(abuf + (size_t)(u.pm * 256 + lr) * 1024 + c0) = ww; }
    }
};
struct OpMoe2 {
    const bf16* A_; const bf16* W2; bf16* ym; const LAS int* tab; int layer, G, vcu;
    static constexpr bool GATHER = false; static constexpr bool HALFSKIP = false;
    __device__ __forceinline__ size_t abase(const pg8::Unit& u) const { return (size_t)u.pm * 256 * 2048; }
    __device__ __forceinline__ const bf16* A() const { return A_; }
    static constexpr int NTYPES = 1; static constexpr bool HOOKS = false;
    __device__ __forceinline__ int utype(const pg8::Unit&) const { return 0; }
    __device__ __forceinline__ int ldb(int) const { return 512; }
    __device__ __forceinline__ bool next(int i, pg8::Unit& u) const {
        const int L = i * G + vcu; const int MT = tab[NBUCKET];
        if (L >= MT * 4) return false;
        u.pm = L >> 2; u.pn = L & 3; moe_decode(tab, u.pm, u.k, u.aux); return true;
    }
    __device__ __forceinline__ const char* bptr(const pg8::Unit& u, int t) const {
        int elo, ehi; pair_of(u.k, elo, ehi); const int e = t < 8 ? elo : ehi;
        return (const char*)W2 + ((size_t)(layer * 16 + e) * 1024 + u.pn * 256) * 1024 + (size_t)(t & 7) * 128;
    }
    __device__ __forceinline__ void epi(const f32x4 (&acc)[2][2][4][2], const pg8::Unit& u, int wr, int wc, int fr, int fq) const {
        bf16* base = ym + (size_t)(u.pm * 256 + wr * 64 + fr) * 1024 + u.pn * 256 + wc * 32 + 8 * fq;
#pragma unroll
        for (int ai = 0; ai < 2; ++ai)
#pragma unroll
            for (int m = 0; m < 4; ++m) { bf16* rowp = base + (size_t)(ai * 128 + m * 16) * 1024;
#pragma unroll
                for (int bj = 0; bj < 2; ++bj) { const f32x4 v0 = acc[ai][bj][m][0], v1 = acc[ai][bj][m][1]; u32x4 w;
                    w.x = pg8::cvt_pk_bf16(v0[0], v0[1]); w.y = pg8::cvt_pk_bf16(v0[2], v0[3]); w.z = pg8::cvt_pk_bf16(v1[0], v1[1]); w.w = pg8::cvt_pk_bf16(v1[2], v1[3]);
                    *(u32x4*)(rowp + bj * 128) = w; } }
    }
};

struct OpMoe12 {
    const char* wsb; const bf16* W1; const bf16* W2; bf16* abuf; bf16* ym; const int* TOK; const float* WLO; const float* WHI; const LAS int* tab; unsigned* ready; unsigned* tmo; int layer, G, vcu;
    static constexpr bool GATHER = true; static constexpr bool HALFSKIP = true; static constexpr int NTYPES = 2; static constexpr bool HOOKS = true;
    __device__ __forceinline__ const bf16* A() const { return (const bf16*)wsb; }
    __device__ __forceinline__ size_t abase(const pg8::Unit&) const { return 0; }
    __device__ __forceinline__ int utype(const pg8::Unit& u) const { return u.pn >> 3; }
    __device__ __forceinline__ int ldb(int ty) const { return ty ? 512 : 1024; }
    __device__ __forceinline__ bool next(int i, pg8::Unit& u) const {
        int L = i * G + vcu; const int MT = tab[NBUCKET];
        if (L < MT * 8) { u.pm = L >> 3; u.pn = L & 7; }
        else { L -= MT * 8; if (L >= MT * 4) return false; u.pm = L >> 2; u.pn = 8 | (L & 3); }
        moe_decode(tab, u.pm, u.k, u.aux); return true;
    }
    __device__ __forceinline__ unsigned arow(const pg8::Unit& u, int lr) const {
        if (u.pn & 8) return (unsigned)WS_PROJ + (unsigned)(u.pm * 256 + lr) * 2048u;
        const int cnt = tab[32 + u.k]; int p = u.aux * 256 + lr; p = p < cnt ? p : cnt - 1;
        return (unsigned)WS_H + (unsigned)TOK[(size_t)u.k * NTOK + p] * 2048u;
    }
    __device__ __forceinline__ const char* bptr(const pg8::Unit& u, int t) const {
        int elo, ehi; pair_of(u.k, elo, ehi);
        if (u.pn & 8) { const int e = t < 8 ? elo : ehi; return (const char*)W2 + ((size_t)(layer * 16 + e) * 1024 + (u.pn & 3) * 256) * 1024 + (size_t)(t & 7) * 128; }
        const int e = u.pn < 4 ? elo : ehi; return (const char*)W1 + ((size_t)(layer * 16 + e) * 1024 + (u.pn & 3) * 256) * 2048 + (size_t)t * 128;
    }
    __device__ __forceinline__ bool half_only(const pg8::Unit& u) const { return tab[32 + u.k] - u.aux * 256 <= 128; }
    __device__ __forceinline__ void a_ready(const pg8::Unit& u) const {
        if (!(u.pn & 8)) return;
        if (threadIdx.x < 64) {
            unsigned* w = ready + 16 * u.pm; unsigned sp = 0;
            while ((unsigned)__builtin_amdgcn_readfirstlane(__hip_atomic_load(w, __ATOMIC_RELAXED, __HIP_MEMORY_SCOPE_AGENT)) < 64u) {
                __builtin_amdgcn_s_sleep(2);
                if (++sp > (1u << 22)) { if (threadIdx.x == 0) __hip_atomic_store(tmo, 1u, __ATOMIC_RELAXED, __HIP_MEMORY_SCOPE_AGENT); break; } }
            __builtin_amdgcn_fence(__ATOMIC_ACQUIRE, "agent");
            asm volatile("s_waitcnt vmcnt(0)" ::: "memory");
        }
        asm volatile("" ::: "memory"); __builtin_amdgcn_s_barrier(); asm volatile("" ::: "memory");
    }
    __device__ __forceinline__ void done(const pg8::Unit& u) const {
        if (u.pn & 8) return;
        asm volatile("s_waitcnt vmcnt(0)" ::: "memory");
        if ((threadIdx.x & 63) == 0) __hip_atomic_fetch_add(ready + 16 * u.pm, 1u, __ATOMIC_RELAXED, __HIP_MEMORY_SCOPE_AGENT);
    }
    __device__ __forceinline__ void epi(const f32x4 (&acc)[2][2][4][2], const pg8::Unit& u, int wr, int wc, int fr, int fq) const {
        if (u.pn & 8) {
            const __amdgpu_buffer_rsrc_t rsy = wt_rsrc(ym, (size_t)A_ROWS * 2048); const unsigned base = ((unsigned)(u.pm * 256 + wr * 64 + fr) * 1024u + (unsigned)((u.pn & 3) * 256 + wc * 32 + 8 * fq)) * 2u;
#pragma unroll
            for (int ai = 0; ai < 2; ++ai)
#pragma unroll
                for (int m = 0; m < 4; ++m) { const unsigned rowp = base + (unsigned)(ai * 128 + m * 16) * 2048u;
#pragma unroll
                    for (int bj = 0; bj < 2; ++bj) { const f32x4 v0 = acc[ai][bj][m][0], v1 = acc[ai][bj][m][1]; u32x4 w;
                        w.x = pg8::cvt_pk_bf16(v0[0], v0[1]); w.y = pg8::cvt_pk_bf16(v0[2], v0[3]); w.z = pg8::cvt_pk_bf16(v1[0], v1[1]); w.w = pg8::cvt_pk_bf16(v1[2], v1[3]);
                        wt_st128(rsy, rowp + bj * 256, w); } }
        } else {
            const int cnt = tab[32 + u.k]; const float* WW = (u.pn < 4 ? WLO : WHI) + (size_t)u.k * NTOK;
            const int lr0 = wr * 64 + fr, c0 = (u.pn >= 4 ? 512 : 0) + (u.pn & 3) * 128 + wc * 32 + 8 * fq;
            const __amdgpu_buffer_rsrc_t rs = __builtin_amdgcn_make_buffer_rsrc((void*)abuf, 0, (int)((size_t)A_ROWS * 2048), 0x00020000);
            float wrow[8];
#pragma unroll
            for (int ai = 0; ai < 2; ++ai)
#pragma unroll
                for (int m = 0; m < 4; ++m) { int p = u.aux * 256 + lr0 + ai * 128 + m * 16; p = p < cnt ? p : cnt - 1; wrow[ai * 4 + m] = WW[p]; }
#pragma unroll
            for (int ai = 0; ai < 2; ++ai)
#pragma unroll
                for (int m = 0; m < 4; ++m) { const int lr = lr0 + ai * 128 + m * 16; const float w = wrow[ai * 4 + m];
                    const f32x4 g0 = acc[ai][0][m][0], g1 = acc[ai][0][m][1], u0 = acc[ai][1][m][0], u1 = acc[ai][1][m][1]; float o[8];
#pragma unroll
                    for (int j = 0; j < 4; ++j) { o[j] = siluf(g0[j]) * u0[j] * w; o[4 + j] = siluf(g1[j]) * u1[j] * w; }
                    u32x4 ww; ww.x = pg8::cvt_pk_bf16(o[0], o[1]); ww.y = pg8::cvt_pk_bf16(o[2], o[3]); ww.z = pg8::cvt_pk_bf16(o[4], o[5]); ww.w = pg8::cvt_pk_bf16(o[6], o[7]);
                    __builtin_amdgcn_raw_buffer_store_b128(ww, rs, (int)(((unsigned)(u.pm * 256 + lr) * 1024u + (unsigned)c0) * 2u), 0, 16); }
        }
    }
};
struct TrItem { const float* W; int N, k0, n0; bf16* WT; int ldk, dst_row0; const float* kscale; };
__device__ __forceinline__ void transpose_load(const TrItem& t, int lane, float (&tv)[32]) {
#pragma unroll
    for (int i = 0; i < 32; ++i) { const int kk = 2 * i + (lane >> 5); tv[i] = __builtin_nontemporal_load(t.W + (size_t)(t.k0 + kk) * t.N + t.n0 + (lane & 31)); }
}
__device__ __forceinline__ void transpose_finish(const TrItem& t, LAS float* scr, int lane, const float (&tv)[32]) {
#pragma unroll
    for (int i = 0; i < 32; ++i) { const int kk = 2 * i + (lane >> 5); scr[kk * 33 + (lane & 31)] = t.kscale ? tv[i] * t.kscale[t.k0 + kk] : tv[i]; }
    asm volatile("s_waitcnt lgkmcnt(0)" ::: "memory");
    const int c = lane & 7;
#pragma unroll
    for (int j = 0; j < 4; ++j) { const int n = (lane >> 3) + 8 * j; const LAS float* s = scr + (8 * c) * 33 + n;
        u32x4 o; o.x = pk2(s[0 * 33], s[1 * 33]); o.y = pk2(s[2 * 33], s[3 * 33]); o.z = pk2(s[4 * 33], s[5 * 33]); o.w = pk2(s[6 * 33], s[7 * 33]);
        *(u32x4*)(t.WT + (size_t)(t.dst_row0 + n) * t.ldk + t.k0 + 8 * c) = o; }
    asm volatile("s_waitcnt lgkmcnt(0)" ::: "memory");
}
__device__ __forceinline__ int win_dst(int n0) { return n0 < 1792 ? n0 : (n0 < 1984 ? 1952 + (n0 - 1792) : 1792 + (n0 - 1984)); }

constexpr int N_WIN = 2 * 16 * 67, N_WOUT = 2 * 16 * 32, N_G = 2 * 16 * 16 * 16, N_U = N_G, N_D = 2 * 16 * 8 * 32, N_UQ = 2 * 3 * 12, N_UKV = 2 * 2 * 16;
constexpr int NIT_W = N_WIN + N_WOUT + N_G + N_U + N_D + N_UQ + N_UKV;
struct MiniF { LAS unsigned char* lds; unsigned char* ws; int tid, lane, wave; };
__device__ __forceinline__ MiniF minif(LAS unsigned char* lds, unsigned char* ws) { MiniF F; F.lds = lds; F.ws = ws; F.tid = threadIdx.x; F.lane = F.tid & 63; F.wave = __builtin_amdgcn_readfirstlane(F.tid >> 6); return F; }
__device__ __forceinline__ TrItem weight_decode(unsigned char* ws, KArgs a, int it) {
    int r = it;
    if (r < N_WIN) { const int l = r / (16 * 67), q = r % (16 * 67), kb = q / 67, nb = q % 67;
        return TrItem{a->in[I_WIN] + (size_t)l * 1024 * IN_COLS, IN_COLS, kb * 64, nb * 32, (bf16*)(ws + WS_WIN) + (size_t)l * NIN_PAD * 1024, 1024, win_dst(nb * 32), nullptr}; } r -= N_WIN;
    if (r < N_WOUT) { const int l = r / 512, q = r % 512, kb = q / 32, nb = q % 32;
        return TrItem{a->in[I_WOUT] + (size_t)l * 1024 * 1024, 1024, kb * 64, nb * 32, (bf16*)(ws + WS_WOUT) + (size_t)l * 1024 * 1024, 1024, nb * 32, nullptr}; } r -= N_WOUT;
    if (r < N_G + N_U) { const bool up = r >= N_G; if (up) r -= N_G; const int le = r / 256, q = r % 256, kb = q / 16, nb = q % 16; const int f0 = nb * 32;
        return TrItem{a->in[up ? I_EWU : I_EWG] + (size_t)le * 1024 * 512, 512, kb * 64, f0, (bf16*)(ws + WS_W1) + (size_t)le * 1024 * 1024, 1024, (f0 >> 7) * 256 + (up ? 128 : 0) + (f0 & 127), nullptr}; } r -= N_G + N_U;
    if (r < N_D) { const int le = r / 256, q = r % 256, kb = q / 32, nb = q % 32;
        return TrItem{a->in[I_EWD] + (size_t)le * 512 * 1024, 1024, kb * 64, nb * 32, (bf16*)(ws + WS_W2) + (size_t)le * 1024 * 512, 512, nb * 32, nullptr}; } r -= N_D;
    if (r < N_UQ) { const int l = r / 36, q = r % 36, kb = q / 12, nb = q % 12;
        return TrItem{a->in[I_WUQ] + (size_t)l * 192 * 384, 384, kb * 64, nb * 32, (bf16*)(ws + WS_WUQ) + (size_t)l * 384 * 192, 192, nb * 32, a->in[I_QANORM] + l * 192}; } r -= N_UQ;
    { const int l = r / 32, q = r % 32, kb = q / 16, nb = q % 16;
        return TrItem{a->in[I_WUKV] + (size_t)l * 128 * 512, 512, kb * 64, nb * 32, (bf16*)(ws + WS_WUKV) + (size_t)l * 512 * 128, 128, nb * 32, a->in[I_KVANORM] + l * 128}; }
}
__device__ __attribute__((noinline)) void p0_weight_item(LAS unsigned char* lds_, unsigned char* ws_, KArgs a, int it) {
    const MiniF F = minif(lds_, ws_);
    LAS float* scr = (LAS float*)(F.lds + F.wave * 16384);
    const TrItem t = weight_decode(F.ws, a, it);
    float tv[32]; transpose_load(t, F.lane, tv); transpose_finish(t, scr, F.lane, tv);
}
__device__ __attribute__((noinline)) void p0_weight_pair(LAS unsigned char* lds_, unsigned char* ws_, KArgs a, int it0, int it1) {
    const MiniF F = minif(lds_, ws_);
    LAS float* scr = (LAS float*)(F.lds + F.wave * 16384);
    const TrItem t0 = weight_decode(F.ws, a, it0), t1 = weight_decode(F.ws, a, it1);
    float tv0[32], tv1[32]; transpose_load(t0, F.lane, tv0); transpose_load(t1, F.lane, tv1);
    transpose_finish(t0, scr, F.lane, tv0); transpose_finish(t1, scr, F.lane, tv1);
}
constexpr int N_MISC_PAD = 2 * 160 * 128, N_MISC_GM = 2 * 4 * 128 * 128 / 4, N_MISC_ROPE = 4096 * 16, N_MISC = N_MISC_PAD + N_MISC_GM + N_MISC_ROPE;
__device__ __attribute__((noinline)) void p0_misc_op(unsigned char* ws, KArgs a, int i) {
    if (i < N_MISC_PAD) { const int l = i / (160 * 128), q = i % (160 * 128);
        *(u32x4*)((bf16*)(ws + WS_WIN) + ((size_t)l * NIN_PAD + 2144) * 1024 + (size_t)q * 8) = (u32x4){0u, 0u, 0u, 0u}; return; } i -= N_MISC_PAD;
    if (i < N_MISC_GM) { const f32x4 v = *(const f32x4*)(a->in[I_GMWS] + (size_t)i * 4); u32x2 o; o.x = pk2(v[0], v[1]); o.y = pk2(v[2], v[3]);
        *(u32x2*)((bf16*)(ws + WS_GMWS) + (size_t)i * 4) = o; return; } i -= N_MISC_GM;
    if (i < N_MISC_ROPE) { const int t = i >> 4, j = i & 15; const float pos = (float)(j < 8 ? (t >> 6) : (t & 63));
        const float inv = powf(10000.0f, -(float)(j & 7) / 8.0f); const float ang = pos * inv;
        ((float*)(ws + WS_ROPE))[i] = cosf(ang); ((float*)(ws + WS_ROPE))[4096 * 16 + i] = sinf(ang); }
}

__device__ __attribute__((noinline)) void p0_mod_item(LAS unsigned char* lds_, unsigned char* ws_, KArgs a, int it) {
    const MiniF F = minif(lds_, ws_);
    LAS float* sc = (LAS float*)F.lds;
    LAS float* part = sc + 9 * 1024;
    float* mod = (float*)(F.ws + WS_MOD);
#pragma unroll
    for (int it2 = 0; it2 < 18; ++it2) { const int i = F.tid + it2 * 512; const int j = i >> 10, k = i & 1023; const float c = j < 8 ? a->in[I_C][j * 1024 + k] : a->in[I_CCTX][k]; sc[i] = siluf(c); }
    __syncthreads();
    const int l = it / 96, cb = it % 96, col = F.tid & 63, kq = F.tid >> 6;
    const float* W = a->in[I_ADAW] + (size_t)l * 1024 * 6144 + cb * 64 + col;
    float acc[9];
#pragma unroll
    for (int j = 0; j < 9; ++j) acc[j] = 0.f;
#pragma unroll 1
    for (int k0 = kq * 128; k0 < kq * 128 + 128; k0 += 16) { float w[16];
#pragma unroll
        for (int q = 0; q < 16; ++q) w[q] = W[(size_t)(k0 + q) * 6144];
#pragma unroll
        for (int q = 0; q < 16; ++q)
#pragma unroll
            for (int j = 0; j < 9; ++j) acc[j] += sc[j * 1024 + k0 + q] * w[q]; }
#pragma unroll
    for (int j = 0; j < 9; ++j) part[(kq * 9 + j) * 64 + col] = acc[j];
    __syncthreads();
    for (int i = F.tid; i < 9 * 64; i += 512) { const int j = i >> 6, c2 = i & 63; float s = a->in[I_ADAB][l * 6144 + cb * 64 + c2];
#pragma unroll
        for (int q = 0; q < 8; ++q) s += part[(q * 9 + j) * 64 + c2];
        mod[((size_t)l * 9 + j) * 6144 + cb * 64 + c2] = s; }
}

__device__ __attribute__((noinline)) void p0_filter_item(LAS unsigned char* lds_, unsigned char* ws_, KArgs a, int it) {
    const MiniF F = minif(lds_, ws_);
    LAS float* z = (LAS float*)F.lds;
    LAS float* h1 = z + 32 * 36;
    LAS float* h2T = h1 + 32 * 64;
    float* fsp = (float*)(F.ws + WS_FS);
    const int set = it < 128 ? 0 : (it < 256 ? 1 : 2), tt_ = it < 256 ? (it & 127) : it - 256;
    const int l = set == 2 ? 0 : set, L = set == 2 ? 256 : 4096, t0 = tt_ * 32;
    const float* w1 = a->in[I_HFW1] + l * 33 * 64; const float* b1 = a->in[I_HFB1] + l * 64; const float* fr = a->in[I_HFFREQ] + l * 64;
    const float* w2 = a->in[I_HFW2] + l * 64 * 64; const float* b2 = a->in[I_HFB2] + l * 64; const float* w3 = a->in[I_HFW3] + (size_t)l * 64 * 1024;
    { const int tl = F.tid >> 4, f = F.tid & 15, tg = t0 + tl;
      const float fb = 1e-4f + (float)f * ((15.0f - 1e-4f) / 15.0f); const float w = 6.283185307179586f * (float)tg / (float)L;
      const float ang = fb * w; z[tl * 36 + 1 + f] = cosf(ang); z[tl * 36 + 17 + f] = -sinf(ang);
      if (f == 0) z[tl * 36] = (float)tg / (float)(L - 1); }
    __syncthreads();
    { const int tl = F.tid >> 4, j0 = (F.tid & 15) * 4; f32x4 s = *(const f32x4*)(b1 + j0);
      f32x4 wv1[33];
#pragma unroll
      for (int i = 0; i < 33; ++i) wv1[i] = *(const f32x4*)(w1 + i * 64 + j0);
#pragma unroll
      for (int i = 0; i < 33; ++i) s += wv1[i] * z[tl * 36 + i];
      const f32x4 f4 = *(const f32x4*)(fr + j0); h1[tl * 64 + j0] = sinf(f4.x * s.x); h1[tl * 64 + j0 + 1] = sinf(f4.y * s.y); h1[tl * 64 + j0 + 2] = sinf(f4.z * s.z); h1[tl * 64 + j0 + 3] = sinf(f4.w * s.w); }
    __syncthreads();
    { const int tl = F.tid >> 4, j0 = (F.tid & 15) * 4; f32x4 s = *(const f32x4*)(b2 + j0);
#pragma unroll
      for (int h = 0; h < 2; ++h) { f32x4 wv2[32];
#pragma unroll
        for (int i = 0; i < 32; ++i) wv2[i] = *(const f32x4*)(w2 + (32 * h + i) * 64 + j0);
#pragma unroll
        for (int i = 0; i < 32; ++i) s += wv2[i] * h1[tl * 64 + 32 * h + i]; }
      const f32x4 f4 = *(const f32x4*)(fr + j0); h2T[(j0) * 32 + tl] = sinf(f4.x * s.x); h2T[(j0 + 1) * 32 + tl] = sinf(f4.y * s.y); h2T[(j0 + 2) * 32 + tl] = sinf(f4.z * s.z); h2T[(j0 + 3) * 32 + tl] = sinf(f4.w * s.w); }
    __syncthreads();
    const int lc = F.lane & 15, lg = F.lane >> 4, og = F.wave >> 2, dir = (F.wave >> 1) & 1, cb = (F.wave & 1) * 128;
    bf16x8 ah[2][2], al[2][2];
#pragma unroll
    for (int tt = 0; tt < 2; ++tt)
#pragma unroll
        for (int ks = 0; ks < 2; ++ks) { float x[8];
#pragma unroll
            for (int i = 0; i < 8; ++i) x[i] = h2T[(32 * ks + 8 * lg + i) * 32 + 16 * tt + lc];
            u32x4 h, l; h.x = pk2(x[0], x[1]); h.y = pk2(x[2], x[3]); h.z = pk2(x[4], x[5]); h.w = pk2(x[6], x[7]);
            l.x = pk2(x[0] - lo_bf(h.x), x[1] - hi_bf(h.x)); l.y = pk2(x[2] - lo_bf(h.y), x[3] - hi_bf(h.y)); l.z = pk2(x[4] - lo_bf(h.z), x[5] - hi_bf(h.z)); l.w = pk2(x[6] - lo_bf(h.w), x[7] - hi_bf(h.w));
            ah[tt][ks] = __builtin_bit_cast(bf16x8, h); al[tt][ks] = __builtin_bit_cast(bf16x8, l); }
    float zt[2][4];
#pragma unroll
    for (int tt = 0; tt < 2; ++tt)
#pragma unroll
        for (int r = 0; r < 4; ++r) zt[tt][r] = z[(16 * tt + 4 * lg + r) * 36];
    const float lo = -3.0701134573253945f, hi = -15.350567286626972f;
    const float* w3c = w3 + (size_t)(8 * lg) * 1024 + 128 * F.wave + lc;
    float wn[2][8];
#pragma unroll
    for (int ks = 0; ks < 2; ++ks)
#pragma unroll
        for (int i = 0; i < 8; ++i) wn[ks][i] = w3c[(size_t)(32 * ks + i) * 1024];
#pragma unroll 1
    for (int ct = 0; ct < 8; ++ct) {
        bf16x8 bh[2], bl[2];
#pragma unroll
        for (int ks = 0; ks < 2; ++ks) { u32x4 h, l; const float* x = wn[ks];
            h.x = pk2(x[0], x[1]); h.y = pk2(x[2], x[3]); h.z = pk2(x[4], x[5]); h.w = pk2(x[6], x[7]);
            l.x = pk2(x[0] - lo_bf(h.x), x[1] - hi_bf(h.x)); l.y = pk2(x[2] - lo_bf(h.y), x[3] - hi_bf(h.y)); l.z = pk2(x[4] - lo_bf(h.z), x[5] - hi_bf(h.z)); l.w = pk2(x[6] - lo_bf(h.w), x[7] - hi_bf(h.w));
            bh[ks] = __builtin_bit_cast(bf16x8, h); bl[ks] = __builtin_bit_cast(bf16x8, l); }
        if (ct < 7) {
#pragma unroll
            for (int ks = 0; ks < 2; ++ks)
#pragma unroll
                for (int i = 0; i < 8; ++i) wn[ks][i] = w3c[(size_t)(32 * ks + i) * 1024 + 16 * (ct + 1)]; }
        f32x4 acc[2];
#pragma unroll
        for (int tt = 0; tt < 2; ++tt) { acc[tt] = (f32x4){0.f, 0.f, 0.f, 0.f};
#pragma unroll
            for (int ks = 0; ks < 2; ++ks) { acc[tt] = mfma16(al[tt][ks], bh[ks], acc[tt]); acc[tt] = mfma16(ah[tt][ks], bl[ks], acc[tt]); acc[tt] = mfma16(ah[tt][ks], bh[ks], acc[tt]); } }
        const int c = cb + 16 * ct + lc;
        const float delta = fabsf(lo + (float)c * ((hi - lo) / 255.0f));
        float as = 0.f;
#pragma unroll
        for (int tt = 0; tt < 2; ++tt)
#pragma unroll
            for (int r = 0; r < 4; ++r) { const float v = acc[tt][r] * __expf(-zt[tt][r] * delta); acc[tt][r] = v; if (dir == 0 || t0 + 16 * tt + 4 * lg + r >= 1) as += fabsf(v); }
        as += __shfl_xor(as, 16); as += __shfl_xor(as, 32);
        if (lg == 0) fsp[((size_t)set * 128 + tt_) * 1024 + 128 * F.wave + 16 * ct + lc] = as;
        if (set < 2) {
            bf16* Gc = (bf16*)(F.ws + WS_G) + ((size_t)(set * 2 + og) * 256 + c) * GLEN;
#pragma unroll
            for (int tt = 0; tt < 2; ++tt) { const int tq = t0 + 16 * tt + 4 * lg; const f32x4 v = acc[tt];
                if (dir == 0) {
                    Gc[GC - tq] = (bf16)f2bf(v[0]); *(unsigned*)(Gc + GC - tq - 2) = pk2(v[2], v[1]); Gc[GC - tq - 3] = (bf16)f2bf(v[3]);
                } else {
                    if (tq == 0) Gc[GC + 1] = (bf16)f2bf(v[1]); else *(unsigned*)(Gc + GC + tq) = pk2(v[0], v[1]);
                    *(unsigned*)(Gc + GC + tq + 2) = pk2(v[2], v[3]); } }
        } else {
            float* Tc = (float*)(F.ws + WS_TC) + (size_t)og * 256 * 512 + (size_t)c * 512;
#pragma unroll
            for (int tt = 0; tt < 2; ++tt)
#pragma unroll
                for (int r = 0; r < 4; ++r) { const int tg = t0 + 16 * tt + 4 * lg + r; if (dir == 0) Tc[256 + tg] = acc[tt][r]; else if (tg >= 1) Tc[256 - tg] = acc[tt][r]; }
        }
    }
}

constexpr int W_OFF_G = N_WIN + N_WOUT, W_OFF_U = W_OFF_G + N_G, W_OFF_D = W_OFF_U + N_U, W_HALF = N_G / 2;
constexpr int NIT_NOW = NIT_W - 3 * W_HALF, NIT_DEF = 3 * W_HALF;
__device__ __forceinline__ int w_now_index(int i) {
    if (i < W_OFF_G + W_HALF) return i; i -= W_OFF_G + W_HALF;
    if (i < W_HALF) return W_OFF_U + i; i -= W_HALF;
    if (i < W_HALF) return W_OFF_D + i; i -= W_HALF;
    return W_OFF_D + N_D + i;
}
__device__ __forceinline__ int w_def_index(int i) { return i < W_HALF ? W_OFF_G + W_HALF + i : (i < 2 * W_HALF ? W_OFF_U + W_HALF + (i - W_HALF) : W_OFF_D + W_HALF + (i - 2 * W_HALF)); }
constexpr int P0_NF = 264, P0_NM = 192, P0_NW = (NIT_NOW + 15) / 16, P0_NX = (N_MISC + 511) / 512, P0_NITEMS = P0_NF + P0_NM + P0_NW + P0_NX;
constexpr int DEF_NBLK = NIT_DEF / 8;
__device__ __forceinline__ void drain_deferred(const Frame& F, KArgs a, int quota) {
    volatile LAS int* slot = (volatile LAS int*)(F.lds + LDS_MISC + 64);
    for (int n = 0; n < quota; ++n) {
        __syncthreads();
        if (F.tid == 0) *slot = (int)atomicAdd(F.ctl + CW_DQ, 1u);
        __syncthreads();
        const int it = *slot;
        if (it >= DEF_NBLK) break;
        p0_weight_item(F.lds, F.ws, a, w_def_index(it * 8 + F.wave));
    }
    __syncthreads();
}
__device__ __forceinline__ void p0_all(const Frame& F, KArgs a, int qoff = 0) {
    volatile LAS int* slot = (volatile LAS int*)(F.lds + LDS_MISC + 64);
    for (;;) {
        __syncthreads();
        if (F.tid == 0) *slot = (int)atomicAdd(F.ctl + CW_P0Q + qoff, 1u);
        __syncthreads();
        const int it = *slot;
        if (it >= P0_NITEMS) break;
        if (it < P0_NF) p0_filter_item(F.lds, F.ws, a, it);
        else if (it < P0_NF + P0_NM) p0_mod_item(F.lds, F.ws, a, it - P0_NF);
        else if (it < P0_NF + P0_NM + P0_NW) { const int wi0 = (it - P0_NF - P0_NM) * 16 + F.wave, wi1 = wi0 + 8;
            if (wi1 < NIT_NOW) p0_weight_pair(F.lds, F.ws, a, w_now_index(wi0), w_now_index(wi1)); else if (wi0 < NIT_NOW) p0_weight_item(F.lds, F.ws, a, w_now_index(wi0)); }
        else { const int i = (it - P0_NF - P0_NM - P0_NW) * 512 + F.tid; if (i < N_MISC) p0_misc_op(F.ws, a, i); }
    }
    __syncthreads();
}
__device__ __forceinline__ void ld_x_row(const float* xrow, int lane, f32x4 (&v)[4]) {
    const f32x4* xr = (const f32x4*)xrow + lane;
#pragma unroll
    for (int j = 0; j < 4; ++j) v[j] = __builtin_nontemporal_load(xr + 64 * j);
}
__device__ __forceinline__ void norm_mod_row(const f32x4 (&v)[4], const float* g, const float* sc, const float* sh, __amdgpu_buffer_rsrc_t rsH, unsigned orow, int lane) {
    float s = 0.f;
#pragma unroll
    for (int j = 0; j < 4; ++j) s += (v[j].x * v[j].x + v[j].y * v[j].y) + (v[j].z * v[j].z + v[j].w * v[j].w);
    const float rstd = frsq(wave_sum(s) * (1.f / 1024.f) + EPS);
#pragma unroll
    for (int j = 0; j < 4; ++j) { const int k = 4 * lane + 256 * j; const f32x4 gg = *(const f32x4*)(g + k), cc = *(const f32x4*)(sc + k), hh = *(const f32x4*)(sh + k);
        const f32x4 y = v[j] * rstd * gg * (cc + 1.f) + hh;
        u32x2 w; w.x = pk2(y.x, y.y); w.y = pk2(y.z, y.w); wt_st64(rsH, orow + (unsigned)(lane * 8 + j * 512), w); }
}
__device__ __forceinline__ void p1_norm(const Frame& F, KArgs a, int layer, const float* xlat, const float* xctx) {
    const float* mod = (const float*)(F.ws + WS_MOD) + (size_t)layer * 9 * 6144; const float* g = a->in[I_N1G] + layer * 1024; bf16* H = (bf16*)(F.ws + WS_H);
    const __amdgpu_buffer_rsrc_t rsH = wt_rsrc(H, (size_t)NTOK * 2048);
    int r = F.gw; f32x4 nv[4];
    if (r < NTOK) ld_x_row(r < NLAT ? xlat + (size_t)r * 1024 : xctx + (size_t)(r - NLAT) * 1024, F.lane, nv);
    for (; r < NTOK; r += F.NGW) {
        f32x4 v[4];
#pragma unroll
        for (int j = 0; j < 4; ++j) v[j] = nv[j];
        const int rn = r + F.NGW; if (rn < NTOK) ld_x_row(rn < NLAT ? xlat + (size_t)rn * 1024 : xctx + (size_t)(rn - NLAT) * 1024, F.lane, nv);
        const float* m = mod + (size_t)mod_idx(r) * 6144;
        norm_mod_row(v, g, m + 1024, m, rsH, (unsigned)r * 2048u, F.lane);
    }
}

constexpr int P7_WROW = 1040, P7_PLANE = 16 * P7_WROW * 2, P7_IMG = 2 * P7_PLANE + 2 * 4096, P7_MISC = 2 * P7_IMG;
static_assert(P7_MISC + 512 + 3 * 2048 + 256 + 512 <= LDS_MISC, "P7 LDS map");
__device__ __forceinline__ void p7_router(const Frame& F, KArgs a, int layer, const bf16* xb, int nrows, bool dry = false) {
    const float* mod = (const float*)(F.ws + WS_MOD) + (size_t)layer * 9 * 6144; const float* g = a->in[I_N2G] + layer * 1024; bf16* H = (bf16*)(F.ws + WS_H);
    LAS unsigned char* L = F.lds;
    LAS float* cvec = (LAS float*)(L + P7_MISC);
    LAS float* cred = cvec + 32;
    LAS int* rb = (LAS int*)(L + P7_MISC + 1024);
    LAS float* rlo = (LAS float*)(L + P7_MISC + 1024 + 2048);
    LAS float* rhi = (LAS float*)(L + P7_MISC + 1024 + 4096);
    LAS int* bcnt = (LAS int*)(L + P7_MISC + 1024 + 6144);
    const int ntl = nrows >> 4, tb = ntl / F.G, trem = ntl % F.G;
    const int cnt = tb + (F.vcu < trem ? 1 : 0), ts = F.vcu * tb + (F.vcu < trem ? F.vcu : trem);
    const int r0 = ts * 16, r1 = r0 + cnt * 16;
    const int mi0 = mod_idx(r0), mi1 = mod_idx(r1 - 1);
    const int lc = F.lane & 15, lg = F.lane >> 4;
    __syncthreads();
    if (F.tid < 64) bcnt[F.tid] = 0;
    for (int im = 0; im < (mi1 != mi0 ? 2 : 1); ++im) {
        const float* m = mod + (size_t)(im ? mi1 : mi0) * 6144; LAS unsigned char* I = L + im * P7_IMG;
        const int k = 2 * F.tid;
        const float G0 = g[k] * (1.f + m[4 * 1024 + k]), G1 = g[k + 1] * (1.f + m[4 * 1024 + k + 1]), s0 = m[3 * 1024 + k], s1 = m[3 * 1024 + k + 1];
        ((LAS float*)(I + 2 * P7_PLANE))[k] = G0; ((LAS float*)(I + 2 * P7_PLANE))[k + 1] = G1; ((LAS float*)(I + 2 * P7_PLANE + 4096))[k] = s0; ((LAS float*)(I + 2 * P7_PLANE + 4096))[k + 1] = s1;
        const f32x4* wp = (const f32x4*)(a->in[I_WROUTER] + (size_t)k * 16);
        float cp[16];
#pragma unroll
        for (int e4 = 0; e4 < 4; ++e4) { const f32x4 wa = wp[e4], wb = wp[4 + e4];
#pragma unroll
            for (int i = 0; i < 4; ++i) { const int e = 4 * e4 + i; const float a0 = G0 * wa[i], a1 = G1 * wb[i];
                const unsigned h = pk2(a0, a1); const unsigned l = pk2(a0 - lo_bf(h), a1 - hi_bf(h));
                *(LAS unsigned*)(I + e * (P7_WROW * 2) + k * 2) = h; *(LAS unsigned*)(I + P7_PLANE + e * (P7_WROW * 2) + k * 2) = l;
                cp[e] = s0 * wa[i] + s1 * wb[i]; } }
#pragma unroll
        for (int s = 0; s < 4; ++s) { const int width = 8 >> s; const bool up = (F.lane >> s) & 1;
#pragma unroll
            for (int i = 0; i < width; ++i) { const float send = up ? cp[i] : cp[i + width], keep = up ? cp[i + width] : cp[i]; cp[i] = keep + __shfl_xor(send, 1 << s); } }
        float tot = cp[0]; tot += __shfl_xor(tot, 16); tot += __shfl_xor(tot, 32);
        if (F.lane < 16) cred[F.wave * 16 + (((F.lane & 1) << 3) | ((F.lane & 2) << 1) | ((F.lane & 4) >> 1) | ((F.lane & 8) >> 3))] = tot;
        __syncthreads();
        if (F.tid < 16) { float c = 0.f;
#pragma unroll
            for (int w = 0; w < 8; ++w) c += cred[w * 16 + F.tid];
            cvec[im * 16 + F.tid] = c; }
        __syncthreads();
    }
    const __amdgpu_buffer_rsrc_t rsH = wt_rsrc(H, (size_t)NTOK * 2048);
    const float rbias0 = a->in[I_RBIAS][4 * lg], rbias1 = a->in[I_RBIAS][4 * lg + 1], rbias2 = a->in[I_RBIAS][4 * lg + 2], rbias3 = a->in[I_RBIAS][4 * lg + 3];
#pragma unroll 1
    for (int t = ts + F.wave; t < ts + cnt; t += 8) {
        const int row = t * 16 + lc; const int im = mod_idx(t * 16) != mi0 ? 1 : 0;
        const LAS unsigned char* I = L + im * P7_IMG;
        const bf16* xr = xb + (size_t)row * 1024 + lg * 8;
        bf16x8 af[32];
#pragma unroll
        for (int ks = 0; ks < 32; ++ks) af[ks] = *(const bf16x8*)(xr + ks * 32);
        f32x4 aS = (f32x4){0.f, 0.f, 0.f, 0.f}, aH = aS, aL = aS;
        const LAS unsigned char* Iw = I + lc * (P7_WROW * 2) + lg * 16;
#pragma unroll
        for (int ks = 0; ks < 32; ++ks) { const bf16x8 wh = *(const LAS bf16x8*)(Iw + ks * 64), wl = *(const LAS bf16x8*)(Iw + P7_PLANE + ks * 64);
            aH = mfma16(wh, af[ks], aH); aL = mfma16(wl, af[ks], aL); aS = mfma16(af[ks], af[ks], aS); }
        const float dsel = (lc & 2) ? ((lc & 1) ? aS[3] : aS[2]) : ((lc & 1) ? aS[1] : aS[0]);
        const float rstd = frsq(__shfl(dsel, lc + 16 * (lc >> 2)) * (1.f / 1024.f) + EPS);
        {
            const f32x4 cv = *(const LAS f32x4*)(cvec + im * 16 + 4 * lg);
            const float s0 = sigmf(rstd * (aH[0] + aL[0]) + cv[0]), s1 = sigmf(rstd * (aH[1] + aL[1]) + cv[1]), s2 = sigmf(rstd * (aH[2] + aL[2]) + cv[2]), s3 = sigmf(rstd * (aH[3] + aL[3]) + cv[3]);
            const float e0 = s0 + rbias0, e1 = s1 + rbias1, e2 = s2 + rbias2, e3 = s3 + rbias3;
            int i1 = 0, i2 = 0; float m1 = -1e30f, m2 = -1e30f, w1 = 0.f, w2 = 0.f;
            { const float ee[4] = {e0, e1, e2, e3}; const float ss[4] = {s0, s1, s2, s3};
#pragma unroll
              for (int q = 0; q < 4; ++q) { const float x = ee[q]; if (x > m1) { m2 = m1; i2 = i1; w2 = w1; m1 = x; i1 = q; w1 = ss[q]; } else if (x > m2) { m2 = x; i2 = q; w2 = ss[q]; } } }
            const float gs = m1 + m2;
            const float g0 = __shfl(gs, lc), g1 = __shfl(gs, lc + 16), g2 = __shfl(gs, lc + 32), g3 = __shfl(gs, lc + 48);
            int best = 0; float bs = g0; if (g1 > bs) { bs = g1; best = 1; } if (g2 > bs) { bs = g2; best = 2; } if (g3 > bs) { bs = g3; best = 3; }
            if (lg == best) {
                const float inv = 1.f / (w1 + w2); const float a1 = w1 * inv, a2 = w2 * inv;
                const int lo = i1 < i2 ? i1 : i2, hi = i1 < i2 ? i2 : i1; const float wl = i1 < i2 ? a1 : a2, wh = i1 < i2 ? a2 : a1;
                const int pp = lo == 0 ? hi - 1 : (lo == 1 ? hi + 1 : 5);
                const int lr = row - r0; rb[lr] = best * 6 + pp; rlo[lr] = wl; rhi[lr] = wh;
            }
        }
        const LAS float* Gs = (const LAS float*)(I + 2 * P7_PLANE) + lg * 8; const unsigned hro = ((unsigned)row * 1024u + (unsigned)lg * 8u) * 2u;
#pragma unroll
        for (int ks = 0; ks < 32; ++ks) { const u32x4 w = __builtin_bit_cast(u32x4, af[ks]);
            const f32x4 ga = *(const LAS f32x4*)(Gs + ks * 32), gb = *(const LAS f32x4*)(Gs + ks * 32 + 4), ha = *(const LAS f32x4*)(Gs + 1024 + ks * 32), hb = *(const LAS f32x4*)(Gs + 1024 + ks * 32 + 4);
            u32x4 o; o.x = pk2(lo_bf(w.x) * rstd * ga.x + ha.x, hi_bf(w.x) * rstd * ga.y + ha.y); o.y = pk2(lo_bf(w.y) * rstd * ga.z + ha.z, hi_bf(w.y) * rstd * ga.w + ha.w);
            o.z = pk2(lo_bf(w.z) * rstd * gb.x + hb.x, hi_bf(w.z) * rstd * gb.y + hb.y); o.w = pk2(lo_bf(w.w) * rstd * gb.z + hb.z, hi_bf(w.w) * rstd * gb.w + hb.w);
            wt_st128(rsH, hro + ks * 64, o); }
    }
    __syncthreads();
    const int n = dry ? 0 : r1 - r0;
    int myslot = -1, myb = 0;
    if (F.tid < n) { myb = rb[F.tid]; myslot = atomicAdd((int*)&bcnt[myb], 1); }
    __syncthreads();
    if (F.tid < NBUCKET && !dry) { const int c = bcnt[F.tid]; bcnt[32 + F.tid] = c > 0 ? (int)atomicAdd(F.ctl + CW_CNT + layer * 32 + F.tid, (unsigned)c) : 0; }
    __syncthreads();
    if (F.tid < n) { const size_t p = (size_t)myb * NTOK + bcnt[32 + myb] + myslot;
        ((int*)(F.ws + WS_TOK))[p] = r0 + F.tid; ((float*)(F.ws + WS_WLO))[p] = rlo[F.tid]; ((float*)(F.ws + WS_WHI))[p] = rhi[F.tid];
        ((int*)(F.ws + WS_POS))[r0 + F.tid] = (myb << 24) | (bcnt[32 + myb] + myslot); }
    __syncthreads();
}

__device__ __forceinline__ void build_moe_tab(const Frame& F, LAS int* tab, int layer) {
    __syncthreads();
    if (F.tid < NBUCKET) tab[32 + F.tid] = (int)__hip_atomic_load(F.ctl + CW_CNT + layer * 32 + F.tid, __ATOMIC_RELAXED, __HIP_MEMORY_SCOPE_AGENT);
    __syncthreads();
    if (F.tid == 0) { int acc = 0; for (int k = 0; k < NBUCKET; ++k) { tab[k] = acc; acc += (tab[32 + k] + 255) >> 8; } tab[NBUCKET] = acc; }
    __syncthreads();
}
__device__ __forceinline__ void moe_ld_row(const Frame& F, const LAS int* tab, const bf16* xrow, int pos, u32x2 (&xw)[4], u32x2 (&yw)[4]) {
    const int k = pos >> 24, slot = pos & 0xffffff; const bf16* yr = (const bf16*)(F.ws + WS_YM) + ((size_t)tab[k] * 256 + slot) * 1024;
#pragma unroll
    for (int j = 0; j < 4; ++j) { xw[j] = *(const u32x2*)(xrow + 4 * F.lane + 256 * j); yw[j] = *(const u32x2*)(yr + 4 * F.lane + 256 * j); }
}
__device__ __forceinline__ float moe_add_row(const Frame& F, const u32x2 (&xw)[4], const u32x2 (&yw)[4], const float* g2, f32x4 (&v)[4]) {
    float s = 0.f;
#pragma unroll
    for (int j = 0; j < 4; ++j) { const f32x4 gg = *(const f32x4*)(g2 + 4 * F.lane + 256 * j);
        f32x4 y; y.x = lo_bf(yw[j].x); y.y = hi_bf(yw[j].x); y.z = lo_bf(yw[j].y); y.w = hi_bf(yw[j].y);
        const f32x4 xv = (f32x4){lo_bf(xw[j].x), hi_bf(xw[j].x), lo_bf(xw[j].y), hi_bf(xw[j].y)};
        v[j] = xv + gg * y; s += (v[j].x * v[j].x + v[j].y * v[j].y) + (v[j].z * v[j].z + v[j].w * v[j].w); }
    return s;
}
__device__ __forceinline__ void p1_norm_moe(const Frame& F, KArgs a, bf16* xb) {
    LAS int* tab = (LAS int*)(F.lds + 131072 + 4096);
    build_moe_tab(F, tab, 0);
    const float* mod0 = (const float*)(F.ws + WS_MOD); const float* mod1 = mod0 + (size_t)9 * 6144; const float* g = a->in[I_N1G] + 1024; bf16* H = (bf16*)(F.ws + WS_H);
    const int* POS = (const int*)(F.ws + WS_POS);
    const __amdgpu_buffer_rsrc_t rsH = wt_rsrc(H, (size_t)NTOK * 2048), rsX = wt_rsrc(xb, (size_t)NTOK * 2048);
    int r = F.gw; u32x2 nx[4], ny[4];
    if (r < NTOK) moe_ld_row(F, tab, xb + (size_t)r * 1024, POS[r], nx, ny);
    int posn = r + F.NGW < NTOK ? POS[r + F.NGW] : 0;
    for (; r < NTOK; r += F.NGW) {
        bf16* xr = xb + (size_t)r * 1024; const int mi = mod_idx(r);
        u32x2 cx[4], cy[4];
#pragma unroll
        for (int j = 0; j < 4; ++j) { cx[j] = nx[j]; cy[j] = ny[j]; }
        { const int rn = r + F.NGW; if (rn < NTOK) moe_ld_row(F, tab, xb + (size_t)rn * 1024, posn, nx, ny); posn = rn + F.NGW < NTOK ? POS[rn + F.NGW] : 0; }
        f32x4 v[4]; const float s = moe_add_row(F, cx, cy, mod0 + (size_t)mi * 6144 + 5 * 1024, v);
        const float rstd = frsq(wave_sum(s) * (1.f / 1024.f) + EPS);
        const float* m = mod1 + (size_t)mi * 6144; const unsigned ro = (unsigned)r * 2048u + (unsigned)F.lane * 8u;
#pragma unroll
        for (int j = 0; j < 4; ++j) { const int k = 4 * F.lane + 256 * j; { u32x2 w; w.x = pk2(v[j].x, v[j].y); w.y = pk2(v[j].z, v[j].w); wt_st64(rsX, ro + j * 512, w); }
            const f32x4 gg = *(const f32x4*)(g + k), cc = *(const f32x4*)(m + 1024 + k), hh = *(const f32x4*)(m + k); const f32x4 y = v[j] * rstd * gg * (cc + 1.f) + hh;
            { u32x2 w; w.x = pk2(y.x, y.y); w.y = pk2(y.z, y.w); wt_st64(rsH, ro + j * 512, w); } }
    }
}

__device__ __forceinline__ void p_final(const Frame& F, KArgs a) {
    const float* g = a->in[I_FNG];
    LAS int* tab = (LAS int*)(F.lds + 131072 + 4096);
    build_moe_tab(F, tab, 1);
    const float* mod1 = (const float*)(F.ws + WS_MOD) + (size_t)9 * 6144; const int* POS = (const int*)(F.ws + WS_POS);
    const bf16* xb = (const bf16*)(F.ws + WS_XB);
    f32x4 gfin[4];
#pragma unroll
    for (int j = 0; j < 4; ++j) gfin[j] = *(const f32x4*)(g + 4 * F.lane + 256 * j);
    int r = F.gw; u32x2 nx[4], ny[4];
    if (r < NLAT) moe_ld_row(F, tab, xb + (size_t)r * 1024, POS[r], nx, ny);
    int posn = r + F.NGW < NLAT ? POS[r + F.NGW] : 0;
    for (; r < NLAT; r += F.NGW) {
        f32x4* xr = (f32x4*)(a->out + (size_t)r * 1024) + F.lane;
        u32x2 cx[4], cy[4];
#pragma unroll
        for (int j = 0; j < 4; ++j) { cx[j] = nx[j]; cy[j] = ny[j]; }
        { const int rn = r + F.NGW; if (rn < NLAT) moe_ld_row(F, tab, xb + (size_t)rn * 1024, posn, nx, ny); posn = rn + F.NGW < NLAT ? POS[rn + F.NGW] : 0; }
        f32x4 v[4]; const float s = moe_add_row(F, cx, cy, mod1 + (size_t)(r >> 12) * 6144 + 5 * 1024, v);
        const float rstd = frsq(wave_sum(s) * (1.f / 1024.f) + EPS);
#pragma unroll
        for (int j = 0; j < 4; ++j) __builtin_nontemporal_store(v[j] * rstd * gfin[j], xr + 64 * j);
    }
}
__device__ __forceinline__ void row_bk(int r, int& b, int& key, bool& lat) { lat = r < NLAT; if (lat) { b = r >> 12; key = r & 4095; } else { const int rc = r - NLAT; b = rc >> 8; key = 4096 + (rc & 255); } }

constexpr int MLA_QROW = 400, MLA_KVROW = 272, MLA_QB = 96 * MLA_QROW;
__device__ __forceinline__ float sumsq8(bf16x8 v) { const u32x4 w = __builtin_bit_cast(u32x4, v); float s = 0.f;
    { const float a = lo_bf(w.x), b = hi_bf(w.x), c = lo_bf(w.y), d = hi_bf(w.y), e = lo_bf(w.z), f = hi_bf(w.z), g = lo_bf(w.w), h = hi_bf(w.w); s = (a * a + b * b) + (c * c + d * d) + ((e * e + f * f) + (g * g + h * h)); } return s; }
template <int LAYER>
__device__ __forceinline__ void p3_mla_stream(const Frame& F_, KArgs a) {
    Frame F = F_; { int t_ = F_.tid; asm volatile("" : "+v"(t_)); F.tid = t_; F.lane = t_ & 63; }
    LAS unsigned char* L = F.lds;
    const int h = F.vcu & 3, lr = F.lane & 15, lq = F.lane >> 4;
    const bf16* proj = (const bf16*)(F.ws + WS_PROJ);
    __syncthreads();
    {
        const bf16* Wq = (const bf16*)(F.ws + WS_WUQ) + ((size_t)LAYER * 384 + h * 96) * 192; const bf16* Wkv = (const bf16*)(F.ws + WS_WUKV) + ((size_t)LAYER * 512 + h * 128) * 128;
#pragma unroll
        for (int it = 0; it < (96 * 24 + 511) / 512; ++it) { const int i = F.tid + it * 512; if (i >= 96 * 24) break; const int n = i / 24, c = i % 24; *(LAS u32x4*)(L + n * MLA_QROW + c * 16) = *(const u32x4*)(Wq + n * 192 + c * 8); }
#pragma unroll
        for (int it = 0; it < 4; ++it) { const int i = F.tid + it * 512; const int n = i >> 4, c = i & 15; *(LAS u32x4*)(L + MLA_QB + n * MLA_KVROW + c * 16) = *(const u32x4*)(Wkv + n * 128 + c * 8); }
    }
    __syncthreads();
    const float* ropec = (const float*)(F.ws + WS_ROPE); const float* ropes = ropec + 4096 * 16;
    const int nblk4 = F.G >> 2;
    bf16x8 aq[6], akv[4], ar, nq[6], nkv[4], nr;
    { const int ch0 = F.vcu >> 2; if (ch0 < NTOK / 128) { const bf16* prow = proj + (size_t)(ch0 * 128 + F.wave * 16 + lr) * PROJ_LD;
#pragma unroll
        for (int ks = 0; ks < 6; ++ks) aq[ks] = *(const bf16x8*)(prow + PJ_MQ + ks * 32 + lq * 8);
#pragma unroll
        for (int ks = 0; ks < 4; ++ks) akv[ks] = *(const bf16x8*)(prow + PJ_MKV + ks * 32 + lq * 8);
        ar = *(const bf16x8*)(prow + PJ_MKV + 128 + lq * 8); } }
#pragma unroll 1
    for (int ch = F.vcu >> 2; ch < NTOK / 128; ch += nblk4) {
        const int rw = ch * 128 + F.wave * 16;
        int lo_ = lr * 1; asm volatile("" : "+v"(lo_));
        const LAS unsigned char* Lq = L + lo_ * MLA_QROW + lq * 16; const LAS unsigned char* Lk = L + MLA_QB + lo_ * MLA_KVROW + lq * 16;
        int b0, key0; bool lat; row_bk(rw, b0, key0, lat);
        const bool want_q = (LAYER == 0) || lat;
        { const int chn = ch + nblk4; if (chn < NTOK / 128) { const bf16* prow = proj + (size_t)(chn * 128 + F.wave * 16 + lr) * PROJ_LD;
#pragma unroll
            for (int ks = 0; ks < 6; ++ks) nq[ks] = *(const bf16x8*)(prow + PJ_MQ + ks * 32 + lq * 8);
#pragma unroll
            for (int ks = 0; ks < 4; ++ks) nkv[ks] = *(const bf16x8*)(prow + PJ_MKV + ks * 32 + lq * 8);
            nr = *(const bf16x8*)(prow + PJ_MKV + 128 + lq * 8); } }
        float sq = 0.f, sk = 0.f;
#pragma unroll
        for (int ks = 0; ks < 6; ++ks) sq += sumsq8(aq[ks]);
#pragma unroll
        for (int ks = 0; ks < 4; ++ks) sk += sumsq8(akv[ks]);
        sq += __shfl_xor(sq, 16); sq += __shfl_xor(sq, 32); sk += __shfl_xor(sk, 16); sk += __shfl_xor(sk, 32);
        const float rq = QSCALE * frsq(sq * (1.f / 192.f) + EPS), rk = frsq(sk * (1.f / 128.f) + EPS);
        if (want_q) {
            f32x4 acc[6];
#pragma unroll
            for (int nt = 0; nt < 6; ++nt) acc[nt] = (f32x4){0.f, 0.f, 0.f, 0.f};
#pragma unroll
            for (int ks = 0; ks < 6; ++ks)
#pragma unroll
                for (int nt = 0; nt < 6; ++nt) acc[nt] = mfma16(*(const LAS bf16x8*)(Lq + nt * 16 * MLA_QROW + ks * 64), aq[ks], acc[nt]);
            if (lat) {
#pragma unroll
                for (int j = 0; j < 4; ++j) { const float cs = ropec[(key0 + lr) * 16 + lq * 4 + j], sn = ropes[(key0 + lr) * 16 + lq * 4 + j]; const float x1 = acc[4][j], x2 = acc[5][j];
                    acc[4][j] = x1 * cs - x2 * sn; acc[5][j] = x1 * sn + x2 * cs; } }
            bf16* Q = (bf16*)(F.ws + WS_Q) + (size_t)(rw + lr) * 384 + h * 96 + lq * 4;
#pragma unroll
            for (int nt = 0; nt < 6; ++nt) { u32x2 w; w.x = pk2(acc[nt][0] * rq, acc[nt][1] * rq); w.y = pk2(acc[nt][2] * rq, acc[nt][3] * rq); *(u32x2*)(Q + nt * 16) = w; }
        }
        {
            f32x4 ak[4], av[4];
#pragma unroll
            for (int nt = 0; nt < 4; ++nt) { ak[nt] = (f32x4){0.f, 0.f, 0.f, 0.f}; av[nt] = (f32x4){0.f, 0.f, 0.f, 0.f}; }
#pragma unroll
            for (int ks = 0; ks < 4; ++ks)
#pragma unroll
                for (int nt = 0; nt < 4; ++nt) {
                    ak[nt] = mfma16(*(const LAS bf16x8*)(Lk + nt * 16 * MLA_KVROW + ks * 64), akv[ks], ak[nt]);
                    av[nt] = mfma16(akv[ks], *(const LAS bf16x8*)(Lk + (64 + nt * 16) * MLA_KVROW + ks * 64), av[nt]); }
            bf16* Kg = (bf16*)(F.ws + WS_K) + ((size_t)(b0 * 4 + h) * NKEY + key0 + lr) * 96;
            bf16* Vt = (bf16*)(F.ws + WS_VT) + (size_t)(b0 * 4 + h) * 64 * NKEY;
            const int vcol = MK_AT16 ? ((key0 & ~31) + 8 * lq + ((key0 >> 2) & 4)) : (key0 + lq * 4);
            const float r0v = __shfl(rk, 4 * lq), r1v = __shfl(rk, 4 * lq + 1), r2v = __shfl(rk, 4 * lq + 2), r3v = __shfl(rk, 4 * lq + 3);
#pragma unroll
            for (int nt = 0; nt < 4; ++nt) {
                u32x2 w; w.x = pk2(ak[nt][0] * rk, ak[nt][1] * rk); w.y = pk2(ak[nt][2] * rk, ak[nt][3] * rk); *(u32x2*)(Kg + nt * 16 + lq * 4) = w;
                u32x2 v; v.x = pk2(av[nt][0] * r0v, av[nt][1] * r1v); v.y = pk2(av[nt][2] * r2v, av[nt][3] * r3v); *(u32x2*)(Vt + (size_t)(nt * 16 + lr) * NKEY + vcol) = v; }
            const u32x4 mine = __builtin_bit_cast(u32x4, ar); u32x4 oth; oth.x = __shfl_xor(mine.x, 32); oth.y = __shfl_xor(mine.y, 32); oth.z = __shfl_xor(mine.z, 32); oth.w = __shfl_xor(mine.w, 32);
            const bool second = lq >= 2; const int j0 = (lq & 1) * 8;
            float xm[8], xo[8];
            xm[0] = lo_bf(mine.x); xm[1] = hi_bf(mine.x); xm[2] = lo_bf(mine.y); xm[3] = hi_bf(mine.y); xm[4] = lo_bf(mine.z); xm[5] = hi_bf(mine.z); xm[6] = lo_bf(mine.w); xm[7] = hi_bf(mine.w);
            xo[0] = lo_bf(oth.x); xo[1] = hi_bf(oth.x); xo[2] = lo_bf(oth.y); xo[3] = hi_bf(oth.y); xo[4] = lo_bf(oth.z); xo[5] = hi_bf(oth.z); xo[6] = lo_bf(oth.w); xo[7] = hi_bf(oth.w);
            float o[8];
#pragma unroll
            for (int j = 0; j < 8; ++j) { float cs = 1.f, sn = 0.f; if (lat) { cs = ropec[(key0 + lr) * 16 + j0 + j]; sn = ropes[(key0 + lr) * 16 + j0 + j]; }
                o[j] = second ? (xo[j] * sn + xm[j] * cs) : (xm[j] * cs - xo[j] * sn); }
            u32x4 w; w.x = pk2(o[0], o[1]); w.y = pk2(o[2], o[3]); w.z = pk2(o[4], o[5]); w.w = pk2(o[6], o[7]);
            *(u32x4*)(Kg + 64 + lq * 8) = w;
        }
#pragma unroll
        for (int ks = 0; ks < 6; ++ks) aq[ks] = nq[ks];
#pragma unroll
        for (int ks = 0; ks < 4; ++ks) akv[ks] = nkv[ks];
        ar = nr;
    }
    __syncthreads();
}

__device__ __forceinline__ void p3_conv_unit(const Frame& F_, KArgs a, int layer, int r0) {
    Frame F = F_; { int t_ = F_.tid; asm volatile("" : "+v"(t_)); F.tid = t_; F.lane = t_ & 63; }
    LAS float* U = (LAS float*)F.lds;
    const bf16* proj = (const bf16*)(F.ws + WS_PROJ);
    const bool lat = r0 < NLAT; const int Ls = lat ? SEQ : CTXL; const int t0 = lat ? (r0 & 4095) : ((r0 - NLAT) & 255);
    __syncthreads();
    u32x4 cwa[6], cwb[6];
#pragma unroll
    for (int it = 0; it < 6; ++it) { const int i = F.tid + it * 512; const int rr = i >> 5, c8 = i & 31; const int t = t0 - 15 + rr;
        if (i < 94 * 32 && t >= 0 && t < Ls) { const bf16* p = proj + (size_t)(r0 - 15 + rr) * PROJ_LD + PJ_CV + c8 * 8; cwa[it] = *(const u32x4*)p; cwb[it] = *(const u32x4*)(p + 256); } }
#pragma unroll
    for (int it = 0; it < 6; ++it) { const int i = F.tid + it * 512; if (i >= 94 * 32) break; const int rr = i >> 5, c8 = i & 31; const int t = t0 - 15 + rr; LAS float* d = U + rr * 256 + c8 * 8;
        if (t >= 0 && t < Ls) { const u32x4 wa = cwa[it], wb = cwb[it];
            d[0] = lo_bf(wa.x) * sigmf(lo_bf(wb.x)); d[1] = hi_bf(wa.x) * sigmf(hi_bf(wb.x)); d[2] = lo_bf(wa.y) * sigmf(lo_bf(wb.y)); d[3] = hi_bf(wa.y) * sigmf(hi_bf(wb.y));
            d[4] = lo_bf(wa.z) * sigmf(lo_bf(wb.z)); d[5] = hi_bf(wa.z) * sigmf(hi_bf(wb.z)); d[6] = lo_bf(wa.w) * sigmf(lo_bf(wb.w)); d[7] = hi_bf(wa.w) * sigmf(hi_bf(wb.w)); }
        else {
#pragma unroll
            for (int j = 0; j < 8; ++j) d[j] = 0.f; } }
    __syncthreads();
    const int c = F.tid & 255, th = F.tid >> 8;
    float o[32];
    {
        const float* w = a->in[I_CVW] + (size_t)layer * 31 * 256 + c; const float bias = a->in[I_CVB][layer * 256 + c];
        float wk[31];
#pragma unroll
        for (int k = 0; k < 31; ++k) wk[k] = w[k * 256];
#pragma unroll
        for (int t = 0; t < 32; ++t) o[t] = bias;
#pragma unroll
        for (int i = 0; i < 62; ++i) { const float v = U[(th * 32 + i) * 256 + c];
#pragma unroll
            for (int t = 0; t < 32; ++t) { if (i - t >= 0 && i - t < 31) o[t] += v * wk[i - t]; } }
    }
    __syncthreads();
#pragma unroll
    for (int t = 0; t < 32; ++t) U[(th * 32 + t) * 256 + c] = o[t];
    __syncthreads();
    const float* lg = a->in[I_CVLNG] + layer * 256; const float* lb = a->in[I_CVLNB] + layer * 256; const float* mg = a->in[I_MIXG] + layer * 1024 + 512;
    bf16* Y = (bf16*)(F.ws + WS_H);
    const f32x4 gg = *(const f32x4*)(lg + 4 * F.lane), bb = *(const f32x4*)(lb + 4 * F.lane), m4 = *(const f32x4*)(mg + 4 * F.lane);
    f32x4 v[8]; float s[8];
#pragma unroll
    for (int i = 0; i < 8; ++i) { v[i] = *(const LAS f32x4*)(U + (F.wave + 8 * i) * 256 + 4 * F.lane); s[i] = (v[i].x + v[i].y) + (v[i].z + v[i].w); }
#pragma unroll
    for (int o2 = 1; o2 < 16; o2 <<= 1) {
#pragma unroll
        for (int i = 0; i < 8; ++i) s[i] = xsum_step(s[i], o2); }
#pragma unroll
    for (int i = 0; i < 8; ++i) { v[i] = v[i] - s[i] * (1.f / 64.f); s[i] = (v[i].x * v[i].x + v[i].y * v[i].y) + (v[i].z * v[i].z + v[i].w * v[i].w); }
#pragma unroll
    for (int o2 = 1; o2 < 16; o2 <<= 1) {
#pragma unroll
        for (int i = 0; i < 8; ++i) s[i] = xsum_step(s[i], o2); }
#pragma unroll
    for (int i = 0; i < 8; ++i) { const float rstd = frsq(s[i] * (1.f / 64.f) + EPS); f32x4 y = v[i] * rstd * gg + bb; y.x = siluf(y.x); y.y = siluf(y.y); y.z = siluf(y.z); y.w = siluf(y.w);
        v[i] = y; s[i] = (y.x * y.x + y.y * y.y) + (y.z * y.z + y.w * y.w); }
#pragma unroll
    for (int o2 = 1; o2 < 64; o2 <<= 1) {
#pragma unroll
        for (int i = 0; i < 8; ++i) s[i] = xsum_step(s[i], o2); }
#pragma unroll
    for (int i = 0; i < 8; ++i) { const float rn = frsq(s[i] * (1.f / 256.f) + EPS); const f32x4 y = v[i] * rn * m4;
        u32x2 w; w.x = pk2(y.x, y.y); w.y = pk2(y.z, y.w); *(u32x2*)(Y + (size_t)(r0 + F.wave + 8 * i) * 1024 + 512 + 4 * F.lane) = w; }
}

__device__ __forceinline__ void p3_gmlp_unit(const Frame& F_, KArgs a, int layer, int r0) {
    Frame F = F_; { int t_ = F_.tid; asm volatile("" : "+v"(t_)); F.tid = t_; F.lane = t_ & 63; }
    LAS bf16* vT = (LAS bf16*)F.lds;
    LAS float* red = (LAS float*)(F.lds + 69632);
    const bf16* proj = (const bf16*)(F.ws + WS_PROJ);
    const float* lg = a->in[I_GMLNG] + layer * 256; const float* lb = a->in[I_GMLNB] + layer * 256;
    __syncthreads();
    u32x2 gw[16];
#pragma unroll
    for (int it = 0; it < 16; ++it) gw[it] = *(const u32x2*)(proj + (size_t)(r0 + F.wave * 16 + it) * PROJ_LD + PJ_GM + 256 + 4 * F.lane);
    {
        f32x4 vv[16]; float sm[16];
#pragma unroll
        for (int it = 0; it < 16; ++it) { const u32x2 w = gw[it]; vv[it].x = gelu_tanh(lo_bf(w.x)); vv[it].y = gelu_tanh(hi_bf(w.x)); vv[it].z = gelu_tanh(lo_bf(w.y)); vv[it].w = gelu_tanh(hi_bf(w.y));
            sm[it] = (vv[it].x + vv[it].y) + (vv[it].z + vv[it].w); }
#pragma unroll
        for (int o2 = 1; o2 < 64; o2 <<= 1) {
#pragma unroll
            for (int it = 0; it < 16; ++it) sm[it] = xsum_step(sm[it], o2); }
#pragma unroll
        for (int it = 0; it < 16; ++it) { vv[it] = vv[it] - sm[it] * (1.f / 256.f); sm[it] = (vv[it].x * vv[it].x + vv[it].y * vv[it].y) + (vv[it].z * vv[it].z + vv[it].w * vv[it].w); }
#pragma unroll
        for (int o2 = 1; o2 < 64; o2 <<= 1) {
#pragma unroll
            for (int it = 0; it < 16; ++it) sm[it] = xsum_step(sm[it], o2); }
        const f32x4 gg = *(const f32x4*)(lg + 4 * F.lane), bb = *(const f32x4*)(lb + 4 * F.lane);
#pragma unroll
        for (int it = 0; it < 16; ++it) { const float rstd = frsq(sm[it] * (1.f / 256.f) + EPS); vv[it] = vv[it] * rstd * gg + bb; }
#pragma unroll
        for (int i = 0; i < 4; ++i) { u32x4 w0, w1;
            w0.x = pk2(vv[0][i], vv[1][i]); w0.y = pk2(vv[2][i], vv[3][i]); w0.z = pk2(vv[4][i], vv[5][i]); w0.w = pk2(vv[6][i], vv[7][i]);
            w1.x = pk2(vv[8][i], vv[9][i]); w1.y = pk2(vv[10][i], vv[11][i]); w1.z = pk2(vv[12][i], vv[13][i]); w1.w = pk2(vv[14][i], vv[15][i]);
            LAS bf16* d = vT + (4 * F.lane + i) * 136 + F.wave * 16; *(LAS u32x4*)d = w0; *(LAS u32x4*)(d + 8) = w1; }
    }
    __syncthreads();
    const int g = F.wave >> 1, ih = F.wave & 1, lr = F.lane & 15, lq = F.lane >> 4;
    const bf16* W = (const bf16*)(F.ws + WS_GMWS) + (size_t)(layer * 4 + g) * 128 * 128;
    u32x2 uw[4][4];
#pragma unroll
    for (int it = 0; it < 4; ++it)
#pragma unroll
        for (int dt = 0; dt < 4; ++dt) uw[it][dt] = *(const u32x2*)(proj + (size_t)(r0 + ih * 64 + it * 16 + lr) * PROJ_LD + PJ_GM + g * 64 + dt * 16 + 4 * lq);
    f32x4 acc[4][4];
#pragma unroll
    for (int dt = 0; dt < 4; ++dt)
#pragma unroll
        for (int it = 0; it < 4; ++it) acc[dt][it] = (f32x4){0.f, 0.f, 0.f, 0.f};
#pragma unroll 2
    for (int ks = 0; ks < 4; ++ks) {
        bf16x8 af[4], bfr[4];
#pragma unroll
        for (int dt = 0; dt < 4; ++dt) af[dt] = *(const LAS bf16x8*)(vT + (g * 64 + dt * 16 + lr) * 136 + ks * 32 + lq * 8);
#pragma unroll
        for (int it = 0; it < 4; ++it) bfr[it] = *(const bf16x8*)(W + (size_t)(ih * 64 + it * 16 + lr) * 128 + ks * 32 + lq * 8);
#pragma unroll
        for (int dt = 0; dt < 4; ++dt)
#pragma unroll
            for (int it = 0; it < 4; ++it) acc[dt][it] = mfma16(af[dt], bfr[it], acc[dt][it]);
    }
    const float* bs = a->in[I_GMBS] + (size_t)(layer * 4 + g) * 128;
#pragma unroll
    for (int it = 0; it < 4; ++it) { const int i = ih * 64 + it * 16 + lr; const float bsi = bs[i]; float ss = 0.f;
#pragma unroll
        for (int dt = 0; dt < 4; ++dt) { const u32x2 w = uw[it][dt];
            f32x4 u; u.x = gelu_tanh(lo_bf(w.x)); u.y = gelu_tanh(hi_bf(w.x)); u.z = gelu_tanh(lo_bf(w.y)); u.w = gelu_tanh(hi_bf(w.y));
            const f32x4 y = u * (acc[dt][it] + bsi); acc[dt][it] = y; ss += (y.x * y.x + y.y * y.y) + (y.z * y.z + y.w * y.w); }
        ss += __shfl_xor(ss, 16); ss += __shfl_xor(ss, 32);
        if (lq == 0) red[g * 128 + i] = ss; }
    __syncthreads();
    const float* mg = a->in[I_MIXG] + layer * 1024 + 256; bf16* Y = (bf16*)(F.ws + WS_H);
#pragma unroll
    for (int it = 0; it < 4; ++it) { const int i = ih * 64 + it * 16 + lr; const float rn = frsq((red[i] + red[128 + i] + red[256 + i] + red[384 + i]) * (1.f / 256.f) + EPS);
#pragma unroll
        for (int dt = 0; dt < 4; ++dt) { const int col = g * 64 + dt * 16 + 4 * lq; const f32x4 m4 = *(const f32x4*)(mg + col); const f32x4 y = acc[dt][it] * rn * m4;
            u32x2 w; w.x = pk2(y.x, y.y); w.y = pk2(y.z, y.w); *(u32x2*)(Y + (size_t)(r0 + i) * 1024 + 256 + col) = w; } }
}
__device__ __forceinline__ f32x16 mfma32(bf16x8 a, bf16x8 b, f32x16 c) { return __builtin_amdgcn_mfma_f32_32x32x16_bf16(a, b, c, 0, 0, 0); }
__device__ __forceinline__ bf16x8 pack8(float a0, float a1, float a2, float a3, float a4, float a5, float a6, float a7) {
    u32x4 w; w.x = pg8::cvt_pk_bf16(a0, a1); w.y = pg8::cvt_pk_bf16(a2, a3); w.z = pg8::cvt_pk_bf16(a4, a5); w.w = pg8::cvt_pk_bf16(a6, a7); return __builtin_bit_cast(bf16x8, w); }

constexpr int AT_KROW = 104, AT_VROW = 72, AT_KB = 64 * AT_KROW * 2, AT_VB = 64 * AT_VROW * 2;
__device__ __forceinline__ float fmax3c(float a, float b, float c) { return __builtin_fmaxf(__builtin_fmaxf(a, b), c); }
__device__ __forceinline__ int imax3(int a, int b, int c) { const int t = a > b ? a : b; return t > c ? t : c; }
__device__ __forceinline__ float max4(f32x4 v) { return fmaxf(fmaxf(v[0], v[1]), fmaxf(v[2], v[3])); }
__device__ __forceinline__ float rowmax32(const f32x16& a, const f32x16& b) {
    float m0 = fmaxf(a[0], a[1]), m1 = fmaxf(a[2], a[3]), m2 = fmaxf(b[0], b[1]), m3 = fmaxf(b[2], b[3]);
#pragma unroll
    for (int r = 4; r < 16; r += 4) { m0 = fmaxf(m0, fmaxf(a[r], a[r + 1])); m1 = fmaxf(m1, fmaxf(a[r + 2], a[r + 3])); m2 = fmaxf(m2, fmaxf(b[r], b[r + 1])); m3 = fmaxf(m3, fmaxf(b[r + 2], b[r + 3])); }
    float m = fmaxf(fmaxf(m0, m1), fmaxf(m2, m3)); return fmaxf(m, __shfl_xor(m, 32));
}
__device__ __forceinline__ void attn_unit(const Frame& F, int b, int h, int qrow0, int key0, int ntile) {
    LAS unsigned char* L = F.lds;
    const bf16* Kg = (const bf16*)(F.ws + WS_K) + ((size_t)(b * 4 + h) * NKEY + key0) * 96;
    const bf16* Vg = (const bf16*)(F.ws + WS_VT) + (size_t)(b * 4 + h) * 64 * NKEY + key0;
    const bf16* Q = (const bf16*)(F.ws + WS_Q);
    int tid_ = F.tid; asm volatile("" : "+v"(tid_));
    const int lane = tid_ & 63, hi = lane >> 5, l31 = lane & 31;
    const int qrow = qrow0 + F.wave * 32 + l31;
    bf16x8 qf[6];
#pragma unroll
    for (int ks = 0; ks < 6; ++ks) qf[ks] = *(const bf16x8*)(Q + (size_t)qrow * 384 + h * 96 + ks * 16 + hi * 8);
    const int kr0 = tid_ / 12, kc0 = tid_ % 12, kr1 = (tid_ + 512) / 12, kc1 = (tid_ + 512) % 12; const bool k2 = tid_ < 256;
    const int vd = tid_ >> 3, vc = tid_ & 7;
    const int klds0 = kr0 * (AT_KROW * 2) + kc0 * 16, klds1 = kr1 * (AT_KROW * 2) + kc1 * 16, vlds = 3 * AT_KB + vd * (AT_VROW * 2) + vc * 16;
    const unsigned kg0 = (unsigned)(kr0 * 96 + kc0 * 8), kg1 = (unsigned)(kr1 * 96 + kc1 * 8), vg0 = (unsigned)(vd * NKEY + vc * 8);
    u32x4 sk0, sk1 = (u32x4){0u, 0u, 0u, 0u}, sv;
    __syncthreads();
    {
        const u32x4 a0 = *(const u32x4*)(Kg + kg0), b0 = *(const u32x4*)(Kg + 64 * 96 + kg0), c0 = *(const u32x4*)(Kg + 128 * 96 + kg0); u32x4 a1 = sk1, b1 = sk1, c1 = sk1;
        if (k2) { a1 = *(const u32x4*)(Kg + kg1); b1 = *(const u32x4*)(Kg + 64 * 96 + kg1); c1 = *(const u32x4*)(Kg + 128 * 96 + kg1); }
        sv = *(const u32x4*)(Vg + vg0);
        *(LAS u32x4*)(L + klds0) = a0; *(LAS u32x4*)(L + AT_KB + klds0) = b0; *(LAS u32x4*)(L + 2 * AT_KB + klds0) = c0;
        if (k2) { *(LAS u32x4*)(L + klds1) = a1; *(LAS u32x4*)(L + AT_KB + klds1) = b1; *(LAS u32x4*)(L + 2 * AT_KB + klds1) = c1; }
        *(LAS u32x4*)(L + vlds) = sv;
    }
    __syncthreads();
    const int prow = (l31 & ~12) | ((l31 & 4) << 1) | ((l31 & 8) >> 1);
    const int koff = prow * (AT_KROW * 2) + hi * 16, voff = 3 * AT_KB + l31 * (AT_VROW * 2) + hi * 16;
    f32x16 O0, O1, SA0, SA1, SB0, SB1;
#pragma unroll
    for (int r = 0; r < 16; ++r) { O0[r] = 0.f; O1[r] = 0.f; SA0[r] = 0.f; SA1[r] = 0.f; }
#pragma unroll
    for (int ks = 0; ks < 6; ++ks) { const bf16x8 k0 = *(const LAS bf16x8*)(L + koff + ks * 32), k1 = *(const LAS bf16x8*)(L + 32 * (AT_KROW * 2) + koff + ks * 32);
        SA0 = mfma32(k0, qf[ks], SA0); SA1 = mfma32(k1, qf[ks], SA1); }
    float m = rowmax32(SA0, SA1), l = 0.f;
#pragma unroll
    for (int r = 0; r < 16; ++r) { SA0[r] -= m; SA1[r] -= m; }
    f32x16 NM;
#pragma unroll
    for (int r = 0; r < 16; ++r) NM[r] = -m;
    int kA = 0, kB = AT_KB, kC = 2 * AT_KB;
    bf16x8 ka0, ka1;
    ka0 = *(const LAS bf16x8*)(L + kB + koff); ka1 = *(const LAS bf16x8*)(L + kB + 32 * (AT_KROW * 2) + koff);
    float one = 1.f; asm volatile("" : "+v"(one));
#define AT_EXP(S0, S1, r) do { S0[r] = __builtin_amdgcn_exp2f(S0[r]); S1[r] = __builtin_amdgcn_exp2f(S1[r]); s0 += S0[r]; } while (0)
#define AT_SUM(S0, S1, r) do { s1 = __builtin_fmaf(S1[r], one, s1); } while (0)
#define AT_KRD(dst0, dst1, ks) do { dst0 = *(const LAS bf16x8*)(Kt + koff + (ks) * 32); dst1 = *(const LAS bf16x8*)(Kt + 32 * (AT_KROW * 2) + koff + (ks) * 32); } while (0)
#define AT_VRD(dst0, dst1, s) do { dst0 = *(const LAS bf16x8*)(Vt + voff + (s) * 32); dst1 = *(const LAS bf16x8*)(Vt + 32 * (AT_VROW * 2) + voff + (s) * 32); } while (0)
#define AT_SB() __builtin_amdgcn_sched_barrier(0)
#define BI(x) __float_as_int(x)
#define AT_TILE(S0, S1, T0, T1, J, NX) do { const int j_ = (J); constexpr bool nx = (NX); const bool nx2 = j_ + 2 < ntile, nx3 = j_ + 3 < ntile; \
        if (nx) sv = *(const u32x4*)(Vg + (size_t)(j_ + 1) * 64 + vg0); \
        if (nx3) { const bf16* kg = Kg + (size_t)(j_ + 3) * 64 * 96; sk0 = *(const u32x4*)(kg + kg0); if (k2) sk1 = *(const u32x4*)(kg + kg1); } \
        const LAS unsigned char* Kt = L + kB; const LAS unsigned char* Vt = L + (j_ & 1) * AT_VB; \
        float s0 = 0.f, s1 = 0.f; bf16x8 kb0, kb1, va0, va1, vb0, vb1; \
          \
        AT_KRD(kb0, kb1, 1); if (nx) { T0 = mfma32(ka0, qf[0], NM); T1 = mfma32(ka1, qf[0], NM); } AT_EXP(S0, S1, 0); AT_EXP(S0, S1, 1); AT_EXP(S0, S1, 2); AT_SB(); \
        AT_KRD(ka0, ka1, 2); if (nx) { T0 = mfma32(kb0, qf[1], T0); T1 = mfma32(kb1, qf[1], T1); } AT_EXP(S0, S1, 3); AT_EXP(S0, S1, 4); AT_EXP(S0, S1, 5); AT_SB(); \
        AT_KRD(kb0, kb1, 3); if (nx) { T0 = mfma32(ka0, qf[2], T0); T1 = mfma32(ka1, qf[2], T1); } AT_EXP(S0, S1, 6); AT_EXP(S0, S1, 7); AT_EXP(S0, S1, 8); AT_SB(); \
        AT_KRD(ka0, ka1, 4); if (nx) { T0 = mfma32(kb0, qf[3], T0); T1 = mfma32(kb1, qf[3], T1); } AT_EXP(S0, S1, 9); AT_EXP(S0, S1, 10); AT_EXP(S0, S1, 11); AT_SB(); \
        AT_KRD(kb0, kb1, 5); if (nx) { T0 = mfma32(ka0, qf[4], T0); T1 = mfma32(ka1, qf[4], T1); } AT_EXP(S0, S1, 12); AT_EXP(S0, S1, 13); AT_SB(); \
        AT_VRD(va0, va1, 0); if (nx) { T0 = mfma32(kb0, qf[5], T0); T1 = mfma32(kb1, qf[5], T1); } AT_EXP(S0, S1, 14); AT_EXP(S0, S1, 15); \
        bf16x8 pf0 = pack8(S0[0], S0[1], S0[2], S0[3], S0[4], S0[5], S0[6], S0[7]), pf1 = pack8(S0[8], S0[9], S0[10], S0[11], S0[12], S0[13], S0[14], S0[15]); AT_SB(); \
          \
        int x0 = 0, x1 = 0, x2 = 0, x3 = 0; \
        AT_VRD(vb0, vb1, 1); O0 = mfma32(va0, pf0, O0); O1 = mfma32(va1, pf0, O1); \
        bf16x8 pf2 = pack8(S1[0], S1[1], S1[2], S1[3], S1[4], S1[5], S1[6], S1[7]), pf3 = pack8(S1[8], S1[9], S1[10], S1[11], S1[12], S1[13], S1[14], S1[15]); \
        AT_SUM(S0, S1, 0); AT_SUM(S0, S1, 1); AT_SUM(S0, S1, 2); AT_SUM(S0, S1, 3); AT_SUM(S0, S1, 4); AT_SUM(S0, S1, 5); AT_SUM(S0, S1, 6); AT_SUM(S0, S1, 7); AT_SB(); \
        AT_VRD(va0, va1, 2); O0 = mfma32(vb0, pf1, O0); O1 = mfma32(vb1, pf1, O1); \
        if (nx) { x0 = imax3(BI(T0[0]), BI(T0[1]), BI(T0[2])); x1 = imax3(BI(T0[3]), BI(T0[4]), BI(T0[5])); x0 = imax3(x0, BI(T0[6]), BI(T0[7])); x1 = imax3(x1, BI(T0[8]), BI(T0[9])); x0 = imax3(x0, BI(T0[10]), BI(T0[11])); x1 = imax3(x1, BI(T0[12]), BI(T0[13])); x0 = imax3(x0, BI(T0[14]), BI(T0[15])); } AT_SUM(S0, S1, 8); AT_SUM(S0, S1, 9); AT_SUM(S0, S1, 10); AT_SUM(S0, S1, 11); AT_SUM(S0, S1, 12); AT_SUM(S0, S1, 13); AT_SUM(S0, S1, 14); AT_SUM(S0, S1, 15); AT_SB(); \
        AT_VRD(vb0, vb1, 3); O0 = mfma32(va0, pf2, O0); O1 = mfma32(va1, pf2, O1); \
        if (nx2) { ka0 = *(const LAS bf16x8*)(L + kC + koff); ka1 = *(const LAS bf16x8*)(L + kC + 32 * (AT_KROW * 2) + koff); } \
        if (nx) { x2 = imax3(BI(T1[0]), BI(T1[1]), BI(T1[2])); x3 = imax3(BI(T1[3]), BI(T1[4]), BI(T1[5])); x2 = imax3(x2, BI(T1[6]), BI(T1[7])); x3 = imax3(x3, BI(T1[8]), BI(T1[9])); x2 = imax3(x2, BI(T1[10]), BI(T1[11])); x3 = imax3(x3, BI(T1[12]), BI(T1[13])); x2 = imax3(x2, BI(T1[14]), BI(T1[15])); } AT_SB(); \
        O0 = mfma32(vb0, pf3, O0); O1 = mfma32(vb1, pf3, O1); \
        l += s0 + s1; \
        if (nx) { int mxi = imax3(x0, x1, x2 > x3 ? x2 : x3); \
            if (__any(mxi > 0x41000000)) { const int oth = __shfl_xor(mxi, 32); mxi = mxi > oth ? mxi : oth; const float d = __builtin_bit_cast(float, mxi > 0 ? mxi : 0), alpha = __builtin_amdgcn_exp2f(-d); m += d; l *= alpha; \
                _Pragma("unroll") for (int r = 0; r < 16; ++r) { O0[r] *= alpha; O1[r] *= alpha; T0[r] -= d; T1[r] -= d; NM[r] = -m; } } \
            *(LAS u32x4*)(L + ((j_ + 1) & 1) * AT_VB + vlds) = sv; \
            if (nx3) { LAS unsigned char* Kn = L + kA; *(LAS u32x4*)(Kn + klds0) = sk0; if (k2) *(LAS u32x4*)(Kn + klds1) = sk1; } } \
        { const int t_ = kA; kA = kB; kB = kC; kC = t_; } \
        asm volatile("s_waitcnt vmcnt(0) lgkmcnt(0)" ::: "memory"); __syncthreads(); } while (0)
    asm volatile(".p2align 8");
#pragma unroll 1
    for (int j = 0; j < ntile - 2; j += 2) { AT_TILE(SA0, SA1, SB0, SB1, j, true); AT_TILE(SB0, SB1, SA0, SA1, j + 1, true); }
    AT_TILE(SA0, SA1, SB0, SB1, ntile - 2, true); AT_TILE(SB0, SB1, SA0, SA1, ntile - 1, false);
#undef AT_TILE
#undef AT_EXP
#undef AT_SUM
#undef AT_KRD
#undef AT_VRD
#undef AT_SB
#undef BI
    l += __shfl_xor(l, 32);
    const float inv = 1.f / l;
    bf16* Y = (bf16*)(F.ws + WS_YAT) + (size_t)qrow * 256 + h * 64;
#pragma unroll
    for (int g = 0; g < 4; ++g) {
        u32x2 w0, w1; w0.x = pk2(O0[4 * g] * inv, O0[4 * g + 1] * inv); w0.y = pk2(O0[4 * g + 2] * inv, O0[4 * g + 3] * inv);
        w1.x = pk2(O1[4 * g] * inv, O1[4 * g + 1] * inv); w1.y = pk2(O1[4 * g + 2] * inv, O1[4 * g + 3] * inv);
        *(u32x2*)(Y + 8 * g + 4 * hi) = w0; *(u32x2*)(Y + 32 + 8 * g + 4 * hi) = w1; }
}

constexpr int AT16_KROW = 224, AT16_VROW = 160, AT16_KB = 64 * AT16_KROW, AT16_VB = 64 * AT16_VROW;
__device__ __forceinline__ void attn_unit16(const Frame& F, int b, int h, int qrow0, int key0, int ntile) {
    LAS unsigned char* L = F.lds;
    const bf16* Kg = (const bf16*)(F.ws + WS_K) + ((size_t)(b * 4 + h) * NKEY + key0) * 96;
    const bf16* Vg = (const bf16*)(F.ws + WS_VT) + (size_t)(b * 4 + h) * 64 * NKEY + key0;
    const bf16* Q = (const bf16*)(F.ws + WS_Q);
    int tid_ = F.tid; asm volatile("" : "+v"(tid_));
    const int lane = tid_ & 63, lc = lane & 15, lg = lane >> 4;
    const int qrow = qrow0 + F.wave * 32 + lc;
    bf16x8 qf[2][3];
#pragma unroll
    for (int qt = 0; qt < 2; ++qt)
#pragma unroll
        for (int ks = 0; ks < 3; ++ks) qf[qt][ks] = *(const bf16x8*)(Q + (size_t)(qrow + 16 * qt) * 384 + h * 96 + ks * 32 + lg * 8);
    const int kr0 = tid_ / 12, kc0 = tid_ % 12, kr1 = (tid_ + 512) / 12, kc1 = (tid_ + 512) % 12; const bool k2 = tid_ < 256;
    const int vd = tid_ >> 3, vc = tid_ & 7;
    const int klds0 = kr0 * AT16_KROW + kc0 * 16, klds1 = kr1 * AT16_KROW + kc1 * 16, vlds = 2 * AT16_KB + vd * AT16_VROW + vc * 16;
    const unsigned kg0 = (unsigned)(kr0 * 96 + kc0 * 8), kg1 = (unsigned)(kr1 * 96 + kc1 * 8), vg0 = (unsigned)(vd * NKEY + vc * 8);
    u32x4 sk0, sk1 = (u32x4){0u, 0u, 0u, 0u}, sv;
    __syncthreads();
    {
        const u32x4 a0 = *(const u32x4*)(Kg + kg0), b0 = *(const u32x4*)(Kg + 64 * 96 + kg0); u32x4 a1 = sk1, b1 = sk1; if (k2) { a1 = *(const u32x4*)(Kg + kg1); b1 = *(const u32x4*)(Kg + 64 * 96 + kg1); }
        sv = *(const u32x4*)(Vg + vg0);
        *(LAS u32x4*)(L + klds0) = a0; *(LAS u32x4*)(L + AT16_KB + klds0) = b0; if (k2) { *(LAS u32x4*)(L + klds1) = a1; *(LAS u32x4*)(L + AT16_KB + klds1) = b1; }
        *(LAS u32x4*)(L + vlds) = sv;
    }
    __syncthreads();
    const int koff = lc * AT16_KROW + lg * 16, voff = 2 * AT16_KB + lc * AT16_VROW + lg * 16;
    f32x4 O[4][2], SA[2][4], SB[2][4];
#pragma unroll
    for (int i = 0; i < 4; ++i) { O[i][0] = (f32x4){0.f, 0.f, 0.f, 0.f}; O[i][1] = (f32x4){0.f, 0.f, 0.f, 0.f}; SA[0][i] = (f32x4){0.f, 0.f, 0.f, 0.f}; SA[1][i] = (f32x4){0.f, 0.f, 0.f, 0.f}; }
#pragma unroll
    for (int ks = 0; ks < 3; ++ks)
#pragma unroll
        for (int kt = 0; kt < 4; ++kt) { const bf16x8 kf = *(const LAS bf16x8*)(L + koff + kt * 16 * AT16_KROW + ks * 64);
            SA[0][kt] = mfma16(kf, qf[0][ks], SA[0][kt]); SA[1][kt] = mfma16(kf, qf[1][ks], SA[1][kt]); }
    float m0, m1, l0 = 0.f, l1 = 0.f;
    {   float xa = fmaxf(fmaxf(max4(SA[0][0]), max4(SA[0][1])), fmaxf(max4(SA[0][2]), max4(SA[0][3]))), xb = fmaxf(fmaxf(max4(SA[1][0]), max4(SA[1][1])), fmaxf(max4(SA[1][2]), max4(SA[1][3])));
        xa = fmaxf(xa, __shfl_xor(xa, 16)); xa = fmaxf(xa, __shfl_xor(xa, 32)); xb = fmaxf(xb, __shfl_xor(xb, 16)); xb = fmaxf(xb, __shfl_xor(xb, 32)); m0 = xa; m1 = xb; }
#pragma unroll
    for (int kt = 0; kt < 4; ++kt)
#pragma unroll
        for (int r = 0; r < 4; ++r) { SA[0][kt][r] -= m0; SA[1][kt][r] -= m1; }
    float one = 1.f; asm volatile("" : "+v"(one));
#define AT_EXP(S, i) do { S[0][(i) >> 2][(i) & 3] = __builtin_amdgcn_exp2f(S[0][(i) >> 2][(i) & 3]); S[1][(i) >> 2][(i) & 3] = __builtin_amdgcn_exp2f(S[1][(i) >> 2][(i) & 3]); s0 += S[0][(i) >> 2][(i) & 3]; s1 = __builtin_fmaf(S[1][(i) >> 2][(i) & 3], one, s1); } while (0)
#define AT_KRD(dst0, dst1, s) do { dst0 = *(const LAS bf16x8*)(Kt + koff + (2 * ((s) & 1)) * 16 * AT16_KROW + ((s) >> 1) * 64); dst1 = *(const LAS bf16x8*)(Kt + koff + (2 * ((s) & 1) + 1) * 16 * AT16_KROW + ((s) >> 1) * 64); } while (0)
#define AT_VRD(dst0, dst1, s) do { dst0 = *(const LAS bf16x8*)(Vt + voff + (2 * ((s) & 1)) * 16 * AT16_VROW + ((s) >> 1) * 64); dst1 = *(const LAS bf16x8*)(Vt + voff + (2 * ((s) & 1) + 1) * 16 * AT16_VROW + ((s) >> 1) * 64); } while (0)
#define AT_QK(T, k0, k1, s) do { if (nx) { T[0][2 * ((s) & 1)] = mfma16(k0, qf[0][(s) >> 1], T[0][2 * ((s) & 1)]); T[1][2 * ((s) & 1)] = mfma16(k0, qf[1][(s) >> 1], T[1][2 * ((s) & 1)]); \
        T[0][2 * ((s) & 1) + 1] = mfma16(k1, qf[0][(s) >> 1], T[0][2 * ((s) & 1) + 1]); T[1][2 * ((s) & 1) + 1] = mfma16(k1, qf[1][(s) >> 1], T[1][2 * ((s) & 1) + 1]); } } while (0)
#define AT_PV(v0, v1, p0, p1, s) do { O[2 * ((s) & 1)][0] = mfma16(v0, p0, O[2 * ((s) & 1)][0]); O[2 * ((s) & 1)][1] = mfma16(v0, p1, O[2 * ((s) & 1)][1]); \
        O[2 * ((s) & 1) + 1][0] = mfma16(v1, p0, O[2 * ((s) & 1) + 1][0]); O[2 * ((s) & 1) + 1][1] = mfma16(v1, p1, O[2 * ((s) & 1) + 1][1]); } while (0)
#define BI(x) __float_as_int(x)
#define AT_MAXQ(T, q, xa, xb) do { xa = imax3(BI(T[q][0][0]), BI(T[q][0][1]), BI(T[q][0][2])); xb = imax3(BI(T[q][0][3]), BI(T[q][1][0]), BI(T[q][1][1])); xa = imax3(xa, BI(T[q][1][2]), BI(T[q][1][3])); xb = imax3(xb, BI(T[q][2][0]), BI(T[q][2][1])); \
        xa = imax3(xa, BI(T[q][2][2]), BI(T[q][2][3])); xb = imax3(xb, BI(T[q][3][0]), BI(T[q][3][1])); xa = imax3(xa, BI(T[q][3][2]), BI(T[q][3][3])); } while (0)
#define AT_SB() __builtin_amdgcn_sched_barrier(0)
#define AT_TILE(S, T, J, NX) do { const int j_ = (J); constexpr bool nx = (NX); const bool nx2 = j_ + 2 < ntile; \
        if (nx) sv = *(const u32x4*)(Vg + (size_t)(j_ + 1) * 64 + vg0); \
        if (nx2) { const bf16* kg = Kg + (size_t)(j_ + 2) * 64 * 96; sk0 = *(const u32x4*)(kg + kg0); if (k2) sk1 = *(const u32x4*)(kg + kg1); } \
        const LAS unsigned char* Kt = L + ((j_ + 1) & 1) * AT16_KB; const LAS unsigned char* Vt = L + (j_ & 1) * AT16_VB; \
        { const float nm0 = -m0, nm1 = -m1; _Pragma("unroll") for (int kt = 0; kt < 4; ++kt) { T[0][kt] = (f32x4){nm0, nm0, nm0, nm0}; T[1][kt] = (f32x4){nm1, nm1, nm1, nm1}; } } \
        float s0 = 0.f, s1 = 0.f; bf16x8 ka0, ka1, kb0, kb1, va0, va1, vb0, vb1; \
        AT_KRD(ka0, ka1, 0); AT_SB(); \
          \
        AT_KRD(kb0, kb1, 1); AT_QK(T, ka0, ka1, 0); AT_EXP(S, 0); AT_EXP(S, 1); AT_EXP(S, 2); AT_SB(); \
        AT_KRD(ka0, ka1, 2); AT_QK(T, kb0, kb1, 1); AT_EXP(S, 3); AT_EXP(S, 4); AT_EXP(S, 5); AT_SB(); \
        AT_KRD(kb0, kb1, 3); AT_QK(T, ka0, ka1, 2); AT_EXP(S, 6); AT_EXP(S, 7); AT_EXP(S, 8); AT_SB(); \
        AT_KRD(ka0, ka1, 4); AT_QK(T, kb0, kb1, 3); AT_EXP(S, 9); AT_EXP(S, 10); AT_EXP(S, 11); AT_SB(); \
        AT_KRD(kb0, kb1, 5); AT_QK(T, ka0, ka1, 4); AT_EXP(S, 12); AT_EXP(S, 13); AT_SB(); \
        AT_VRD(va0, va1, 0); AT_QK(T, kb0, kb1, 5); AT_EXP(S, 14); AT_EXP(S, 15); \
        const bf16x8 pf00 = pack8(S[0][0][0], S[0][0][1], S[0][0][2], S[0][0][3], S[0][1][0], S[0][1][1], S[0][1][2], S[0][1][3]), pf01 = pack8(S[1][0][0], S[1][0][1], S[1][0][2], S[1][0][3], S[1][1][0], S[1][1][1], S[1][1][2], S[1][1][3]); AT_SB(); \
          \
        int x0 = 0, x1 = 0, x2 = 0, x3 = 0; \
        AT_VRD(vb0, vb1, 1); AT_PV(va0, va1, pf00, pf01, 0); \
        const bf16x8 pf10 = pack8(S[0][2][0], S[0][2][1], S[0][2][2], S[0][2][3], S[0][3][0], S[0][3][1], S[0][3][2], S[0][3][3]), pf11 = pack8(S[1][2][0], S[1][2][1], S[1][2][2], S[1][2][3], S[1][3][0], S[1][3][1], S[1][3][2], S[1][3][3]); \
        l0 += s0; l1 += s1; AT_SB(); \
        AT_VRD(va0, va1, 2); AT_PV(vb0, vb1, pf00, pf01, 1); AT_MAXQ(T, 0, x0, x1); AT_SB(); \
        AT_VRD(vb0, vb1, 3); AT_PV(va0, va1, pf10, pf11, 2); AT_MAXQ(T, 1, x2, x3); AT_SB(); \
        AT_PV(vb0, vb1, pf10, pf11, 3); \
        if (nx) { int mxa = x0 > x1 ? x0 : x1, mxb = x2 > x3 ? x2 : x3; \
            if (__any((mxa > mxb ? mxa : mxb) > 0x41000000)) { { const int oa = __shfl_xor(mxa, 16), ob = __shfl_xor(mxb, 16); mxa = mxa > oa ? mxa : oa; mxb = mxb > ob ? mxb : ob; } \
                { const int oa = __shfl_xor(mxa, 32), ob = __shfl_xor(mxb, 32); mxa = mxa > oa ? mxa : oa; mxb = mxb > ob ? mxb : ob; } \
                const float d0 = __builtin_bit_cast(float, mxa > 0 ? mxa : 0), d1 = __builtin_bit_cast(float, mxb > 0 ? mxb : 0), al0 = __builtin_amdgcn_exp2f(-d0), al1 = __builtin_amdgcn_exp2f(-d1); m0 += d0; m1 += d1; l0 *= al0; l1 *= al1; \
                _Pragma("unroll") for (int i = 0; i < 4; ++i) _Pragma("unroll") for (int r = 0; r < 4; ++r) { O[i][0][r] *= al0; O[i][1][r] *= al1; T[0][i][r] -= d0; T[1][i][r] -= d1; } } \
            *(LAS u32x4*)(L + 2 * AT16_KB + ((j_ + 1) & 1) * AT16_VB + (vlds - 2 * AT16_KB)) = sv; \
            if (nx2) { LAS unsigned char* Kn = L + (j_ & 1) * AT16_KB; *(LAS u32x4*)(Kn + klds0) = sk0; if (k2) *(LAS u32x4*)(Kn + klds1) = sk1; } } \
        asm volatile("s_waitcnt vmcnt(0) lgkmcnt(0)" ::: "memory"); __syncthreads(); } while (0)
    asm volatile(".p2align 8");
#pragma unroll 1
    for (int j = 0; j < ntile - 2; j += 2) { AT_TILE(SA, SB, j, true); AT_TILE(SB, SA, j + 1, true); }
    AT_TILE(SA, SB, ntile - 2, true); AT_TILE(SB, SA, ntile - 1, false);
#undef AT_TILE
#undef AT_EXP
#undef AT_KRD
#undef AT_VRD
#undef AT_QK
#undef AT_PV
#undef AT_MAXQ
#undef BI
#undef AT_SB
    l0 += __shfl_xor(l0, 16); l1 += __shfl_xor(l1, 16); l0 += __shfl_xor(l0, 32); l1 += __shfl_xor(l1, 32);
    const float inv0 = 1.f / l0, inv1 = 1.f / l1;
    bf16* Y = (bf16*)(F.ws + WS_YAT) + (size_t)qrow * 256 + h * 64 + 4 * lg;
#pragma unroll
    for (int dt = 0; dt < 4; ++dt) {
        u32x2 w0, w1; w0.x = pk2(O[dt][0][0] * inv0, O[dt][0][1] * inv0); w0.y = pk2(O[dt][0][2] * inv0, O[dt][0][3] * inv0);
        w1.x = pk2(O[dt][1][0] * inv1, O[dt][1][1] * inv1); w1.y = pk2(O[dt][1][2] * inv1, O[dt][1][3] * inv1);
        *(u32x2*)(Y + 16 * dt) = w0; *(u32x2*)(Y + 16 * 256 + 16 * dt) = w1; }
}

__device__ __forceinline__ float filt_inv_norm(const Frame& F, int set, int ntile, int o, int c) {
    const float* fsp = (const float*)(F.ws + WS_FS) + (size_t)set * 128 * 1024 + o * 512 + c;
    float s = 0.f;
    for (int t = F.lane; t < ntile; t += 64) s += fsp[(size_t)t * 1024] + fsp[(size_t)t * 1024 + 256];
    return 1.f / wave_sum(s);
}
constexpr int HY_UROW = 5408, HY_UB = 8 * HY_UROW * 2, HY_G0 = HY_UB, HY_G1 = HY_G0 + GLEN * 2 + 64;
__device__ __forceinline__ int hy_uoff(int t) { const int T = t + 512; return T + 8 * (T >> 7); }
static_assert((HY_G0 / 4) % 32 == 0 && (HY_G1 / 4) % 32 == 16, "G copies on opposite bank halves");
__device__ __forceinline__ bf16x8 lds_rd8_a4(const LAS unsigned char* p) { const LAS unsigned* q = (const LAS unsigned*)p; u32x4 w; w.x = q[0]; w.y = q[1]; w.z = q[2]; w.w = q[3]; return __builtin_bit_cast(bf16x8, w); }
__device__ __forceinline__ void hyena_unit(const Frame& F, KArgs a, int layer, int c) {
    LAS unsigned char* L = F.lds; LAS bf16* U = (LAS bf16*)L;
    bf16* hyT = (bf16*)(F.ws + WS_HYT);
    const float* sw = a->in[I_HSW] + (size_t)layer * 3 * 768; const float* sb = a->in[I_HSB] + layer * 768;
    int tid_ = F.tid; asm volatile("" : "+v"(tid_));
    const int lane = tid_ & 63, w = F.wave, hi = lane >> 5, l31 = lane & 31;
    __syncthreads();
    {
        const bf16* vrow = hyT + (size_t)(512 + c) * NTOK; const float w0 = sw[512 + c], w1 = sw[768 + 512 + c], w2 = sw[1536 + 512 + c], bb = sb[512 + c];
        for (int i = tid_; i < 8 * 512; i += 512) { const int b = i >> 9, t0 = (i & 511) * 8; const bf16* p = vrow + b * 4096 + t0; const u32x4 x = *(const u32x4*)p;
            float v[10]; v[0] = t0 > 0 ? bf2f(p[-1]) : 0.f; v[9] = t0 + 8 < 4096 ? bf2f(p[8]) : 0.f;
            v[1] = lo_bf(x.x); v[2] = hi_bf(x.x); v[3] = lo_bf(x.y); v[4] = hi_bf(x.y); v[5] = lo_bf(x.z); v[6] = hi_bf(x.z); v[7] = lo_bf(x.w); v[8] = hi_bf(x.w);
            float o[8];
#pragma unroll
            for (int k = 0; k < 8; ++k) o[k] = w0 * v[k] + w1 * v[k + 1] + w2 * v[k + 2] + bb;
            u32x4 ww; ww.x = pk2(o[0], o[1]); ww.y = pk2(o[2], o[3]); ww.z = pk2(o[4], o[5]); ww.w = pk2(o[6], o[7]);
            *(LAS u32x4*)(U + b * HY_UROW + hy_uoff(t0)) = ww; }
        for (int i = tid_; i < 8 * 132; i += 512) { const int b = i / 132, q = i % 132; const int e = q < 68 ? q * 8 : 4896 + (q - 68) * 8;
            *(LAS u32x4*)(U + b * HY_UROW + e) = (u32x4){0u, 0u, 0u, 0u}; }
    }
    const int sel = l31 & 1;
    const int abase = (sel ? HY_G1 : HY_G0) + (GC - l31 + 8 * hi + sel) * 2;
    const int nb = l31 & 7, qq = l31 >> 3, qsb = 16 * w + 4 * qq;
    const int ubase = (nb * HY_UROW + 8 * hi) * 2;
#pragma unroll 1
    for (int o = 0; o < 2; ++o) {
        {
            const bf16* Gg = (const bf16*)(F.ws + WS_G) + ((size_t)(layer * 2 + o) * 256 + c) * GLEN;
            for (int i = tid_; i < GLEN / 8; i += 512) { u32x4 x = *(const u32x4*)(Gg + i * 8);
                if (i < 5 || i >= 1027) { const int m0 = i * 8; unsigned* xp = (unsigned*)&x;
#pragma unroll
                    for (int k = 0; k < 4; ++k) { const int ma = m0 + 2 * k, mb = ma + 1; unsigned v = xp[k]; if (ma < 33 || ma > 8223) v &= 0xffff0000u; if (mb < 33 || mb > 8223) v &= 0x0000ffffu; xp[k] = v; } }
                *(LAS u32x4*)(L + HY_G0 + i * 16) = x; }
            __syncthreads();
            const LAS unsigned* g0 = (const LAS unsigned*)(L + HY_G0); LAS unsigned* g1 = (LAS unsigned*)(L + HY_G1);
            for (int i = tid_; i <= GLEN / 2; i += 512) { const unsigned dp = i > 0 ? g0[i - 1] : 0u, d = i < GLEN / 2 ? g0[i] : 0u; g1[i] = (dp >> 16) | (d << 16); }
            __syncthreads();
        }
        f32x16 acc[4];
#pragma unroll
        for (int j = 0; j < 4; ++j)
#pragma unroll
            for (int r = 0; r < 16; ++r) acc[j][r] = 0.f;
        bf16x8 A[4][2];
        const int e0 = 16 * w - 127;
#define HY_LOADA(slot, delta) do { const LAS unsigned char* _p = L + abase - 64 * (delta); A[slot][0] = lds_rd8_a4(_p); A[slot][1] = lds_rd8_a4(_p + 32); } while (0)
#define HY_LOADF(d0, d1, e) do { const int qx = qsb + 16 - (e); const LAS unsigned char* _u = L + ubase + (32 * qx + 8 * (qx >> 2)) * 2; d0 = *(const LAS bf16x8*)_u; d1 = *(const LAS bf16x8*)(_u + 32); } while (0)
        HY_LOADA(0, e0); HY_LOADA(1, e0 + 1); HY_LOADA(2, e0 + 2); HY_LOADA(3, e0 + 3);
        bf16x8 fa0, fa1, fb0, fb1;
        HY_LOADF(fa0, fa1, e0);
#define HY_STEP(g, FC0, FC1, FN0, FN1) do { const int e = eb + (g); \
            HY_LOADF(FN0, FN1, e + 1); \
            acc[0] = mfma32(A[(g) & 3][0], FC0, acc[0]); acc[0] = mfma32(A[(g) & 3][1], FC1, acc[0]); \
            __builtin_amdgcn_sched_barrier(0); \
            HY_LOADA((g) & 3, e + 4); \
            _Pragma("unroll") for (int j = 1; j < 4; ++j) { acc[j] = mfma32(A[((g) + j) & 3][0], FC0, acc[j]); acc[j] = mfma32(A[((g) + j) & 3][1], FC1, acc[j]); } \
            __builtin_amdgcn_sched_barrier(0); } while (0)
        asm volatile(".p2align 8");
#pragma unroll 1
        for (int eb = e0; eb < e0 + 140; eb += 4) { HY_STEP(0, fa0, fa1, fb0, fb1); HY_STEP(1, fb0, fb1, fa0, fa1); HY_STEP(2, fa0, fa1, fb0, fb1); HY_STEP(3, fb0, fb1, fa0, fa1); }
#undef HY_LOADF
#undef HY_STEP
#undef HY_LOADA
        __syncthreads();
        const float inv = filt_inv_norm(F, layer, 128, o, c);
        const float hb = a->in[I_HBIAS][(size_t)(layer * 2 + o) * 256 + c];
        const int gcol = o == 0 ? c : 256 + c; const bf16* grow = hyT + (size_t)gcol * NTOK + nb * 4096;
        const float w0 = sw[gcol], w1 = sw[768 + gcol], w2 = sw[1536 + gcol], bb = sb[gcol];
        bf16* yrow = (bf16*)(F.ws + WS_YT) + (size_t)c * NTOK + nb * 4096;
#pragma unroll
        for (int j = 0; j < 4; ++j) { const int q = 16 * w + 4 * qq + j;
#pragma unroll
            for (int g4 = 0; g4 < 4; ++g4) { const int t = 32 * q + 8 * g4 + 4 * hi; const bf16* p = grow + t; const u32x2 x = *(const u32x2*)p;
                float v[6]; v[0] = t > 0 ? bf2f(p[-1]) : 0.f; v[5] = t + 4 < 4096 ? bf2f(p[4]) : 0.f; v[1] = lo_bf(x.x); v[2] = hi_bf(x.x); v[3] = lo_bf(x.y); v[4] = hi_bf(x.y);
                LAS bf16* up = U + nb * HY_UROW + hy_uoff(t); const u32x2 uu = *(const LAS u32x2*)up;
                const float u0 = lo_bf(uu.x), u1 = hi_bf(uu.x), u2 = lo_bf(uu.y), u3 = hi_bf(uu.y);
                const float y0 = (w0 * v[0] + w1 * v[1] + w2 * v[2] + bb) * (acc[j][4 * g4] * inv + hb * u0);
                const float y1 = (w0 * v[1] + w1 * v[2] + w2 * v[3] + bb) * (acc[j][4 * g4 + 1] * inv + hb * u1);
                const float y2 = (w0 * v[2] + w1 * v[3] + w2 * v[4] + bb) * (acc[j][4 * g4 + 2] * inv + hb * u2);
                const float y3 = (w0 * v[3] + w1 * v[4] + w2 * v[5] + bb) * (acc[j][4 * g4 + 3] * inv + hb * u3);
                u32x2 wv; wv.x = pk2(y0, y1); wv.y = pk2(y2, y3);
                if (o == 0) *(LAS u32x2*)up = wv; else *(u32x2*)(yrow + t) = wv; } }
        __syncthreads();
    }
}

constexpr int HY16_UROW = 5664, HY16_G0 = 8 * HY16_UROW * 2, HY16_G1 = HY16_G0 + GLEN * 2 + 64;
__device__ __forceinline__ int hy16_uoff(int t) { const int T = t + 512; return T + 16 * (T >> 7); }
static_assert((HY16_G0 / 4) % 32 == 0 && (HY16_G1 / 4) % 32 == 16 && HY16_G1 + GLEN * 2 + 4 <= LDS_MISC, "hyena16 LDS map");
__device__ __forceinline__ void hyena_unit16(const Frame& F, KArgs a, int layer, int c) {
    LAS unsigned char* L = F.lds; LAS bf16* U = (LAS bf16*)L;
    bf16* hyT = (bf16*)(F.ws + WS_HYT);
    const float* sw = a->in[I_HSW] + (size_t)layer * 3 * 768; const float* sb = a->in[I_HSB] + layer * 768;
    int tid_ = F.tid; asm volatile("" : "+v"(tid_));
    const int lane = tid_ & 63, w = F.wave, hi = lane >> 5, l31 = lane & 31;
    const float inv_o[2] = {filt_inv_norm(F, layer, 128, 0, c), filt_inv_norm(F, layer, 128, 1, c)};
    __syncthreads();
    {
        const bf16* vrow = hyT + (size_t)(512 + c) * NTOK; const float w0 = sw[512 + c], w1 = sw[768 + 512 + c], w2 = sw[1536 + 512 + c], bb = sb[512 + c];
#pragma unroll
        for (int it = 0; it < 8; ++it) { const int i = tid_ + it * 512; const int b = i >> 9, t0 = (i & 511) * 8;     const bf16* p = vrow + b * 4096 + t0; const u32x4 x = *(const u32x4*)p;
            float v[10]; v[0] = t0 > 0 ? bf2f(p[-1]) : 0.f; v[9] = t0 + 8 < 4096 ? bf2f(p[8]) : 0.f;
            v[1] = lo_bf(x.x); v[2] = hi_bf(x.x); v[3] = lo_bf(x.y); v[4] = hi_bf(x.y); v[5] = lo_bf(x.z); v[6] = hi_bf(x.z); v[7] = lo_bf(x.w); v[8] = hi_bf(x.w);
            float o[8];
#pragma unroll
            for (int k = 0; k < 8; ++k) o[k] = w0 * v[k] + w1 * v[k + 1] + w2 * v[k + 2] + bb;
            u32x4 ww; ww.x = pk2(o[0], o[1]); ww.y = pk2(o[2], o[3]); ww.z = pk2(o[4], o[5]); ww.w = pk2(o[6], o[7]);
            *(LAS u32x4*)(U + b * HY16_UROW + hy16_uoff(t0)) = ww; }
        for (int i = tid_; i < 8 * 132; i += 512) { const int b = i / 132, q = i % 132; const int e = q < 72 ? q * 8 : 5184 + (q - 72) * 8;
            *(LAS u32x4*)(U + b * HY16_UROW + e) = (u32x4){0u, 0u, 0u, 0u}; }
    }
    const int lc = lane & 15, lg = lane >> 4, sel = lc & 1;
    const int abase = (sel ? HY16_G1 : HY16_G0) + (GC - lc + 8 * lg + sel) * 2;
    const int nb = lc & 7, qh = lc >> 3;
    const int ubase = (nb * HY16_UROW + 8 * lg) * 2, qsb0 = 16 * w + 4 * qh, qsb1 = qsb0 + 8;
#pragma unroll 1
    for (int o = 0; o < 2; ++o) {
        {
            const bf16* Gg = (const bf16*)(F.ws + WS_G) + ((size_t)(layer * 2 + o) * 256 + c) * GLEN;
            for (int i = tid_; i < GLEN / 8; i += 512) { u32x4 x = *(const u32x4*)(Gg + i * 8);
                if (i < 5 || i >= 1027) { const int m0 = i * 8; unsigned* xp = (unsigned*)&x;
#pragma unroll
                    for (int k = 0; k < 4; ++k) { const int ma = m0 + 2 * k, mb = ma + 1; unsigned v = xp[k]; if (ma < 33 || ma > 8223) v &= 0xffff0000u; if (mb < 33 || mb > 8223) v &= 0x0000ffffu; xp[k] = v; } }
                *(LAS u32x4*)(L + HY16_G0 + i * 16) = x; }
            __syncthreads();
            const LAS unsigned* g0 = (const LAS unsigned*)(L + HY16_G0); LAS unsigned* g1 = (LAS unsigned*)(L + HY16_G1);
            for (int i = tid_; i <= GLEN / 2; i += 512) { const unsigned dp = i > 0 ? g0[i - 1] : 0u, d = i < GLEN / 2 ? g0[i] : 0u; g1[i] = (dp >> 16) | (d << 16); }
            __syncthreads();
        }
        f32x4 acc[4][2][2];
#pragma unroll
        for (int j = 0; j < 4; ++j)
#pragma unroll
            for (int ih = 0; ih < 2; ++ih)
#pragma unroll
                for (int nh = 0; nh < 2; ++nh) acc[j][ih][nh] = (f32x4){0.f, 0.f, 0.f, 0.f};
        bf16x8 A[4][2];
        const int e0 = 16 * w - 127;
#define HY_LOADA(slot, delta) do { const LAS unsigned char* _p = L + abase - 64 * (delta); A[slot][0] = lds_rd8_a4(_p); A[slot][1] = lds_rd8_a4(_p - 32); } while (0)
#define HY_LOADF(d0, d1, e) do { const int qx0 = qsb0 + 16 - (e), qx1 = qsb1 + 16 - (e); \
            d0 = *(const LAS bf16x8*)(L + ubase + (32 * qx0 + 16 * (qx0 >> 2)) * 2); d1 = *(const LAS bf16x8*)(L + ubase + (32 * qx1 + 16 * (qx1 >> 2)) * 2); } while (0)
        HY_LOADA(0, e0); HY_LOADA(1, e0 + 1); HY_LOADA(2, e0 + 2); HY_LOADA(3, e0 + 3);
        bf16x8 fa0, fa1, fb0, fb1;
        HY_LOADF(fa0, fa1, e0);
#define HY_MM(j, sl, FC0, FC1) do { acc[j][0][0] = mfma16(A[sl][0], FC0, acc[j][0][0]); acc[j][0][1] = mfma16(A[sl][0], FC1, acc[j][0][1]); \
            acc[j][1][0] = mfma16(A[sl][1], FC0, acc[j][1][0]); acc[j][1][1] = mfma16(A[sl][1], FC1, acc[j][1][1]); } while (0)
#define HY_STEP(g, FC0, FC1, FN0, FN1) do { const int e = eb + (g); \
            HY_LOADF(FN0, FN1, e + 1); \
            HY_MM(0, (g) & 3, FC0, FC1); \
            __builtin_amdgcn_sched_barrier(0); \
            HY_LOADA((g) & 3, e + 4); \
            HY_MM(1, ((g) + 1) & 3, FC0, FC1); HY_MM(2, ((g) + 2) & 3, FC0, FC1); HY_MM(3, ((g) + 3) & 3, FC0, FC1); \
            __builtin_amdgcn_sched_barrier(0); } while (0)
        asm volatile(".p2align 8");
#pragma unroll 1
        for (int eb = e0; eb < e0 + 140; eb += 4) { HY_STEP(0, fa0, fa1, fb0, fb1); HY_STEP(1, fb0, fb1, fa0, fa1); HY_STEP(2, fa0, fa1, fb0, fb1); HY_STEP(3, fb0, fb1, fa0, fa1); }
#undef HY_LOADF
#undef HY_STEP
#undef HY_MM
#undef HY_LOADA
        __syncthreads();
        const float inv = o == 0 ? inv_o[0] : inv_o[1];
        const float hb = a->in[I_HBIAS][(size_t)(layer * 2 + o) * 256 + c];
        const int gcol = o == 0 ? c : 256 + c; const bf16* grow = hyT + (size_t)gcol * NTOK + nb * 4096;
        const float w0 = sw[gcol], w1 = sw[768 + gcol], w2 = sw[1536 + gcol], bb = sb[gcol];
        bf16* yrow = (bf16*)(F.ws + WS_YT) + (size_t)c * NTOK + nb * 4096;
        u32x2 gx[16]; float gm[16], gp[16];
#pragma unroll
        for (int j = 0; j < 4; ++j)
#pragma unroll
            for (int nh = 0; nh < 2; ++nh) { const int q = 16 * w + 4 * (2 * nh + qh) + j;
#pragma unroll
                for (int ih = 0; ih < 2; ++ih) { const int t = 32 * q + 16 * ih + 4 * lg, ix = (j * 2 + nh) * 2 + ih; const bf16* p = grow + t;
                    gx[ix] = *(const u32x2*)p; gm[ix] = t > 0 ? bf2f(p[-1]) : 0.f; gp[ix] = t + 4 < 4096 ? bf2f(p[4]) : 0.f; } }
#pragma unroll
        for (int j = 0; j < 4; ++j)
#pragma unroll
            for (int nh = 0; nh < 2; ++nh) { const int q = 16 * w + 4 * (2 * nh + qh) + j;
#pragma unroll
                for (int ih = 0; ih < 2; ++ih) { const int t = 32 * q + 16 * ih + 4 * lg, ix = (j * 2 + nh) * 2 + ih; const u32x2 x = gx[ix];
                    float v[6]; v[0] = gm[ix]; v[5] = gp[ix]; v[1] = lo_bf(x.x); v[2] = hi_bf(x.x); v[3] = lo_bf(x.y); v[4] = hi_bf(x.y);
                    LAS bf16* up = U + nb * HY16_UROW + hy16_uoff(t); const u32x2 uu = *(const LAS u32x2*)up;
                    const float u0 = lo_bf(uu.x), u1 = hi_bf(uu.x), u2 = lo_bf(uu.y), u3 = hi_bf(uu.y); const f32x4 ac = acc[j][ih][nh];
                    const float y0 = (w0 * v[0] + w1 * v[1] + w2 * v[2] + bb) * (ac[0] * inv + hb * u0);
                    const float y1 = (w0 * v[1] + w1 * v[2] + w2 * v[3] + bb) * (ac[1] * inv + hb * u1);
                    const float y2 = (w0 * v[2] + w1 * v[3] + w2 * v[4] + bb) * (ac[2] * inv + hb * u2);
                    const float y3 = (w0 * v[3] + w1 * v[4] + w2 * v[5] + bb) * (ac[3] * inv + hb * u3);
                    u32x2 wv; wv.x = pk2(y0, y1); wv.y = pk2(y2, y3);
                    if (o == 0) *(LAS u32x2*)up = wv; else *(u32x2*)(yrow + t) = wv; } }
        __syncthreads();
    }
}

__device__ __forceinline__ void hyena_ctx_unit(const Frame& F_, KArgs a, int c) {
    Frame F = F_; { int t_ = F_.tid; asm volatile("" : "+v"(t_)); F.tid = t_; F.lane = t_ & 63; }
    LAS float* u = (LAS float*)F.lds;
    LAS float* y1 = u + 2048;
    LAS float* T = y1 + 2048;
    bf16* hyT = (bf16*)(F.ws + WS_HYT);
    const float* sw = a->in[I_HSW]; const float* sb = a->in[I_HSB];
    __syncthreads();
#pragma unroll
    for (int it = 0; it < 2; ++it) { const int i = F.tid + it * 512; T[i] = ((const float*)(F.ws + WS_TC))[((size_t)(i >> 9) * 256 + c) * 512 + (i & 511)]; }
    if (F.tid < 2) T[F.tid * 512] = 0.f;
    {
        const bf16* vrow = hyT + (size_t)(512 + c) * NTOK + NLAT; const float w0 = sw[512 + c], w1 = sw[768 + 512 + c], w2 = sw[1536 + 512 + c], bb = sb[512 + c];
#pragma unroll
        for (int it = 0; it < 4; ++it) { const int i = F.tid + it * 512; const int t = i & 255; const float vm = t > 0 ? bf2f(vrow[i - 1]) : 0.f, v0 = bf2f(vrow[i]), vp = t < 255 ? bf2f(vrow[i + 1]) : 0.f; u[i] = w0 * vm + w1 * v0 + w2 * vp + bb; }
    }
    __syncthreads();
#pragma unroll 1
    for (int o = 0; o < 2; ++o) {
        const LAS float* in = o == 0 ? u : y1; const float inv = filt_inv_norm(F, 2, 8, o, c); const float hb = a->in[I_HBIAS][(size_t)o * 256 + c];
        const int gcol = o == 0 ? c : 256 + c; const bf16* grow = hyT + (size_t)gcol * NTOK + NLAT; const float w0g = sw[gcol], w1g = sw[768 + gcol], w2g = sw[1536 + gcol], bbg = sb[gcol];
        {
            const int q = F.wave, lc = F.lane & 15, lg = F.lane >> 4, nb = lc & 7; const LAS float* Tp = T + o * 512 + 256; const LAS float* ip = in + nb * 256 + 8 * lg;
            f32x4 acc[2] = {(f32x4){0.f, 0.f, 0.f, 0.f}, (f32x4){0.f, 0.f, 0.f, 0.f}};
#pragma unroll 2
            for (int ub = 0; ub < 8; ++ub) {
                const f32x4 xa = *(const LAS f32x4*)(ip + 32 * ub), xb = *(const LAS f32x4*)(ip + 32 * ub + 4);
                const bf16x8 bf = pack8(xa[0], xa[1], xa[2], xa[3], xb[0], xb[1], xb[2], xb[3]);
#pragma unroll
                for (int ih = 0; ih < 2; ++ih) { const LAS float* tp = Tp + 32 * (q - ub) + 16 * ih + lc - 8 * lg;
                    const bf16x8 af = pack8(tp[0], tp[-1], tp[-2], tp[-3], tp[-4], tp[-5], tp[-6], tp[-7]);
                    acc[ih] = mfma16(af, bf, acc[ih]); }
            }
            if (lc < 8) {
#pragma unroll
                for (int ih = 0; ih < 2; ++ih)
#pragma unroll
                    for (int r = 0; r < 4; ++r) { const int t = 32 * q + 16 * ih + 4 * lg + r, i = nb * 256 + t;
                        const float gm = t > 0 ? bf2f(grow[i - 1]) : 0.f, g0 = bf2f(grow[i]), gp = t < 255 ? bf2f(grow[i + 1]) : 0.f;
                        const float y = (w0g * gm + w1g * g0 + w2g * gp + bbg) * (acc[ih][r] * inv + hb * in[i]);
                        if (o == 0) y1[i] = y; else ((bf16*)(F.ws + WS_YT))[(size_t)c * NTOK + NLAT + i] = (bf16)f2bf(y); }
            }
        }
        __syncthreads();
    }
}

__device__ __forceinline__ void p5_unit(const Frame& F_, KArgs a, int layer, int r0) {
    Frame F = F_; { int t_ = F_.tid; asm volatile("" : "+v"(t_)); F.tid = t_; F.lane = t_ & 63; }
    LAS bf16* T = (LAS bf16*)F.lds;
    const bf16* yT = (const bf16*)(F.ws + WS_YT); const bf16* yat = (const bf16*)(F.ws + WS_YAT); bf16* Y = (bf16*)(F.ws + WS_H);
    const float* mg = a->in[I_MIXG] + layer * 1024;
    u32x4 t0, t1; u32x2 xa[4];
    { const int c = F.tid >> 2, q = F.tid & 3; t0 = *(const u32x4*)(yT + (size_t)c * NTOK + r0 + q * 8); t1 = *(const u32x4*)(yT + (size_t)(c + 128) * NTOK + r0 + q * 8); }
#pragma unroll
    for (int i = 0; i < 4; ++i) xa[i] = *(const u32x2*)(yat + (size_t)(r0 + F.wave + 8 * i) * 256 + 4 * F.lane);
    __syncthreads();
    { const int c = F.tid >> 2, q = F.tid & 3; *(LAS u32x4*)(T + c * 40 + q * 8) = t0; *(LAS u32x4*)(T + (c + 128) * 40 + q * 8) = t1; }
    __syncthreads();
    const f32x4 mh = *(const f32x4*)(mg + 4 * F.lane), ma = *(const f32x4*)(mg + 768 + 4 * F.lane);
    f32x4 vh[4], va[4]; float sh[4], sa[4];
#pragma unroll
    for (int i = 0; i < 4; ++i) { const int r = F.wave + 8 * i;
        vh[i].x = bf2f(T[(4 * F.lane) * 40 + r]); vh[i].y = bf2f(T[(4 * F.lane + 1) * 40 + r]); vh[i].z = bf2f(T[(4 * F.lane + 2) * 40 + r]); vh[i].w = bf2f(T[(4 * F.lane + 3) * 40 + r]);
        va[i].x = lo_bf(xa[i].x); va[i].y = hi_bf(xa[i].x); va[i].z = lo_bf(xa[i].y); va[i].w = hi_bf(xa[i].y);
        sh[i] = (vh[i].x * vh[i].x + vh[i].y * vh[i].y) + (vh[i].z * vh[i].z + vh[i].w * vh[i].w); sa[i] = (va[i].x * va[i].x + va[i].y * va[i].y) + (va[i].z * va[i].z + va[i].w * va[i].w); }
#pragma unroll
    for (int o = 1; o < 64; o <<= 1) {
#pragma unroll
        for (int i = 0; i < 4; ++i) { sh[i] = xsum_step(sh[i], o); sa[i] = xsum_step(sa[i], o); } }
#pragma unroll
    for (int i = 0; i < 4; ++i) { const int r = F.wave + 8 * i;
        const float rh = frsq(sh[i] * (1.f / 256.f) + EPS), ra = frsq(sa[i] * (1.f / 256.f) + EPS);
        const f32x4 yh = vh[i] * rh * mh, ya = va[i] * ra * ma; u32x2 w; bf16* yr = Y + (size_t)(r0 + r) * 1024 + 4 * F.lane;
        w.x = pk2(yh.x, yh.y); w.y = pk2(yh.z, yh.w); *(u32x2*)yr = w; w.x = pk2(ya.x, ya.y); w.y = pk2(ya.z, ya.w); *(u32x2*)(yr + 768) = w; }
}
#if MK_AT16
#define ATTN_UNIT attn_unit16
#else
#define ATTN_UNIT attn_unit
#endif
#ifndef MK_HY16
#define MK_HY16 1
#endif
#if MK_HY16
#define HYENA_UNIT hyena_unit16
#else
#define HYENA_UNIT hyena_unit
#endif
#ifndef MK_XBAR
#define MK_XBAR 0
#endif
#ifndef MK_HALF
#define MK_HALF 0u
#endif
#ifndef MK_DUP
#define MK_DUP 0u
#endif
#define DUPN(k) (((MK_DUP >> (k)) & 1u) ? 2 : 1)
#ifndef MK_PHASES
#define MK_PHASES 0xFFFFFu
#endif
template <int LAYER>
__device__ __forceinline__ void layer_phases(Frame F, const XcdBarrier& bar, int lo, int hi) {
    constexpr int PB = 1 + 9 * LAYER;
    const Frame F0 = F;
#define HALF(k) do { F = F0; relaunder(F); act = true; if ((MK_HALF >> (k)) & 1u) { F.G = F0.G / 2; F.NGW = F.G * 8; act = F.vcu < F.G; } } while (0)
    bool act = true;
    unsigned char* ws = F.ws;
    const float* modl = (const float*)(ws + WS_MOD) + (size_t)LAYER * 9 * 6144;
    bf16* xb = (bf16*)(ws + WS_XB);
#define IN(k) (((MK_PHASES >> (k)) & 1u) && lo <= (k) && (k) < hi)
#define SEAM(k) do { if (IN(k) && IN((k) + 1)) xcd_barrier(bar); } while (0)
#define BODY_P1 { if (LAYER == 0) p1_norm(F, kargs(), 0, kargs()->in[I_X], kargs()->in[I_CTX]); else p1_norm_moe(F, kargs(), xb); }
    HALF(0);
    if (act && IN(PB + 0)) { BODY_P1 if (DUPN(0) == 2) BODY_P1 }
    SEAM(PB + 0);
#define BODY_P2 { OpIn op{(const bf16*)(ws + WS_H), (const bf16*)(ws + WS_WIN) + (size_t)LAYER * NIN_PAD * 1024, (bf16*)(ws + WS_PROJ), (bf16*)(ws + WS_HYT), LAYER, F.G, F.vcu}; \
        pg8::gemm_phase<OpIn, true>(F.lds, op, 1024); }
    HALF(1);
    if (act && IN(PB + 1)) { BODY_P2 if (DUPN(1) == 2) BODY_P2
        if (LAYER == 0) { constexpr int TOT = 136 * 9; if ((TOT - 1 - F.vcu) / F.G + 1 < (TOT + F.G - 1) / F.G || F.vcu >= TOT) drain_deferred(F, kargs(), 5); } }
    SEAM(PB + 1);
    HALF(2);
    if (act && IN(PB + 2)) for (int rep = 0; rep < DUPN(2); ++rep) {
        constexpr int NGM = LAYER == 0 ? NTOK / 128 : NLAT / 128, NCV = LAYER == 0 ? NTOK / 64 : NLAT / 64, NML = 0;
        for (int r3 = 0; r3 < DUPN(24); ++r3) p3_mla_stream<LAYER>(F, kargs());
        {
            volatile LAS int* slot = (volatile LAS int*)(F.lds + LDS_MISC + 64);
            for (;;) {
                __syncthreads();
                if (F.tid == 0) *slot = (int)atomicAdd(F.ctl + CW_P3Q + LAYER * 16, 1u);
                __syncthreads();
                const int u = *slot;
                if (u >= NGM + NCV) break;
                if (u < NGM) { for (int r2 = 0; r2 < DUPN(22); ++r2) p3_gmlp_unit(F, kargs(), LAYER, u * 128); }
                else { for (int r2 = 0; r2 < DUPN(23); ++r2) p3_conv_unit(F, kargs(), LAYER, (u - NGM) * 64); }
            }
        }
    }
    SEAM(PB + 2);
    HALF(3);
    if (act && IN(PB + 3)) {
        constexpr int NU = LAYER == 0 ? 256 + 512 + 32 + 256 : 256 + 512;
        for (int u = F.vcu; u < NU; u += F.G) {
            if (u < 256) { for (int rep = 0; rep < DUPN(17); ++rep) HYENA_UNIT(F, kargs(), LAYER, u); }
            else if (u < 768) { const int id = u - 256; for (int rep = 0; rep < DUPN(16); ++rep) ATTN_UNIT(F, id >> 6, (id >> 4) & 3, (id >> 6) * 4096 + (id & 15) * 256, 0, NKEY / 64); }
            else if (u < 800) { const int id = u - 768; ATTN_UNIT(F, id >> 2, id & 3, NLAT + (id >> 2) * 256, 4096, 4); }
            else hyena_ctx_unit(F, kargs(), u - 800);
        }
    }
    SEAM(PB + 3);
    HALF(4);
    if (act && IN(PB + 4)) for (int rep = 0; rep < DUPN(4); ++rep) {
        constexpr int NU = (LAYER == 0 ? NTOK : NLAT) / 32;
        for (int u = F.vcu; u < NU; u += F.G) p5_unit(F, kargs(), LAYER, u * 32);
    }
    SEAM(PB + 4);
    HALF(5);
    if (act && IN(PB + 5)) {
        OpOut op{(const bf16*)(ws + WS_H), (const bf16*)(ws + WS_WOUT) + (size_t)LAYER * 1024 * 1024, kargs()->in[I_X], kargs()->in[I_CTX], xb, modl, LAYER, F.G, F.vcu, 1.f};
        pg8::gemm_phase<OpOut, true>(F.lds, op, 1024);
        if (LAYER == 0) { constexpr int TOT = 136 * 4; if ((TOT - 1 - F.vcu) / F.G + 1 < (TOT + F.G - 1) / F.G || F.vcu >= TOT) drain_deferred(F, kargs(), 5); }
    }
    SEAM(PB + 5);
    HALF(6);
    if (act && IN(PB + 6)) for (int rep = 0; rep < DUPN(6); ++rep) p7_router(F, kargs(), LAYER, xb, LAYER == 0 ? NTOK : NLAT, rep > 0);
    if (LAYER == 1 && IN(PB + 6)) drain_deferred(F, kargs(), 1 << 20);
    SEAM(PB + 6);
    LAS int* tab = (LAS int*)(F.lds + 131072 + 4096);
    HALF(7);
    if (IN(PB + 7) || IN(PB + 8)) {
        __syncthreads();
        if (F.tid < NBUCKET) tab[32 + F.tid] = (int)__hip_atomic_load(F.ctl + CW_CNT + LAYER * 32 + F.tid, __ATOMIC_RELAXED, __HIP_MEMORY_SCOPE_AGENT);
        __syncthreads();
        if (F.tid == 0) { int acc = 0; for (int k = 0; k < NBUCKET; ++k) { tab[k] = acc; acc += (tab[32 + k] + 255) >> 8; } tab[NBUCKET] = acc; }
        __syncthreads();
        moe_tile_map(tab, F.tid);
        __syncthreads();
    }
    HALF(7);
    if (act && IN(PB + 7)) {
        OpMoe12 op{(const char*)ws, (const bf16*)(ws + WS_W1), (const bf16*)(ws + WS_W2), (bf16*)(ws + WS_PROJ), (bf16*)(ws + WS_YM), (const int*)(ws + WS_TOK), (const float*)(ws + WS_WLO), (const float*)(ws + WS_WHI), tab,
                   (unsigned*)(F.ctl + CW_RDY + LAYER * 4096), (unsigned*)(F.ctl + CW_TMO), LAYER, F.G, F.vcu};
        pg8::gemm_phase<OpMoe12, true>(F.lds, op, 1024);
        if (LAYER == 0) { const int TOT = tab[NBUCKET] * 12; if (F.vcu >= TOT || (TOT - 1 - F.vcu) / F.G + 1 < (TOT + F.G - 1) / F.G) drain_deferred(F, kargs(), 5); }
    }
    SEAM(PB + 8);
#undef IN
#undef SEAM
}

constexpr int N_PHASES = 20;
__global__ void __launch_bounds__(512, 2) mk_fwd(Args a_) {
    extern __shared__ __attribute__((aligned(16))) unsigned char lds_raw[];
#ifdef MK_PAD
    asm volatile(".rept %0\n\ts_nop 0\n\t.endr" :: "i"(MK_PAD));
#endif
    Frame F;
    F.lds = (LAS unsigned char*)lds_raw; F.ws = a_.ws; F.ctl = (unsigned*)(a_.ws + WS_CTL);
    F.tid = threadIdx.x; F.lane = F.tid & 63; F.wave = __builtin_amdgcn_readfirstlane(F.tid >> 6);
    F.G = gridDim.x; { const int bx = blockIdx.x; F.vcu = (F.G % 8 == 0) ? (bx % 8) * (F.G / 8) + bx / 8 : bx; }
    F.gw = F.vcu * 8 + F.wave; F.NGW = F.G * 8;
    volatile LAS unsigned* misc = (volatile LAS unsigned*)(F.lds + LDS_MISC);
    if (F.tid < 64) misc[F.tid] = 0u;
    __syncthreads();
    const int lo = a_.ph_lo, hi = a_.ph_hi;
    XcdBarrier bar; bar.bar = F.ctl + CW_BAR; bar.x = 0; bar.st = misc;
    if (hi - lo > 1) bar = xcd_barrier_post(F.ctl + CW_BAR, misc);
    if ((MK_PHASES & 1u) && lo <= 0 && 0 < hi) { if (!((MK_HALF >> 10) & 1u) || F.vcu < F.G / 2) p0_all(F, kargs());
        if ((MK_DUP >> 20) & 1u) { xcd_barrier(bar); p0_all(F, kargs(), 16); }
        if (hi > 1) xcd_barrier(bar); }
    layer_phases<0>(F, bar, lo, hi);
    layer_phases<1>(F, bar, lo, hi);
    relaunder(F);
    bool actf = true; if ((MK_HALF >> 9) & 1u) { F.G /= 2; F.NGW = F.G * 8; actf = F.vcu < F.G; }
    if (actf && ((MK_PHASES >> 19) & 1u) && lo <= 19 && 19 < hi) p_final(F, kargs());
#if MK_XBAR
    for (int i = 0; i < MK_XBAR; ++i) xcd_barrier(bar);
#endif
}

#ifndef MK_SPLIT
#define MK_SPLIT 0
#endif
extern "C" void kernel_launch(void* const* d_in, const int* in_sizes, int n_in, void* d_out, int out_size, void* d_ws, size_t ws_size, hipStream_t stream) {
    static int grid = 0;
    if (grid == 0) {
        if (n_in != 38 || out_size != NLAT * 1024 || ws_size < WS_END) { fprintf(stderr, "kernel_launch: unexpected shapes (n_in %d out %d ws %zu, need %zu)\n", n_in, out_size, ws_size, (size_t)WS_END); grid = -1; return; }
        int dev = 0, cus = 0, per_cu = 0;
        hipGetDevice(&dev); hipDeviceGetAttribute(&cus, hipDeviceAttributeMultiprocessorCount, dev);
        if (hipFuncSetAttribute((const void*)mk_fwd, hipFuncAttributeMaxDynamicSharedMemorySize, LDS_BYTES) != hipSuccess) { fprintf(stderr, "kernel_launch: hipFuncSetAttribute failed\n"); grid = -1; return; }
        if (hipOccupancyMaxActiveBlocksPerMultiprocessor(&per_cu, (const void*)mk_fwd, 512, LDS_BYTES) != hipSuccess || per_cu < 1) { fprintf(stderr, "kernel_launch: occupancy query says %d\n", per_cu); }
        (void)hipGetLastError();
        grid = cus;
    }
    if (grid < 0) return;
    hipMemsetAsync((char*)d_ws + WS_CTL, 0, CTL_BYTES, stream);
    Args a{};
    for (int i = 0; i < 38; ++i) a.in[i] = (const float*)d_in[i];
    a.out = (float*)d_out; a.ws = (unsigned char*)d_ws;
#if MK_SPLIT
    for (int p = 0; p < N_PHASES; ++p) { a.ph_lo = p; a.ph_hi = p + 1; hipLaunchKernelGGL(mk_fwd, dim3(grid), dim3(512), LDS_BYTES, stream, a); }
#else
    a.ph_lo = 0; a.ph_hi = N_PHASES; hipLaunchKernelGGL(mk_fwd, dim3(grid), dim3(512), LDS_BYTES, stream, a);
#endif
}
```

```cpp
#include <hip/hip_runtime.h>
#include <cstdio>
#include <cstdint>
#include <cmath>

#define LAS __attribute__((address_space(3)))
#define GAS __attribute__((address_space(1)))
typedef unsigned short bf16;
typedef short bf16x8 __attribute__((ext_vector_type(8)));
typedef short bf16x4 __attribute__((ext_vector_type(4)));
typedef float f32x4 __attribute__((ext_vector_type(4)));
typedef float f32x2 __attribute__((ext_vector_type(2)));
typedef float f32x16 __attribute__((ext_vector_type(16)));
typedef unsigned u32x4 __attribute__((ext_vector_type(4)));
typedef unsigned u32x2 __attribute__((ext_vector_type(2)));

constexpr int NB = 8, SEQ = 4096, CTXL = 256, DM = 1024, DEPTH = 2;
constexpr int NLAT = NB * SEQ, NCTX = NB * CTXL, NTOK = NLAT + NCTX;
constexpr int IN_COLS = 2144, NIN_PAD = 2304;
constexpr int HY_OFF = 0, GM_OFF = 768, CV_OFF = 1280, MQ_OFF = 1792, MKV_OFF = 1984;
constexpr int PROJ_LD = 1536;
constexpr int PJ_GM = 0, PJ_CV = 512, PJ_MKV = 1024, PJ_MQ = 1184;
constexpr int NKEY = SEQ + CTXL;
constexpr int NEXP = 16, DEXP = 512, NBUCKET = 24;
constexpr int A_ROWS = 41216;
constexpr float EPS = 1e-6f;
constexpr int GC = 4128, GLEN = 8256;
constexpr float QSCALE = 0.10206207261596577f * 1.4426950408889634f;

constexpr size_t al256(size_t x) { return (x + 255) & ~(size_t)255; }
constexpr size_t WS_CTL = 0, CTL_BYTES = 1u << 20;
constexpr size_t WS_MOD = WS_CTL + CTL_BYTES;
constexpr size_t WS_ROPE = al256(WS_MOD + (size_t)2 * 9 * 6144 * 4);
constexpr size_t WS_WIN = al256(WS_ROPE + (size_t)2 * 4096 * 16 * 4);
constexpr size_t WS_WOUT = al256(WS_WIN + (size_t)2 * NIN_PAD * 1024 * 2);
constexpr size_t WS_W1 = al256(WS_WOUT + (size_t)2 * 1024 * 1024 * 2);
constexpr size_t WS_W2 = al256(WS_W1 + (size_t)2 * 16 * 1024 * 1024 * 2);
constexpr size_t WS_WUQ = al256(WS_W2 + (size_t)2 * 16 * 1024 * 512 * 2);
constexpr size_t WS_WUKV = al256(WS_WUQ + (size_t)2 * 384 * 192 * 2);
constexpr size_t WS_GMWS = al256(WS_WUKV + (size_t)2 * 512 * 128 * 2);
constexpr size_t WS_G = al256(WS_GMWS + (size_t)2 * 4 * 128 * 128 * 2);
constexpr size_t WS_TC = al256(WS_G + (size_t)2 * 2 * 256 * GLEN * 2);
constexpr size_t WS_H = al256(WS_TC + (size_t)2 * 256 * 512 * 4);
constexpr size_t WS_PROJ = al256(WS_H + (size_t)NTOK * 1024 * 2);
constexpr size_t WS_HYT = al256(WS_PROJ + (size_t)NTOK * PROJ_LD * 2);
constexpr size_t WS_Q = al256(WS_HYT + (size_t)768 * NTOK * 2);
constexpr size_t WS_K = al256(WS_Q + (size_t)NTOK * 384 * 2);
constexpr size_t WS_VT = al256(WS_K + (size_t)NB * 4 * NKEY * 96 * 2);
constexpr size_t WS_TOK = al256(WS_VT + (size_t)NB * 4 * 64 * NKEY * 2);
constexpr size_t WS_WLO = al256(WS_TOK + (size_t)NBUCKET * NTOK * 4);
constexpr size_t WS_WHI = al256(WS_WLO + (size_t)NBUCKET * NTOK * 4);
constexpr size_t WS_YT = WS_PROJ;
constexpr size_t WS_YAT = al256(WS_YT + (size_t)256 * NTOK * 2);
static_assert(WS_YAT + (size_t)NTOK * 256 * 2 <= WS_PROJ + (size_t)NTOK * PROJ_LD * 2, "yt/yat overlay");
constexpr size_t WS_FS = al256(WS_WHI + (size_t)NBUCKET * NTOK * 4);
constexpr size_t WS_POS = al256(WS_FS + (size_t)3 * 128 * 1024 * 4);
constexpr size_t WS_XB = al256(WS_POS + (size_t)NTOK * 4);
constexpr size_t WS_END = al256(WS_XB + (size_t)NTOK * 1024 * 2);
constexpr size_t WS_YM = WS_HYT;
static_assert(WS_YM + (size_t)A_ROWS * 1024 * 2 <= WS_VT, "ym overlay");
static_assert((size_t)A_ROWS * 1024 * 2 <= (size_t)NTOK * PROJ_LD * 2, "a overlays proj");
static_assert(WS_END <= (size_t)512 * 1024 * 1024, "workspace");
constexpr int CW_BAR = 1024;
constexpr int CW_CNT = 8192;
constexpr int CW_P0Q = 8192 + 128;
constexpr int CW_DQ = 8192 + 192;
constexpr int CW_P3Q = 8192 + 320;
constexpr int CW_TMO = 8192 + 256;
constexpr int CW_RDY = 16384;

constexpr int LDS_BYTES = 160 * 1024;
constexpr int LDS_MISC = 131072 + 28672;

__device__ __forceinline__ float bf2f(bf16 v) { return __builtin_bit_cast(float, (unsigned)v << 16); }
typedef __bf16 hw_bf16x2 __attribute__((ext_vector_type(2)));
__device__ __forceinline__ unsigned pk2(float lo, float hi) { const f32x2 v = {lo, hi}; const hw_bf16x2 b = __builtin_convertvector(v, hw_bf16x2); return __builtin_bit_cast(unsigned, b); }
__device__ __forceinline__ unsigned f2bf(float f) { return pk2(f, 0.f) & 0xffffu; }
__device__ __forceinline__ float lo_bf(unsigned w) { return __builtin_bit_cast(float, w << 16); }
__device__ __forceinline__ float hi_bf(unsigned w) { return __builtin_bit_cast(float, w & 0xffff0000u); }
template <int CTRL> __device__ __forceinline__ float dpp_f(float v) { return __builtin_bit_cast(float, __builtin_amdgcn_update_dpp(0, __builtin_bit_cast(int, v), CTRL, 0xF, 0xF, true)); }
__device__ __forceinline__ float xsum_step(float v, int o) {
    switch (o) { case 1: return v + dpp_f<0xB1>(v); case 2: return v + dpp_f<0x4E>(v); case 4: return v + dpp_f<0x141>(v); case 8: return v + dpp_f<0x140>(v); default: return v + __shfl_xor(v, o); }
}
__device__ __forceinline__ float wave_sum(float v) {
#pragma unroll
    for (int o = 1; o < 64; o <<= 1) v = xsum_step(v, o);
    return v;
}
__device__ __forceinline__ float frsq(float x) { return __builtin_amdgcn_rsqf(x); }
__device__ __forceinline__ float siluf(float x) { return x * __builtin_amdgcn_rcpf(1.f + __expf(-x)); }
__device__ __forceinline__ float sigmf(float x) { return __builtin_amdgcn_rcpf(1.f + __expf(-x)); }
__device__ __forceinline__ float gelu_tanh(float x) { constexpr float K0 = -2.3022081967f, K1 = -2.3022081967f * 0.044715f; const float q = x * __builtin_fmaf(x * x, K1, K0); return x * __builtin_amdgcn_rcpf(1.f + __builtin_amdgcn_exp2f(q)); }
__device__ __forceinline__ int mod_idx(int r) { return r < NLAT ? (r >> 12) : 8; }

#define XB_TMO      128
#define XB_XCNT(j)  (256  + 64 * (j))
#define XB_XSUB(j)  (1280 + 64 * (j))
#define XB_XGEN(j)  (2304 + 64 * (j))
#define XB_TOP      3328
#define XB_TOPGEN   3392
#define XCD_BAR_WORDS 3456
#define XB_SPIN_CAP (1u << 22)
__device__ __forceinline__ unsigned xb_ld(unsigned* p)              { return __hip_atomic_load(p, __ATOMIC_RELAXED, __HIP_MEMORY_SCOPE_AGENT); }
__device__ __forceinline__ unsigned xb_add(unsigned* p, unsigned v) { return __hip_atomic_fetch_add(p, v, __ATOMIC_RELAXED, __HIP_MEMORY_SCOPE_AGENT); }
__device__ __forceinline__ unsigned xb_xcc_id() { return (unsigned)__builtin_amdgcn_s_getreg((3 << 11) | 20) & 0xFu; }
#define XB_SPIN(cond, bar) do { unsigned _sp = 0; while (cond) { __builtin_amdgcn_s_sleep(1); \
    if ((++_sp & 255u) == 0u) { if (xb_ld(&(bar)[XB_TMO])) break; if (_sp > XB_SPIN_CAP) { atomicAdd(&(bar)[XB_TMO], 1u); break; } } } } while (0)
struct XcdBarrier { unsigned* bar; unsigned x; volatile LAS unsigned* st; };
__device__ __forceinline__ XcdBarrier xcd_barrier_post(unsigned* bar, volatile LAS unsigned* st) {
    XcdBarrier b; b.bar = bar; b.x = xb_xcc_id(); b.st = st;
    if (threadIdx.x == 0) (void)xb_add(&bar[XB_XCNT(b.x)], 1u);
    return b;
}
__device__ __forceinline__ void xcd_barrier_complete(unsigned* bar, unsigned x, unsigned& nloc, unsigned& nx) {
    const unsigned G = gridDim.x * gridDim.y * gridDim.z;
    unsigned sum, cnt, mine, sp = 0u;
    for (;;) {
        sum = 0u; cnt = 0u; mine = 0u;
#pragma unroll
        for (unsigned j = 0; j < 16; ++j) { const unsigned c = xb_ld(&bar[XB_XCNT(j)]); sum += c; cnt += (c > 0u) ? 1u : 0u; mine = (j == x) ? c : mine; }
        if (sum == G) break;
        __builtin_amdgcn_s_sleep(1);
        if ((++sp & 255u) == 0u) { if (xb_ld(&bar[XB_TMO])) break; if (sp > XB_SPIN_CAP) { atomicAdd(&bar[XB_TMO], 1u); break; } }
    }
    nloc = mine > 0u ? mine : 1u; nx = cnt > 0u ? cnt : 1u;
}
__device__ __forceinline__ void xcd_barrier(const XcdBarrier& b) {
    asm volatile("s_waitcnt vmcnt(0)" ::: "memory");
    __syncthreads();
    if (threadIdx.x == 0) {
        unsigned* bar = b.bar;
        __builtin_amdgcn_s_waitcnt(0);
        unsigned nloc = b.st[0], nx = b.st[1];
        if (nloc == 0u) { xcd_barrier_complete(bar, b.x, nloc, nx); b.st[0] = nloc; b.st[1] = nx; }
        const unsigned mygen = b.st[2]; b.st[2] = mygen + 1u;
        const unsigned old = xb_add(&bar[XB_XSUB(b.x)], 1u);
        const unsigned gen = old / nloc;
        if (old + 1u == (gen + 1u) * nloc) {
            __builtin_amdgcn_fence(__ATOMIC_RELEASE, "agent");
            asm volatile("s_waitcnt vmcnt(0)" ::: "memory");
            const unsigned og = xb_add(&bar[XB_TOP], 1u);
            const unsigned tg = og / nx;
            if (og + 1u == (tg + 1u) * nx) xb_add(&bar[XB_TOPGEN], 1u);
            else XB_SPIN(xb_ld(&bar[XB_TOPGEN]) == tg, bar);
            __builtin_amdgcn_fence(__ATOMIC_ACQUIRE, "agent");
            asm volatile("s_waitcnt vmcnt(0)" ::: "memory");
        } else {
            XB_SPIN(xb_ld(&bar[XB_TOPGEN]) == mygen, bar);
            __builtin_amdgcn_fence(__ATOMIC_ACQUIRE, "agent");
            asm volatile("s_waitcnt vmcnt(0)" ::: "memory");
        }
    }
    __syncthreads();
}

struct Args {
    const float* in[38]; float* out; unsigned char* ws; int ph_lo, ph_hi;
};
typedef const __attribute__((address_space(4))) Args* KArgs;
__device__ __forceinline__ KArgs kargs() { KArgs p = (KArgs)__builtin_amdgcn_kernarg_segment_ptr(); asm volatile("" : "+s"(p)); return p; }
struct Frame {
    LAS unsigned char* lds; unsigned char* ws; unsigned* ctl;
    int tid, lane, wave, G, vcu, gw, NGW;
};
__device__ __forceinline__ void relaunder(Frame& F) {
    int t = threadIdx.x; asm volatile("" : "+v"(t));
    F.tid = t; F.lane = t & 63; F.wave = __builtin_amdgcn_readfirstlane(t >> 6); F.gw = F.vcu * 8 + F.wave;
}
enum { I_X = 0, I_C, I_CTX, I_CCTX, I_ADAW, I_ADAB, I_N1G, I_N2G, I_WIN, I_HSW, I_HSB, I_HFW1, I_HFB1, I_HFFREQ, I_HFW2, I_HFB2, I_HFW3, I_HBIAS,
       I_GMLNG, I_GMLNB, I_GMWS, I_GMBS, I_CVW, I_CVB, I_CVLNG, I_CVLNB, I_QANORM, I_WUQ, I_KVANORM, I_WUKV, I_MIXG, I_WOUT, I_WROUTER, I_RBIAS,
       I_EWG, I_EWU, I_EWD, I_FNG };

__device__ __forceinline__ f32x4 mfma16(bf16x8 a, bf16x8 b, f32x4 c) { return __builtin_amdgcn_mfma_f32_16x16x32_bf16(a, b, c, 0, 0, 0); }
#ifndef MK_AT16
#define MK_AT16 0
#endif
namespace pg8 {
constexpr int BM = 256, BK = 64, HALF = 128, HTB = HALF * BK * 2, STAGE_BYTES = 8 * HTB;
__host__ __device__ __forceinline__ int lds_byte(int r, int c) { const int st = (r >> 4) * 2 + (c >> 5), rr = r & 15, cc = c & 31, ob = rr * 64 + cc * 2; return st * 1024 + (ob ^ (((ob >> 9) & 1) << 5)); }
__host__ __device__ __forceinline__ void stage_rc(int b, int& R, int& C) { const int st = b / 1024, sb = b % 1024, swz = sb ^ (((sb >> 9) & 1) << 5); R = (st >> 1) * 16 + swz / 64; C = (st & 1) * 32 + (swz % 64) / 2; }
__host__ __device__ __forceinline__ int perm32(int rho) { const int n = rho >> 4, i = rho & 15; return 8 * (i >> 2) + 4 * n + (i & 3); }
struct Unit { int pm, pn, k, aux; };
__device__ __forceinline__ unsigned cvt_pk_bf16(float lo, float hi) { unsigned r; asm volatile("v_cvt_pk_bf16_f32 %0, %1, %2" : "=v"(r) : "v"(lo), "v"(hi)); return r; }

template <class Op, bool ALIGN_EPI>
__device__ __forceinline__ void gemm_phase(LAS unsigned char* lds, const Op& op, const int K) {
    const int tid = threadIdx.x, wid = __builtin_amdgcn_readfirstlane(tid >> 6), lane = tid & 63, wr = wid >> 2, wc = wid & 3, fr = lane & 15, fq = lane >> 4;
    const int nt = K / BK;
    int Rs[2], Cs[2]; constexpr int NTY = Op::NTYPES; unsigned voffB[NTY][2], hstepB[NTY];
#pragma unroll
    for (int ty = 0; ty < NTY; ++ty) { hstepB[ty] = (unsigned)HALF * op.ldb(ty) * 2u;
#pragma unroll
        for (int i = 0; i < 2; ++i) { stage_rc(tid * 16 + i * 8192, Rs[i], Cs[i]); const int Rb = (Rs[i] & ~31) + perm32(Rs[i] & 31); voffB[ty][i] = (unsigned)(Rb * op.ldb(ty) + Cs[i]) * 2u; } }
    const unsigned ldsw = (unsigned)wid * 1024u;
    const int aoff = lds_byte(wr * 64 + fr, fq * 8), boff = lds_byte(wc * 32 + fr, fq * 8);
    const char* const Ab = (const char*)op.A();
#define PG8_SA(b, h) (((b) * 2 + (h)) * HTB)
#define PG8_SB(b, h) ((4 + (b) * 2 + (h)) * HTB)
#define PG8_STAGE_A(bufoff, offs, h, kb) do { _Pragma("unroll") for (int _i = 0; _i < 2; ++_i) \
        __builtin_amdgcn_global_load_lds((const unsigned*)(Ab + (size_t)(offs)[h][_i] + (kb)), (LAS unsigned*)(lds + (bufoff) + ldsw + _i * 8192), 16, 0, 0); } while (0)
#define PG8_STAGE_B(bufoff, gbase, ty) do { _Pragma("unroll") for (int _i = 0; _i < 2; ++_i) \
        __builtin_amdgcn_global_load_lds((const unsigned*)((const char*)(gbase) + (NTY == 1 ? voffB[0][_i] : ((ty) ? voffB[NTY - 1][_i] : voffB[0][_i]))), (LAS unsigned*)(lds + (bufoff) + ldsw + _i * 8192), 16, 0, 0); } while (0)
#define PG8_HS(ty) (NTY == 1 ? hstepB[0] : ((ty) ? hstepB[NTY - 1] : hstepB[0]))
#define PG8_LDA(dst, b, h) do { _Pragma("unroll") for (int m = 0; m < 4; ++m) _Pragma("unroll") for (int k = 0; k < 2; ++k) dst[m][k] = *(const LAS bf16x8*)(lds + PG8_SA(b, h) + aoff + m * 2048 + k * 1024); } while (0)
#define PG8_LDB(dst, b, h) do { _Pragma("unroll") for (int n = 0; n < 2; ++n) _Pragma("unroll") for (int k = 0; k < 2; ++k) dst[n][k] = *(const LAS bf16x8*)(lds + PG8_SB(b, h) + boff + n * 2048 + k * 1024); } while (0)
#define PG8_MMA(ai, bj, At, Bt) do { __builtin_amdgcn_s_setprio(1); _Pragma("unroll") for (int m = 0; m < 4; ++m) _Pragma("unroll") for (int n = 0; n < 2; ++n) _Pragma("unroll") for (int k = 0; k < 2; ++k) \
        acc[ai][bj][m][n] = __builtin_amdgcn_mfma_f32_16x16x32_bf16(Bt[n][k], At[m][k], acc[ai][bj][m][n], 0, 0, 0); __builtin_amdgcn_s_setprio(0); } while (0)
#define PG8_WAIT_V(n) asm volatile("s_waitcnt vmcnt(" #n ")" ::: "memory")
#define PG8_WAIT_L(n) asm volatile("s_waitcnt lgkmcnt(" #n ")" ::: "memory")
#define PG8_BAR __builtin_amdgcn_s_barrier()
#define PG8_SCHED __builtin_amdgcn_sched_barrier(0)
    Unit cur, nxt; int ui = 0;
    if (!op.next(0, cur)) return;
    f32x4 acc[2][2][4][2];
#pragma unroll
    for (int a = 0; a < 2; ++a)
#pragma unroll
        for (int b = 0; b < 2; ++b)
#pragma unroll
            for (int m = 0; m < 4; ++m)
#pragma unroll
                for (int n = 0; n < 2; ++n) acc[a][b][m][n] = (f32x4){0.f, 0.f, 0.f, 0.f};
    bf16x8 At[4][2], B0[2][2], B1[2][2];
    constexpr int NAO = Op::GATHER ? 2 : 1;
    unsigned caoff[2][2], naoff[NAO][2];
    size_t cbase = 0, nbase = 0;
#pragma unroll
    for (int h = 0; h < 2; ++h)
#pragma unroll
        for (int i = 0; i < 2; ++i) { if constexpr (Op::GATHER) caoff[h][i] = op.arow(cur, h * HALF + Rs[i]) + (unsigned)Cs[i] * 2u; else caoff[h][i] = (unsigned)(h * HALF + Rs[i]) * 2048u + (unsigned)Cs[i] * 2u; }
    if constexpr (!Op::GATHER) cbase = op.abase(cur);
    {
        if constexpr (Op::HOOKS) op.a_ready(cur);
        const char* b0 = op.bptr(cur, 0); const char* b1 = op.bptr(cur, 1); const int tyc = op.utype(cur);
        PG8_STAGE_B(PG8_SB(0, 0), b0, tyc); PG8_STAGE_B(PG8_SB(0, 1), b0 + PG8_HS(tyc), tyc); PG8_STAGE_A(PG8_SA(0, 0), caoff, 0, cbase); PG8_STAGE_A(PG8_SA(0, 1), caoff, 1, cbase);
        if (wr == 1) PG8_BAR;
        PG8_WAIT_V(2); PG8_BAR;
        PG8_STAGE_B(PG8_SB(1, 0), b1, tyc); PG8_STAGE_A(PG8_SA(1, 0), caoff, 0, cbase + 128); PG8_STAGE_B(PG8_SB(1, 1), b1 + PG8_HS(tyc), tyc);
        PG8_WAIT_V(6); PG8_BAR;
    }
    for (;;) {
        const bool has_next = op.next(ui + 1, nxt);
        bool skip1 = false; if constexpr (Op::HALFSKIP) skip1 = op.half_only(cur);
        if (!has_next) nxt = cur;
        if constexpr (Op::HOOKS) { if (has_next) op.a_ready(nxt); }
        const int tycur = op.utype(cur), tynxt = op.utype(nxt);
        if constexpr (Op::GATHER) {
#pragma unroll
            for (int h = 0; h < 2; ++h)
#pragma unroll
                for (int i = 0; i < 2; ++i) naoff[h][i] = has_next ? op.arow(nxt, h * HALF + Rs[i]) + (unsigned)Cs[i] * 2u : caoff[h][i];
        } else nbase = op.abase(nxt);
        asm volatile(".p2align 8");
        for (int t = 0; t < nt; t += 2) {
            const bool last = (t == nt - 2);
            const size_t ka1 = cbase + (size_t)(t + 1) * 128u;
            const size_t ka2 = last ? nbase : cbase + (size_t)(t + 2) * 128u, ka3 = ka2 + 128u;
            unsigned a2off[2][2];
#pragma unroll
            for (int h = 0; h < 2; ++h)
#pragma unroll
                for (int i = 0; i < 2; ++i) { if constexpr (Op::GATHER) a2off[h][i] = last ? naoff[h][i] : caoff[h][i]; else a2off[h][i] = caoff[h][i]; }
            const char* b2 = last ? op.bptr(nxt, 0) : op.bptr(cur, t + 2);
            const char* b3 = last ? op.bptr(nxt, 1) : op.bptr(cur, t + 3); const int ty2 = last ? tynxt : tycur;
            PG8_LDB(B0, 0, 0); PG8_LDB(B1, 0, 1); PG8_SCHED; PG8_LDA(At, 0, 0); PG8_STAGE_A(PG8_SA(1, 1), caoff, 1, ka1);
            PG8_WAIT_V(8); PG8_WAIT_L(0); PG8_BAR; PG8_MMA(0, 0, At, B0); PG8_MMA(0, 1, At, B1); PG8_BAR; PG8_SCHED;
            PG8_LDA(At, 0, 1); PG8_STAGE_B(PG8_SB(0, 0), b2, ty2); PG8_STAGE_B(PG8_SB(0, 1), b2 + PG8_HS(ty2), ty2); PG8_STAGE_A(PG8_SA(0, 0), a2off, 0, ka2);
            PG8_WAIT_V(8); PG8_WAIT_L(0); PG8_BAR; if (!skip1) { PG8_MMA(1, 0, At, B0); PG8_MMA(1, 1, At, B1); } PG8_BAR; PG8_SCHED;
            PG8_LDB(B0, 1, 0); PG8_LDB(B1, 1, 1); PG8_SCHED; PG8_LDA(At, 1, 0); PG8_STAGE_A(PG8_SA(0, 1), a2off, 1, ka2);
            PG8_WAIT_V(8); PG8_WAIT_L(0); PG8_BAR; PG8_MMA(0, 0, At, B0); PG8_MMA(0, 1, At, B1); PG8_BAR; PG8_SCHED;
            PG8_LDA(At, 1, 1); PG8_STAGE_B(PG8_SB(1, 0), b3, ty2); PG8_STAGE_B(PG8_SB(1, 1), b3 + PG8_HS(ty2), ty2); PG8_STAGE_A(PG8_SA(1, 0), a2off, 0, ka3);
            PG8_WAIT_V(8); PG8_WAIT_L(0); PG8_BAR; if (!skip1) { PG8_MMA(1, 0, At, B0); PG8_MMA(1, 1, At, B1); } PG8_BAR; PG8_SCHED;
        }
        if constexpr (ALIGN_EPI) { if (wr == 0) PG8_BAR; }
        op.epi(acc, cur, wr, wc, fr, fq);
        if constexpr (Op::HOOKS) op.done(cur);
        if (!has_next) break;
#pragma unroll
        for (int a = 0; a < 2; ++a)
#pragma unroll
            for (int b = 0; b < 2; ++b)
#pragma unroll
                for (int m = 0; m < 4; ++m)
#pragma unroll
                    for (int n = 0; n < 2; ++n) acc[a][b][m][n] = (f32x4){0.f, 0.f, 0.f, 0.f};
        cur = nxt; ++ui;
        if constexpr (Op::GATHER) {
#pragma unroll
            for (int h = 0; h < 2; ++h)
#pragma unroll
                for (int i = 0; i < 2; ++i) caoff[h][i] = naoff[h][i];
        } else cbase = nbase;
        if constexpr (ALIGN_EPI) { if (wr == 1) PG8_BAR; }
    }
    PG8_WAIT_V(0);
    if constexpr (!ALIGN_EPI) { if (wr == 0) PG8_BAR; }
    PG8_BAR;
#undef PG8_SA
#undef PG8_SB
#undef PG8_STAGE_A
#undef PG8_STAGE_B
#undef PG8_HS
#undef PG8_LDA
#undef PG8_LDB
#undef PG8_MMA
#undef PG8_WAIT_V
#undef PG8_WAIT_L
#undef PG8_BAR
#undef PG8_SCHED
}
}
struct OpIn {
    const bf16* A_; const bf16* Bt; bf16* proj; bf16* hyT; int layer, G, vcu;
    __device__ __forceinline__ const bf16* A() const { return A_; }
    static constexpr int NTYPES = 1; static constexpr bool HOOKS = false;
    __device__ __forceinline__ int utype(const pg8::Unit&) const { return 0; }
    __device__ __forceinline__ int ldb(int) const { return 1024; }
    __device__ __forceinline__ bool next(int i, pg8::Unit& u) const {
        const int L = i * G + vcu; const int nlat = 128 * 9, total = layer == 0 ? 136 * 9 : nlat + 8;
        if (L >= total) return false;
        if (layer == 0 || L < nlat) { u.pm = L / 9; u.pn = L % 9; } else { u.pm = 128 + (L - nlat); u.pn = 7; }
        u.k = 0; u.aux = 0; return true;
    }
    static constexpr bool GATHER = false; static constexpr bool HALFSKIP = false;
    __device__ __forceinline__ size_t abase(const pg8::Unit& u) const { return (size_t)u.pm * 256 * 2048; }
    __device__ __forceinline__ const char* bptr(const pg8::Unit& u, int t) const { return (const char*)Bt + (size_t)u.pn * 256 * 2048 + (size_t)t * 128; }
    __device__ __forceinline__ void epi(const f32x4 (&acc)[2][2][4][2], const pg8::Unit& u, int wr, int wc, int fr, int fq) const {
        const int row0 = u.pm * 256 + wr * 64 + fr, lc0 = wc * 32 + 8 * fq;
        if (u.pn >= 3) {
            bf16* base = proj + (size_t)row0 * PROJ_LD + (u.pn - 3) * 256 + lc0;
#pragma unroll
            for (int ai = 0; ai < 2; ++ai)
#pragma unroll
                for (int m = 0; m < 4; ++m) { bf16* rowp = base + (size_t)(ai * 128 + m * 16) * PROJ_LD;
#pragma unroll
                    for (int bj = 0; bj < 2; ++bj) { const f32x4 v0 = acc[ai][bj][m][0], v1 = acc[ai][bj][m][1]; u32x4 w;
                        w.x = pg8::cvt_pk_bf16(v0[0], v0[1]); w.y = pg8::cvt_pk_bf16(v0[2], v0[3]); w.z = pg8::cvt_pk_bf16(v1[0], v1[1]); w.w = pg8::cvt_pk_bf16(v1[2], v1[3]);
                        *(u32x4*)(rowp + bj * 128) = w; } }
        } else {
            bf16* base = hyT + (size_t)(u.pn * 256 + lc0) * NTOK + row0;
#pragma unroll
            for (int ai = 0; ai < 2; ++ai)
#pragma unroll
                for (int m = 0; m < 4; ++m)
#pragma unroll
                    for (int bj = 0; bj < 2; ++bj)
#pragma unroll
                        for (int n = 0; n < 2; ++n)
#pragma unroll
                            for (int j = 0; j < 4; j += 2) { const unsigned w = pk2(acc[ai][bj][m][n][j], acc[ai][bj][m][n][j + 1]);
                                base[(size_t)(bj * 128 + 4 * n + j) * NTOK + ai * 128 + m * 16] = (bf16)(w & 0xffffu); base[(size_t)(bj * 128 + 4 * n + j + 1) * NTOK + ai * 128 + m * 16] = (bf16)(w >> 16); }
        }
    }
};

struct OpOut {
    const bf16* A_; const bf16* Bt; const float* xin_lat; const float* xin_ctx; bf16* xb; const float* mod; int layer, G, vcu; float scale;
    __device__ __forceinline__ const bf16* A() const { return A_; }
    static constexpr int NTYPES = 1; static constexpr bool HOOKS = false;
    __device__ __forceinline__ int utype(const pg8::Unit&) const { return 0; }
    __device__ __forceinline__ int ldb(int) const { return 1024; }
    __device__ __forceinline__ bool next(int i, pg8::Unit& u) const {
        const int L = i * G + vcu; const int total = (layer == 0 ? 136 : 128) * 4;
        if (L >= total) return false;
        u.pm = L >> 2; u.pn = L & 3; u.k = 0; u.aux = 0; return true;
    }
    static constexpr bool GATHER = false; static constexpr bool HALFSKIP = false;
    __device__ __forceinline__ size_t abase(const pg8::Unit& u) const { return (size_t)u.pm * 256 * 2048; }
    __device__ __forceinline__ const char* bptr(const pg8::Unit& u, int t) const { return (const char*)Bt + (size_t)u.pn * 256 * 2048 + (size_t)t * 128; }
    __device__ __forceinline__ void epi(const f32x4 (&acc)[2][2][4][2], const pg8::Unit& u, int wr, int wc, int fr, int fq) const {
        const int grow0 = u.pm * 256; const bool isl = grow0 < NLAT;
        const float* xi = isl ? xin_lat + (size_t)grow0 * 1024 : xin_ctx + (size_t)(grow0 - NLAT) * 1024;
        const float* g1 = mod + (size_t)mod_idx(grow0) * 6144 + 2 * 1024;
        const int lr0 = wr * 64 + fr, c0 = u.pn * 256 + wc * 32 + 8 * fq;
#pragma unroll
        for (int bj = 0; bj < 2; ++bj) { const int col = c0 + bj * 128; const f32x4 ga = *(const f32x4*)(g1 + col) * scale, gb = *(const f32x4*)(g1 + col + 4) * scale;
            u32x4 xw[8];
            if (layer != 0) {
#pragma unroll
                for (int ai = 0; ai < 2; ++ai)
#pragma unroll
                    for (int m = 0; m < 4; ++m) xw[ai * 4 + m] = *(const u32x4*)(xb + (size_t)(grow0 + lr0 + ai * 128 + m * 16) * 1024 + col); }
#pragma unroll
            for (int ai = 0; ai < 2; ++ai) {
                f32x4 xfa[4], xfb[4];
                if (layer == 0) {
#pragma unroll
                    for (int m = 0; m < 4; ++m) { const float* xp = xi + (size_t)(lr0 + ai * 128 + m * 16) * 1024 + col; xfa[m] = *(const f32x4*)xp; xfb[m] = *(const f32x4*)(xp + 4); } }
#pragma unroll
                for (int m = 0; m < 4; ++m) { const int lr = lr0 + ai * 128 + m * 16; bf16* xo = xb + (size_t)(grow0 + lr) * 1024 + col;
                    f32x4 xa, xv;
                    if (layer == 0) { xa = xfa[m]; xv = xfb[m]; }
                    else { const u32x4 w = xw[ai * 4 + m]; xa = (f32x4){lo_bf(w.x), hi_bf(w.x), lo_bf(w.y), hi_bf(w.y)}; xv = (f32x4){lo_bf(w.z), hi_bf(w.z), lo_bf(w.w), hi_bf(w.w)}; }
                    const f32x4 r0 = xa + ga * acc[ai][bj][m][0], r1 = xv + gb * acc[ai][bj][m][1]; u32x4 w;
                    w.x = pg8::cvt_pk_bf16(r0[0], r0[1]); w.y = pg8::cvt_pk_bf16(r0[2], r0[3]); w.z = pg8::cvt_pk_bf16(r1[0], r1[1]); w.w = pg8::cvt_pk_bf16(r1[2], r1[3]);
                    *(u32x4*)xo = w; } } }
    }
};

struct MoeTab { const LAS int* t; };
__device__ __forceinline__ void moe_decode(const LAS int* tab, int mi, int& k, int& j) { const int v = tab[64 + mi]; k = v >> 16; j = v & 0xffff; }
__device__ __forceinline__ void moe_tile_map(LAS int* tab, int tid) {
    for (int mi = tid; mi < tab[NBUCKET]; mi += 512) { int kk = 0;
#pragma unroll
        for (int q = 1; q < NBUCKET; ++q) if (tab[q] <= mi) kk = q;
        tab[64 + mi] = (kk << 16) | (mi - tab[kk]); }
}
__device__ __forceinline__ void pair_of(int k, int& elo, int& ehi) {
    const int g = k / 6, p = k - g * 6;
    const int lo = p < 3 ? 0 : (p < 5 ? 1 : 2), hi = p < 3 ? p + 1 : (p < 5 ? p - 1 : 3);
    elo = g * 4 + lo; ehi = g * 4 + hi;
}
struct OpMoe1 {
    const bf16* A_; const bf16* W1; bf16* abuf; const int* TOK; const float* WLO; const float* WHI; const LAS int* tab; int layer, G, vcu;
    __device__ __forceinline__ const bf16* A() const { return A_; }
    static constexpr int NTYPES = 1; static constexpr bool HOOKS = false;
    __device__ __forceinline__ int utype(const pg8::Unit&) const { return 0; }
    __device__ __forceinline__ int ldb(int) const { return 1024; }
    __device__ __forceinline__ bool next(int i, pg8::Unit& u) const {
        const int L = i * G + vcu; const int MT = tab[NBUCKET];
        if (L >= MT * 8) return false;
        u.pm = L >> 3; u.pn = L & 7; moe_decode(tab, u.pm, u.k, u.aux); return true;
    }
    static constexpr bool GATHER = true; static constexpr bool HALFSKIP = false;
    __device__ __forceinline__ size_t abase(const pg8::Unit&) const { return 0; }
    __device__ __forceinline__ unsigned arow(const pg8::Unit& u, int lr) const {
        const int cnt = tab[32 + u.k]; int p = u.aux * 256 + lr; p = p < cnt ? p : cnt - 1;
        return (unsigned)TOK[(size_t)u.k * NTOK + p] * 2048u;
    }
    __device__ __forceinline__ const char* bptr(const pg8::Unit& u, int t) const {
        int elo, ehi; pair_of(u.k, elo, ehi); const int e = u.pn < 4 ? elo : ehi;
        return (const char*)W1 + ((size_t)(layer * 16 + e) * 1024 + (u.pn & 3) * 256) * 2048 + (size_t)t * 128;
    }
    __device__ __forceinline__ void epi(const f32x4 (&acc)[2][2][4][2], const pg8::Unit& u, int wr, int wc, int fr, int fq) const {
        const int cnt = tab[32 + u.k]; const float* WW = (u.pn < 4 ? WLO : WHI) + (size_t)u.k * NTOK;
        const int lr0 = wr * 64 + fr, c0 = (u.pn >= 4 ? 512 : 0) + (u.pn & 3) * 128 + wc * 32 + 8 * fq;
#pragma unroll
        for (int ai = 0; ai < 2; ++ai)
#pragma unroll
            for (int m = 0; m < 4; ++m) { const int lr = lr0 + ai * 128 + m * 16; int p = u.aux * 256 + lr; p = p < cnt ? p : cnt - 1; const float w = WW[p];
                const f32x4 g0 = acc[ai][0][m][0], g1 = acc[ai][0][m][1], u0 = acc[ai][1][m][0], u1 = acc[ai][1][m][1]; float o[8];
#pragma unroll
                for (int j = 0; j < 4; ++j) { o[j] = siluf(g0[j]) * u0[j] * w; o[4 + j] = siluf(g1[j]) * u1[j] * w; }
                u32x4 ww; ww.x = pg8::cvt_pk_bf16(o[0], o[1]); ww.y = pg8::cvt_pk_bf16(o[2], o[3]); ww.z = pg8::cvt_pk_bf16(o[4], o[5]); ww.w = pg8::cvt_pk_bf16(o[6], o[7]);
                *(u32x4*)(abuf + (size_t)(u.pm * 256 + lr) * 1024 + c0) = ww; }
    }
};
struct OpMoe2 {
    const bf16* A_; const bf16* W2; bf16* ym; const LAS int* tab; int layer, G, vcu;
    static constexpr bool GATHER = false; static constexpr bool HALFSKIP = false;
    __device__ __forceinline__ size_t abase(const pg8::Unit& u) const { return (size_t)u.pm * 256 * 2048; }
    __device__ __forceinline__ const bf16* A() const { return A_; }
    static constexpr int NTYPES = 1; static constexpr bool HOOKS = false;
    __device__ __forceinline__ int utype(const pg8::Unit&) const { return 0; }
    __device__ __forceinline__ int ldb(int) const { return 512; }
    __device__ __forceinline__ bool next(int i, pg8::Unit& u) const {
        const int L = i * G + vcu; const int MT = tab[NBUCKET];
        if (L >= MT * 4) return false;
        u.pm = L >> 2; u.pn = L & 3; moe_decode(tab, u.pm, u.k, u.aux); return true;
    }
    __device__ __forceinline__ const char* bptr(const pg8::Unit& u, int t) const {
        int elo, ehi; pair_of(u.k, elo, ehi); const int e = t < 8 ? elo : ehi;
        return (const char*)W2 + ((size_t)(layer * 16 + e) * 1024 + u.pn * 256) * 1024 + (size_t)(t & 7) * 128;
    }
    __device__ __forceinline__ void epi(const f32x4 (&acc)[2][2][4][2], const pg8::Unit& u, int wr, int wc, int fr, int fq) const {
        bf16* base = ym + (size_t)(u.pm * 256 + wr * 64 + fr) * 1024 + u.pn * 256 + wc * 32 + 8 * fq;
#pragma unroll
        for (int ai = 0; ai < 2; ++ai)
#pragma unroll
            for (int m = 0; m < 4; ++m) { bf16* rowp = base + (size_t)(ai * 128 + m * 16) * 1024;
#pragma unroll
                for (int bj = 0; bj < 2; ++bj) { const f32x4 v0 = acc[ai][bj][m][0], v1 = acc[ai][bj][m][1]; u32x4 w;
                    w.x = pg8::cvt_pk_bf16(v0[0], v0[1]); w.y = pg8::cvt_pk_bf16(v0[2], v0[3]); w.z = pg8::cvt_pk_bf16(v1[0], v1[1]); w.w = pg8::cvt_pk_bf16(v1[2], v1[3]);
                    *(u32x4*)(rowp + bj * 128) = w; } }
    }
};

struct OpMoe12 {
    const char* wsb; const bf16* W1; const bf16* W2; bf16* abuf; bf16* ym; const int* TOK; const float* WLO; const float* WHI; const LAS int* tab; unsigned* ready; unsigned* tmo; int layer, G, vcu;
    static constexpr bool GATHER = true; static constexpr bool HALFSKIP = true; static constexpr int NTYPES = 2; static constexpr bool HOOKS = true;
    __device__ __forceinline__ const bf16* A() const { return (const bf16*)wsb; }
    __device__ __forceinline__ size_t abase(const pg8::Unit&) const { return 0; }
    __device__ __forceinline__ int utype(const pg8::Unit& u) const { return u.pn >> 3; }
    __device__ __forceinline__ int ldb(int ty) const { return ty ? 512 : 1024; }
    __device__ __forceinline__ bool next(int i, pg8::Unit& u) const {
        int L = i * G + vcu; const int MT = tab[NBUCKET];
        if (L < MT * 8) { u.pm = L >> 3; u.pn = L & 7; }
        else { L -= MT * 8; if (L >= MT * 4) return false; u.pm = L >> 2; u.pn = 8 | (L & 3); }
        moe_decode(tab, u.pm, u.k, u.aux); return true;
    }
    __device__ __forceinline__ unsigned arow(const pg8::Unit& u, int lr) const {
        if (u.pn & 8) return (unsigned)WS_PROJ + (unsigned)(u.pm * 256 + lr) * 2048u;
        const int cnt = tab[32 + u.k]; int p = u.aux * 256 + lr; p = p < cnt ? p : cnt - 1;
        return (unsigned)WS_H + (unsigned)TOK[(size_t)u.k * NTOK + p] * 2048u;
    }
    __device__ __forceinline__ const char* bptr(const pg8::Unit& u, int t) const {
        int elo, ehi; pair_of(u.k, elo, ehi);
        if (u.pn & 8) { const int e = t < 8 ? elo : ehi; return (const char*)W2 + ((size_t)(layer * 16 + e) * 1024 + (u.pn & 3) * 256) * 1024 + (size_t)(t & 7) * 128; }
        const int e = u.pn < 4 ? elo : ehi; return (const char*)W1 + ((size_t)(layer * 16 + e) * 1024 + (u.pn & 3) * 256) * 2048 + (size_t)t * 128;
    }
    __device__ __forceinline__ bool half_only(const pg8::Unit& u) const { return tab[32 + u.k] - u.aux * 256 <= 128; }
    __device__ __forceinline__ void a_ready(const pg8::Unit& u) const {
        if (!(u.pn & 8)) return;
        if (threadIdx.x < 64) {
            unsigned* w = ready + 16 * u.pm; unsigned sp = 0;
            while ((unsigned)__builtin_amdgcn_readfirstlane(__hip_atomic_load(w, __ATOMIC_RELAXED, __HIP_MEMORY_SCOPE_AGENT)) < 64u) {
                __builtin_amdgcn_s_sleep(2);
                if (++sp > (1u << 22)) { if (threadIdx.x == 0) __hip_atomic_store(tmo, 1u, __ATOMIC_RELAXED, __HIP_MEMORY_SCOPE_AGENT); break; } }
            __builtin_amdgcn_fence(__ATOMIC_ACQUIRE, "agent");
            asm volatile("s_waitcnt vmcnt(0)" ::: "memory");
        }
        asm volatile("" ::: "memory"); __builtin_amdgcn_s_barrier(); asm volatile("" ::: "memory");
    }
    __device__ __forceinline__ void done(const pg8::Unit& u) const {
        if (u.pn & 8) return;
        asm volatile("s_waitcnt vmcnt(0)" ::: "memory");
        if ((threadIdx.x & 63) == 0) __hip_atomic_fetch_add(ready + 16 * u.pm, 1u, __ATOMIC_RELAXED, __HIP_MEMORY_SCOPE_AGENT);
    }
    __device__ __forceinline__ void epi(const f32x4 (&acc)[2][2][4][2], const pg8::Unit& u, int wr, int wc, int fr, int fq) const {
        if (u.pn & 8) {
            bf16* base = ym + (size_t)(u.pm * 256 + wr * 64 + fr) * 1024 + (u.pn & 3) * 256 + wc * 32 + 8 * fq;
#pragma unroll
            for (int ai = 0; ai < 2; ++ai)
#pragma unroll
                for (int m = 0; m < 4; ++m) { bf16* rowp = base + (size_t)(ai * 128 + m * 16) * 1024;
#pragma unroll
                    for (int bj = 0; bj < 2; ++bj) { const f32x4 v0 = acc[ai][bj][m][0], v1 = acc[ai][bj][m][1]; u32x4 w;
                        w.x = pg8::cvt_pk_bf16(v0[0], v0[1]); w.y = pg8::cvt_pk_bf16(v0[2], v0[3]); w.z = pg8::cvt_pk_bf16(v1[0], v1[1]); w.w = pg8::cvt_pk_bf16(v1[2], v1[3]);
                        *(u32x4*)(rowp + bj * 128) = w; } }
        } else {
            const int cnt = tab[32 + u.k]; const float* WW = (u.pn < 4 ? WLO : WHI) + (size_t)u.k * NTOK;
            const int lr0 = wr * 64 + fr, c0 = (u.pn >= 4 ? 512 : 0) + (u.pn & 3) * 128 + wc * 32 + 8 * fq;
            const __amdgpu_buffer_rsrc_t rs = __builtin_amdgcn_make_buffer_rsrc((void*)abuf, 0, (int)((size_t)A_ROWS * 2048), 0x00020000);
            float wrow[8];
#pragma unroll
            for (int ai = 0; ai < 2; ++ai)
#pragma unroll
                for (int m = 0; m < 4; ++m) { int p = u.aux * 256 + lr0 + ai * 128 + m * 16; p = p < cnt ? p : cnt - 1; wrow[ai * 4 + m] = WW[p]; }
#pragma unroll
            for (int ai = 0; ai < 2; ++ai)
#pragma unroll
                for (int m = 0; m < 4; ++m) { const int lr = lr0 + ai * 128 + m * 16; const float w = wrow[ai * 4 + m];
                    const f32x4 g0 = acc[ai][0][m][0], g1 = acc[ai][0][m][1], u0 = acc[ai][1][m][0], u1 = acc[ai][1][m][1]; float o[8];
#pragma unroll
                    for (int j = 0; j < 4; ++j) { o[j] = siluf(g0[j]) * u0[j] * w; o[4 + j] = siluf(g1[j]) * u1[j] * w; }
                    u32x4 ww; ww.x = pg8::cvt_pk_bf16(o[0], o[1]); ww.y = pg8::cvt_pk_bf16(o[2], o[3]); ww.z = pg8::cvt_pk_bf16(o[4], o[5]); ww.w = pg8::cvt_pk_bf16(o[6], o[7]);
                    __builtin_amdgcn_raw_buffer_store_b128(ww, rs, (int)(((unsigned)(u.pm * 256 + lr) * 1024u + (unsigned)c0) * 2u), 0, 16); }
        }
    }
};
struct TrItem { const float* W; int N, k0, n0; bf16* WT; int ldk, dst_row0; const float* kscale; };
__device__ __forceinline__ void transpose_load(const TrItem& t, int lane, float (&tv)[32]) {
#pragma unroll
    for (int i = 0; i < 32; ++i) { const int kk = 2 * i + (lane >> 5); tv[i] = __builtin_nontemporal_load(t.W + (size_t)(t.k0 + kk) * t.N + t.n0 + (lane & 31)); }
}
__device__ __forceinline__ void transpose_finish(const TrItem& t, LAS float* scr, int lane, const float (&tv)[32]) {
#pragma unroll
    for (int i = 0; i < 32; ++i) { const int kk = 2 * i + (lane >> 5); scr[kk * 33 + (lane & 31)] = t.kscale ? tv[i] * t.kscale[t.k0 + kk] : tv[i]; }
    asm volatile("s_waitcnt lgkmcnt(0)" ::: "memory");
    const int c = lane & 7;
#pragma unroll
    for (int j = 0; j < 4; ++j) { const int n = (lane >> 3) + 8 * j; const LAS float* s = scr + (8 * c) * 33 + n;
        u32x4 o; o.x = pk2(s[0 * 33], s[1 * 33]); o.y = pk2(s[2 * 33], s[3 * 33]); o.z = pk2(s[4 * 33], s[5 * 33]); o.w = pk2(s[6 * 33], s[7 * 33]);
        *(u32x4*)(t.WT + (size_t)(t.dst_row0 + n) * t.ldk + t.k0 + 8 * c) = o; }
    asm volatile("s_waitcnt lgkmcnt(0)" ::: "memory");
}
__device__ __forceinline__ int win_dst(int n0) { return n0 < 1792 ? n0 : (n0 < 1984 ? 1952 + (n0 - 1792) : 1792 + (n0 - 1984)); }

constexpr int N_WIN = 2 * 16 * 67, N_WOUT = 2 * 16 * 32, N_G = 2 * 16 * 16 * 16, N_U = N_G, N_D = 2 * 16 * 8 * 32, N_UQ = 2 * 3 * 12, N_UKV = 2 * 2 * 16;
constexpr int NIT_W = N_WIN + N_WOUT + N_G + N_U + N_D + N_UQ + N_UKV;
struct MiniF { LAS unsigned char* lds; unsigned char* ws; int tid, lane, wave; };
__device__ __forceinline__ MiniF minif(LAS unsigned char* lds, unsigned char* ws) { MiniF F; F.lds = lds; F.ws = ws; F.tid = threadIdx.x; F.lane = F.tid & 63; F.wave = __builtin_amdgcn_readfirstlane(F.tid >> 6); return F; }
__device__ __forceinline__ TrItem weight_decode(unsigned char* ws, KArgs a, int it) {
    int r = it;
    if (r < N_WIN) { const int l = r / (16 * 67), q = r % (16 * 67), kb = q / 67, nb = q % 67;
        return TrItem{a->in[I_WIN] + (size_t)l * 1024 * IN_COLS, IN_COLS, kb * 64, nb * 32, (bf16*)(ws + WS_WIN) + (size_t)l * NIN_PAD * 1024, 1024, win_dst(nb * 32), nullptr}; } r -= N_WIN;
    if (r < N_WOUT) { const int l = r / 512, q = r % 512, kb = q / 32, nb = q % 32;
        return TrItem{a->in[I_WOUT] + (size_t)l * 1024 * 1024, 1024, kb * 64, nb * 32, (bf16*)(ws + WS_WOUT) + (size_t)l * 1024 * 1024, 1024, nb * 32, nullptr}; } r -= N_WOUT;
    if (r < N_G + N_U) { const bool up = r >= N_G; if (up) r -= N_G; const int le = r / 256, q = r % 256, kb = q / 16, nb = q % 16; const int f0 = nb * 32;
        return TrItem{a->in[up ? I_EWU : I_EWG] + (size_t)le * 1024 * 512, 512, kb * 64, f0, (bf16*)(ws + WS_W1) + (size_t)le * 1024 * 1024, 1024, (f0 >> 7) * 256 + (up ? 128 : 0) + (f0 & 127), nullptr}; } r -= N_G + N_U;
    if (r < N_D) { const int le = r / 256, q = r % 256, kb = q / 32, nb = q % 32;
        return TrItem{a->in[I_EWD] + (size_t)le * 512 * 1024, 1024, kb * 64, nb * 32, (bf16*)(ws + WS_W2) + (size_t)le * 1024 * 512, 512, nb * 32, nullptr}; } r -= N_D;
    if (r < N_UQ) { const int l = r / 36, q = r % 36, kb = q / 12, nb = q % 12;
        return TrItem{a->in[I_WUQ] + (size_t)l * 192 * 384, 384, kb * 64, nb * 32, (bf16*)(ws + WS_WUQ) + (size_t)l * 384 * 192, 192, nb * 32, a->in[I_QANORM] + l * 192}; } r -= N_UQ;
    { const int l = r / 32, q = r % 32, kb = q / 16, nb = q % 16;
        return TrItem{a->in[I_WUKV] + (size_t)l * 128 * 512, 512, kb * 64, nb * 32, (bf16*)(ws + WS_WUKV) + (size_t)l * 512 * 128, 128, nb * 32, a->in[I_KVANORM] + l * 128}; }
}
__device__ __attribute__((noinline)) void p0_weight_item(LAS unsigned char* lds_, unsigned char* ws_, KArgs a, int it) {
    const MiniF F = minif(lds_, ws_);
    LAS float* scr = (LAS float*)(F.lds + F.wave * 16384);
    const TrItem t = weight_decode(F.ws, a, it);
    float tv[32]; transpose_load(t, F.lane, tv); transpose_finish(t, scr, F.lane, tv);
}
__device__ __attribute__((noinline)) void p0_weight_pair(LAS unsigned char* lds_, unsigned char* ws_, KArgs a, int it0, int it1) {
    const MiniF F = minif(lds_, ws_);
    LAS float* scr = (LAS float*)(F.lds + F.wave * 16384);
    const TrItem t0 = weight_decode(F.ws, a, it0), t1 = weight_decode(F.ws, a, it1);
    float tv0[32], tv1[32]; transpose_load(t0, F.lane, tv0); transpose_load(t1, F.lane, tv1);
    transpose_finish(t0, scr, F.lane, tv0); transpose_finish(t1, scr, F.lane, tv1);
}
constexpr int N_MISC_PAD = 2 * 160 * 128, N_MISC_GM = 2 * 4 * 128 * 128 / 4, N_MISC_ROPE = 4096 * 16, N_MISC = N_MISC_PAD + N_MISC_GM + N_MISC_ROPE;
__device__ __attribute__((noinline)) void p0_misc_op(unsigned char* ws, KArgs a, int i) {
    if (i < N_MISC_PAD) { const int l = i / (160 * 128), q = i % (160 * 128);
        *(u32x4*)((bf16*)(ws + WS_WIN) + ((size_t)l * NIN_PAD + 2144) * 1024 + (size_t)q * 8) = (u32x4){0u, 0u, 0u, 0u}; return; } i -= N_MISC_PAD;
    if (i < N_MISC_GM) { const f32x4 v = *(const f32x4*)(a->in[I_GMWS] + (size_t)i * 4); u32x2 o; o.x = pk2(v[0], v[1]); o.y = pk2(v[2], v[3]);
        *(u32x2*)((bf16*)(ws + WS_GMWS) + (size_t)i * 4) = o; return; } i -= N_MISC_GM;
    if (i < N_MISC_ROPE) { const int t = i >> 4, j = i & 15; const float pos = (float)(j < 8 ? (t >> 6) : (t & 63));
        const float inv = powf(10000.0f, -(float)(j & 7) / 8.0f); const float ang = pos * inv;
        ((float*)(ws + WS_ROPE))[i] = cosf(ang); ((float*)(ws + WS_ROPE))[4096 * 16 + i] = sinf(ang); }
}

__device__ __attribute__((noinline)) void p0_mod_item(LAS unsigned char* lds_, unsigned char* ws_, KArgs a, int it) {
    const MiniF F = minif(lds_, ws_);
    LAS float* sc = (LAS float*)F.lds;
    LAS float* part = sc + 9 * 1024;
    float* mod = (float*)(F.ws + WS_MOD);
#pragma unroll
    for (int it2 = 0; it2 < 18; ++it2) { const int i = F.tid + it2 * 512; const int j = i >> 10, k = i & 1023; const float c = j < 8 ? a->in[I_C][j * 1024 + k] : a->in[I_CCTX][k]; sc[i] = siluf(c); }
    __syncthreads();
    const int l = it / 96, cb = it % 96, col = F.tid & 63, kq = F.tid >> 6;
    const float* W = a->in[I_ADAW] + (size_t)l * 1024 * 6144 + cb * 64 + col;
    float acc[9];
#pragma unroll
    for (int j = 0; j < 9; ++j) acc[j] = 0.f;
#pragma unroll 1
    for (int k0 = kq * 128; k0 < kq * 128 + 128; k0 += 16) { float w[16];
#pragma unroll
        for (int q = 0; q < 16; ++q) w[q] = W[(size_t)(k0 + q) * 6144];
#pragma unroll
        for (int q = 0; q < 16; ++q)
#pragma unroll
            for (int j = 0; j < 9; ++j) acc[j] += sc[j * 1024 + k0 + q] * w[q]; }
#pragma unroll
    for (int j = 0; j < 9; ++j) part[(kq * 9 + j) * 64 + col] = acc[j];
    __syncthreads();
    for (int i = F.tid; i < 9 * 64; i += 512) { const int j = i >> 6, c2 = i & 63; float s = a->in[I_ADAB][l * 6144 + cb * 64 + c2];
#pragma unroll
        for (int q = 0; q < 8; ++q) s += part[(q * 9 + j) * 64 + c2];
        mod[((size_t)l * 9 + j) * 6144 + cb * 64 + c2] = s; }
}

__device__ __attribute__((noinline)) void p0_filter_item(LAS unsigned char* lds_, unsigned char* ws_, KArgs a, int it) {
    const MiniF F = minif(lds_, ws_);
    LAS float* z = (LAS float*)F.lds;
    LAS float* h1 = z + 32 * 36;
    LAS float* h2T = h1 + 32 * 64;
    float* fsp = (float*)(F.ws + WS_FS);
    const int set = it < 128 ? 0 : (it < 256 ? 1 : 2), tt_ = it < 256 ? (it & 127) : it - 256;
    const int l = set == 2 ? 0 : set, L = set == 2 ? 256 : 4096, t0 = tt_ * 32;
    const float* w1 = a->in[I_HFW1] + l * 33 * 64; const float* b1 = a->in[I_HFB1] + l * 64; const float* fr = a->in[I_HFFREQ] + l * 64;
    const float* w2 = a->in[I_HFW2] + l * 64 * 64; const float* b2 = a->in[I_HFB2] + l * 64; const float* w3 = a->in[I_HFW3] + (size_t)l * 64 * 1024;
    { const int tl = F.tid >> 4, f = F.tid & 15, tg = t0 + tl;
      const float fb = 1e-4f + (float)f * ((15.0f - 1e-4f) / 15.0f); const float w = 6.283185307179586f * (float)tg / (float)L;
      const float ang = fb * w; z[tl * 36 + 1 + f] = cosf(ang); z[tl * 36 + 17 + f] = -sinf(ang);
      if (f == 0) z[tl * 36] = (float)tg / (float)(L - 1); }
    __syncthreads();
    { const int tl = F.tid >> 4, j0 = (F.tid & 15) * 4; f32x4 s = *(const f32x4*)(b1 + j0);
      f32x4 wv1[33];
#pragma unroll
      for (int i = 0; i < 33; ++i) wv1[i] = *(const f32x4*)(w1 + i * 64 + j0);
#pragma unroll
      for (int i = 0; i < 33; ++i) s += wv1[i] * z[tl * 36 + i];
      const f32x4 f4 = *(const f32x4*)(fr + j0); h1[tl * 64 + j0] = sinf(f4.x * s.x); h1[tl * 64 + j0 + 1] = sinf(f4.y * s.y); h1[tl * 64 + j0 + 2] = sinf(f4.z * s.z); h1[tl * 64 + j0 + 3] = sinf(f4.w * s.w); }
    __syncthreads();
    { const int tl = F.tid >> 4, j0 = (F.tid & 15) * 4; f32x4 s = *(const f32x4*)(b2 + j0);
#pragma unroll
      for (int h = 0; h < 2; ++h) { f32x4 wv2[32];
#pragma unroll
        for (int i = 0; i < 32; ++i) wv2[i] = *(const f32x4*)(w2 + (32 * h + i) * 64 + j0);
#pragma unroll
        for (int i = 0; i < 32; ++i) s += wv2[i] * h1[tl * 64 + 32 * h + i]; }
      const f32x4 f4 = *(const f32x4*)(fr + j0); h2T[(j0) * 32 + tl] = sinf(f4.x * s.x); h2T[(j0 + 1) * 32 + tl] = sinf(f4.y * s.y); h2T[(j0 + 2) * 32 + tl] = sinf(f4.z * s.z); h2T[(j0 + 3) * 32 + tl] = sinf(f4.w * s.w); }
    __syncthreads();
    const int lc = F.lane & 15, lg = F.lane >> 4, og = F.wave >> 2, dir = (F.wave >> 1) & 1, cb = (F.wave & 1) * 128;
    bf16x8 ah[2][2], al[2][2];
#pragma unroll
    for (int tt = 0; tt < 2; ++tt)
#pragma unroll
        for (int ks = 0; ks < 2; ++ks) { float x[8];
#pragma unroll
            for (int i = 0; i < 8; ++i) x[i] = h2T[(32 * ks + 8 * lg + i) * 32 + 16 * tt + lc];
            u32x4 h, l; h.x = pk2(x[0], x[1]); h.y = pk2(x[2], x[3]); h.z = pk2(x[4], x[5]); h.w = pk2(x[6], x[7]);
            l.x = pk2(x[0] - lo_bf(h.x), x[1] - hi_bf(h.x)); l.y = pk2(x[2] - lo_bf(h.y), x[3] - hi_bf(h.y)); l.z = pk2(x[4] - lo_bf(h.z), x[5] - hi_bf(h.z)); l.w = pk2(x[6] - lo_bf(h.w), x[7] - hi_bf(h.w));
            ah[tt][ks] = __builtin_bit_cast(bf16x8, h); al[tt][ks] = __builtin_bit_cast(bf16x8, l); }
    float zt[2][4];
#pragma unroll
    for (int tt = 0; tt < 2; ++tt)
#pragma unroll
        for (int r = 0; r < 4; ++r) zt[tt][r] = z[(16 * tt + 4 * lg + r) * 36];
    const float lo = -3.0701134573253945f, hi = -15.350567286626972f;
    const float* w3c = w3 + (size_t)(8 * lg) * 1024 + 128 * F.wave + lc;
    float wn[2][8];
#pragma unroll
    for (int ks = 0; ks < 2; ++ks)
#pragma unroll
        for (int i = 0; i < 8; ++i) wn[ks][i] = w3c[(size_t)(32 * ks + i) * 1024];
#pragma unroll 1
    for (int ct = 0; ct < 8; ++ct) {
        bf16x8 bh[2], bl[2];
#pragma unroll
        for (int ks = 0; ks < 2; ++ks) { u32x4 h, l; const float* x = wn[ks];
            h.x = pk2(x[0], x[1]); h.y = pk2(x[2], x[3]); h.z = pk2(x[4], x[5]); h.w = pk2(x[6], x[7]);
            l.x = pk2(x[0] - lo_bf(h.x), x[1] - hi_bf(h.x)); l.y = pk2(x[2] - lo_bf(h.y), x[3] - hi_bf(h.y)); l.z = pk2(x[4] - lo_bf(h.z), x[5] - hi_bf(h.z)); l.w = pk2(x[6] - lo_bf(h.w), x[7] - hi_bf(h.w));
            bh[ks] = __builtin_bit_cast(bf16x8, h); bl[ks] = __builtin_bit_cast(bf16x8, l); }
        if (ct < 7) {
#pragma unroll
            for (int ks = 0; ks < 2; ++ks)
#pragma unroll
                for (int i = 0; i < 8; ++i) wn[ks][i] = w3c[(size_t)(32 * ks + i) * 1024 + 16 * (ct + 1)]; }
        f32x4 acc[2];
#pragma unroll
        for (int tt = 0; tt < 2; ++tt) { acc[tt] = (f32x4){0.f, 0.f, 0.f, 0.f};
#pragma unroll
            for (int ks = 0; ks < 2; ++ks) { acc[tt] = mfma16(al[tt][ks], bh[ks], acc[tt]); acc[tt] = mfma16(ah[tt][ks], bl[ks], acc[tt]); acc[tt] = mfma16(ah[tt][ks], bh[ks], acc[tt]); } }
        const int c = cb + 16 * ct + lc;
        const float delta = fabsf(lo + (float)c * ((hi - lo) / 255.0f));
        float as = 0.f;
#pragma unroll
        for (int tt = 0; tt < 2; ++tt)
#pragma unroll
            for (int r = 0; r < 4; ++r) { const float v = acc[tt][r] * __expf(-zt[tt][r] * delta); acc[tt][r] = v; if (dir == 0 || t0 + 16 * tt + 4 * lg + r >= 1) as += fabsf(v); }
        as += __shfl_xor(as, 16); as += __shfl_xor(as, 32);
        if (lg == 0) fsp[((size_t)set * 128 + tt_) * 1024 + 128 * F.wave + 16 * ct + lc] = as;
        if (set < 2) {
            bf16* Gc = (bf16*)(F.ws + WS_G) + ((size_t)(set * 2 + og) * 256 + c) * GLEN;
#pragma unroll
            for (int tt = 0; tt < 2; ++tt) { const int tq = t0 + 16 * tt + 4 * lg; const f32x4 v = acc[tt];
                if (dir == 0) {
                    Gc[GC - tq] = (bf16)f2bf(v[0]); *(unsigned*)(Gc + GC - tq - 2) = pk2(v[2], v[1]); Gc[GC - tq - 3] = (bf16)f2bf(v[3]);
                } else {
                    if (tq == 0) Gc[GC + 1] = (bf16)f2bf(v[1]); else *(unsigned*)(Gc + GC + tq) = pk2(v[0], v[1]);
                    *(unsigned*)(Gc + GC + tq + 2) = pk2(v[2], v[3]); } }
        } else {
            float* Tc = (float*)(F.ws + WS_TC) + (size_t)og * 256 * 512 + (size_t)c * 512;
#pragma unroll
            for (int tt = 0; tt < 2; ++tt)
#pragma unroll
                for (int r = 0; r < 4; ++r) { const int tg = t0 + 16 * tt + 4 * lg + r; if (dir == 0) Tc[256 + tg] = acc[tt][r]; else if (tg >= 1) Tc[256 - tg] = acc[tt][r]; }
        }
    }
}

constexpr int W_OFF_G = N_WIN + N_WOUT, W_OFF_U = W_OFF_G + N_G, W_OFF_D = W_OFF_U + N_U, W_HALF = N_G / 2;
constexpr int NIT_NOW = NIT_W - 3 * W_HALF, NIT_DEF = 3 * W_HALF;
__device__ __forceinline__ int w_now_index(int i) {
    if (i < W_OFF_G + W_HALF) return i; i -= W_OFF_G + W_HALF;
    if (i < W_HALF) return W_OFF_U + i; i -= W_HALF;
    if (i < W_HALF) return W_OFF_D + i; i -= W_HALF;
    return W_OFF_D + N_D + i;
}
__device__ __forceinline__ int w_def_index(int i) { return i < W_HALF ? W_OFF_G + W_HALF + i : (i < 2 * W_HALF ? W_OFF_U + W_HALF + (i - W_HALF) : W_OFF_D + W_HALF + (i - 2 * W_HALF)); }
constexpr int P0_NF = 264, P0_NM = 192, P0_NW = (NIT_NOW + 15) / 16, P0_NX = (N_MISC + 511) / 512, P0_NITEMS = P0_NF + P0_NM + P0_NW + P0_NX;
constexpr int DEF_NBLK = NIT_DEF / 8;
__device__ __forceinline__ void drain_deferred(const Frame& F, KArgs a, int quota) {
    volatile LAS int* slot = (volatile LAS int*)(F.lds + LDS_MISC + 64);
    for (int n = 0; n < quota; ++n) {
        __syncthreads();
        if (F.tid == 0) *slot = (int)atomicAdd(F.ctl + CW_DQ, 1u);
        __syncthreads();
        const int it = *slot;
        if (it >= DEF_NBLK) break;
        p0_weight_item(F.lds, F.ws, a, w_def_index(it * 8 + F.wave));
    }
    __syncthreads();
}
__device__ __forceinline__ void p0_all(const Frame& F, KArgs a, int qoff = 0) {
    volatile LAS int* slot = (volatile LAS int*)(F.lds + LDS_MISC + 64);
    for (;;) {
        __syncthreads();
        if (F.tid == 0) *slot = (int)atomicAdd(F.ctl + CW_P0Q + qoff, 1u);
        __syncthreads();
        const int it = *slot;
        if (it >= P0_NITEMS) break;
        if (it < P0_NF) p0_filter_item(F.lds, F.ws, a, it);
        else if (it < P0_NF + P0_NM) p0_mod_item(F.lds, F.ws, a, it - P0_NF);
        else if (it < P0_NF + P0_NM + P0_NW) { const int wi0 = (it - P0_NF - P0_NM) * 16 + F.wave, wi1 = wi0 + 8;
            if (wi1 < NIT_NOW) p0_weight_pair(F.lds, F.ws, a, w_now_index(wi0), w_now_index(wi1)); else if (wi0 < NIT_NOW) p0_weight_item(F.lds, F.ws, a, w_now_index(wi0)); }
        else { const int i = (it - P0_NF - P0_NM - P0_NW) * 512 + F.tid; if (i < N_MISC) p0_misc_op(F.ws, a, i); }
    }
    __syncthreads();
}
__device__ __forceinline__ void ld_x_row(const float* xrow, int lane, f32x4 (&v)[4]) {
    const f32x4* xr = (const f32x4*)xrow + lane;
#pragma unroll
    for (int j = 0; j < 4; ++j) v[j] = __builtin_nontemporal_load(xr + 64 * j);
}
__device__ __forceinline__ void norm_mod_row(const f32x4 (&v)[4], const float* g, const float* sc, const float* sh, bf16* orow, int lane) {
    float s = 0.f;
#pragma unroll
    for (int j = 0; j < 4; ++j) s += (v[j].x * v[j].x + v[j].y * v[j].y) + (v[j].z * v[j].z + v[j].w * v[j].w);
    const float rstd = frsq(wave_sum(s) * (1.f / 1024.f) + EPS);
    unsigned long long* o8 = (unsigned long long*)orow + lane;
#pragma unroll
    for (int j = 0; j < 4; ++j) { const int k = 4 * lane + 256 * j; const f32x4 gg = *(const f32x4*)(g + k), cc = *(const f32x4*)(sc + k), hh = *(const f32x4*)(sh + k);
        const f32x4 y = v[j] * rstd * gg * (cc + 1.f) + hh;
        o8[64 * j] = (unsigned long long)pk2(y.x, y.y) | ((unsigned long long)pk2(y.z, y.w) << 32); }
}
__device__ __forceinline__ void p1_norm(const Frame& F, KArgs a, int layer, const float* xlat, const float* xctx) {
    const float* mod = (const float*)(F.ws + WS_MOD) + (size_t)layer * 9 * 6144; const float* g = a->in[I_N1G] + layer * 1024; bf16* H = (bf16*)(F.ws + WS_H);
    int r = F.gw; f32x4 nv[4];
    if (r < NTOK) ld_x_row(r < NLAT ? xlat + (size_t)r * 1024 : xctx + (size_t)(r - NLAT) * 1024, F.lane, nv);
    for (; r < NTOK; r += F.NGW) {
        f32x4 v[4];
#pragma unroll
        for (int j = 0; j < 4; ++j) v[j] = nv[j];
        const int rn = r + F.NGW; if (rn < NTOK) ld_x_row(rn < NLAT ? xlat + (size_t)rn * 1024 : xctx + (size_t)(rn - NLAT) * 1024, F.lane, nv);
        const float* m = mod + (size_t)mod_idx(r) * 6144;
        norm_mod_row(v, g, m + 1024, m, H + (size_t)r * 1024, F.lane);
    }
}

constexpr int P7_WROW = 1040, P7_PLANE = 16 * P7_WROW * 2, P7_IMG = 2 * P7_PLANE + 2 * 4096, P7_MISC = 2 * P7_IMG;
static_assert(P7_MISC + 512 + 3 * 2048 + 256 + 512 <= LDS_MISC, "P7 LDS map");
__device__ __forceinline__ void p7_router(const Frame& F, KArgs a, int layer, const bf16* xb, int nrows, bool dry = false) {
    const float* mod = (const float*)(F.ws + WS_MOD) + (size_t)layer * 9 * 6144; const float* g = a->in[I_N2G] + layer * 1024; bf16* H = (bf16*)(F.ws + WS_H);
    LAS unsigned char* L = F.lds;
    LAS float* cvec = (LAS float*)(L + P7_MISC);
    LAS float* cred = cvec + 32;
    LAS int* rb = (LAS int*)(L + P7_MISC + 1024);
    LAS float* rlo = (LAS float*)(L + P7_MISC + 1024 + 2048);
    LAS float* rhi = (LAS float*)(L + P7_MISC + 1024 + 4096);
    LAS int* bcnt = (LAS int*)(L + P7_MISC + 1024 + 6144);
    const int ntl = nrows >> 4, tb = ntl / F.G, trem = ntl % F.G;
    const int cnt = tb + (F.vcu < trem ? 1 : 0), ts = F.vcu * tb + (F.vcu < trem ? F.vcu : trem);
    const int r0 = ts * 16, r1 = r0 + cnt * 16;
    const int mi0 = mod_idx(r0), mi1 = mod_idx(r1 - 1);
    const int lc = F.lane & 15, lg = F.lane >> 4;
    __syncthreads();
    if (F.tid < 64) bcnt[F.tid] = 0;
    for (int im = 0; im < (mi1 != mi0 ? 2 : 1); ++im) {
        const float* m = mod + (size_t)(im ? mi1 : mi0) * 6144; LAS unsigned char* I = L + im * P7_IMG;
        const int k = 2 * F.tid;
        const float G0 = g[k] * (1.f + m[4 * 1024 + k]), G1 = g[k + 1] * (1.f + m[4 * 1024 + k + 1]), s0 = m[3 * 1024 + k], s1 = m[3 * 1024 + k + 1];
        ((LAS float*)(I + 2 * P7_PLANE))[k] = G0; ((LAS float*)(I + 2 * P7_PLANE))[k + 1] = G1; ((LAS float*)(I + 2 * P7_PLANE + 4096))[k] = s0; ((LAS float*)(I + 2 * P7_PLANE + 4096))[k + 1] = s1;
        const f32x4* wp = (const f32x4*)(a->in[I_WROUTER] + (size_t)k * 16);
        float cp[16];
#pragma unroll
        for (int e4 = 0; e4 < 4; ++e4) { const f32x4 wa = wp[e4], wb = wp[4 + e4];
#pragma unroll
            for (int i = 0; i < 4; ++i) { const int e = 4 * e4 + i; const float a0 = G0 * wa[i], a1 = G1 * wb[i];
                const unsigned h = pk2(a0, a1); const unsigned l = pk2(a0 - lo_bf(h), a1 - hi_bf(h));
                *(LAS unsigned*)(I + e * (P7_WROW * 2) + k * 2) = h; *(LAS unsigned*)(I + P7_PLANE + e * (P7_WROW * 2) + k * 2) = l;
                cp[e] = s0 * wa[i] + s1 * wb[i]; } }
#pragma unroll
        for (int s = 0; s < 4; ++s) { const int width = 8 >> s; const bool up = (F.lane >> s) & 1;
#pragma unroll
            for (int i = 0; i < width; ++i) { const float send = up ? cp[i] : cp[i + width], keep = up ? cp[i + width] : cp[i]; cp[i] = keep + __shfl_xor(send, 1 << s); } }
        float tot = cp[0]; tot += __shfl_xor(tot, 16); tot += __shfl_xor(tot, 32);
        if (F.lane < 16) cred[F.wave * 16 + (((F.lane & 1) << 3) | ((F.lane & 2) << 1) | ((F.lane & 4) >> 1) | ((F.lane & 8) >> 3))] = tot;
        __syncthreads();
        if (F.tid < 16) { float c = 0.f;
#pragma unroll
            for (int w = 0; w < 8; ++w) c += cred[w * 16 + F.tid];
            cvec[im * 16 + F.tid] = c; }
        __syncthreads();
    }
    const float rbias0 = a->in[I_RBIAS][4 * lg], rbias1 = a->in[I_RBIAS][4 * lg + 1], rbias2 = a->in[I_RBIAS][4 * lg + 2], rbias3 = a->in[I_RBIAS][4 * lg + 3];
#pragma unroll 1
    for (int t = ts + F.wave; t < ts + cnt; t += 8) {
        const int row = t * 16 + lc; const int im = mod_idx(t * 16) != mi0 ? 1 : 0;
        const LAS unsigned char* I = L + im * P7_IMG;
        const bf16* xr = xb + (size_t)row * 1024 + lg * 8;
        bf16x8 af[32];
#pragma unroll
        for (int ks = 0; ks < 32; ++ks) af[ks] = *(const bf16x8*)(xr + ks * 32);
        f32x4 aS = (f32x4){0.f, 0.f, 0.f, 0.f}, aH = aS, aL = aS;
        const LAS unsigned char* Iw = I + lc * (P7_WROW * 2) + lg * 16;
#pragma unroll
        for (int ks = 0; ks < 32; ++ks) { const bf16x8 wh = *(const LAS bf16x8*)(Iw + ks * 64), wl = *(const LAS bf16x8*)(Iw + P7_PLANE + ks * 64);
            aH = mfma16(wh, af[ks], aH); aL = mfma16(wl, af[ks], aL); aS = mfma16(af[ks], af[ks], aS); }
        const float dsel = (lc & 2) ? ((lc & 1) ? aS[3] : aS[2]) : ((lc & 1) ? aS[1] : aS[0]);
        const float rstd = frsq(__shfl(dsel, lc + 16 * (lc >> 2)) * (1.f / 1024.f) + EPS);
        {
            const f32x4 cv = *(const LAS f32x4*)(cvec + im * 16 + 4 * lg);
            const float s0 = sigmf(rstd * (aH[0] + aL[0]) + cv[0]), s1 = sigmf(rstd * (aH[1] + aL[1]) + cv[1]), s2 = sigmf(rstd * (aH[2] + aL[2]) + cv[2]), s3 = sigmf(rstd * (aH[3] + aL[3]) + cv[3]);
            const float e0 = s0 + rbias0, e1 = s1 + rbias1, e2 = s2 + rbias2, e3 = s3 + rbias3;
            int i1 = 0, i2 = 0; float m1 = -1e30f, m2 = -1e30f, w1 = 0.f, w2 = 0.f;
            { const float ee[4] = {e0, e1, e2, e3}; const float ss[4] = {s0, s1, s2, s3};
#pragma unroll
              for (int q = 0; q < 4; ++q) { const float x = ee[q]; if (x > m1) { m2 = m1; i2 = i1; w2 = w1; m1 = x; i1 = q; w1 = ss[q]; } else if (x > m2) { m2 = x; i2 = q; w2 = ss[q]; } } }
            const float gs = m1 + m2;
            const float g0 = __shfl(gs, lc), g1 = __shfl(gs, lc + 16), g2 = __shfl(gs, lc + 32), g3 = __shfl(gs, lc + 48);
            int best = 0; float bs = g0; if (g1 > bs) { bs = g1; best = 1; } if (g2 > bs) { bs = g2; best = 2; } if (g3 > bs) { bs = g3; best = 3; }
            if (lg == best) {
                const float inv = 1.f / (w1 + w2); const float a1 = w1 * inv, a2 = w2 * inv;
                const int lo = i1 < i2 ? i1 : i2, hi = i1 < i2 ? i2 : i1; const float wl = i1 < i2 ? a1 : a2, wh = i1 < i2 ? a2 : a1;
                const int pp = lo == 0 ? hi - 1 : (lo == 1 ? hi + 1 : 5);
                const int lr = row - r0; rb[lr] = best * 6 + pp; rlo[lr] = wl; rhi[lr] = wh;
            }
        }
        const LAS float* Gs = (const LAS float*)(I + 2 * P7_PLANE) + lg * 8; bf16* hr = H + (size_t)row * 1024 + lg * 8;
#pragma unroll
        for (int ks = 0; ks < 32; ++ks) { const u32x4 w = __builtin_bit_cast(u32x4, af[ks]);
            const f32x4 ga = *(const LAS f32x4*)(Gs + ks * 32), gb = *(const LAS f32x4*)(Gs + ks * 32 + 4), ha = *(const LAS f32x4*)(Gs + 1024 + ks * 32), hb = *(const LAS f32x4*)(Gs + 1024 + ks * 32 + 4);
            u32x4 o; o.x = pk2(lo_bf(w.x) * rstd * ga.x + ha.x, hi_bf(w.x) * rstd * ga.y + ha.y); o.y = pk2(lo_bf(w.y) * rstd * ga.z + ha.z, hi_bf(w.y) * rstd * ga.w + ha.w);
            o.z = pk2(lo_bf(w.z) * rstd * gb.x + hb.x, hi_bf(w.z) * rstd * gb.y + hb.y); o.w = pk2(lo_bf(w.w) * rstd * gb.z + hb.z, hi_bf(w.w) * rstd * gb.w + hb.w);
            *(u32x4*)(hr + ks * 32) = o; }
    }
    __syncthreads();
    const int n = dry ? 0 : r1 - r0;
    int myslot = -1, myb = 0;
    if (F.tid < n) { myb = rb[F.tid]; myslot = atomicAdd((int*)&bcnt[myb], 1); }
    __syncthreads();
    if (F.tid < NBUCKET && !dry) { const int c = bcnt[F.tid]; bcnt[32 + F.tid] = c > 0 ? (int)atomicAdd(F.ctl + CW_CNT + layer * 32 + F.tid, (unsigned)c) : 0; }
    __syncthreads();
    if (F.tid < n) { const size_t p = (size_t)myb * NTOK + bcnt[32 + myb] + myslot;
        ((int*)(F.ws + WS_TOK))[p] = r0 + F.tid; ((float*)(F.ws + WS_WLO))[p] = rlo[F.tid]; ((float*)(F.ws + WS_WHI))[p] = rhi[F.tid];
        ((int*)(F.ws + WS_POS))[r0 + F.tid] = (myb << 24) | (bcnt[32 + myb] + myslot); }
    __syncthreads();
}

__device__ __forceinline__ void build_moe_tab(const Frame& F, LAS int* tab, int layer) {
    __syncthreads();
    if (F.tid < NBUCKET) tab[32 + F.tid] = (int)__hip_atomic_load(F.ctl + CW_CNT + layer * 32 + F.tid, __ATOMIC_RELAXED, __HIP_MEMORY_SCOPE_AGENT);
    __syncthreads();
    if (F.tid == 0) { int acc = 0; for (int k = 0; k < NBUCKET; ++k) { tab[k] = acc; acc += (tab[32 + k] + 255) >> 8; } tab[NBUCKET] = acc; }
    __syncthreads();
}
__device__ __forceinline__ void moe_ld_row(const Frame& F, const LAS int* tab, const bf16* xrow, int pos, u32x2 (&xw)[4], u32x2 (&yw)[4]) {
    const int k = pos >> 24, slot = pos & 0xffffff; const bf16* yr = (const bf16*)(F.ws + WS_YM) + ((size_t)tab[k] * 256 + slot) * 1024;
#pragma unroll
    for (int j = 0; j < 4; ++j) { xw[j] = *(const u32x2*)(xrow + 4 * F.lane + 256 * j); yw[j] = *(const u32x2*)(yr + 4 * F.lane + 256 * j); }
}
__device__ __forceinline__ float moe_add_row(const Frame& F, const u32x2 (&xw)[4], const u32x2 (&yw)[4], const float* g2, f32x4 (&v)[4]) {
    float s = 0.f;
#pragma unroll
    for (int j = 0; j < 4; ++j) { const f32x4 gg = *(const f32x4*)(g2 + 4 * F.lane + 256 * j);
        f32x4 y; y.x = lo_bf(yw[j].x); y.y = hi_bf(yw[j].x); y.z = lo_bf(yw[j].y); y.w = hi_bf(yw[j].y);
        const f32x4 xv = (f32x4){lo_bf(xw[j].x), hi_bf(xw[j].x), lo_bf(xw[j].y), hi_bf(xw[j].y)};
        v[j] = xv + gg * y; s += (v[j].x * v[j].x + v[j].y * v[j].y) + (v[j].z * v[j].z + v[j].w * v[j].w); }
    return s;
}
__device__ __forceinline__ void p1_norm_moe(const Frame& F, KArgs a, bf16* xb) {
    LAS int* tab = (LAS int*)(F.lds + 131072 + 4096);
    build_moe_tab(F, tab, 0);
    const float* mod0 = (const float*)(F.ws + WS_MOD); const float* mod1 = mod0 + (size_t)9 * 6144; const float* g = a->in[I_N1G] + 1024; bf16* H = (bf16*)(F.ws + WS_H);
    const int* POS = (const int*)(F.ws + WS_POS);
    int r = F.gw; u32x2 nx[4], ny[4];
    if (r < NTOK) moe_ld_row(F, tab, xb + (size_t)r * 1024, POS[r], nx, ny);
    int posn = r + F.NGW < NTOK ? POS[r + F.NGW] : 0;
    for (; r < NTOK; r += F.NGW) {
        bf16* xr = xb + (size_t)r * 1024; const int mi = mod_idx(r);
        u32x2 cx[4], cy[4];
#pragma unroll
        for (int j = 0; j < 4; ++j) { cx[j] = nx[j]; cy[j] = ny[j]; }
        { const int rn = r + F.NGW; if (rn < NTOK) moe_ld_row(F, tab, xb + (size_t)rn * 1024, posn, nx, ny); posn = rn + F.NGW < NTOK ? POS[rn + F.NGW] : 0; }
        f32x4 v[4]; const float s = moe_add_row(F, cx, cy, mod0 + (size_t)mi * 6144 + 5 * 1024, v);
        const float rstd = frsq(wave_sum(s) * (1.f / 1024.f) + EPS);
        const float* m = mod1 + (size_t)mi * 6144; unsigned long long* xo = (unsigned long long*)xr + F.lane; unsigned long long* o8 = (unsigned long long*)(H + (size_t)r * 1024) + F.lane;
#pragma unroll
        for (int j = 0; j < 4; ++j) { const int k = 4 * F.lane + 256 * j; xo[64 * j] = (unsigned long long)pk2(v[j].x, v[j].y) | ((unsigned long long)pk2(v[j].z, v[j].w) << 32);
            const f32x4 gg = *(const f32x4*)(g + k), cc = *(const f32x4*)(m + 1024 + k), hh = *(const f32x4*)(m + k); const f32x4 y = v[j] * rstd * gg * (cc + 1.f) + hh;
            o8[64 * j] = (unsigned long long)pk2(y.x, y.y) | ((unsigned long long)pk2(y.z, y.w) << 32); }
    }
}

__device__ __forceinline__ void p_final(const Frame& F, KArgs a) {
    const float* g = a->in[I_FNG];
    LAS int* tab = (LAS int*)(F.lds + 131072 + 4096);
    build_moe_tab(F, tab, 1);
    const float* mod1 = (const float*)(F.ws + WS_MOD) + (size_t)9 * 6144; const int* POS = (const int*)(F.ws + WS_POS);
    const bf16* xb = (const bf16*)(F.ws + WS_XB);
    f32x4 gfin[4];
#pragma unroll
    for (int j = 0; j < 4; ++j) gfin[j] = *(const f32x4*)(g + 4 * F.lane + 256 * j);
    int r = F.gw; u32x2 nx[4], ny[4];
    if (r < NLAT) moe_ld_row(F, tab, xb + (size_t)r * 1024, POS[r], nx, ny);
    int posn = r + F.NGW < NLAT ? POS[r + F.NGW] : 0;
    for (; r < NLAT; r += F.NGW) {
        f32x4* xr = (f32x4*)(a->out + (size_t)r * 1024) + F.lane;
        u32x2 cx[4], cy[4];
#pragma unroll
        for (int j = 0; j < 4; ++j) { cx[j] = nx[j]; cy[j] = ny[j]; }
        { const int rn = r + F.NGW; if (rn < NLAT) moe_ld_row(F, tab, xb + (size_t)rn * 1024, posn, nx, ny); posn = rn + F.NGW < NLAT ? POS[rn + F.NGW] : 0; }
        f32x4 v[4]; const float s = moe_add_row(F, cx, cy, mod1 + (size_t)(r >> 12) * 6144 + 5 * 1024, v);
        const float rstd = frsq(wave_sum(s) * (1.f / 1024.f) + EPS);
#pragma unroll
        for (int j = 0; j < 4; ++j) __builtin_nontemporal_store(v[j] * rstd * gfin[j], xr + 64 * j);
    }
}
__device__ __forceinline__ void row_bk(int r, int& b, int& key, bool& lat) { lat = r < NLAT; if (lat) { b = r >> 12; key = r & 4095; } else { const int rc = r - NLAT; b = rc >> 8; key = 4096 + (rc & 255); } }

constexpr int MLA_QROW = 400, MLA_KVROW = 272, MLA_QB = 96 * MLA_QROW;
__device__ __forceinline__ float sumsq8(bf16x8 v) { const u32x4 w = __builtin_bit_cast(u32x4, v); float s = 0.f;
    { const float a = lo_bf(w.x), b = hi_bf(w.x), c = lo_bf(w.y), d = hi_bf(w.y), e = lo_bf(w.z), f = hi_bf(w.z), g = lo_bf(w.w), h = hi_bf(w.w); s = (a * a + b * b) + (c * c + d * d) + ((e * e + f * f) + (g * g + h * h)); } return s; }
template <int LAYER>
__device__ __forceinline__ void p3_mla_stream(const Frame& F_, KArgs a) {
    Frame F = F_; { int t_ = F_.tid; asm volatile("" : "+v"(t_)); F.tid = t_; F.lane = t_ & 63; }
    LAS unsigned char* L = F.lds;
    const int h = F.vcu & 3, lr = F.lane & 15, lq = F.lane >> 4;
    const bf16* proj = (const bf16*)(F.ws + WS_PROJ);
    __syncthreads();
    {
        const bf16* Wq = (const bf16*)(F.ws + WS_WUQ) + ((size_t)LAYER * 384 + h * 96) * 192; const bf16* Wkv = (const bf16*)(F.ws + WS_WUKV) + ((size_t)LAYER * 512 + h * 128) * 128;
#pragma unroll
        for (int it = 0; it < (96 * 24 + 511) / 512; ++it) { const int i = F.tid + it * 512; if (i >= 96 * 24) break; const int n = i / 24, c = i % 24; *(LAS u32x4*)(L + n * MLA_QROW + c * 16) = *(const u32x4*)(Wq + n * 192 + c * 8); }
#pragma unroll
        for (int it = 0; it < 4; ++it) { const int i = F.tid + it * 512; const int n = i >> 4, c = i & 15; *(LAS u32x4*)(L + MLA_QB + n * MLA_KVROW + c * 16) = *(const u32x4*)(Wkv + n * 128 + c * 8); }
    }
    __syncthreads();
    const float* ropec = (const float*)(F.ws + WS_ROPE); const float* ropes = ropec + 4096 * 16;
    const int nblk4 = F.G >> 2;
    bf16x8 aq[6], akv[4], ar, nq[6], nkv[4], nr;
    { const int ch0 = F.vcu >> 2; if (ch0 < NTOK / 128) { const bf16* prow = proj + (size_t)(ch0 * 128 + F.wave * 16 + lr) * PROJ_LD;
#pragma unroll
        for (int ks = 0; ks < 6; ++ks) aq[ks] = *(const bf16x8*)(prow + PJ_MQ + ks * 32 + lq * 8);
#pragma unroll
        for (int ks = 0; ks < 4; ++ks) akv[ks] = *(const bf16x8*)(prow + PJ_MKV + ks * 32 + lq * 8);
        ar = *(const bf16x8*)(prow + PJ_MKV + 128 + lq * 8); } }
#pragma unroll 1
    for (int ch = F.vcu >> 2; ch < NTOK / 128; ch += nblk4) {
        const int rw = ch * 128 + F.wave * 16;
        int lo_ = lr * 1; asm volatile("" : "+v"(lo_));
        const LAS unsigned char* Lq = L + lo_ * MLA_QROW + lq * 16; const LAS unsigned char* Lk = L + MLA_QB + lo_ * MLA_KVROW + lq * 16;
        int b0, key0; bool lat; row_bk(rw, b0, key0, lat);
        const bool want_q = (LAYER == 0) || lat;
        { const int chn = ch + nblk4; if (chn < NTOK / 128) { const bf16* prow = proj + (size_t)(chn * 128 + F.wave * 16 + lr) * PROJ_LD;
#pragma unroll
            for (int ks = 0; ks < 6; ++ks) nq[ks] = *(const bf16x8*)(prow + PJ_MQ + ks * 32 + lq * 8);
#pragma unroll
            for (int ks = 0; ks < 4; ++ks) nkv[ks] = *(const bf16x8*)(prow + PJ_MKV + ks * 32 + lq * 8);
            nr = *(const bf16x8*)(prow + PJ_MKV + 128 + lq * 8); } }
        float sq = 0.f, sk = 0.f;
#pragma unroll
        for (int ks = 0; ks < 6; ++ks) sq += sumsq8(aq[ks]);
#pragma unroll
        for (int ks = 0; ks < 4; ++ks) sk += sumsq8(akv[ks]);
        sq += __shfl_xor(sq, 16); sq += __shfl_xor(sq, 32); sk += __shfl_xor(sk, 16); sk += __shfl_xor(sk, 32);
        const float rq = QSCALE * frsq(sq * (1.f / 192.f) + EPS), rk = frsq(sk * (1.f / 128.f) + EPS);
        if (want_q) {
            f32x4 acc[6];
#pragma unroll
            for (int nt = 0; nt < 6; ++nt) acc[nt] = (f32x4){0.f, 0.f, 0.f, 0.f};
#pragma unroll
            for (int ks = 0; ks < 6; ++ks)
#pragma unroll
                for (int nt = 0; nt < 6; ++nt) acc[nt] = mfma16(*(const LAS bf16x8*)(Lq + nt * 16 * MLA_QROW + ks * 64), aq[ks], acc[nt]);
            if (lat) {
#pragma unroll
                for (int j = 0; j < 4; ++j) { const float cs = ropec[(key0 + lr) * 16 + lq * 4 + j], sn = ropes[(key0 + lr) * 16 + lq * 4 + j]; const float x1 = acc[4][j], x2 = acc[5][j];
                    acc[4][j] = x1 * cs - x2 * sn; acc[5][j] = x1 * sn + x2 * cs; } }
            bf16* Q = (bf16*)(F.ws + WS_Q) + (size_t)(rw + lr) * 384 + h * 96 + lq * 4;
#pragma unroll
            for (int nt = 0; nt < 6; ++nt) { u32x2 w; w.x = pk2(acc[nt][0] * rq, acc[nt][1] * rq); w.y = pk2(acc[nt][2] * rq, acc[nt][3] * rq); *(u32x2*)(Q + nt * 16) = w; }
        }
        {
            f32x4 ak[4], av[4];
#pragma unroll
            for (int nt = 0; nt < 4; ++nt) { ak[nt] = (f32x4){0.f, 0.f, 0.f, 0.f}; av[nt] = (f32x4){0.f, 0.f, 0.f, 0.f}; }
#pragma unroll
            for (int ks = 0; ks < 4; ++ks)
#pragma unroll
                for (int nt = 0; nt < 4; ++nt) {
                    ak[nt] = mfma16(*(const LAS bf16x8*)(Lk + nt * 16 * MLA_KVROW + ks * 64), akv[ks], ak[nt]);
                    av[nt] = mfma16(akv[ks], *(const LAS bf16x8*)(Lk + (64 + nt * 16) * MLA_KVROW + ks * 64), av[nt]); }
            bf16* Kg = (bf16*)(F.ws + WS_K) + ((size_t)(b0 * 4 + h) * NKEY + key0 + lr) * 96;
            bf16* Vt = (bf16*)(F.ws + WS_VT) + (size_t)(b0 * 4 + h) * 64 * NKEY;
            const int vcol = MK_AT16 ? ((key0 & ~31) + 8 * lq + ((key0 >> 2) & 4)) : (key0 + lq * 4);
            const float r0v = __shfl(rk, 4 * lq), r1v = __shfl(rk, 4 * lq + 1), r2v = __shfl(rk, 4 * lq + 2), r3v = __shfl(rk, 4 * lq + 3);
#pragma unroll
            for (int nt = 0; nt < 4; ++nt) {
                u32x2 w; w.x = pk2(ak[nt][0] * rk, ak[nt][1] * rk); w.y = pk2(ak[nt][2] * rk, ak[nt][3] * rk); *(u32x2*)(Kg + nt * 16 + lq * 4) = w;
                u32x2 v; v.x = pk2(av[nt][0] * r0v, av[nt][1] * r1v); v.y = pk2(av[nt][2] * r2v, av[nt][3] * r3v); *(u32x2*)(Vt + (size_t)(nt * 16 + lr) * NKEY + vcol) = v; }
            const u32x4 mine = __builtin_bit_cast(u32x4, ar); u32x4 oth; oth.x = __shfl_xor(mine.x, 32); oth.y = __shfl_xor(mine.y, 32); oth.z = __shfl_xor(mine.z, 32); oth.w = __shfl_xor(mine.w, 32);
            const bool second = lq >= 2; const int j0 = (lq & 1) * 8;
            float xm[8], xo[8];
            xm[0] = lo_bf(mine.x); xm[1] = hi_bf(mine.x); xm[2] = lo_bf(mine.y); xm[3] = hi_bf(mine.y); xm[4] = lo_bf(mine.z); xm[5] = hi_bf(mine.z); xm[6] = lo_bf(mine.w); xm[7] = hi_bf(mine.w);
            xo[0] = lo_bf(oth.x); xo[1] = hi_bf(oth.x); xo[2] = lo_bf(oth.y); xo[3] = hi_bf(oth.y); xo[4] = lo_bf(oth.z); xo[5] = hi_bf(oth.z); xo[6] = lo_bf(oth.w); xo[7] = hi_bf(oth.w);
            float o[8];
#pragma unroll
            for (int j = 0; j < 8; ++j) { float cs = 1.f, sn = 0.f; if (lat) { cs = ropec[(key0 + lr) * 16 + j0 + j]; sn = ropes[(key0 + lr) * 16 + j0 + j]; }
                o[j] = second ? (xo[j] * sn + xm[j] * cs) : (xm[j] * cs - xo[j] * sn); }
            u32x4 w; w.x = pk2(o[0], o[1]); w.y = pk2(o[2], o[3]); w.z = pk2(o[4], o[5]); w.w = pk2(o[6], o[7]);
            *(u32x4*)(Kg + 64 + lq * 8) = w;
        }
#pragma unroll
        for (int ks = 0; ks < 6; ++ks) aq[ks] = nq[ks];
#pragma unroll
        for (int ks = 0; ks < 4; ++ks) akv[ks] = nkv[ks];
        ar = nr;
    }
    __syncthreads();
}

__device__ __forceinline__ void p3_conv_unit(const Frame& F_, KArgs a, int layer, int r0) {
    Frame F = F_; { int t_ = F_.tid; asm volatile("" : "+v"(t_)); F.tid = t_; F.lane = t_ & 63; }
    LAS float* U = (LAS float*)F.lds;
    const bf16* proj = (const bf16*)(F.ws + WS_PROJ);
    const bool lat = r0 < NLAT; const int Ls = lat ? SEQ : CTXL; const int t0 = lat ? (r0 & 4095) : ((r0 - NLAT) & 255);
    __syncthreads();
    u32x4 cwa[6], cwb[6];
#pragma unroll
    for (int it = 0; it < 6; ++it) { const int i = F.tid + it * 512; const int rr = i >> 5, c8 = i & 31; const int t = t0 - 15 + rr;
        if (i < 94 * 32 && t >= 0 && t < Ls) { const bf16* p = proj + (size_t)(r0 - 15 + rr) * PROJ_LD + PJ_CV + c8 * 8; cwa[it] = *(const u32x4*)p; cwb[it] = *(const u32x4*)(p + 256); } }
#pragma unroll
    for (int it = 0; it < 6; ++it) { const int i = F.tid + it * 512; if (i >= 94 * 32) break; const int rr = i >> 5, c8 = i & 31; const int t = t0 - 15 + rr; LAS float* d = U + rr * 256 + c8 * 8;
        if (t >= 0 && t < Ls) { const u32x4 wa = cwa[it], wb = cwb[it];
            d[0] = lo_bf(wa.x) * sigmf(lo_bf(wb.x)); d[1] = hi_bf(wa.x) * sigmf(hi_bf(wb.x)); d[2] = lo_bf(wa.y) * sigmf(lo_bf(wb.y)); d[3] = hi_bf(wa.y) * sigmf(hi_bf(wb.y));
            d[4] = lo_bf(wa.z) * sigmf(lo_bf(wb.z)); d[5] = hi_bf(wa.z) * sigmf(hi_bf(wb.z)); d[6] = lo_bf(wa.w) * sigmf(lo_bf(wb.w)); d[7] = hi_bf(wa.w) * sigmf(hi_bf(wb.w)); }
        else {
#pragma unroll
            for (int j = 0; j < 8; ++j) d[j] = 0.f; } }
    __syncthreads();
    const int c = F.tid & 255, th = F.tid >> 8;
    float o[32];
    {
        const float* w = a->in[I_CVW] + (size_t)layer * 31 * 256 + c; const float bias = a->in[I_CVB][layer * 256 + c];
        float wk[31];
#pragma unroll
        for (int k = 0; k < 31; ++k) wk[k] = w[k * 256];
#pragma unroll
        for (int t = 0; t < 32; ++t) o[t] = bias;
#pragma unroll
        for (int i = 0; i < 62; ++i) { const float v = U[(th * 32 + i) * 256 + c];
#pragma unroll
            for (int t = 0; t < 32; ++t) { if (i - t >= 0 && i - t < 31) o[t] += v * wk[i - t]; } }
    }
    __syncthreads();
#pragma unroll
    for (int t = 0; t < 32; ++t) U[(th * 32 + t) * 256 + c] = o[t];
    __syncthreads();
    const float* lg = a->in[I_CVLNG] + layer * 256; const float* lb = a->in[I_CVLNB] + layer * 256; const float* mg = a->in[I_MIXG] + layer * 1024 + 512;
    bf16* Y = (bf16*)(F.ws + WS_H);
    const f32x4 gg = *(const f32x4*)(lg + 4 * F.lane), bb = *(const f32x4*)(lb + 4 * F.lane), m4 = *(const f32x4*)(mg + 4 * F.lane);
    f32x4 v[8]; float s[8];
#pragma unroll
    for (int i = 0; i < 8; ++i) { v[i] = *(const LAS f32x4*)(U + (F.wave + 8 * i) * 256 + 4 * F.lane); s[i] = (v[i].x + v[i].y) + (v[i].z + v[i].w); }
#pragma unroll
    for (int o2 = 1; o2 < 16; o2 <<= 1) {
#pragma unroll
        for (int i = 0; i < 8; ++i) s[i] = xsum_step(s[i], o2); }
#pragma unroll
    for (int i = 0; i < 8; ++i) { v[i] = v[i] - s[i] * (1.f / 64.f); s[i] = (v[i].x * v[i].x + v[i].y * v[i].y) + (v[i].z * v[i].z + v[i].w * v[i].w); }
#pragma unroll
    for (int o2 = 1; o2 < 16; o2 <<= 1) {
#pragma unroll
        for (int i = 0; i < 8; ++i) s[i] = xsum_step(s[i], o2); }
#pragma unroll
    for (int i = 0; i < 8; ++i) { const float rstd = frsq(s[i] * (1.f / 64.f) + EPS); f32x4 y = v[i] * rstd * gg + bb; y.x = siluf(y.x); y.y = siluf(y.y); y.z = siluf(y.z); y.w = siluf(y.w);
        v[i] = y; s[i] = (y.x * y.x + y.y * y.y) + (y.z * y.z + y.w * y.w); }
#pragma unroll
    for (int o2 = 1; o2 < 64; o2 <<= 1) {
#pragma unroll
        for (int i = 0; i < 8; ++i) s[i] = xsum_step(s[i], o2); }
#pragma unroll
    for (int i = 0; i < 8; ++i) { const float rn = frsq(s[i] * (1.f / 256.f) + EPS); const f32x4 y = v[i] * rn * m4;
        u32x2 w; w.x = pk2(y.x, y.y); w.y = pk2(y.z, y.w); *(u32x2*)(Y + (size_t)(r0 + F.wave + 8 * i) * 1024 + 512 + 4 * F.lane) = w; }
}

__device__ __forceinline__ void p3_gmlp_unit(const Frame& F_, KArgs a, int layer, int r0) {
    Frame F = F_; { int t_ = F_.tid; asm volatile("" : "+v"(t_)); F.tid = t_; F.lane = t_ & 63; }
    LAS bf16* vT = (LAS bf16*)F.lds;
    LAS float* red = (LAS float*)(F.lds + 69632);
    const bf16* proj = (const bf16*)(F.ws + WS_PROJ);
    const float* lg = a->in[I_GMLNG] + layer * 256; const float* lb = a->in[I_GMLNB] + layer * 256;
    __syncthreads();
    u32x2 gw[16];
#pragma unroll
    for (int it = 0; it < 16; ++it) gw[it] = *(const u32x2*)(proj + (size_t)(r0 + F.wave * 16 + it) * PROJ_LD + PJ_GM + 256 + 4 * F.lane);
    {
        f32x4 vv[16]; float sm[16];
#pragma unroll
        for (int it = 0; it < 16; ++it) { const u32x2 w = gw[it]; vv[it].x = gelu_tanh(lo_bf(w.x)); vv[it].y = gelu_tanh(hi_bf(w.x)); vv[it].z = gelu_tanh(lo_bf(w.y)); vv[it].w = gelu_tanh(hi_bf(w.y));
            sm[it] = (vv[it].x + vv[it].y) + (vv[it].z + vv[it].w); }
#pragma unroll
        for (int o2 = 1; o2 < 64; o2 <<= 1) {
#pragma unroll
            for (int it = 0; it < 16; ++it) sm[it] = xsum_step(sm[it], o2); }
#pragma unroll
        for (int it = 0; it < 16; ++it) { vv[it] = vv[it] - sm[it] * (1.f / 256.f); sm[it] = (vv[it].x * vv[it].x + vv[it].y * vv[it].y) + (vv[it].z * vv[it].z + vv[it].w * vv[it].w); }
#pragma unroll
        for (int o2 = 1; o2 < 64; o2 <<= 1) {
#pragma unroll
            for (int it = 0; it < 16; ++it) sm[it] = xsum_step(sm[it], o2); }
        const f32x4 gg = *(const f32x4*)(lg + 4 * F.lane), bb = *(const f32x4*)(lb + 4 * F.lane);
#pragma unroll
        for (int it = 0; it < 16; ++it) { const float rstd = frsq(sm[it] * (1.f / 256.f) + EPS); vv[it] = vv[it] * rstd * gg + bb; }
#pragma unroll
        for (int i = 0; i < 4; ++i) { u32x4 w0, w1;
            w0.x = pk2(vv[0][i], vv[1][i]); w0.y = pk2(vv[2][i], vv[3][i]); w0.z = pk2(vv[4][i], vv[5][i]); w0.w = pk2(vv[6][i], vv[7][i]);
            w1.x = pk2(vv[8][i], vv[9][i]); w1.y = pk2(vv[10][i], vv[11][i]); w1.z = pk2(vv[12][i], vv[13][i]); w1.w = pk2(vv[14][i], vv[15][i]);
            LAS bf16* d = vT + (4 * F.lane + i) * 136 + F.wave * 16; *(LAS u32x4*)d = w0; *(LAS u32x4*)(d + 8) = w1; }
    }
    __syncthreads();
    const int g = F.wave >> 1, ih = F.wave & 1, lr = F.lane & 15, lq = F.lane >> 4;
    const bf16* W = (const bf16*)(F.ws + WS_GMWS) + (size_t)(layer * 4 + g) * 128 * 128;
    u32x2 uw[4][4];
#pragma unroll
    for (int it = 0; it < 4; ++it)
#pragma unroll
        for (int dt = 0; dt < 4; ++dt) uw[it][dt] = *(const u32x2*)(proj + (size_t)(r0 + ih * 64 + it * 16 + lr) * PROJ_LD + PJ_GM + g * 64 + dt * 16 + 4 * lq);
    f32x4 acc[4][4];
#pragma unroll
    for (int dt = 0; dt < 4; ++dt)
#pragma unroll
        for (int it = 0; it < 4; ++it) acc[dt][it] = (f32x4){0.f, 0.f, 0.f, 0.f};
#pragma unroll
    for (int ks = 0; ks < 4; ++ks) {
        bf16x8 af[4], bfr[4];
#pragma unroll
        for (int dt = 0; dt < 4; ++dt) af[dt] = *(const LAS bf16x8*)(vT + (g * 64 + dt * 16 + lr) * 136 + ks * 32 + lq * 8);
#pragma unroll
        for (int it = 0; it < 4; ++it) bfr[it] = *(const bf16x8*)(W + (size_t)(ih * 64 + it * 16 + lr) * 128 + ks * 32 + lq * 8);
#pragma unroll
        for (int dt = 0; dt < 4; ++dt)
#pragma unroll
            for (int it = 0; it < 4; ++it) acc[dt][it] = mfma16(af[dt], bfr[it], acc[dt][it]);
    }
    const float* bs = a->in[I_GMBS] + (size_t)(layer * 4 + g) * 128;
#pragma unroll
    for (int it = 0; it < 4; ++it) { const int i = ih * 64 + it * 16 + lr; const float bsi = bs[i]; float ss = 0.f;
#pragma unroll
        for (int dt = 0; dt < 4; ++dt) { const u32x2 w = uw[it][dt];
            f32x4 u; u.x = gelu_tanh(lo_bf(w.x)); u.y = gelu_tanh(hi_bf(w.x)); u.z = gelu_tanh(lo_bf(w.y)); u.w = gelu_tanh(hi_bf(w.y));
            const f32x4 y = u * (acc[dt][it] + bsi); acc[dt][it] = y; ss += (y.x * y.x + y.y * y.y) + (y.z * y.z + y.w * y.w); }
        ss += __shfl_xor(ss, 16); ss += __shfl_xor(ss, 32);
        if (lq == 0) red[g * 128 + i] = ss; }
    __syncthreads();
    const float* mg = a->in[I_MIXG] + layer * 1024 + 256; bf16* Y = (bf16*)(F.ws + WS_H);
#pragma unroll
    for (int it = 0; it < 4; ++it) { const int i = ih * 64 + it * 16 + lr; const float rn = frsq((red[i] + red[128 + i] + red[256 + i] + red[384 + i]) * (1.f / 256.f) + EPS);
#pragma unroll
        for (int dt = 0; dt < 4; ++dt) { const int col = g * 64 + dt * 16 + 4 * lq; const f32x4 m4 = *(const f32x4*)(mg + col); const f32x4 y = acc[dt][it] * rn * m4;
            u32x2 w; w.x = pk2(y.x, y.y); w.y = pk2(y.z, y.w); *(u32x2*)(Y + (size_t)(r0 + i) * 1024 + 256 + col) = w; } }
}
__device__ __forceinline__ f32x16 mfma32(bf16x8 a, bf16x8 b, f32x16 c) { return __builtin_amdgcn_mfma_f32_32x32x16_bf16(a, b, c, 0, 0, 0); }
__device__ __forceinline__ bf16x8 pack8(float a0, float a1, float a2, float a3, float a4, float a5, float a6, float a7) {
    u32x4 w; w.x = pg8::cvt_pk_bf16(a0, a1); w.y = pg8::cvt_pk_bf16(a2, a3); w.z = pg8::cvt_pk_bf16(a4, a5); w.w = pg8::cvt_pk_bf16(a6, a7); return __builtin_bit_cast(bf16x8, w); }

constexpr int AT_KROW = 104, AT_VROW = 72, AT_KB = 64 * AT_KROW * 2, AT_VB = 64 * AT_VROW * 2;
__device__ __forceinline__ float fmax3c(float a, float b, float c) { return __builtin_fmaxf(__builtin_fmaxf(a, b), c); }
__device__ __forceinline__ int imax3(int a, int b, int c) { const int t = a > b ? a : b; return t > c ? t : c; }
__device__ __forceinline__ float max4(f32x4 v) { return fmaxf(fmaxf(v[0], v[1]), fmaxf(v[2], v[3])); }
__device__ __forceinline__ float rowmax32(const f32x16& a, const f32x16& b) {
    float m0 = fmaxf(a[0], a[1]), m1 = fmaxf(a[2], a[3]), m2 = fmaxf(b[0], b[1]), m3 = fmaxf(b[2], b[3]);
#pragma unroll
    for (int r = 4; r < 16; r += 4) { m0 = fmaxf(m0, fmaxf(a[r], a[r + 1])); m1 = fmaxf(m1, fmaxf(a[r + 2], a[r + 3])); m2 = fmaxf(m2, fmaxf(b[r], b[r + 1])); m3 = fmaxf(m3, fmaxf(b[r + 2], b[r + 3])); }
    float m = fmaxf(fmaxf(m0, m1), fmaxf(m2, m3)); return fmaxf(m, __shfl_xor(m, 32));
}
__device__ __forceinline__ void attn_unit(const Frame& F, int b, int h, int qrow0, int key0, int ntile) {
    LAS unsigned char* L = F.lds;
    const bf16* Kg = (const bf16*)(F.ws + WS_K) + ((size_t)(b * 4 + h) * NKEY + key0) * 96;
    const bf16* Vg = (const bf16*)(F.ws + WS_VT) + (size_t)(b * 4 + h) * 64 * NKEY + key0;
    const bf16* Q = (const bf16*)(F.ws + WS_Q);
    int tid_ = F.tid; asm volatile("" : "+v"(tid_));
    const int lane = tid_ & 63, hi = lane >> 5, l31 = lane & 31;
    const int qrow = qrow0 + F.wave * 32 + l31;
    bf16x8 qf[6];
#pragma unroll
    for (int ks = 0; ks < 6; ++ks) qf[ks] = *(const bf16x8*)(Q + (size_t)qrow * 384 + h * 96 + ks * 16 + hi * 8);
    const int kr0 = tid_ / 12, kc0 = tid_ % 12, kr1 = (tid_ + 512) / 12, kc1 = (tid_ + 512) % 12; const bool k2 = tid_ < 256;
    const int vd = tid_ >> 3, vc = tid_ & 7;
    const int klds0 = kr0 * (AT_KROW * 2) + kc0 * 16, klds1 = kr1 * (AT_KROW * 2) + kc1 * 16, vlds = 3 * AT_KB + vd * (AT_VROW * 2) + vc * 16;
    const unsigned kg0 = (unsigned)(kr0 * 96 + kc0 * 8), kg1 = (unsigned)(kr1 * 96 + kc1 * 8), vg0 = (unsigned)(vd * NKEY + vc * 8);
    u32x4 sk0, sk1 = (u32x4){0u, 0u, 0u, 0u}, sv;
    __syncthreads();
    {
        const u32x4 a0 = *(const u32x4*)(Kg + kg0), b0 = *(const u32x4*)(Kg + 64 * 96 + kg0), c0 = *(const u32x4*)(Kg + 128 * 96 + kg0); u32x4 a1 = sk1, b1 = sk1, c1 = sk1;
        if (k2) { a1 = *(const u32x4*)(Kg + kg1); b1 = *(const u32x4*)(Kg + 64 * 96 + kg1); c1 = *(const u32x4*)(Kg + 128 * 96 + kg1); }
        sv = *(const u32x4*)(Vg + vg0);
        *(LAS u32x4*)(L + klds0) = a0; *(LAS u32x4*)(L + AT_KB + klds0) = b0; *(LAS u32x4*)(L + 2 * AT_KB + klds0) = c0;
        if (k2) { *(LAS u32x4*)(L + klds1) = a1; *(LAS u32x4*)(L + AT_KB + klds1) = b1; *(LAS u32x4*)(L + 2 * AT_KB + klds1) = c1; }
        *(LAS u32x4*)(L + vlds) = sv;
    }
    __syncthreads();
    const int prow = (l31 & ~12) | ((l31 & 4) << 1) | ((l31 & 8) >> 1);
    const int koff = prow * (AT_KROW * 2) + hi * 16, voff = 3 * AT_KB + l31 * (AT_VROW * 2) + hi * 16;
    f32x16 O0, O1, SA0, SA1, SB0, SB1;
#pragma unroll
    for (int r = 0; r < 16; ++r) { O0[r] = 0.f; O1[r] = 0.f; SA0[r] = 0.f; SA1[r] = 0.f; }
#pragma unroll
    for (int ks = 0; ks < 6; ++ks) { const bf16x8 k0 = *(const LAS bf16x8*)(L + koff + ks * 32), k1 = *(const LAS bf16x8*)(L + 32 * (AT_KROW * 2) + koff + ks * 32);
        SA0 = mfma32(k0, qf[ks], SA0); SA1 = mfma32(k1, qf[ks], SA1); }
    float m = rowmax32(SA0, SA1), l = 0.f;
#pragma unroll
    for (int r = 0; r < 16; ++r) { SA0[r] -= m; SA1[r] -= m; }
    f32x16 NM;
#pragma unroll
    for (int r = 0; r < 16; ++r) NM[r] = -m;
    int kA = 0, kB = AT_KB, kC = 2 * AT_KB;
    bf16x8 ka0, ka1;
    ka0 = *(const LAS bf16x8*)(L + kB + koff); ka1 = *(const LAS bf16x8*)(L + kB + 32 * (AT_KROW * 2) + koff);
    float one = 1.f; asm volatile("" : "+v"(one));
#define AT_EXP(S0, S1, r) do { S0[r] = __builtin_amdgcn_exp2f(S0[r]); S1[r] = __builtin_amdgcn_exp2f(S1[r]); s0 += S0[r]; } while (0)
#define AT_SUM(S0, S1, r) do { s1 = __builtin_fmaf(S1[r], one, s1); } while (0)
#define AT_KRD(dst0, dst1, ks) do { dst0 = *(const LAS bf16x8*)(Kt + koff + (ks) * 32); dst1 = *(const LAS bf16x8*)(Kt + 32 * (AT_KROW * 2) + koff + (ks) * 32); } while (0)
#define AT_VRD(dst0, dst1, s) do { dst0 = *(const LAS bf16x8*)(Vt + voff + (s) * 32); dst1 = *(const LAS bf16x8*)(Vt + 32 * (AT_VROW * 2) + voff + (s) * 32); } while (0)
#define AT_SB() __builtin_amdgcn_sched_barrier(0)
#define BI(x) __float_as_int(x)
#define AT_TILE(S0, S1, T0, T1, J, NX) do { const int j_ = (J); constexpr bool nx = (NX); const bool nx2 = j_ + 2 < ntile, nx3 = j_ + 3 < ntile; \
        if (nx) sv = *(const u32x4*)(Vg + (size_t)(j_ + 1) * 64 + vg0); \
        if (nx3) { const bf16* kg = Kg + (size_t)(j_ + 3) * 64 * 96; sk0 = *(const u32x4*)(kg + kg0); if (k2) sk1 = *(const u32x4*)(kg + kg1); } \
        const LAS unsigned char* Kt = L + kB; const LAS unsigned char* Vt = L + (j_ & 1) * AT_VB; \
        float s0 = 0.f, s1 = 0.f; bf16x8 kb0, kb1, va0, va1, vb0, vb1; \
          \
        AT_KRD(kb0, kb1, 1); if (nx) { T0 = mfma32(ka0, qf[0], NM); T1 = mfma32(ka1, qf[0], NM); } AT_EXP(S0, S1, 0); AT_EXP(S0, S1, 1); AT_EXP(S0, S1, 2); AT_SB(); \
        AT_KRD(ka0, ka1, 2); if (nx) { T0 = mfma32(kb0, qf[1], T0); T1 = mfma32(kb1, qf[1], T1); } AT_EXP(S0, S1, 3); AT_EXP(S0, S1, 4); AT_EXP(S0, S1, 5); AT_SB(); \
        AT_KRD(kb0, kb1, 3); if (nx) { T0 = mfma32(ka0, qf[2], T0); T1 = mfma32(ka1, qf[2], T1); } AT_EXP(S0, S1, 6); AT_EXP(S0, S1, 7); AT_EXP(S0, S1, 8); AT_SB(); \
        AT_KRD(ka0, ka1, 4); if (nx) { T0 = mfma32(kb0, qf[3], T0); T1 = mfma32(kb1, qf[3], T1); } AT_EXP(S0, S1, 9); AT_EXP(S0, S1, 10); AT_EXP(S0, S1, 11); AT_SB(); \
        AT_KRD(kb0, kb1, 5); if (nx) { T0 = mfma32(ka0, qf[4], T0); T1 = mfma32(ka1, qf[4], T1); } AT_EXP(S0, S1, 12); AT_EXP(S0, S1, 13); AT_SB(); \
        AT_VRD(va0, va1, 0); if (nx) { T0 = mfma32(kb0, qf[5], T0); T1 = mfma32(kb1, qf[5], T1); } AT_EXP(S0, S1, 14); AT_EXP(S0, S1, 15); \
        bf16x8 pf0 = pack8(S0[0], S0[1], S0[2], S0[3], S0[4], S0[5], S0[6], S0[7]), pf1 = pack8(S0[8], S0[9], S0[10], S0[11], S0[12], S0[13], S0[14], S0[15]); AT_SB(); \
          \
        int x0 = 0, x1 = 0, x2 = 0, x3 = 0; \
        AT_VRD(vb0, vb1, 1); O0 = mfma32(va0, pf0, O0); O1 = mfma32(va1, pf0, O1); \
        bf16x8 pf2 = pack8(S1[0], S1[1], S1[2], S1[3], S1[4], S1[5], S1[6], S1[7]), pf3 = pack8(S1[8], S1[9], S1[10], S1[11], S1[12], S1[13], S1[14], S1[15]); \
        AT_SUM(S0, S1, 0); AT_SUM(S0, S1, 1); AT_SUM(S0, S1, 2); AT_SUM(S0, S1, 3); AT_SUM(S0, S1, 4); AT_SUM(S0, S1, 5); AT_SUM(S0, S1, 6); AT_SUM(S0, S1, 7); AT_SB(); \
        AT_VRD(va0, va1, 2); O0 = mfma32(vb0, pf1, O0); O1 = mfma32(vb1, pf1, O1); \
        if (nx) { x0 = imax3(BI(T0[0]), BI(T0[1]), BI(T0[2])); x1 = imax3(BI(T0[3]), BI(T0[4]), BI(T0[5])); x0 = imax3(x0, BI(T0[6]), BI(T0[7])); x1 = imax3(x1, BI(T0[8]), BI(T0[9])); x0 = imax3(x0, BI(T0[10]), BI(T0[11])); x1 = imax3(x1, BI(T0[12]), BI(T0[13])); x0 = imax3(x0, BI(T0[14]), BI(T0[15])); } AT_SUM(S0, S1, 8); AT_SUM(S0, S1, 9); AT_SUM(S0, S1, 10); AT_SUM(S0, S1, 11); AT_SUM(S0, S1, 12); AT_SUM(S0, S1, 13); AT_SUM(S0, S1, 14); AT_SUM(S0, S1, 15); AT_SB(); \
        AT_VRD(vb0, vb1, 3); O0 = mfma32(va0, pf2, O0); O1 = mfma32(va1, pf2, O1); \
        if (nx2) { ka0 = *(const LAS bf16x8*)(L + kC + koff); ka1 = *(const LAS bf16x8*)(L + kC + 32 * (AT_KROW * 2) + koff); } \
        if (nx) { x2 = imax3(BI(T1[0]), BI(T1[1]), BI(T1[2])); x3 = imax3(BI(T1[3]), BI(T1[4]), BI(T1[5])); x2 = imax3(x2, BI(T1[6]), BI(T1[7])); x3 = imax3(x3, BI(T1[8]), BI(T1[9])); x2 = imax3(x2, BI(T1[10]), BI(T1[11])); x3 = imax3(x3, BI(T1[12]), BI(T1[13])); x2 = imax3(x2, BI(T1[14]), BI(T1[15])); } AT_SB(); \
        O0 = mfma32(vb0, pf3, O0); O1 = mfma32(vb1, pf3, O1); \
        l += s0 + s1; \
        if (nx) { int mxi = imax3(x0, x1, x2 > x3 ? x2 : x3); \
            if (__any(mxi > 0x41000000)) { const int oth = __shfl_xor(mxi, 32); mxi = mxi > oth ? mxi : oth; const float d = __builtin_bit_cast(float, mxi > 0 ? mxi : 0), alpha = __builtin_amdgcn_exp2f(-d); m += d; l *= alpha; \
                _Pragma("unroll") for (int r = 0; r < 16; ++r) { O0[r] *= alpha; O1[r] *= alpha; T0[r] -= d; T1[r] -= d; NM[r] = -m; } } \
            *(LAS u32x4*)(L + ((j_ + 1) & 1) * AT_VB + vlds) = sv; \
            if (nx3) { LAS unsigned char* Kn = L + kA; *(LAS u32x4*)(Kn + klds0) = sk0; if (k2) *(LAS u32x4*)(Kn + klds1) = sk1; } } \
        { const int t_ = kA; kA = kB; kB = kC; kC = t_; } \
        asm volatile("s_waitcnt vmcnt(0) lgkmcnt(0)" ::: "memory"); __syncthreads(); } while (0)
    asm volatile(".p2align 8");
#pragma unroll 1
    for (int j = 0; j < ntile - 2; j += 2) { AT_TILE(SA0, SA1, SB0, SB1, j, true); AT_TILE(SB0, SB1, SA0, SA1, j + 1, true); }
    AT_TILE(SA0, SA1, SB0, SB1, ntile - 2, true); AT_TILE(SB0, SB1, SA0, SA1, ntile - 1, false);
#undef AT_TILE
#undef AT_EXP
#undef AT_SUM
#undef AT_KRD
#undef AT_VRD
#undef AT_SB
#undef BI
    l += __shfl_xor(l, 32);
    const float inv = 1.f / l;
    bf16* Y = (bf16*)(F.ws + WS_YAT) + (size_t)qrow * 256 + h * 64;
#pragma unroll
    for (int g = 0; g < 4; ++g) {
        u32x2 w0, w1; w0.x = pk2(O0[4 * g] * inv, O0[4 * g + 1] * inv); w0.y = pk2(O0[4 * g + 2] * inv, O0[4 * g + 3] * inv);
        w1.x = pk2(O1[4 * g] * inv, O1[4 * g + 1] * inv); w1.y = pk2(O1[4 * g + 2] * inv, O1[4 * g + 3] * inv);
        *(u32x2*)(Y + 8 * g + 4 * hi) = w0; *(u32x2*)(Y + 32 + 8 * g + 4 * hi) = w1; }
}

constexpr int AT16_KROW = 224, AT16_VROW = 160, AT16_KB = 64 * AT16_KROW, AT16_VB = 64 * AT16_VROW;
__device__ __forceinline__ void attn_unit16(const Frame& F, int b, int h, int qrow0, int key0, int ntile) {
    LAS unsigned char* L = F.lds;
    const bf16* Kg = (const bf16*)(F.ws + WS_K) + ((size_t)(b * 4 + h) * NKEY + key0) * 96;
    const bf16* Vg = (const bf16*)(F.ws + WS_VT) + (size_t)(b * 4 + h) * 64 * NKEY + key0;
    const bf16* Q = (const bf16*)(F.ws + WS_Q);
    int tid_ = F.tid; asm volatile("" : "+v"(tid_));
    const int lane = tid_ & 63, lc = lane & 15, lg = lane >> 4;
    const int qrow = qrow0 + F.wave * 32 + lc;
    bf16x8 qf[2][3];
#pragma unroll
    for (int qt = 0; qt < 2; ++qt)
#pragma unroll
        for (int ks = 0; ks < 3; ++ks) qf[qt][ks] = *(const bf16x8*)(Q + (size_t)(qrow + 16 * qt) * 384 + h * 96 + ks * 32 + lg * 8);
    const int kr0 = tid_ / 12, kc0 = tid_ % 12, kr1 = (tid_ + 512) / 12, kc1 = (tid_ + 512) % 12; const bool k2 = tid_ < 256;
    const int vd = tid_ >> 3, vc = tid_ & 7;
    const int klds0 = kr0 * AT16_KROW + kc0 * 16, klds1 = kr1 * AT16_KROW + kc1 * 16, vlds = 2 * AT16_KB + vd * AT16_VROW + vc * 16;
    const unsigned kg0 = (unsigned)(kr0 * 96 + kc0 * 8), kg1 = (unsigned)(kr1 * 96 + kc1 * 8), vg0 = (unsigned)(vd * NKEY + vc * 8);
    u32x4 sk0, sk1 = (u32x4){0u, 0u, 0u, 0u}, sv;
    __syncthreads();
    {
        const u32x4 a0 = *(const u32x4*)(Kg + kg0), b0 = *(const u32x4*)(Kg + 64 * 96 + kg0); u32x4 a1 = sk1, b1 = sk1; if (k2) { a1 = *(const u32x4*)(Kg + kg1); b1 = *(const u32x4*)(Kg + 64 * 96 + kg1); }
        sv = *(const u32x4*)(Vg + vg0);
        *(LAS u32x4*)(L + klds0) = a0; *(LAS u32x4*)(L + AT16_KB + klds0) = b0; if (k2) { *(LAS u32x4*)(L + klds1) = a1; *(LAS u32x4*)(L + AT16_KB + klds1) = b1; }
        *(LAS u32x4*)(L + vlds) = sv;
    }
    __syncthreads();
    const int koff = lc * AT16_KROW + lg * 16, voff = 2 * AT16_KB + lc * AT16_VROW + lg * 16;
    f32x4 O[4][2], SA[2][4], SB[2][4];
#pragma unroll
    for (int i = 0; i < 4; ++i) { O[i][0] = (f32x4){0.f, 0.f, 0.f, 0.f}; O[i][1] = (f32x4){0.f, 0.f, 0.f, 0.f}; SA[0][i] = (f32x4){0.f, 0.f, 0.f, 0.f}; SA[1][i] = (f32x4){0.f, 0.f, 0.f, 0.f}; }
#pragma unroll
    for (int ks = 0; ks < 3; ++ks)
#pragma unroll
        for (int kt = 0; kt < 4; ++kt) { const bf16x8 kf = *(const LAS bf16x8*)(L + koff + kt * 16 * AT16_KROW + ks * 64);
            SA[0][kt] = mfma16(kf, qf[0][ks], SA[0][kt]); SA[1][kt] = mfma16(kf, qf[1][ks], SA[1][kt]); }
    float m0, m1, l0 = 0.f, l1 = 0.f;
    {   float xa = fmaxf(fmaxf(max4(SA[0][0]), max4(SA[0][1])), fmaxf(max4(SA[0][2]), max4(SA[0][3]))), xb = fmaxf(fmaxf(max4(SA[1][0]), max4(SA[1][1])), fmaxf(max4(SA[1][2]), max4(SA[1][3])));
        xa = fmaxf(xa, __shfl_xor(xa, 16)); xa = fmaxf(xa, __shfl_xor(xa, 32)); xb = fmaxf(xb, __shfl_xor(xb, 16)); xb = fmaxf(xb, __shfl_xor(xb, 32)); m0 = xa; m1 = xb; }
#pragma unroll
    for (int kt = 0; kt < 4; ++kt)
#pragma unroll
        for (int r = 0; r < 4; ++r) { SA[0][kt][r] -= m0; SA[1][kt][r] -= m1; }
    float one = 1.f; asm volatile("" : "+v"(one));
#define AT_EXP(S, i) do { S[0][(i) >> 2][(i) & 3] = __builtin_amdgcn_exp2f(S[0][(i) >> 2][(i) & 3]); S[1][(i) >> 2][(i) & 3] = __builtin_amdgcn_exp2f(S[1][(i) >> 2][(i) & 3]); s0 += S[0][(i) >> 2][(i) & 3]; s1 = __builtin_fmaf(S[1][(i) >> 2][(i) & 3], one, s1); } while (0)
#define AT_KRD(dst0, dst1, s) do { dst0 = *(const LAS bf16x8*)(Kt + koff + (2 * ((s) & 1)) * 16 * AT16_KROW + ((s) >> 1) * 64); dst1 = *(const LAS bf16x8*)(Kt + koff + (2 * ((s) & 1) + 1) * 16 * AT16_KROW + ((s) >> 1) * 64); } while (0)
#define AT_VRD(dst0, dst1, s) do { dst0 = *(const LAS bf16x8*)(Vt + voff + (2 * ((s) & 1)) * 16 * AT16_VROW + ((s) >> 1) * 64); dst1 = *(const LAS bf16x8*)(Vt + voff + (2 * ((s) & 1) + 1) * 16 * AT16_VROW + ((s) >> 1) * 64); } while (0)
#define AT_QK(T, k0, k1, s) do { if (nx) { T[0][2 * ((s) & 1)] = mfma16(k0, qf[0][(s) >> 1], T[0][2 * ((s) & 1)]); T[1][2 * ((s) & 1)] = mfma16(k0, qf[1][(s) >> 1], T[1][2 * ((s) & 1)]); \
        T[0][2 * ((s) & 1) + 1] = mfma16(k1, qf[0][(s) >> 1], T[0][2 * ((s) & 1) + 1]); T[1][2 * ((s) & 1) + 1] = mfma16(k1, qf[1][(s) >> 1], T[1][2 * ((s) & 1) + 1]); } } while (0)
#define AT_PV(v0, v1, p0, p1, s) do { O[2 * ((s) & 1)][0] = mfma16(v0, p0, O[2 * ((s) & 1)][0]); O[2 * ((s) & 1)][1] = mfma16(v0, p1, O[2 * ((s) & 1)][1]); \
        O[2 * ((s) & 1) + 1][0] = mfma16(v1, p0, O[2 * ((s) & 1) + 1][0]); O[2 * ((s) & 1) + 1][1] = mfma16(v1, p1, O[2 * ((s) & 1) + 1][1]); } while (0)
#define BI(x) __float_as_int(x)
#define AT_MAXQ(T, q, xa, xb) do { xa = imax3(BI(T[q][0][0]), BI(T[q][0][1]), BI(T[q][0][2])); xb = imax3(BI(T[q][0][3]), BI(T[q][1][0]), BI(T[q][1][1])); xa = imax3(xa, BI(T[q][1][2]), BI(T[q][1][3])); xb = imax3(xb, BI(T[q][2][0]), BI(T[q][2][1])); \
        xa = imax3(xa, BI(T[q][2][2]), BI(T[q][2][3])); xb = imax3(xb, BI(T[q][3][0]), BI(T[q][3][1])); xa = imax3(xa, BI(T[q][3][2]), BI(T[q][3][3])); } while (0)
#define AT_SB() __builtin_amdgcn_sched_barrier(0)
#define AT_TILE(S, T, J, NX) do { const int j_ = (J); constexpr bool nx = (NX); const bool nx2 = j_ + 2 < ntile; \
        if (nx) sv = *(const u32x4*)(Vg + (size_t)(j_ + 1) * 64 + vg0); \
        if (nx2) { const bf16* kg = Kg + (size_t)(j_ + 2) * 64 * 96; sk0 = *(const u32x4*)(kg + kg0); if (k2) sk1 = *(const u32x4*)(kg + kg1); } \
        const LAS unsigned char* Kt = L + ((j_ + 1) & 1) * AT16_KB; const LAS unsigned char* Vt = L + (j_ & 1) * AT16_VB; \
        { const float nm0 = -m0, nm1 = -m1; _Pragma("unroll") for (int kt = 0; kt < 4; ++kt) { T[0][kt] = (f32x4){nm0, nm0, nm0, nm0}; T[1][kt] = (f32x4){nm1, nm1, nm1, nm1}; } } \
        float s0 = 0.f, s1 = 0.f; bf16x8 ka0, ka1, kb0, kb1, va0, va1, vb0, vb1; \
        AT_KRD(ka0, ka1, 0); AT_SB(); \
          \
        AT_KRD(kb0, kb1, 1); AT_QK(T, ka0, ka1, 0); AT_EXP(S, 0); AT_EXP(S, 1); AT_EXP(S, 2); AT_SB(); \
        AT_KRD(ka0, ka1, 2); AT_QK(T, kb0, kb1, 1); AT_EXP(S, 3); AT_EXP(S, 4); AT_EXP(S, 5); AT_SB(); \
        AT_KRD(kb0, kb1, 3); AT_QK(T, ka0, ka1, 2); AT_EXP(S, 6); AT_EXP(S, 7); AT_EXP(S, 8); AT_SB(); \
        AT_KRD(ka0, ka1, 4); AT_QK(T, kb0, kb1, 3); AT_EXP(S, 9); AT_EXP(S, 10); AT_EXP(S, 11); AT_SB(); \
        AT_KRD(kb0, kb1, 5); AT_QK(T, ka0, ka1, 4); AT_EXP(S, 12); AT_EXP(S, 13); AT_SB(); \
        AT_VRD(va0, va1, 0); AT_QK(T, kb0, kb1, 5); AT_EXP(S, 14); AT_EXP(S, 15); \
        const bf16x8 pf00 = pack8(S[0][0][0], S[0][0][1], S[0][0][2], S[0][0][3], S[0][1][0], S[0][1][1], S[0][1][2], S[0][1][3]), pf01 = pack8(S[1][0][0], S[1][0][1], S[1][0][2], S[1][0][3], S[1][1][0], S[1][1][1], S[1][1][2], S[1][1][3]); AT_SB(); \
          \
        int x0 = 0, x1 = 0, x2 = 0, x3 = 0; \
        AT_VRD(vb0, vb1, 1); AT_PV(va0, va1, pf00, pf01, 0); \
        const bf16x8 pf10 = pack8(S[0][2][0], S[0][2][1], S[0][2][2], S[0][2][3], S[0][3][0], S[0][3][1], S[0][3][2], S[0][3][3]), pf11 = pack8(S[1][2][0], S[1][2][1], S[1][2][2], S[1][2][3], S[1][3][0], S[1][3][1], S[1][3][2], S[1][3][3]); \
        l0 += s0; l1 += s1; AT_SB(); \
        AT_VRD(va0, va1, 2); AT_PV(vb0, vb1, pf00, pf01, 1); AT_MAXQ(T, 0, x0, x1); AT_SB(); \
        AT_VRD(vb0, vb1, 3); AT_PV(va0, va1, pf10, pf11, 2); AT_MAXQ(T, 1, x2, x3); AT_SB(); \
        AT_PV(vb0, vb1, pf10, pf11, 3); \
        if (nx) { int mxa = x0 > x1 ? x0 : x1, mxb = x2 > x3 ? x2 : x3; \
            if (__any((mxa > mxb ? mxa : mxb) > 0x41000000)) { { const int oa = __shfl_xor(mxa, 16), ob = __shfl_xor(mxb, 16); mxa = mxa > oa ? mxa : oa; mxb = mxb > ob ? mxb : ob; } \
                { const int oa = __shfl_xor(mxa, 32), ob = __shfl_xor(mxb, 32); mxa = mxa > oa ? mxa : oa; mxb = mxb > ob ? mxb : ob; } \
                const float d0 = __builtin_bit_cast(float, mxa > 0 ? mxa : 0), d1 = __builtin_bit_cast(float, mxb > 0 ? mxb : 0), al0 = __builtin_amdgcn_exp2f(-d0), al1 = __builtin_amdgcn_exp2f(-d1); m0 += d0; m1 += d1; l0 *= al0; l1 *= al1; \
                _Pragma("unroll") for (int i = 0; i < 4; ++i) _Pragma("unroll") for (int r = 0; r < 4; ++r) { O[i][0][r] *= al0; O[i][1][r] *= al1; T[0][i][r] -= d0; T[1][i][r] -= d1; } } \
            *(LAS u32x4*)(L + 2 * AT16_KB + ((j_ + 1) & 1) * AT16_VB + (vlds - 2 * AT16_KB)) = sv; \
            if (nx2) { LAS unsigned char* Kn = L + (j_ & 1) * AT16_KB; *(LAS u32x4*)(Kn + klds0) = sk0; if (k2) *(LAS u32x4*)(Kn + klds1) = sk1; } } \
        asm volatile("s_waitcnt vmcnt(0) lgkmcnt(0)" ::: "memory"); __syncthreads(); } while (0)
    asm volatile(".p2align 8");
#pragma unroll 1
    for (int j = 0; j < ntile - 2; j += 2) { AT_TILE(SA, SB, j, true); AT_TILE(SB, SA, j + 1, true); }
    AT_TILE(SA, SB, ntile - 2, true); AT_TILE(SB, SA, ntile - 1, false);
#undef AT_TILE
#undef AT_EXP
#undef AT_KRD
#undef AT_VRD
#undef AT_QK
#undef AT_PV
#undef AT_MAXQ
#undef BI
#undef AT_SB
    l0 += __shfl_xor(l0, 16); l1 += __shfl_xor(l1, 16); l0 += __shfl_xor(l0, 32); l1 += __shfl_xor(l1, 32);
    const float inv0 = 1.f / l0, inv1 = 1.f / l1;
    bf16* Y = (bf16*)(F.ws + WS_YAT) + (size_t)qrow * 256 + h * 64 + 4 * lg;
#pragma unroll
    for (int dt = 0; dt < 4; ++dt) {
        u32x2 w0, w1; w0.x = pk2(O[dt][0][0] * inv0, O[dt][0][1] * inv0); w0.y = pk2(O[dt][0][2] * inv0, O[dt][0][3] * inv0);
        w1.x = pk2(O[dt][1][0] * inv1, O[dt][1][1] * inv1); w1.y = pk2(O[dt][1][2] * inv1, O[dt][1][3] * inv1);
        *(u32x2*)(Y + 16 * dt) = w0; *(u32x2*)(Y + 16 * 256 + 16 * dt) = w1; }
}

__device__ __forceinline__ float filt_inv_norm(const Frame& F, int set, int ntile, int o, int c) {
    const float* fsp = (const float*)(F.ws + WS_FS) + (size_t)set * 128 * 1024 + o * 512 + c;
    float s = 0.f;
    for (int t = F.lane; t < ntile; t += 64) s += fsp[(size_t)t * 1024] + fsp[(size_t)t * 1024 + 256];
    return 1.f / wave_sum(s);
}
constexpr int HY_UROW = 5408, HY_UB = 8 * HY_UROW * 2, HY_G0 = HY_UB, HY_G1 = HY_G0 + GLEN * 2 + 64;
__device__ __forceinline__ int hy_uoff(int t) { const int T = t + 512; return T + 8 * (T >> 7); }
static_assert((HY_G0 / 4) % 32 == 0 && (HY_G1 / 4) % 32 == 16, "G copies on opposite bank halves");
__device__ __forceinline__ bf16x8 lds_rd8_a4(const LAS unsigned char* p) { const LAS unsigned* q = (const LAS unsigned*)p; u32x4 w; w.x = q[0]; w.y = q[1]; w.z = q[2]; w.w = q[3]; return __builtin_bit_cast(bf16x8, w); }
__device__ __forceinline__ void hyena_unit(const Frame& F, KArgs a, int layer, int c) {
    LAS unsigned char* L = F.lds; LAS bf16* U = (LAS bf16*)L;
    bf16* hyT = (bf16*)(F.ws + WS_HYT);
    const float* sw = a->in[I_HSW] + (size_t)layer * 3 * 768; const float* sb = a->in[I_HSB] + layer * 768;
    int tid_ = F.tid; asm volatile("" : "+v"(tid_));
    const int lane = tid_ & 63, w = F.wave, hi = lane >> 5, l31 = lane & 31;
    __syncthreads();
    {
        const bf16* vrow = hyT + (size_t)(512 + c) * NTOK; const float w0 = sw[512 + c], w1 = sw[768 + 512 + c], w2 = sw[1536 + 512 + c], bb = sb[512 + c];
        for (int i = tid_; i < 8 * 512; i += 512) { const int b = i >> 9, t0 = (i & 511) * 8; const bf16* p = vrow + b * 4096 + t0; const u32x4 x = *(const u32x4*)p;
            float v[10]; v[0] = t0 > 0 ? bf2f(p[-1]) : 0.f; v[9] = t0 + 8 < 4096 ? bf2f(p[8]) : 0.f;
            v[1] = lo_bf(x.x); v[2] = hi_bf(x.x); v[3] = lo_bf(x.y); v[4] = hi_bf(x.y); v[5] = lo_bf(x.z); v[6] = hi_bf(x.z); v[7] = lo_bf(x.w); v[8] = hi_bf(x.w);
            float o[8];
#pragma unroll
            for (int k = 0; k < 8; ++k) o[k] = w0 * v[k] + w1 * v[k + 1] + w2 * v[k + 2] + bb;
            u32x4 ww; ww.x = pk2(o[0], o[1]); ww.y = pk2(o[2], o[3]); ww.z = pk2(o[4], o[5]); ww.w = pk2(o[6], o[7]);
            *(LAS u32x4*)(U + b * HY_UROW + hy_uoff(t0)) = ww; }
        for (int i = tid_; i < 8 * 132; i += 512) { const int b = i / 132, q = i % 132; const int e = q < 68 ? q * 8 : 4896 + (q - 68) * 8;
            *(LAS u32x4*)(U + b * HY_UROW + e) = (u32x4){0u, 0u, 0u, 0u}; }
    }
    const int sel = l31 & 1;
    const int abase = (sel ? HY_G1 : HY_G0) + (GC - l31 + 8 * hi + sel) * 2;
    const int nb = l31 & 7, qq = l31 >> 3, qsb = 16 * w + 4 * qq;
    const int ubase = (nb * HY_UROW + 8 * hi) * 2;
#pragma unroll 1
    for (int o = 0; o < 2; ++o) {
        {
            const bf16* Gg = (const bf16*)(F.ws + WS_G) + ((size_t)(layer * 2 + o) * 256 + c) * GLEN;
            for (int i = tid_; i < GLEN / 8; i += 512) { u32x4 x = *(const u32x4*)(Gg + i * 8);
                if (i < 5 || i >= 1027) { const int m0 = i * 8; unsigned* xp = (unsigned*)&x;
#pragma unroll
                    for (int k = 0; k < 4; ++k) { const int ma = m0 + 2 * k, mb = ma + 1; unsigned v = xp[k]; if (ma < 33 || ma > 8223) v &= 0xffff0000u; if (mb < 33 || mb > 8223) v &= 0x0000ffffu; xp[k] = v; } }
                *(LAS u32x4*)(L + HY_G0 + i * 16) = x; }
            __syncthreads();
            const LAS unsigned* g0 = (const LAS unsigned*)(L + HY_G0); LAS unsigned* g1 = (LAS unsigned*)(L + HY_G1);
            for (int i = tid_; i <= GLEN / 2; i += 512) { const unsigned dp = i > 0 ? g0[i - 1] : 0u, d = i < GLEN / 2 ? g0[i] : 0u; g1[i] = (dp >> 16) | (d << 16); }
            __syncthreads();
        }
        f32x16 acc[4];
#pragma unroll
        for (int j = 0; j < 4; ++j)
#pragma unroll
            for (int r = 0; r < 16; ++r) acc[j][r] = 0.f;
        bf16x8 A[4][2];
        const int e0 = 16 * w - 127;
#define HY_LOADA(slot, delta) do { const LAS unsigned char* _p = L + abase - 64 * (delta); A[slot][0] = lds_rd8_a4(_p); A[slot][1] = lds_rd8_a4(_p + 32); } while (0)
#define HY_LOADF(d0, d1, e) do { const int qx = qsb + 16 - (e); const LAS unsigned char* _u = L + ubase + (32 * qx + 8 * (qx >> 2)) * 2; d0 = *(const LAS bf16x8*)_u; d1 = *(const LAS bf16x8*)(_u + 32); } while (0)
        HY_LOADA(0, e0); HY_LOADA(1, e0 + 1); HY_LOADA(2, e0 + 2); HY_LOADA(3, e0 + 3);
        bf16x8 fa0, fa1, fb0, fb1;
        HY_LOADF(fa0, fa1, e0);
#define HY_STEP(g, FC0, FC1, FN0, FN1) do { const int e = eb + (g); \
            HY_LOADF(FN0, FN1, e + 1); \
            acc[0] = mfma32(A[(g) & 3][0], FC0, acc[0]); acc[0] = mfma32(A[(g) & 3][1], FC1, acc[0]); \
            __builtin_amdgcn_sched_barrier(0); \
            HY_LOADA((g) & 3, e + 4); \
            _Pragma("unroll") for (int j = 1; j < 4; ++j) { acc[j] = mfma32(A[((g) + j) & 3][0], FC0, acc[j]); acc[j] = mfma32(A[((g) + j) & 3][1], FC1, acc[j]); } \
            __builtin_amdgcn_sched_barrier(0); } while (0)
        asm volatile(".p2align 8");
#pragma unroll 1
        for (int eb = e0; eb < e0 + 140; eb += 4) { HY_STEP(0, fa0, fa1, fb0, fb1); HY_STEP(1, fb0, fb1, fa0, fa1); HY_STEP(2, fa0, fa1, fb0, fb1); HY_STEP(3, fb0, fb1, fa0, fa1); }
#undef HY_LOADF
#undef HY_STEP
#undef HY_LOADA
        __syncthreads();
        const float inv = filt_inv_norm(F, layer, 128, o, c);
        const float hb = a->in[I_HBIAS][(size_t)(layer * 2 + o) * 256 + c];
        const int gcol = o == 0 ? c : 256 + c; const bf16* grow = hyT + (size_t)gcol * NTOK + nb * 4096;
        const float w0 = sw[gcol], w1 = sw[768 + gcol], w2 = sw[1536 + gcol], bb = sb[gcol];
        bf16* yrow = (bf16*)(F.ws + WS_YT) + (size_t)c * NTOK + nb * 4096;
#pragma unroll
        for (int j = 0; j < 4; ++j) { const int q = 16 * w + 4 * qq + j;
#pragma unroll
            for (int g4 = 0; g4 < 4; ++g4) { const int t = 32 * q + 8 * g4 + 4 * hi; const bf16* p = grow + t; const u32x2 x = *(const u32x2*)p;
                float v[6]; v[0] = t > 0 ? bf2f(p[-1]) : 0.f; v[5] = t + 4 < 4096 ? bf2f(p[4]) : 0.f; v[1] = lo_bf(x.x); v[2] = hi_bf(x.x); v[3] = lo_bf(x.y); v[4] = hi_bf(x.y);
                LAS bf16* up = U + nb * HY_UROW + hy_uoff(t); const u32x2 uu = *(const LAS u32x2*)up;
                const float u0 = lo_bf(uu.x), u1 = hi_bf(uu.x), u2 = lo_bf(uu.y), u3 = hi_bf(uu.y);
                const float y0 = (w0 * v[0] + w1 * v[1] + w2 * v[2] + bb) * (acc[j][4 * g4] * inv + hb * u0);
                const float y1 = (w0 * v[1] + w1 * v[2] + w2 * v[3] + bb) * (acc[j][4 * g4 + 1] * inv + hb * u1);
                const float y2 = (w0 * v[2] + w1 * v[3] + w2 * v[4] + bb) * (acc[j][4 * g4 + 2] * inv + hb * u2);
                const float y3 = (w0 * v[3] + w1 * v[4] + w2 * v[5] + bb) * (acc[j][4 * g4 + 3] * inv + hb * u3);
                u32x2 wv; wv.x = pk2(y0, y1); wv.y = pk2(y2, y3);
                if (o == 0) *(LAS u32x2*)up = wv; else *(u32x2*)(yrow + t) = wv; } }
        __syncthreads();
    }
}

constexpr int HY16_UROW = 5664, HY16_G0 = 8 * HY16_UROW * 2, HY16_G1 = HY16_G0 + GLEN * 2 + 64;
__device__ __forceinline__ int hy16_uoff(int t) { const int T = t + 512; return T + 16 * (T >> 7); }
static_assert((HY16_G0 / 4) % 32 == 0 && (HY16_G1 / 4) % 32 == 16 && HY16_G1 + GLEN * 2 + 4 <= LDS_MISC, "hyena16 LDS map");
__device__ __forceinline__ void hyena_unit16(const Frame& F, KArgs a, int layer, int c) {
    LAS unsigned char* L = F.lds; LAS bf16* U = (LAS bf16*)L;
    bf16* hyT = (bf16*)(F.ws + WS_HYT);
    const float* sw = a->in[I_HSW] + (size_t)layer * 3 * 768; const float* sb = a->in[I_HSB] + layer * 768;
    int tid_ = F.tid; asm volatile("" : "+v"(tid_));
    const int lane = tid_ & 63, w = F.wave, hi = lane >> 5, l31 = lane & 31;
    const float inv_o[2] = {filt_inv_norm(F, layer, 128, 0, c), filt_inv_norm(F, layer, 128, 1, c)};
    __syncthreads();
    {
        const bf16* vrow = hyT + (size_t)(512 + c) * NTOK; const float w0 = sw[512 + c], w1 = sw[768 + 512 + c], w2 = sw[1536 + 512 + c], bb = sb[512 + c];
#pragma unroll
        for (int it = 0; it < 8; ++it) { const int i = tid_ + it * 512; const int b = i >> 9, t0 = (i & 511) * 8;     const bf16* p = vrow + b * 4096 + t0; const u32x4 x = *(const u32x4*)p;
            float v[10]; v[0] = t0 > 0 ? bf2f(p[-1]) : 0.f; v[9] = t0 + 8 < 4096 ? bf2f(p[8]) : 0.f;
            v[1] = lo_bf(x.x); v[2] = hi_bf(x.x); v[3] = lo_bf(x.y); v[4] = hi_bf(x.y); v[5] = lo_bf(x.z); v[6] = hi_bf(x.z); v[7] = lo_bf(x.w); v[8] = hi_bf(x.w);
            float o[8];
#pragma unroll
            for (int k = 0; k < 8; ++k) o[k] = w0 * v[k] + w1 * v[k + 1] + w2 * v[k + 2] + bb;
            u32x4 ww; ww.x = pk2(o[0], o[1]); ww.y = pk2(o[2], o[3]); ww.z = pk2(o[4], o[5]); ww.w = pk2(o[6], o[7]);
            *(LAS u32x4*)(U + b * HY16_UROW + hy16_uoff(t0)) = ww; }
        for (int i = tid_; i < 8 * 132; i += 512) { const int b = i / 132, q = i % 132; const int e = q < 72 ? q * 8 : 5184 + (q - 72) * 8;
            *(LAS u32x4*)(U + b * HY16_UROW + e) = (u32x4){0u, 0u, 0u, 0u}; }
    }
    const int lc = lane & 15, lg = lane >> 4, sel = lc & 1;
    const int abase = (sel ? HY16_G1 : HY16_G0) + (GC - lc + 8 * lg + sel) * 2;
    const int nb = lc & 7, qh = lc >> 3;
    const int ubase = (nb * HY16_UROW + 8 * lg) * 2, qsb0 = 16 * w + 4 * qh, qsb1 = qsb0 + 8;
#pragma unroll 1
    for (int o = 0; o < 2; ++o) {
        {
            const bf16* Gg = (const bf16*)(F.ws + WS_G) + ((size_t)(layer * 2 + o) * 256 + c) * GLEN;
#pragma unroll
            for (int it = 0; it < (GLEN / 8 + 511) / 512; ++it) { const int i = tid_ + it * 512; if (i >= GLEN / 8) break; u32x4 x = *(const u32x4*)(Gg + i * 8);
                if (i < 5 || i >= 1027) { const int m0 = i * 8; unsigned* xp = (unsigned*)&x;
#pragma unroll
                    for (int k = 0; k < 4; ++k) { const int ma = m0 + 2 * k, mb = ma + 1; unsigned v = xp[k]; if (ma < 33 || ma > 8223) v &= 0xffff0000u; if (mb < 33 || mb > 8223) v &= 0x0000ffffu; xp[k] = v; } }
                *(LAS u32x4*)(L + HY16_G0 + i * 16) = x; }
            __syncthreads();
            const LAS unsigned* g0 = (const LAS unsigned*)(L + HY16_G0); LAS unsigned* g1 = (LAS unsigned*)(L + HY16_G1);
            for (int i = tid_; i <= GLEN / 2; i += 512) { const unsigned dp = i > 0 ? g0[i - 1] : 0u, d = i < GLEN / 2 ? g0[i] : 0u; g1[i] = (dp >> 16) | (d << 16); }
            __syncthreads();
        }
        f32x4 acc[4][2][2];
#pragma unroll
        for (int j = 0; j < 4; ++j)
#pragma unroll
            for (int ih = 0; ih < 2; ++ih)
#pragma unroll
                for (int nh = 0; nh < 2; ++nh) acc[j][ih][nh] = (f32x4){0.f, 0.f, 0.f, 0.f};
        bf16x8 A[4][2];
        const int e0 = 16 * w - 127;
#define HY_LOADA(slot, delta) do { const LAS unsigned char* _p = L + abase - 64 * (delta); A[slot][0] = lds_rd8_a4(_p); A[slot][1] = lds_rd8_a4(_p - 32); } while (0)
#define HY_LOADF(d0, d1, e) do { const int qx0 = qsb0 + 16 - (e), qx1 = qsb1 + 16 - (e); \
            d0 = *(const LAS bf16x8*)(L + ubase + (32 * qx0 + 16 * (qx0 >> 2)) * 2); d1 = *(const LAS bf16x8*)(L + ubase + (32 * qx1 + 16 * (qx1 >> 2)) * 2); } while (0)
        HY_LOADA(0, e0); HY_LOADA(1, e0 + 1); HY_LOADA(2, e0 + 2); HY_LOADA(3, e0 + 3);
        bf16x8 fa0, fa1, fb0, fb1;
        HY_LOADF(fa0, fa1, e0);
#define HY_MM(j, sl, FC0, FC1) do { acc[j][0][0] = mfma16(A[sl][0], FC0, acc[j][0][0]); acc[j][0][1] = mfma16(A[sl][0], FC1, acc[j][0][1]); \
            acc[j][1][0] = mfma16(A[sl][1], FC0, acc[j][1][0]); acc[j][1][1] = mfma16(A[sl][1], FC1, acc[j][1][1]); } while (0)
#define HY_STEP(g, FC0, FC1, FN0, FN1) do { const int e = eb + (g); \
            HY_LOADF(FN0, FN1, e + 1); \
            HY_MM(0, (g) & 3, FC0, FC1); \
            __builtin_amdgcn_sched_barrier(0); \
            HY_LOADA((g) & 3, e + 4); \
            HY_MM(1, ((g) + 1) & 3, FC0, FC1); HY_MM(2, ((g) + 2) & 3, FC0, FC1); HY_MM(3, ((g) + 3) & 3, FC0, FC1); \
            __builtin_amdgcn_sched_barrier(0); } while (0)
        asm volatile(".p2align 8");
#pragma unroll 1
        for (int eb = e0; eb < e0 + 140; eb += 4) { HY_STEP(0, fa0, fa1, fb0, fb1); HY_STEP(1, fb0, fb1, fa0, fa1); HY_STEP(2, fa0, fa1, fb0, fb1); HY_STEP(3, fb0, fb1, fa0, fa1); }
#undef HY_LOADF
#undef HY_STEP
#undef HY_MM
#undef HY_LOADA
        __syncthreads();
        const float inv = o == 0 ? inv_o[0] : inv_o[1];
        const float hb = a->in[I_HBIAS][(size_t)(layer * 2 + o) * 256 + c];
        const int gcol = o == 0 ? c : 256 + c; const bf16* grow = hyT + (size_t)gcol * NTOK + nb * 4096;
        const float w0 = sw[gcol], w1 = sw[768 + gcol], w2 = sw[1536 + gcol], bb = sb[gcol];
        bf16* yrow = (bf16*)(F.ws + WS_YT) + (size_t)c * NTOK + nb * 4096;
        u32x2 gx[16]; float gm[16], gp[16];
#pragma unroll
        for (int j = 0; j < 4; ++j)
#pragma unroll
            for (int nh = 0; nh < 2; ++nh) { const int q = 16 * w + 4 * (2 * nh + qh) + j;
#pragma unroll
                for (int ih = 0; ih < 2; ++ih) { const int t = 32 * q + 16 * ih + 4 * lg, ix = (j * 2 + nh) * 2 + ih; const bf16* p = grow + t;
                    gx[ix] = *(const u32x2*)p; gm[ix] = t > 0 ? bf2f(p[-1]) : 0.f; gp[ix] = t + 4 < 4096 ? bf2f(p[4]) : 0.f; } }
#pragma unroll
        for (int j = 0; j < 4; ++j)
#pragma unroll
            for (int nh = 0; nh < 2; ++nh) { const int q = 16 * w + 4 * (2 * nh + qh) + j;
#pragma unroll
                for (int ih = 0; ih < 2; ++ih) { const int t = 32 * q + 16 * ih + 4 * lg, ix = (j * 2 + nh) * 2 + ih; const u32x2 x = gx[ix];
                    float v[6]; v[0] = gm[ix]; v[5] = gp[ix]; v[1] = lo_bf(x.x); v[2] = hi_bf(x.x); v[3] = lo_bf(x.y); v[4] = hi_bf(x.y);
                    LAS bf16* up = U + nb * HY16_UROW + hy16_uoff(t); const u32x2 uu = *(const LAS u32x2*)up;
                    const float u0 = lo_bf(uu.x), u1 = hi_bf(uu.x), u2 = lo_bf(uu.y), u3 = hi_bf(uu.y); const f32x4 ac = acc[j][ih][nh];
                    const float y0 = (w0 * v[0] + w1 * v[1] + w2 * v[2] + bb) * (ac[0] * inv + hb * u0);
                    const float y1 = (w0 * v[1] + w1 * v[2] + w2 * v[3] + bb) * (ac[1] * inv + hb * u1);
                    const float y2 = (w0 * v[2] + w1 * v[3] + w2 * v[4] + bb) * (ac[2] * inv + hb * u2);
                    const float y3 = (w0 * v[3] + w1 * v[4] + w2 * v[5] + bb) * (ac[3] * inv + hb * u3);
                    u32x2 wv; wv.x = pk2(y0, y1); wv.y = pk2(y2, y3);
                    if (o == 0) *(LAS u32x2*)up = wv; else *(u32x2*)(yrow + t) = wv; } }
        __syncthreads();
    }
}

__device__ __forceinline__ void hyena_ctx_unit(const Frame& F_, KArgs a, int c) {
    Frame F = F_; { int t_ = F_.tid; asm volatile("" : "+v"(t_)); F.tid = t_; F.lane = t_ & 63; }
    LAS float* u = (LAS float*)F.lds;
    LAS float* y1 = u + 2048;
    LAS float* T = y1 + 2048;
    bf16* hyT = (bf16*)(F.ws + WS_HYT);
    const float* sw = a->in[I_HSW]; const float* sb = a->in[I_HSB];
    __syncthreads();
#pragma unroll
    for (int it = 0; it < 2; ++it) { const int i = F.tid + it * 512; T[i] = ((const float*)(F.ws + WS_TC))[((size_t)(i >> 9) * 256 + c) * 512 + (i & 511)]; }
    if (F.tid < 2) T[F.tid * 512] = 0.f;
    {
        const bf16* vrow = hyT + (size_t)(512 + c) * NTOK + NLAT; const float w0 = sw[512 + c], w1 = sw[768 + 512 + c], w2 = sw[1536 + 512 + c], bb = sb[512 + c];
#pragma unroll
        for (int it = 0; it < 4; ++it) { const int i = F.tid + it * 512; const int t = i & 255; const float vm = t > 0 ? bf2f(vrow[i - 1]) : 0.f, v0 = bf2f(vrow[i]), vp = t < 255 ? bf2f(vrow[i + 1]) : 0.f; u[i] = w0 * vm + w1 * v0 + w2 * vp + bb; }
    }
    __syncthreads();
#pragma unroll 1
    for (int o = 0; o < 2; ++o) {
        const LAS float* in = o == 0 ? u : y1; const float inv = filt_inv_norm(F, 2, 8, o, c); const float hb = a->in[I_HBIAS][(size_t)o * 256 + c];
        const int gcol = o == 0 ? c : 256 + c; const bf16* grow = hyT + (size_t)gcol * NTOK + NLAT; const float w0g = sw[gcol], w1g = sw[768 + gcol], w2g = sw[1536 + gcol], bbg = sb[gcol];
        {
            const int q = F.wave, lc = F.lane & 15, lg = F.lane >> 4, nb = lc & 7; const LAS float* Tp = T + o * 512 + 256; const LAS float* ip = in + nb * 256 + 8 * lg;
            f32x4 acc[2] = {(f32x4){0.f, 0.f, 0.f, 0.f}, (f32x4){0.f, 0.f, 0.f, 0.f}};
#pragma unroll 2
            for (int ub = 0; ub < 8; ++ub) {
                const f32x4 xa = *(const LAS f32x4*)(ip + 32 * ub), xb = *(const LAS f32x4*)(ip + 32 * ub + 4);
                const bf16x8 bf = pack8(xa[0], xa[1], xa[2], xa[3], xb[0], xb[1], xb[2], xb[3]);
#pragma unroll
                for (int ih = 0; ih < 2; ++ih) { const LAS float* tp = Tp + 32 * (q - ub) + 16 * ih + lc - 8 * lg;
                    const bf16x8 af = pack8(tp[0], tp[-1], tp[-2], tp[-3], tp[-4], tp[-5], tp[-6], tp[-7]);
                    acc[ih] = mfma16(af, bf, acc[ih]); }
            }
            if (lc < 8) {
#pragma unroll
                for (int ih = 0; ih < 2; ++ih)
#pragma unroll
                    for (int r = 0; r < 4; ++r) { const int t = 32 * q + 16 * ih + 4 * lg + r, i = nb * 256 + t;
                        const float gm = t > 0 ? bf2f(grow[i - 1]) : 0.f, g0 = bf2f(grow[i]), gp = t < 255 ? bf2f(grow[i + 1]) : 0.f;
                        const float y = (w0g * gm + w1g * g0 + w2g * gp + bbg) * (acc[ih][r] * inv + hb * in[i]);
                        if (o == 0) y1[i] = y; else ((bf16*)(F.ws + WS_YT))[(size_t)c * NTOK + NLAT + i] = (bf16)f2bf(y); }
            }
        }
        __syncthreads();
    }
}

__device__ __forceinline__ void p5_unit(const Frame& F_, KArgs a, int layer, int r0) {
    Frame F = F_; { int t_ = F_.tid; asm volatile("" : "+v"(t_)); F.tid = t_; F.lane = t_ & 63; }
    LAS bf16* T = (LAS bf16*)F.lds;
    const bf16* yT = (const bf16*)(F.ws + WS_YT); const bf16* yat = (const bf16*)(F.ws + WS_YAT); bf16* Y = (bf16*)(F.ws + WS_H);
    const float* mg = a->in[I_MIXG] + layer * 1024;
    u32x4 t0, t1; u32x2 xa[4];
    { const int c = F.tid >> 2, q = F.tid & 3; t0 = *(const u32x4*)(yT + (size_t)c * NTOK + r0 + q * 8); t1 = *(const u32x4*)(yT + (size_t)(c + 128) * NTOK + r0 + q * 8); }
#pragma unroll
    for (int i = 0; i < 4; ++i) xa[i] = *(const u32x2*)(yat + (size_t)(r0 + F.wave + 8 * i) * 256 + 4 * F.lane);
    __syncthreads();
    { const int c = F.tid >> 2, q = F.tid & 3; *(LAS u32x4*)(T + c * 40 + q * 8) = t0; *(LAS u32x4*)(T + (c + 128) * 40 + q * 8) = t1; }
    __syncthreads();
    const f32x4 mh = *(const f32x4*)(mg + 4 * F.lane), ma = *(const f32x4*)(mg + 768 + 4 * F.lane);
    f32x4 vh[4], va[4]; float sh[4], sa[4];
#pragma unroll
    for (int i = 0; i < 4; ++i) { const int r = F.wave + 8 * i;
        vh[i].x = bf2f(T[(4 * F.lane) * 40 + r]); vh[i].y = bf2f(T[(4 * F.lane + 1) * 40 + r]); vh[i].z = bf2f(T[(4 * F.lane + 2) * 40 + r]); vh[i].w = bf2f(T[(4 * F.lane + 3) * 40 + r]);
        va[i].x = lo_bf(xa[i].x); va[i].y = hi_bf(xa[i].x); va[i].z = lo_bf(xa[i].y); va[i].w = hi_bf(xa[i].y);
        sh[i] = (vh[i].x * vh[i].x + vh[i].y * vh[i].y) + (vh[i].z * vh[i].z + vh[i].w * vh[i].w); sa[i] = (va[i].x * va[i].x + va[i].y * va[i].y) + (va[i].z * va[i].z + va[i].w * va[i].w); }
#pragma unroll
    for (int o = 1; o < 64; o <<= 1) {
#pragma unroll
        for (int i = 0; i < 4; ++i) { sh[i] = xsum_step(sh[i], o); sa[i] = xsum_step(sa[i], o); } }
#pragma unroll
    for (int i = 0; i < 4; ++i) { const int r = F.wave + 8 * i;
        const float rh = frsq(sh[i] * (1.f / 256.f) + EPS), ra = frsq(sa[i] * (1.f / 256.f) + EPS);
        const f32x4 yh = vh[i] * rh * mh, ya = va[i] * ra * ma; u32x2 w; bf16* yr = Y + (size_t)(r0 + r) * 1024 + 4 * F.lane;
        w.x = pk2(yh.x, yh.y); w.y = pk2(yh.z, yh.w); *(u32x2*)yr = w; w.x = pk2(ya.x, ya.y); w.y = pk2(ya.z, ya.w); *(u32x2*)(yr + 768) = w; }
}
#if MK_AT16
#define ATTN_UNIT attn_unit16
#else
#define ATTN_UNIT attn_unit
#endif
#ifndef MK_HY16
#define MK_HY16 1
#endif
#if MK_HY16
#define HYENA_UNIT hyena_unit16
#else
#define HYENA_UNIT hyena_unit
#endif
#ifndef MK_XBAR
#define MK_XBAR 0
#endif
#ifndef MK_HALF
#define MK_HALF 0u
#endif
#ifndef MK_DUP
#define MK_DUP 0u
#endif
#define DUPN(k) (((MK_DUP >> (k)) & 1u) ? 2 : 1)
#ifndef MK_PHASES
#define MK_PHASES 0xFFFFFu
#endif
template <int LAYER>
__device__ __forceinline__ void layer_phases(Frame F, const XcdBarrier& bar, int lo, int hi) {
    constexpr int PB = 1 + 9 * LAYER;
    const Frame F0 = F;
#define HALF(k) do { F = F0; relaunder(F); act = true; if ((MK_HALF >> (k)) & 1u) { F.G = F0.G / 2; F.NGW = F.G * 8; act = F.vcu < F.G; } } while (0)
    bool act = true;
    unsigned char* ws = F.ws;
    const float* modl = (const float*)(ws + WS_MOD) + (size_t)LAYER * 9 * 6144;
    bf16* xb = (bf16*)(ws + WS_XB);
#define IN(k) (((MK_PHASES >> (k)) & 1u) && lo <= (k) && (k) < hi)
#define SEAM(k) do { if (IN(k) && IN((k) + 1)) xcd_barrier(bar); } while (0)
#define BODY_P1 { if (LAYER == 0) p1_norm(F, kargs(), 0, kargs()->in[I_X], kargs()->in[I_CTX]); else p1_norm_moe(F, kargs(), xb); }
    HALF(0);
    if (act && IN(PB + 0)) { BODY_P1 if (DUPN(0) == 2) BODY_P1 }
    SEAM(PB + 0);
#define BODY_P2 { OpIn op{(const bf16*)(ws + WS_H), (const bf16*)(ws + WS_WIN) + (size_t)LAYER * NIN_PAD * 1024, (bf16*)(ws + WS_PROJ), (bf16*)(ws + WS_HYT), LAYER, F.G, F.vcu}; \
        pg8::gemm_phase<OpIn, true>(F.lds, op, 1024); }
    HALF(1);
    if (act && IN(PB + 1)) { BODY_P2 if (DUPN(1) == 2) BODY_P2
        if (LAYER == 0) { constexpr int TOT = 136 * 9; if ((TOT - 1 - F.vcu) / F.G + 1 < (TOT + F.G - 1) / F.G || F.vcu >= TOT) drain_deferred(F, kargs(), 5); } }
    SEAM(PB + 1);
    HALF(2);
    if (act && IN(PB + 2)) for (int rep = 0; rep < DUPN(2); ++rep) {
        constexpr int NGM = LAYER == 0 ? NTOK / 128 : NLAT / 128, NCV = LAYER == 0 ? NTOK / 64 : NLAT / 64, NML = 0;
        for (int r3 = 0; r3 < DUPN(24); ++r3) p3_mla_stream<LAYER>(F, kargs());
        {
            volatile LAS int* slot = (volatile LAS int*)(F.lds + LDS_MISC + 64);
            for (;;) {
                __syncthreads();
                if (F.tid == 0) *slot = (int)atomicAdd(F.ctl + CW_P3Q + LAYER * 16, 1u);
                __syncthreads();
                const int u = *slot;
                if (u >= NGM + NCV) break;
                if (u < NGM) { for (int r2 = 0; r2 < DUPN(22); ++r2) p3_gmlp_unit(F, kargs(), LAYER, u * 128); }
                else { for (int r2 = 0; r2 < DUPN(23); ++r2) p3_conv_unit(F, kargs(), LAYER, (u - NGM) * 64); }
            }
        }
    }
    SEAM(PB + 2);
    HALF(3);
    if (act && IN(PB + 3)) {
        constexpr int NU = LAYER == 0 ? 256 + 512 + 32 + 256 : 256 + 512;
        for (int u = F.vcu; u < NU; u += F.G) {
            if (u < 256) { for (int rep = 0; rep < DUPN(17); ++rep) HYENA_UNIT(F, kargs(), LAYER, u); }
            else if (u < 768) { const int id = u - 256; for (int rep = 0; rep < DUPN(16); ++rep) ATTN_UNIT(F, id >> 6, (id >> 4) & 3, (id >> 6) * 4096 + (id & 15) * 256, 0, NKEY / 64); }
            else if (u < 800) { const int id = u - 768; ATTN_UNIT(F, id >> 2, id & 3, NLAT + (id >> 2) * 256, 4096, 4); }
            else hyena_ctx_unit(F, kargs(), u - 800);
        }
    }
    SEAM(PB + 3);
    HALF(4);
    if (act && IN(PB + 4)) for (int rep = 0; rep < DUPN(4); ++rep) {
        constexpr int NU = (LAYER == 0 ? NTOK : NLAT) / 32;
        for (int u = F.vcu; u < NU; u += F.G) p5_unit(F, kargs(), LAYER, u * 32);
    }
    SEAM(PB + 4);
    HALF(5);
    if (act && IN(PB + 5)) {
        OpOut op{(const bf16*)(ws + WS_H), (const bf16*)(ws + WS_WOUT) + (size_t)LAYER * 1024 * 1024, kargs()->in[I_X], kargs()->in[I_CTX], xb, modl, LAYER, F.G, F.vcu, 1.f};
        pg8::gemm_phase<OpOut, true>(F.lds, op, 1024);
        if (LAYER == 0) { constexpr int TOT = 136 * 4; if ((TOT - 1 - F.vcu) / F.G + 1 < (TOT + F.G - 1) / F.G || F.vcu >= TOT) drain_deferred(F, kargs(), 5); }
    }
    SEAM(PB + 5);
    HALF(6);
    if (act && IN(PB + 6)) for (int rep = 0; rep < DUPN(6); ++rep) p7_router(F, kargs(), LAYER, xb, LAYER == 0 ? NTOK : NLAT, rep > 0);
    if (LAYER == 1 && IN(PB + 6)) drain_deferred(F, kargs(), 1 << 20);
    SEAM(PB + 6);
    LAS int* tab = (LAS int*)(F.lds + 131072 + 4096);
    HALF(7);
    if (IN(PB + 7) || IN(PB + 8)) {
        __syncthreads();
        if (F.tid < NBUCKET) tab[32 + F.tid] = (int)__hip_atomic_load(F.ctl + CW_CNT + LAYER * 32 + F.tid, __ATOMIC_RELAXED, __HIP_MEMORY_SCOPE_AGENT);
        __syncthreads();
        if (F.tid == 0) { int acc = 0; for (int k = 0; k < NBUCKET; ++k) { tab[k] = acc; acc += (tab[32 + k] + 255) >> 8; } tab[NBUCKET] = acc; }
        __syncthreads();
        moe_tile_map(tab, F.tid);
        __syncthreads();
    }
    HALF(7);
    if (act && IN(PB + 7)) {
        OpMoe12 op{(const char*)ws, (const bf16*)(ws + WS_W1), (const bf16*)(ws + WS_W2), (bf16*)(ws + WS_PROJ), (bf16*)(ws + WS_YM), (const int*)(ws + WS_TOK), (const float*)(ws + WS_WLO), (const float*)(ws + WS_WHI), tab,
                   (unsigned*)(F.ctl + CW_RDY + LAYER * 4096), (unsigned*)(F.ctl + CW_TMO), LAYER, F.G, F.vcu};
        pg8::gemm_phase<OpMoe12, true>(F.lds, op, 1024);
        if (LAYER == 0) { const int TOT = tab[NBUCKET] * 12; if (F.vcu >= TOT || (TOT - 1 - F.vcu) / F.G + 1 < (TOT + F.G - 1) / F.G) drain_deferred(F, kargs(), 5); }
    }
    SEAM(PB + 8);
#undef IN
#undef SEAM
}

constexpr int N_PHASES = 20;
__global__ void __launch_bounds__(512, 2) mk_fwd(Args a_) {
    extern __shared__ __attribute__((aligned(16))) unsigned char lds_raw[];
#ifdef MK_PAD
    asm volatile(".rept %0\n\ts_nop 0\n\t.endr" :: "i"(MK_PAD));
#endif
    Frame F;
    F.lds = (LAS unsigned char*)lds_raw; F.ws = a_.ws; F.ctl = (unsigned*)(a_.ws + WS_CTL);
    F.tid = threadIdx.x; F.lane = F.tid & 63; F.wave = __builtin_amdgcn_readfirstlane(F.tid >> 6);
    F.G = gridDim.x; { const int bx = blockIdx.x; F.vcu = (F.G % 8 == 0) ? (bx % 8) * (F.G / 8) + bx / 8 : bx; }
    F.gw = F.vcu * 8 + F.wave; F.NGW = F.G * 8;
    volatile LAS unsigned* misc = (volatile LAS unsigned*)(F.lds + LDS_MISC);
    if (F.tid < 64) misc[F.tid] = 0u;
    __syncthreads();
    const int lo = a_.ph_lo, hi = a_.ph_hi;
    XcdBarrier bar; bar.bar = F.ctl + CW_BAR; bar.x = 0; bar.st = misc;
    if (hi - lo > 1) bar = xcd_barrier_post(F.ctl + CW_BAR, misc);
    if ((MK_PHASES & 1u) && lo <= 0 && 0 < hi) { if (!((MK_HALF >> 10) & 1u) || F.vcu < F.G / 2) p0_all(F, kargs());
        if ((MK_DUP >> 20) & 1u) { xcd_barrier(bar); p0_all(F, kargs(), 16); }
        if (hi > 1) xcd_barrier(bar); }
    layer_phases<0>(F, bar, lo, hi);
    layer_phases<1>(F, bar, lo, hi);
    relaunder(F);
    bool actf = true; if ((MK_HALF >> 9) & 1u) { F.G /= 2; F.NGW = F.G * 8; actf = F.vcu < F.G; }
    if (actf && ((MK_PHASES >> 19) & 1u) && lo <= 19 && 19 < hi) p_final(F, kargs());
#if MK_XBAR
    for (int i = 0; i < MK_XBAR; ++i) xcd_barrier(bar);
#endif
}

#ifndef MK_SPLIT
#define MK_SPLIT 0
#endif
extern "C" void kernel_launch(void* const* d_in, const int* in_sizes, int n_in, void* d_out, int out_size, void* d_ws, size_t ws_size, hipStream_t stream) {
    static int grid = 0;
    if (grid == 0) {
        if (n_in != 38 || out_size != NLAT * 1024 || ws_size < WS_END) { fprintf(stderr, "kernel_launch: unexpected shapes (n_in %d out %d ws %zu, need %zu)\n", n_in, out_size, ws_size, (size_t)WS_END); grid = -1; return; }
        int dev = 0, cus = 0, per_cu = 0;
        hipGetDevice(&dev); hipDeviceGetAttribute(&cus, hipDeviceAttributeMultiprocessorCount, dev);
        if (hipFuncSetAttribute((const void*)mk_fwd, hipFuncAttributeMaxDynamicSharedMemorySize, LDS_BYTES) != hipSuccess) { fprintf(stderr, "kernel_launch: hipFuncSetAttribute failed\n"); grid = -1; return; }
        if (hipOccupancyMaxActiveBlocksPerMultiprocessor(&per_cu, (const void*)mk_fwd, 512, LDS_BYTES) != hipSuccess || per_cu < 1) { fprintf(stderr, "kernel_launch: occupancy query says %d\n", per_cu); }
        (void)hipGetLastError();
        grid = cus;
    }
    if (grid < 0) return;
    hipMemsetAsync((char*)d_ws + WS_CTL, 0, CTL_BYTES, stream);
    Args a{};
    for (int i = 0; i < 38; ++i) a.in[i] = (const float*)d_in[i];
    a.out = (float*)d_out; a.ws = (unsigned char*)d_ws;
#if MK_SPLIT
    for (int p = 0; p < N_PHASES; ++p) { a.ph_lo = p; a.ph_hi = p + 1; hipLaunchKernelGGL(mk_fwd, dim3(grid), dim3(512), LDS_BYTES, stream, a); }
#else
    a.ph_lo = 0; a.ph_hi = N_PHASES; hipLaunchKernelGGL(mk_fwd, dim3(grid), dim3(512), LDS_BYTES, stream, a);
#endif
}
```
